# Optimizing an MI355X kernel written in HIP

```python
import math
import jax, jax.numpy as jnp
from jax import lax
import numpy as np

D_MODEL = 1024
BATCH = 8
SEQ = 4096
DEPTH = 4

CTX_LEN = 256
GRID_W = 64

N_HEADS = 8
QK_NOPE_DIM = 128
QK_ROPE_DIM = 64
V_HEAD_DIM = 128
Q_LORA_RANK = 256
KV_LORA_RANK = 256
ROPE_BASE = 10000.0
Q_BLOCK = 128
MLA_SCALE = (QK_NOPE_DIM + QK_ROPE_DIM) ** -0.5
MLA_WIDTH = N_HEADS * V_HEAD_DIM

S5_WIDTH = 1024
S5_GROUP = 16
S5_GROUPS = S5_WIDTH // S5_GROUP
S5_STATE = 64
DT_MIN = 1e-3
DT_MAX = 1e-1

D_FF = 2816
FFN_RESIDUAL_WEIGHT = 0.5
N_ADA = 9
EPS = 1e-6

IN_SPLITS = (Q_LORA_RANK, KV_LORA_RANK, QK_ROPE_DIM, S5_WIDTH, D_MODEL)
IN_COLS = Q_LORA_RANK + KV_LORA_RANK + QK_ROPE_DIM + S5_WIDTH + 2 * D_MODEL

kernel_name = "hybrid_mla_s5_macaron_dit"


def rmsnorm(x, g):
    xf = x.astype(jnp.float32)
    y = xf * lax.rsqrt(jnp.mean(xf * xf, axis=-1, keepdims=True) + EPS)
    return (y * g.astype(jnp.float32)).astype(x.dtype)


def sublayer_in(h, g_pre, mod, s):
    return rmsnorm(h, g_pre) * (1 + mod[:, 3 * s + 1]) + mod[:, 3 * s]


def sublayer_out(h, y, g_post, mod, s, weight):
    return h + weight * mod[:, 3 * s + 2] * rmsnorm(y, g_post)


def swiglu(h, w_gate, w_up, w_down):
    return (jax.nn.silu(h @ w_gate) * (h @ w_up)) @ w_down


def axial_rope_tables(n_tokens):
    rows = n_tokens // GRID_W
    row = jnp.repeat(jnp.arange(rows, dtype=jnp.float32), GRID_W)
    col = jnp.tile(jnp.arange(GRID_W, dtype=jnp.float32), rows)
    n_freq = QK_ROPE_DIM // 4
    inv_freq = ROPE_BASE ** (-jnp.arange(n_freq, dtype=jnp.float32) / n_freq)
    ang_r = row[:, None] * inv_freq
    ang_c = col[:, None] * inv_freq
    ang = jnp.concatenate([ang_r, ang_r, ang_c, ang_c], axis=-1)
    return jnp.cos(ang), jnp.sin(ang)


def rotate_blocks(x):
    xb = x.reshape(x.shape[:-1] + (2, 2, QK_ROPE_DIM // 4))
    rot = jnp.stack([-xb[..., 1, :], xb[..., 0, :]], axis=-2)
    return rot.reshape(x.shape)


def apply_rope(x, cos, sin):
    return x * cos + rotate_blocks(x) * sin


def split_in_proj(z):
    idx = np.cumsum(IN_SPLITS).tolist()
    return jnp.split(z, idx, axis=-1)


def mla_queries(c_q, q_norm, w_uq):
    B, L = c_q.shape[:2]
    q = (rmsnorm(c_q, q_norm) @ w_uq).reshape(B, L, N_HEADS, QK_NOPE_DIM + QK_ROPE_DIM)
    return q[..., :QK_NOPE_DIM], q[..., QK_NOPE_DIM:]


def mla_keys_values(c_kv, kv_norm, w_ukv):
    B, L = c_kv.shape[:2]
    kv = (rmsnorm(c_kv, kv_norm) @ w_ukv).reshape(B, L, N_HEADS, QK_NOPE_DIM + V_HEAD_DIM)
    return kv[..., :QK_NOPE_DIM], kv[..., QK_NOPE_DIM:]


def mla_attend(q_n, q_r, k_n, k_r, v):
    s = jnp.einsum('bqhd,bkhd->bhqk', q_n, k_n) + jnp.einsum('bqhr,bkr->bhqk', q_r, k_r)
    p = jax.nn.softmax(s.astype(jnp.float32) * MLA_SCALE, axis=-1).astype(v.dtype)
    return jnp.einsum('bhqk,bkhd->bqhd', p, v)


def s5_discretise(a_re, a_im, log_dt, b_re, b_im):
    a = lax.complex(a_re.astype(jnp.float32), a_im.astype(jnp.float32))
    dt = jnp.exp(log_dt.astype(jnp.float32))[:, None]
    a_bar = jnp.exp(a * dt)
    b = lax.complex(b_re.astype(jnp.float32), b_im.astype(jnp.float32))
    b_bar = ((a_bar - 1.0) / a)[..., None] * b
    return a_bar, b_bar


def ssm_combine(e1, e2):
    a1, b1 = e1
    a2, b2 = e2
    return a1 * a2, a2 * b1 + b2


def s5_scan(u, a_bar, b_bar, reverse, init):
    L = u.shape[1]
    bu = jnp.einsum('blgc,gnc->blgn', u.astype(jnp.float32).astype(jnp.complex64), b_bar)
    if init is not None:
        first = L - 1 if reverse else 0
        bu = bu.at[:, first].add(a_bar * init)
    a = jnp.broadcast_to(a_bar, (1, L) + a_bar.shape)
    _, xs = lax.associative_scan(ssm_combine, (a, bu), reverse=reverse, axis=1)
    return xs


def s5_readout(xs, c_mat):
    return jnp.einsum('blgn,gcn->blgc', xs, c_mat).real


def s5_bidirectional(u_x, u_c, a_re, a_im, log_dt, b_re, b_im, c_re, c_im, d_skip, need_ctx_out):
    B, L, _ = u_x.shape
    Lc = u_c.shape[1]
    ux = u_x.reshape(B, L, S5_GROUPS, S5_GROUP)
    uc = u_c.reshape(B, Lc, S5_GROUPS, S5_GROUP)
    d32 = d_skip.astype(jnp.float32)
    y_x = d32 * u_x.astype(jnp.float32)
    y_c = d32 * u_c.astype(jnp.float32) if need_ctx_out else None
    for direction in range(2):
        reverse = direction == 1
        a_bar, b_bar = s5_discretise(a_re[direction], a_im[direction], log_dt[direction],
                                     b_re[direction], b_im[direction])
        c_mat = lax.complex(c_re[direction].astype(jnp.float32), c_im[direction].astype(jnp.float32))
        xs_c = s5_scan(uc, a_bar, b_bar, reverse, None)
        s_ctx = xs_c[:, 0] if reverse else xs_c[:, -1]
        xs_x = s5_scan(ux, a_bar, b_bar, reverse, s_ctx)
        y_x = y_x + s5_readout(xs_x, c_mat).reshape(B, L, S5_WIDTH)
        if need_ctx_out:
            y_c = y_c + s5_readout(xs_c, c_mat).reshape(B, Lc, S5_WIDTH)
    y_x = y_x.astype(u_x.dtype)
    if need_ctx_out:
        y_c = y_c.astype(u_c.dtype)
    return y_x, y_c


def s5_glu(y, glu_w, glu_b):
    z = jax.nn.gelu(y)
    return z * jax.nn.sigmoid(z @ glu_w + glu_b)


def token_mixer(h_x, h_c, cos, sin, need_ctx_out, w_in, q_norm, w_uq, kv_norm, w_ukv, w_o_mla,
                a_re, a_im, log_dt, b_re, b_im, c_re, c_im, d_skip, glu_w, glu_b, w_o_s5, w_out):
    B, L, _ = h_x.shape
    Lc = h_c.shape[1]
    cq_x, ckv_x, kr_x, u_x, gm_x, gs_x = split_in_proj(h_x @ w_in)
    cq_c, ckv_c, kr_c, u_c, gm_c, gs_c = split_in_proj(h_c @ w_in)

    qn_x, qr_x = mla_queries(cq_x, q_norm, w_uq)
    qr_x = apply_rope(qr_x, cos[:, None, :], sin[:, None, :])
    kr_x = apply_rope(kr_x, cos, sin)
    kn_x, v_x = mla_keys_values(ckv_x, kv_norm, w_ukv)
    kn_c, v_c = mla_keys_values(ckv_c, kv_norm, w_ukv)
    kn_all = jnp.concatenate([kn_x, kn_c], axis=1)
    kr_all = jnp.concatenate([kr_x, kr_c], axis=1)
    v_all = jnp.concatenate([v_x, v_c], axis=1)
    nb = L // Q_BLOCK

    def to_blocks(t):
        return jnp.moveaxis(t.reshape((B, nb, Q_BLOCK) + t.shape[2:]), 1, 0)

    o_x = lax.map(lambda qb: mla_attend(qb[0], qb[1], kn_all, kr_all, v_all),
                  (to_blocks(qn_x), to_blocks(qr_x)))
    o_x = jnp.moveaxis(o_x, 0, 1).reshape(B, L, MLA_WIDTH)
    y_mla_x = o_x @ w_o_mla

    s_x, s_c = s5_bidirectional(u_x, u_c, a_re, a_im, log_dt, b_re, b_im, c_re, c_im, d_skip, need_ctx_out)
    y_s5_x = s5_glu(s_x, glu_w, glu_b) @ w_o_s5

    y_x = (jax.nn.sigmoid(gm_x) * y_mla_x + jax.nn.sigmoid(gs_x) * y_s5_x) @ w_out
    if not need_ctx_out:
        return y_x, None
    qn_c, qr_c = mla_queries(cq_c, q_norm, w_uq)
    o_c = mla_attend(qn_c, qr_c, kn_c, kr_c, v_c).reshape(B, Lc, MLA_WIDTH)
    y_mla_c = o_c @ w_o_mla
    y_s5_c = s5_glu(s_c, glu_w, glu_b) @ w_o_s5
    y_c = (jax.nn.sigmoid(gm_c) * y_mla_c + jax.nn.sigmoid(gs_c) * y_s5_c) @ w_out
    return y_x, y_c


def setup_inputs(seed: int = 0) -> dict:
    key = jax.random.key(seed)
    ks = jax.random.split(key, 32)
    f32 = jnp.float32

    def nrm(k, shape, scale):
        return jax.random.normal(k, shape, f32) * scale

    def gain(k, shape):
        return 1.0 + 0.05 * jax.random.normal(k, shape, f32)

    ssm_shape = (DEPTH, 2, S5_GROUPS, S5_STATE)
    n_idx = jnp.arange(S5_STATE, dtype=f32)
    a_re = -0.5 + 0.01 * jax.random.normal(ks[14], ssm_shape, f32)
    a_im = jnp.pi * n_idx + 0.01 * jax.random.normal(ks[15], ssm_shape, f32)
    return {
        'x': nrm(ks[0], (BATCH, SEQ, D_MODEL), 1.0),
        'c': nrm(ks[1], (BATCH, D_MODEL), 1.0),
        'ctx': nrm(ks[2], (BATCH, CTX_LEN, D_MODEL), 1.0),
        'c_ctx': nrm(ks[3], (D_MODEL,), 1.0),
        'ada_w': nrm(ks[4], (DEPTH, D_MODEL, N_ADA * D_MODEL), 0.02),
        'ada_b': nrm(ks[5], (DEPTH, N_ADA * D_MODEL), 0.01),
        'norm_pre': gain(ks[6], (DEPTH, 3, D_MODEL)),
        'norm_post': gain(ks[7], (DEPTH, 3, D_MODEL)),
        'ffn_w_gate': nrm(ks[8], (DEPTH, 2, D_MODEL, D_FF), D_MODEL ** -0.5),
        'ffn_w_up': nrm(ks[9], (DEPTH, 2, D_MODEL, D_FF), D_MODEL ** -0.5),
        'ffn_w_down': nrm(ks[10], (DEPTH, 2, D_FF, D_MODEL), D_FF ** -0.5),
        'w_in': nrm(ks[11], (DEPTH, D_MODEL, IN_COLS), D_MODEL ** -0.5),
        'q_norm': gain(ks[12], (DEPTH, Q_LORA_RANK)),
        'w_uq': nrm(ks[13], (DEPTH, Q_LORA_RANK, N_HEADS * (QK_NOPE_DIM + QK_ROPE_DIM)), Q_LORA_RANK ** -0.5),
        'kv_norm': gain(ks[16], (DEPTH, KV_LORA_RANK)),
        'w_ukv': nrm(ks[17], (DEPTH, KV_LORA_RANK, N_HEADS * (QK_NOPE_DIM + V_HEAD_DIM)), KV_LORA_RANK ** -0.5),
        'w_o_mla': nrm(ks[18], (DEPTH, MLA_WIDTH, D_MODEL), MLA_WIDTH ** -0.5),
        's5_a_re': a_re,
        's5_a_im': a_im,
        's5_log_dt': jax.random.uniform(ks[19], (DEPTH, 2, S5_GROUPS), f32,
                                        minval=math.log(DT_MIN), maxval=math.log(DT_MAX)),
        's5_b_re': nrm(ks[20], (DEPTH, 2, S5_GROUPS, S5_STATE, S5_GROUP), (2 * S5_GROUP) ** -0.5),
        's5_b_im': nrm(ks[21], (DEPTH, 2, S5_GROUPS, S5_STATE, S5_GROUP), (2 * S5_GROUP) ** -0.5),
        's5_c_re': nrm(ks[22], (DEPTH, 2, S5_GROUPS, S5_GROUP, S5_STATE), S5_STATE ** -0.5),
        's5_c_im': nrm(ks[23], (DEPTH, 2, S5_GROUPS, S5_GROUP, S5_STATE), S5_STATE ** -0.5),
        's5_d': nrm(ks[24], (DEPTH, S5_WIDTH), 1.0),
        'glu_w': nrm(ks[25], (DEPTH, S5_WIDTH, S5_WIDTH), S5_WIDTH ** -0.5),
        'glu_b': nrm(ks[26], (DEPTH, S5_WIDTH), 0.01),
        'w_o_s5': nrm(ks[27], (DEPTH, S5_WIDTH, D_MODEL), S5_WIDTH ** -0.5),
        'w_out': nrm(ks[28], (DEPTH, D_MODEL, D_MODEL), D_MODEL ** -0.5),
    }


def reference(x, c, ctx, c_ctx, ada_w, ada_b, norm_pre, norm_post, ffn_w_gate, ffn_w_up, ffn_w_down,
              w_in, q_norm, w_uq, kv_norm, w_ukv, w_o_mla, s5_a_re, s5_a_im, s5_log_dt,
              s5_b_re, s5_b_im, s5_c_re, s5_c_im, s5_d, glu_w, glu_b, w_o_s5, w_out):
    B, L, _ = x.shape
    cos, sin = axial_rope_tables(L)
    cos = cos.astype(x.dtype)
    sin = sin.astype(x.dtype)
    silu_c = jax.nn.silu(c)
    silu_cc = jax.nn.silu(c_ctx)
    for l in range(DEPTH):
        last = l == DEPTH - 1
        mod_x = (silu_c @ ada_w[l] + ada_b[l]).reshape(B, N_ADA, 1, D_MODEL)
        mod_c = (silu_cc @ ada_w[l] + ada_b[l]).reshape(1, N_ADA, 1, D_MODEL)

        y = swiglu(sublayer_in(x, norm_pre[l, 0], mod_x, 0), ffn_w_gate[l, 0], ffn_w_up[l, 0], ffn_w_down[l, 0])
        x = sublayer_out(x, y, norm_post[l, 0], mod_x, 0, FFN_RESIDUAL_WEIGHT)
        y = swiglu(sublayer_in(ctx, norm_pre[l, 0], mod_c, 0), ffn_w_gate[l, 0], ffn_w_up[l, 0], ffn_w_down[l, 0])
        ctx = sublayer_out(ctx, y, norm_post[l, 0], mod_c, 0, FFN_RESIDUAL_WEIGHT)

        y_x, y_c = token_mixer(
            sublayer_in(x, norm_pre[l, 1], mod_x, 1), sublayer_in(ctx, norm_pre[l, 1], mod_c, 1),
            cos, sin, not last, w_in[l], q_norm[l], w_uq[l], kv_norm[l], w_ukv[l], w_o_mla[l],
            s5_a_re[l], s5_a_im[l], s5_log_dt[l], s5_b_re[l], s5_b_im[l], s5_c_re[l], s5_c_im[l],
            s5_d[l], glu_w[l], glu_b[l], w_o_s5[l], w_out[l])
        x = sublayer_out(x, y_x, norm_post[l, 1], mod_x, 1, 1.0)

        y = swiglu(sublayer_in(x, norm_pre[l, 2], mod_x, 2), ffn_w_gate[l, 1], ffn_w_up[l, 1], ffn_w_down[l, 1])
        x = sublayer_out(x, y, norm_post[l, 2], mod_x, 2, FFN_RESIDUAL_WEIGHT)
        if not last:
            ctx = sublayer_out(ctx, y_c, norm_post[l, 1], mod_c, 1, 1.0)
            y = swiglu(sublayer_in(ctx, norm_pre[l, 2], mod_c, 2), ffn_w_gate[l, 1], ffn_w_up[l, 1], ffn_w_down[l, 1])
            ctx = sublayer_out(ctx, y, norm_post[l, 2], mod_c, 2, FFN_RESIDUAL_WEIGHT)
    return x
```

```cpp
#include <hip/hip_runtime.h>
#include <hip/hip_cooperative_groups.h>
#include <cstdio>
#include <cstdint>
namespace cg = cooperative_groups;
#ifndef MK_MULTI
#define MK_MULTI 0
#endif
namespace pg8 {
#define PG8_LAS __attribute__((address_space(3)))
typedef unsigned short bf16_t;
typedef short bf16x8 __attribute__((ext_vector_type(8)));
typedef float f32x4 __attribute__((ext_vector_type(4)));
typedef unsigned u32x4 __attribute__((ext_vector_type(4)));
constexpr int BM = 256, BK = 64, HALF = 128, HTB = HALF * BK * 2  , STAGE_BYTES = 8 * HTB, NXCD = 8, WGM = 8;

__host__ __device__ __forceinline__ int lds_byte(int r, int c) { const int st = (r >> 4) * 2 + (c >> 5), rr = r & 15, cc = c & 31, ob = rr * 64 + cc * 2; return st * 1024 + (ob ^ (((ob >> 9) & 1) << 5)); }
__host__ __device__ __forceinline__ void stage_rc(int b, int& R, int& C) { const int st = b / 1024, sb = b % 1024, swz = sb ^ (((sb >> 9) & 1) << 5); R = (st >> 1) * 16 + swz / 64; C = (st & 1) * 32 + (swz % 64) / 2; }
__host__ __device__ __forceinline__ int perm32(int rho) { const int n = rho >> 4, i = rho & 15; return 8 * (i >> 2) + 4 * n + (i & 3); }

struct Unit { int pm, pn; };
struct Gemm { const bf16_t* A; const bf16_t* Bt; int M, N, K, lda; };

struct StaticOrder {
    int nM, nN, nwg, G, c;
    __host__ __device__ void init(int M, int N, int G_, int c_) { nM = M / BM; nN = N / BM; nwg = nM * nN; G = G_; c = c_; }
    __host__ __device__ bool next(int i, Unit& u) const {
        const long L = (long)i * G + c; if (L >= nwg) return false;
        int wgid = (int)L; { const int q = nwg / NXCD, r = nwg % NXCD, xcd = wgid % NXCD, off = wgid / NXCD; wgid = (xcd < r ? xcd * (q + 1) : r * (q + 1) + (xcd - r) * q) + off; }
        const int nig = WGM * nN, gid = wgid / nig, fm = gid * WGM, gsz = (nM - fm) < WGM ? (nM - fm) : WGM;
        u.pm = fm + ((wgid % nig) % gsz); u.pn = (wgid % nig) / gsz; return true;
    }
    __device__ __forceinline__ void a_ready(const Unit&) const {}
    __device__ __forceinline__ void done(const Unit&) const {}
};

__device__ __forceinline__ unsigned cvt_pk_bf16(float lo, float hi) { unsigned r; asm volatile("v_cvt_pk_bf16_f32 %0, %1, %2" : "=v"(r) : "v"(lo), "v"(hi)); return r; }
template <class Epi, class Sched, bool ALIGN_EPI = false, bool SP2 = false>
__device__ __forceinline__ void gemm_phase(PG8_LAS unsigned char* lds, const Gemm g, const Sched& S, const Epi& E, const int tid) {
    const int wid = __builtin_amdgcn_readfirstlane(tid >> 6), lane = tid & 63, wr = wid >> 2, wc = wid & 3, fr = lane & 15, fq = lane >> 4;
    const int K = g.K, nt = K / BK;
    unsigned voffA[2], voffB[2];
#pragma unroll
    for (int i = 0; i < 2; ++i) { int R, C; stage_rc(tid * 16 + i * 8192, R, C); const int Rb = Epi::PERM ? ((R & ~31) + perm32(R & 31)) : R;
        voffA[i] = (unsigned)(R * g.lda + C) * 2u; voffB[i] = (unsigned)(Rb * K + C) * 2u; }
    const size_t kstep = (size_t)(BK * 2);
    const size_t hstep = (size_t)HALF * K * 2;
    const size_t tstep = 2 * hstep; const size_t hstepA = (size_t)HALF * g.lda * 2, tstepA = 2 * hstepA;
    const unsigned ldsw = (unsigned)wid * 1024u;
    const int aoff = lds_byte(wr * 64 + fr, fq * 8), boff = lds_byte(wc * 32 + fr, fq * 8);
#define PG8_SA(b, h) (((b) * 2 + (h)) * HTB)
#define PG8_SB(b, h) ((4 + (b) * 2 + (h)) * HTB)
#define PG8_STAGE(bufoff, gbase, voff) do { _Pragma("unroll") for (int _i = 0; _i < 2; ++_i) \
        __builtin_amdgcn_global_load_lds((const unsigned*)((const char*)(gbase) + (voff)[_i]), (PG8_LAS unsigned*)(lds + (bufoff) + ldsw + _i * 8192), 16, 0, 0); } while (0)
#define PG8_LDA(dst, b, h) do { _Pragma("unroll") for (int m = 0; m < 4; ++m) _Pragma("unroll") for (int k = 0; k < 2; ++k) dst[m][k] = *(const PG8_LAS bf16x8*)(lds + PG8_SA(b, h) + aoff + m * 2048 + k * 1024); } while (0)
#define PG8_LDB(dst, b, h) do { _Pragma("unroll") for (int n = 0; n < 2; ++n) _Pragma("unroll") for (int k = 0; k < 2; ++k) dst[n][k] = *(const PG8_LAS bf16x8*)(lds + PG8_SB(b, h) + boff + n * 2048 + k * 1024); } while (0)
#define PG8_MMA(ai, bj, At, Bt) do { __builtin_amdgcn_s_setprio(1); _Pragma("unroll") for (int m = 0; m < 4; ++m) _Pragma("unroll") for (int n = 0; n < 2; ++n) _Pragma("unroll") for (int k = 0; k < 2; ++k) \
        acc[ai][bj][m][n] = __builtin_amdgcn_mfma_f32_16x16x32_bf16(Bt[n][k], At[m][k], acc[ai][bj][m][n], 0, 0, 0); __builtin_amdgcn_s_setprio(0); } while (0)
#define PG8_WAIT_V(n) asm volatile("s_waitcnt vmcnt(" #n ")" ::: "memory")
#define PG8_WAIT_L(n) asm volatile("s_waitcnt lgkmcnt(" #n ")" ::: "memory")
#define PG8_BAR __builtin_amdgcn_s_barrier()
#define PG8_SCHED __builtin_amdgcn_sched_barrier(0)
    Unit cur, nxt; int ui = 0;
    if (!S.next(0, cur)) return;
    f32x4 acc[2][2][4][2];
#pragma unroll
    for (int a = 0; a < 2; ++a)
#pragma unroll
        for (int b = 0; b < 2; ++b)
#pragma unroll
            for (int m = 0; m < 4; ++m)
#pragma unroll
                for (int n = 0; n < 2; ++n) acc[a][b][m][n] = (f32x4){0.f, 0.f, 0.f, 0.f};
    bf16x8 At[4][2], B0[2][2], B1[2][2];
    const char* cA = (const char*)g.A + (size_t)cur.pm * tstepA; const char* cB = (const char*)g.Bt + (size_t)cur.pn * tstep;
    S.a_ready(cur);
    if constexpr (SP2) {
        PG8_STAGE(PG8_SB(0, 0), cB, voffB); PG8_STAGE(PG8_SB(0, 1), cB + hstep, voffB); PG8_STAGE(PG8_SA(0, 0), cA, voffA); PG8_STAGE(PG8_SA(0, 1), cA + hstepA, voffA);
        if (wr == 1) PG8_BAR;
        PG8_WAIT_V(2); PG8_BAR;
        PG8_STAGE(PG8_SB(1, 0), cB + kstep, voffB); PG8_STAGE(PG8_SA(1, 0), cA + kstep, voffA); PG8_STAGE(PG8_SB(1, 1), cB + hstep + kstep, voffB);
        PG8_WAIT_V(6); PG8_BAR;
    } else {
        PG8_STAGE(PG8_SB(0, 0), cB, voffB); PG8_STAGE(PG8_SA(0, 0), cA, voffA); PG8_STAGE(PG8_SB(0, 1), cB + hstep, voffB); PG8_STAGE(PG8_SA(0, 1), cA + hstepA, voffA);
        if (wr == 1) PG8_BAR;
        PG8_WAIT_V(4); PG8_BAR;
        PG8_STAGE(PG8_SB(1, 0), cB + kstep, voffB); PG8_STAGE(PG8_SA(1, 0), cA + kstep, voffA); PG8_STAGE(PG8_SB(1, 1), cB + hstep + kstep, voffB);
        PG8_WAIT_V(6); PG8_BAR;
    }
    for (;;) {
        const bool has_next = S.next(ui + 1, nxt);
        const char* nA = has_next ? (const char*)g.A + (size_t)nxt.pm * tstepA : cA; const char* nB = has_next ? (const char*)g.Bt + (size_t)nxt.pn * tstep : cB;
        for (int t = 0; t < nt; t += 2) {
            const bool last = (t == nt - 2);
            const char* a1 = cA + (size_t)(t + 1) * kstep;
            const char* a2 = last ? nA : cA + (size_t)(t + 2) * kstep; const char* b2 = last ? nB : cB + (size_t)(t + 2) * kstep;
            const char* a3 = a2 + kstep; const char* b3 = b2 + kstep;
            if (last && has_next) S.a_ready(nxt);
            if constexpr (SP2) {
            PG8_LDB(B0, 0, 0); PG8_LDB(B1, 0, 1); PG8_SCHED; PG8_LDA(At, 0, 0); PG8_STAGE(PG8_SA(1, 1), a1 + hstepA, voffA);
            PG8_WAIT_V(8); PG8_WAIT_L(0); PG8_BAR; PG8_MMA(0, 0, At, B0); PG8_MMA(0, 1, At, B1); PG8_BAR; PG8_SCHED;
            PG8_LDA(At, 0, 1); PG8_STAGE(PG8_SB(0, 0), b2, voffB); PG8_STAGE(PG8_SB(0, 1), b2 + hstep, voffB); PG8_STAGE(PG8_SA(0, 0), a2, voffA);
            PG8_WAIT_V(8); PG8_WAIT_L(0); PG8_BAR; PG8_MMA(1, 0, At, B0); PG8_MMA(1, 1, At, B1); PG8_BAR; PG8_SCHED;
            PG8_LDB(B0, 1, 0); PG8_LDB(B1, 1, 1); PG8_SCHED; PG8_LDA(At, 1, 0); PG8_STAGE(PG8_SA(0, 1), a2 + hstepA, voffA);
            PG8_WAIT_V(8); PG8_WAIT_L(0); PG8_BAR; PG8_MMA(0, 0, At, B0); PG8_MMA(0, 1, At, B1); PG8_BAR; PG8_SCHED;
            PG8_LDA(At, 1, 1); PG8_STAGE(PG8_SB(1, 0), b3, voffB); PG8_STAGE(PG8_SB(1, 1), b3 + hstep, voffB); PG8_STAGE(PG8_SA(1, 0), a3, voffA);
            PG8_WAIT_V(8); PG8_WAIT_L(0); PG8_BAR; PG8_MMA(1, 0, At, B0); PG8_MMA(1, 1, At, B1); PG8_BAR; PG8_SCHED;
            } else {
            PG8_LDB(B0, 0, 0); PG8_SCHED; PG8_LDA(At, 0, 0); PG8_STAGE(PG8_SA(1, 1), a1 + hstepA, voffA);
            PG8_WAIT_L(8); PG8_BAR; PG8_WAIT_L(0); PG8_MMA(0, 0, At, B0); PG8_BAR; PG8_SCHED;
            PG8_LDB(B1, 0, 1); PG8_STAGE(PG8_SB(0, 0), b2, voffB);
            PG8_BAR; PG8_WAIT_L(0); PG8_MMA(0, 1, At, B1); PG8_BAR;
            PG8_LDA(At, 0, 1); PG8_STAGE(PG8_SA(0, 0), a2, voffA);
            PG8_BAR; PG8_WAIT_L(0); PG8_MMA(1, 0, At, B0); PG8_BAR; PG8_SCHED;
            PG8_STAGE(PG8_SB(0, 1), b2 + hstep, voffB);
            PG8_WAIT_V(6); PG8_BAR; PG8_MMA(1, 1, At, B1); PG8_BAR;
            PG8_LDB(B0, 1, 0); PG8_SCHED; PG8_LDA(At, 1, 0); PG8_STAGE(PG8_SA(0, 1), a2 + hstepA, voffA);
            PG8_WAIT_L(8); PG8_BAR; PG8_WAIT_L(0); PG8_MMA(0, 0, At, B0); PG8_BAR; PG8_SCHED;
            PG8_LDB(B1, 1, 1); PG8_STAGE(PG8_SB(1, 0), b3, voffB);
            PG8_BAR; PG8_WAIT_L(0); PG8_MMA(0, 1, At, B1); PG8_BAR;
            PG8_LDA(At, 1, 1); PG8_STAGE(PG8_SA(1, 0), a3, voffA);
            PG8_BAR; PG8_WAIT_L(0); PG8_MMA(1, 0, At, B0); PG8_BAR; PG8_SCHED;
            PG8_STAGE(PG8_SB(1, 1), b3 + hstep, voffB);
            PG8_WAIT_V(6); PG8_BAR; PG8_MMA(1, 1, At, B1); PG8_BAR;
            }
        }
        if constexpr (ALIGN_EPI) { if (wr == 0) PG8_BAR; }
        if constexpr (!Epi::AFTER_DRAIN) { E(acc, cur, wr, wc, fr, fq); S.done(cur); }
        if (!has_next) break;
#pragma unroll
        for (int a = 0; a < 2; ++a)
#pragma unroll
            for (int b = 0; b < 2; ++b)
#pragma unroll
                for (int m = 0; m < 4; ++m)
#pragma unroll
                    for (int n = 0; n < 2; ++n) acc[a][b][m][n] = (f32x4){0.f, 0.f, 0.f, 0.f};
        cur = nxt; cA = nA; cB = nB; ++ui;
        if constexpr (ALIGN_EPI) { if (wr == 1) PG8_BAR; }
    }
    PG8_WAIT_V(0);
    if constexpr (!ALIGN_EPI) { if (wr == 0) PG8_BAR; }
    PG8_BAR;
    if constexpr (Epi::AFTER_DRAIN) { E.fused(acc, cur, wr, wc, fr, fq, lds, wid, lane); S.done(cur); }
#undef PG8_SA
#undef PG8_SB
#undef PG8_STAGE
#undef PG8_LDA
#undef PG8_LDB
#undef PG8_MMA
#undef PG8_WAIT_V
#undef PG8_WAIT_L
#undef PG8_BAR
#undef PG8_SCHED
}
}
using pg8::bf16_t; using pg8::f32x4; using pg8::u32x4; using pg8::bf16x8; using pg8::Unit;
#define LAS __attribute__((address_space(3)))
typedef float f32x16 __attribute__((ext_vector_type(16)));
typedef unsigned u32x2 __attribute__((ext_vector_type(2)));
typedef short s16x4 __attribute__((ext_vector_type(4)));
constexpr int NB = 8, SEQ = 4096, CTXL = 256, DM = 1024, FF = 2816, DEPTH = 4, NH = 8;
constexpr int R_LAT = NB * SEQ, R_CTX = NB * CTXL, R = R_LAT + R_CTX;
constexpr float EPS = 1e-6f;
constexpr int NCH = 34;
constexpr size_t W_GUA = 0, W_DA = W_GUA + (size_t)5632 * 1024, W_GUB = W_DA + (size_t)1024 * 2816, W_DB = W_GUB + (size_t)5632 * 1024,
                 W_IN = W_DB + (size_t)1024 * 2816, W_UQ = W_IN + (size_t)3840 * 1024, W_UKV = W_UQ + (size_t)1536 * 256, W_OMLA = W_UKV + (size_t)2048 * 256,
                 W_GLU = W_OMLA + (size_t)1024 * 1024, W_OS5 = W_GLU + (size_t)1024 * 1024, W_OUT = W_OS5 + (size_t)1024 * 1024, W_END = W_OUT + (size_t)1024 * 1024;
constexpr size_t al256(size_t x) { return (x + 255) & ~(size_t)255; }
constexpr size_t WS_MOD = 0;
constexpr size_t WS_ROPE = WS_MOD + al256((size_t)4 * 9 * 9216 * 4);
constexpr size_t WS_YSS = WS_ROPE + al256(64 * 16 * 8);
constexpr size_t WS_CSS = WS_YSS + al256((size_t)R * 16 * 4);
constexpr size_t WS_S5E = WS_CSS + al256((size_t)R * 8 * 4);
constexpr size_t WS_XC = WS_S5E + al256((size_t)8 * 2 * 64 * NCH * 64 * 8);
constexpr size_t WS_WL = WS_XC + al256((size_t)R_CTX * DM * 4);
constexpr size_t WS_H = WS_WL + al256(W_END * 2);
constexpr size_t WS_BIG = WS_H + al256((size_t)R * DM * 2);
constexpr size_t B_CQ = 0, B_U = B_CQ + (size_t)R * 768 * 2, B_Q = B_U + (size_t)R * 1024 * 2, B_KV = B_Q + (size_t)R * 1536 * 2, B_SG = B_KV + (size_t)R * 2048 * 2, B_END = B_SG + (size_t)R * 2048 * 2;
constexpr size_t B_ACT = 0, B_Y = (size_t)R * FF * 2;
constexpr size_t B_T = B_Q, B_G = B_KV, B_M = B_U;
static_assert(B_Y >= B_T + (size_t)R * 1024 * 2 && B_Y + (size_t)R * 1024 * 2 <= B_SG, "Y overlay");
constexpr size_t WS_END = WS_BIG + B_END;
constexpr int LDS_BYTES = 131072 + 4096;

__device__ __forceinline__ float bf2f(unsigned h) { return __uint_as_float(h << 16); }
__device__ __forceinline__ unsigned pk2(float lo, float hi) { return pg8::cvt_pk_bf16(lo, hi); }
__device__ __forceinline__ float sigm(float x) { return __builtin_amdgcn_rcpf(1.f + __builtin_amdgcn_exp2f(-1.4426950408889634f * x)); }
__device__ __forceinline__ float gelu_tanh(float x) { return x * sigm(1.5957691216057308f * (x + 0.044715f * x * x * x)); }
__device__ __forceinline__ void unpack8(const u32x4 w, float (&f)[8]) {
    f[0] = bf2f(w.x & 0xffffu); f[1] = __uint_as_float(w.x & 0xffff0000u); f[2] = bf2f(w.y & 0xffffu); f[3] = __uint_as_float(w.y & 0xffff0000u);
    f[4] = bf2f(w.z & 0xffffu); f[5] = __uint_as_float(w.z & 0xffff0000u); f[6] = bf2f(w.w & 0xffffu); f[7] = __uint_as_float(w.w & 0xffff0000u);
}
__device__ __forceinline__ u32x4 pack8(const float (&f)[8]) { u32x4 w; w.x = pk2(f[0], f[1]); w.y = pk2(f[2], f[3]); w.z = pk2(f[4], f[5]); w.w = pk2(f[6], f[7]); return w; }
__device__ __forceinline__ float wave_sum(float v) {
#pragma unroll
    for (int o = 1; o < 64; o <<= 1) v += __shfl_xor(v, o);
    return v;
}
__device__ __forceinline__ void rope8(float (&v)[8], int row, int wc, int fq, const float* tab) {
    const int t = row & 4095, pos = (wc & 1) ? (t & 63) : (t >> 6);
    const f32x4* tp = (const f32x4*)(tab + (pos * 16 + 8 * (fq & 1)) * 2);
    const f32x4 t0 = tp[0], t1 = tp[1], t2 = tp[2], t3 = tp[3];
    const float cs[8] = {t0[0], t0[2], t1[0], t1[2], t2[0], t2[2], t3[0], t3[2]}, sn[8] = {t0[1], t0[3], t1[1], t1[3], t2[1], t2[3], t3[1], t3[3]};
    const float sgn = (fq < 2) ? -1.f : 1.f;
#pragma unroll
    for (int j = 0; j < 8; ++j) { const float p = __shfl_xor(v[j], 32); v[j] = v[j] * cs[j] + sgn * p * sn[j]; }
}

struct Epi {
    static constexpr bool PERM = true, AFTER_DRAIN = false;
    int mode;
    bf16_t* o0; bf16_t* o1; bf16_t* o2; const bf16_t* i0; const bf16_t* i1; float* ss; const float* css; const float* bias; const float* rope;
    __device__ __forceinline__ void operator()(const f32x4 (&acc)[2][2][4][2], const Unit& u, int wr, int wc, int fr, int fq) const {
        const int row0 = u.pm * 256 + wr * 64 + fr, cb = wc * 32 + 8 * fq, pn = u.pn;
        if (mode == 0) {
            bf16_t* base = o0 + (size_t)pn * 128 + cb;
#pragma unroll
            for (int ai = 0; ai < 2; ++ai)
#pragma unroll
                for (int m = 0; m < 4; ++m) { const int row = row0 + ai * 128 + m * 16; float v[8];
#pragma unroll
                    for (int n = 0; n < 2; ++n)
#pragma unroll
                        for (int j = 0; j < 4; ++j) { const float g = acc[ai][0][m][n][j], up = acc[ai][1][m][n][j]; v[4 * n + j] = g * sigm(g) * up; }
                    *(u32x4*)(base + (size_t)row * FF) = pack8(v); }
        } else if (mode == 1) {
            bf16_t* base = o0 + pn * 256 + cb;
#pragma unroll
            for (int ai = 0; ai < 2; ++ai)
#pragma unroll
                for (int m = 0; m < 4; ++m) { const int row = row0 + ai * 128 + m * 16; float s = 0.f;
#pragma unroll
                    for (int bj = 0; bj < 2; ++bj) { float v[8];
#pragma unroll
                        for (int n = 0; n < 2; ++n)
#pragma unroll
                            for (int j = 0; j < 4; ++j) { const float x = acc[ai][bj][m][n][j]; v[4 * n + j] = x; s += x * x; }
                        *(u32x4*)(base + (size_t)row * 1024 + bj * 128) = pack8(v); }
                    s += __shfl_xor(s, 16); s += __shfl_xor(s, 32);
                    if (fq == 0) ss[row * 16 + pn * 4 + wc] = s; }
        } else if (mode == 2) {
            bf16_t* dst; int ldc;
            if (pn < 3) { dst = o0 + pn * 256; ldc = 768; } else if (pn < 7) { dst = o1 + (pn - 3) * 256; ldc = 1024; } else { dst = o2 + (pn - 7) * 256; ldc = 2048; }
            const bool sg = pn >= 7, docss = pn < 2, dorope = (pn == 2) && (u.pm < 128) && (wc < 2);
            dst += cb;
#pragma unroll
            for (int ai = 0; ai < 2; ++ai)
#pragma unroll
                for (int m = 0; m < 4; ++m) { const int row = row0 + ai * 128 + m * 16; float s = 0.f;
#pragma unroll
                    for (int bj = 0; bj < 2; ++bj) { float v[8];
#pragma unroll
                        for (int n = 0; n < 2; ++n)
#pragma unroll
                            for (int j = 0; j < 4; ++j) { float x = acc[ai][bj][m][n][j]; if (sg) x = sigm(x); v[4 * n + j] = x; s += x * x; }
                        if (bj == 0 && dorope) rope8(v, row, wc, fq, rope);
                        *(u32x4*)(dst + (size_t)row * ldc + bj * 128) = pack8(v); }
                    if (docss) { s += __shfl_xor(s, 16); s += __shfl_xor(s, 32); if (fq == 0) ss[row * 8 + pn * 4 + wc] = s; } }
        } else if (mode == 3 || mode == 4) {
            const int ldc = (mode == 3) ? 1536 : 2048; const float* cp = css + ((mode == 3) ? 0 : 4);
            const bool dorope = (mode == 3) && (pn >= 4) && (u.pm < 128);
            bf16_t* dst = o0 + pn * 256 + cb;
#pragma unroll
            for (int ai = 0; ai < 2; ++ai)
#pragma unroll
                for (int m = 0; m < 4; ++m) { const int row = row0 + ai * 128 + m * 16; const f32x4 c4 = *(const f32x4*)(cp + row * 8);
                    const float rs = 1.0f / sqrtf(((c4[0] + c4[1]) + (c4[2] + c4[3])) * (1.0f / 256.0f) + EPS);
#pragma unroll
                    for (int bj = 0; bj < 2; ++bj) { float v[8];
#pragma unroll
                        for (int n = 0; n < 2; ++n)
#pragma unroll
                            for (int j = 0; j < 4; ++j) v[4 * n + j] = acc[ai][bj][m][n][j] * rs;
                        if (dorope) rope8(v, row, wc, fq, rope);
                        *(u32x4*)(dst + (size_t)row * ldc + bj * 128) = pack8(v); } }
        } else {
            const int col = pn * 256 + cb;
#pragma unroll
            for (int ai = 0; ai < 2; ++ai)
#pragma unroll
                for (int m = 0; m < 4; ++m) { const int row = row0 + ai * 128 + m * 16;
#pragma unroll
                    for (int bj = 0; bj < 2; ++bj) { const int c = col + bj * 128; float v[8], a[8], b[8];
#pragma unroll
                        for (int n = 0; n < 2; ++n)
#pragma unroll
                            for (int j = 0; j < 4; ++j) v[4 * n + j] = acc[ai][bj][m][n][j];
                        if (mode == 5) { unpack8(*(const u32x4*)(i0 + (size_t)row * 1024 + c), a); const f32x4 b0 = *(const f32x4*)(bias + c), b1 = *(const f32x4*)(bias + c + 4);
#pragma unroll
                            for (int j = 0; j < 4; ++j) { v[j] = a[j] * sigm(v[j] + b0[j]); v[4 + j] = a[4 + j] * sigm(v[4 + j] + b1[j]); } }
                        else if (mode == 6) { unpack8(*(const u32x4*)(i0 + (size_t)row * 2048 + c), a);
#pragma unroll
                            for (int j = 0; j < 8; ++j) v[j] = a[j] * v[j]; }
                        else { unpack8(*(const u32x4*)(i0 + (size_t)row * 1024 + c), a); unpack8(*(const u32x4*)(i1 + (size_t)row * 2048 + c), b);
#pragma unroll
                            for (int j = 0; j < 8; ++j) v[j] = a[j] + b[j] * v[j]; }
                        *(u32x4*)(o0 + (size_t)row * 1024 + c) = pack8(v); } }
        }
    }
};
__device__ __forceinline__ void conv_item(const float* W, int ldsrc, int srccol, const float* kscale, bf16_t* WT, int K, int n0, int k0, LAS float* scr, int lane) {
    if (srccol >= 0) {
#pragma unroll 8
        for (int i = 0; i < 32; ++i) { const int kk = 2 * i + (lane >> 5); float w = W[(size_t)(k0 + kk) * ldsrc + srccol + (lane & 31)]; if (kscale) w *= kscale[k0 + kk]; scr[kk * 33 + (lane & 31)] = w; }
    } else {
#pragma unroll 8
        for (int i = 0; i < 32; ++i) { const int kk = 2 * i + (lane >> 5); scr[kk * 33 + (lane & 31)] = 0.f; }
    }
    asm volatile("s_waitcnt lgkmcnt(0)" ::: "memory");
    const int c = lane & 7;
#pragma unroll
    for (int j = 0; j < 4; ++j) { const int n = (lane >> 3) + 8 * j; const LAS float* s = scr + (8 * c) * 33 + n;
        u32x4 o; o.x = pk2(s[0 * 33], s[1 * 33]); o.y = pk2(s[2 * 33], s[3 * 33]); o.z = pk2(s[4 * 33], s[5 * 33]); o.w = pk2(s[6 * 33], s[7 * 33]);
        *(u32x4*)(WT + (size_t)(n0 + n) * K + k0 + 8 * c) = o; }
    asm volatile("s_waitcnt lgkmcnt(0)" ::: "memory");
}
struct WPtrs { const float *gate, *up, *down, *win, *qn, *wuq, *kvn, *wukv, *womla, *glu, *wos5, *wout; };
__device__ __forceinline__ void conv_layer(const WPtrs& P, int l, bf16_t* WL, LAS unsigned char* lds, int gw, int NGW, int wave, int lane) {
    LAS float* scr = (LAS float*)(lds + wave * 16384);
    constexpr int I_GU = 16 * 176, I_D = 44 * 32, I_IN = 16 * 120, I_UQ = 4 * 48, I_UKV = 4 * 64, I_SQ = 16 * 32;
    constexpr int NIT = 2 * I_GU + 2 * I_D + I_IN + I_UQ + I_UKV + 4 * I_SQ;
    for (int it = gw; it < NIT; it += NGW) {
        int r = it;
        if (r < 2 * I_GU) { const int f = r / I_GU; r -= f * I_GU; const int nb = r % 176, kb = r / 176, n0 = nb * 32, tile = n0 >> 8, within = n0 & 255, half = within >> 7, ffc = tile * 128 + (within & 127);
            const size_t so = (size_t)(l * 2 + f) * 1024 * FF; bf16_t* dst = WL + (f ? W_GUB : W_GUA);
            if (half) conv_item(P.up + so, FF, ffc, nullptr, dst, 1024, n0, kb * 64, scr, lane); else conv_item(P.gate + so, FF, ffc, nullptr, dst, 1024, n0, kb * 64, scr, lane);
            continue; }
        r -= 2 * I_GU;
        if (r < 2 * I_D) { const int f = r / I_D; r -= f * I_D; const int nb = r % 32, kb = r / 32;
            conv_item(P.down + (size_t)(l * 2 + f) * FF * 1024, 1024, nb * 32, nullptr, WL + (f ? W_DB : W_DA), FF, nb * 32, kb * 64, scr, lane); continue; }
        r -= 2 * I_D;
        if (r < I_IN) { const int nb = r % 120, kb = r / 120, n0 = nb * 32; int sc;
            if (n0 < 512) sc = n0; else if (n0 < 768) sc = (n0 < 576) ? n0 : -1; else sc = n0 - 768 + 576;
            conv_item(P.win + (size_t)l * 1024 * 3648, 3648, sc, nullptr, WL + W_IN, 1024, n0, kb * 64, scr, lane); continue; }
        r -= I_IN;
        if (r < I_UQ) { const int nb = r % 48, kb = r / 48, n0 = nb * 32; int sc;
            if (n0 < 1024) sc = (n0 >> 7) * 192 + (n0 & 127); else { const int rr = n0 - 1024; sc = (rr >> 6) * 192 + 128 + (rr & 63); }
            conv_item(P.wuq + (size_t)l * 256 * 1536, 1536, sc, P.qn + l * 256, WL + W_UQ, 256, n0, kb * 64, scr, lane); continue; }
        r -= I_UQ;
        if (r < I_UKV) { const int nb = r % 64, kb = r / 64;
            conv_item(P.wukv + (size_t)l * 256 * 2048, 2048, nb * 32, P.kvn + l * 256, WL + W_UKV, 256, nb * 32, kb * 64, scr, lane); continue; }
        r -= I_UKV;
        { const int q = r / I_SQ; r -= q * I_SQ; const int nb = r % 32, kb = r / 32; const size_t so = (size_t)l * 1024 * 1024;
          if (q == 0) conv_item(P.womla + so, 1024, nb * 32, nullptr, WL + W_OMLA, 1024, nb * 32, kb * 64, scr, lane);
          else if (q == 1) conv_item(P.glu + so, 1024, nb * 32, nullptr, WL + W_GLU, 1024, nb * 32, kb * 64, scr, lane);
          else if (q == 2) conv_item(P.wos5 + so, 1024, nb * 32, nullptr, WL + W_OS5, 1024, nb * 32, kb * 64, scr, lane);
          else conv_item(P.wout + so, 1024, nb * 32, nullptr, WL + W_OUT, 1024, nb * 32, kb * 64, scr, lane); }
    }
}

__device__ __forceinline__ void mods_phase(const float* c, const float* c_ctx, const float* ada_w, const float* ada_b, float* MOD, float* ROPE, LAS unsigned char* lds, const int tid) {

    LAS float* sc = (LAS float*)lds;
    LAS float* red = (LAS float*)(lds + 9 * 1024 * 4);
    if (blockIdx.x == gridDim.x - 1) {
        for (int e = tid; e < 1024; e += 512) { const int pos = e >> 4, i = e & 15; const float inv = exp2f(-(float)i * (13.287712379549449f / 16.0f)); const float ang = (float)pos * inv;
            float sn_, cs_; sincosf(ang, &sn_, &cs_); ROPE[2 * e] = cs_; ROPE[2 * e + 1] = sn_; }
    }
    bool have = false;
    for (int item = blockIdx.x; item < 576; item += gridDim.x) {
        if (!have) { for (int e = tid; e < 9 * 1024; e += 512) { const float v = (e < 8192) ? c[e] : c_ctx[e - 8192]; sc[e] = v * sigm(v); } have = true; }
        __syncthreads();
        const int l = item / 144, j0 = (item % 144) * 64, ks = tid >> 6, jj = tid & 63;
        const float* w = ada_w + ((size_t)l * 1024 + ks * 128) * 9216 + j0 + jj;
        float a[9];
#pragma unroll
        for (int s = 0; s < 9; ++s) a[s] = 0.f;
#pragma unroll 4
        for (int k = 0; k < 128; ++k) { const float wv = w[(size_t)k * 9216];
#pragma unroll
            for (int s = 0; s < 9; ++s) a[s] += sc[s * 1024 + ks * 128 + k] * wv; }
#pragma unroll
        for (int s = 0; s < 9; ++s) red[(ks * 9 + s) * 64 + jj] = a[s];
        __syncthreads();
        for (int e = tid; e < 576; e += 512) { const int s = e >> 6, j = e & 63; float t = 0.f;
#pragma unroll
            for (int q = 0; q < 8; ++q) t += red[(q * 9 + s) * 64 + j];
            MOD[((size_t)l * 9 + s) * 9216 + j0 + j] = t + ada_b[l * 9216 + j0 + j]; }
    }
    __syncthreads();
}

__device__ __forceinline__ void e_phase(const float* xin, const float* ctxin, float* xl, float* xc, const bf16_t* Y, const float* YSS, const float* MOD,
                                        const float* npre, const float* npost, bf16_t* H, int l, int s, int nl, int ns, int gw, int NGW, int lane) {
    for (int row = gw; row < R; row += NGW) {
        const bool lat = row < R_LAT; const int set = lat ? (row >> 12) : 8;
        float* xr = lat ? xl + (size_t)row * DM : xc + (size_t)(row - R_LAT) * DM;
        const float* xs = (s < 0) ? (lat ? xin + (size_t)row * DM : ctxin + (size_t)(row - R_LAT) * DM) : xr;
        f32x4 v[4];
#pragma unroll
        for (int j = 0; j < 4; ++j) v[j] = ((const f32x4*)xs)[lane + 64 * j];
        if (s >= 0) {
            const float part = (lane < 16) ? YSS[row * 16 + lane] : 0.f;
            const float rs = 1.0f / sqrtf(wave_sum(part) * (1.0f / 1024.0f) + EPS);
            const float wgt = (s == 1) ? 1.0f : 0.5f;
            const float* gate = MOD + ((size_t)(l * 9 + set) * 9 + 3 * s + 2) * 1024; const float* gp = npost + (l * 3 + s) * 1024;
#pragma unroll
            for (int j = 0; j < 4; ++j) { const u32x2 yw = ((const u32x2*)(Y + (size_t)row * DM))[lane + 64 * j];
                const f32x4 g4 = ((const f32x4*)gate)[lane + 64 * j], p4 = ((const f32x4*)gp)[lane + 64 * j];
                f32x4 y4; y4[0] = bf2f(yw.x & 0xffffu); y4[1] = __uint_as_float(yw.x & 0xffff0000u); y4[2] = bf2f(yw.y & 0xffffu); y4[3] = __uint_as_float(yw.y & 0xffff0000u);
                v[j] += (wgt * rs) * g4 * y4 * p4; }
        }
#pragma unroll
        for (int j = 0; j < 4; ++j) ((f32x4*)xr)[lane + 64 * j] = v[j];
        if (nl >= 0) {
            float q = 0.f;
#pragma unroll
            for (int j = 0; j < 4; ++j) q += (v[j][0] * v[j][0] + v[j][1] * v[j][1]) + (v[j][2] * v[j][2] + v[j][3] * v[j][3]);
            const float rs2 = 1.0f / sqrtf(wave_sum(q) * (1.0f / 1024.0f) + EPS);
            const float* mb = MOD + ((size_t)(nl * 9 + set) * 9 + 3 * ns) * 1024; const float* gp = npre + (nl * 3 + ns) * 1024;
#pragma unroll
            for (int j = 0; j < 4; ++j) { const f32x4 sh = ((const f32x4*)mb)[lane + 64 * j], sc = ((const f32x4*)(mb + 1024))[lane + 64 * j], p4 = ((const f32x4*)gp)[lane + 64 * j];
                const f32x4 h = v[j] * rs2 * p4 * (1.0f + sc) + sh;
                u32x2 o; o.x = pk2(h[0], h[1]); o.y = pk2(h[2], h[3]); ((u32x2*)(H + (size_t)row * DM))[lane + 64 * j] = o; }
        }
    }
}
struct S5In { const float *a_re, *a_im, *log_dt, *b_re, *b_im, *c_re, *c_im, *dsk; };
__device__ __forceinline__ void s5_coefs(const S5In& P, int l, int d, int g, int lane, float& ar, float& ai, float (&bbr)[16], float (&bbi)[16]) {
    const int idx = (l * 2 + d) * 64 + g;
    const float are = P.a_re[idx * 64 + lane], aim = P.a_im[idx * 64 + lane];
    const float dt = expf(P.log_dt[idx]);
    const float mag = expf(dt * are); float sn, cs; sincosf(dt * aim, &sn, &cs);
    ar = mag * cs; ai = mag * sn;
    const float nr = ar - 1.f, ni = ai, den = 1.0f / (are * are + aim * aim);
    const float cr = (nr * are + ni * aim) * den, ci = (ni * are - nr * aim) * den;
    const f32x4* br = (const f32x4*)(P.b_re + (size_t)(idx * 64 + lane) * 16); const f32x4* bi = (const f32x4*)(P.b_im + (size_t)(idx * 64 + lane) * 16);
#pragma unroll
    for (int q = 0; q < 4; ++q) { const f32x4 r4 = br[q], i4 = bi[q];
#pragma unroll
        for (int j = 0; j < 4; ++j) { bbr[4 * q + j] = cr * r4[j] - ci * i4[j]; bbi[4 * q + j] = cr * i4[j] + ci * r4[j]; } }
}
__device__ __forceinline__ int s5_range_base(int b, int r) { return (r < 2) ? R_LAT + b * 256 + 128 * r : b * 4096 + 128 * (r - 2); }
__device__ __forceinline__ void s5_stage_u(const bf16_t* U, int base, int g, LAS float* ubuf, int lane) {
#pragma unroll
    for (int i = 0; i < 8; ++i) { const int idx = i * 64 + lane, j = idx >> 2, q = idx & 3;
        const u32x2 w = *(const u32x2*)(U + (size_t)(base + j) * 1024 + g * 16 + 4 * q);
        f32x4 f; f[0] = bf2f(w.x & 0xffffu); f[1] = __uint_as_float(w.x & 0xffff0000u); f[2] = bf2f(w.y & 0xffffu); f[3] = __uint_as_float(w.y & 0xffff0000u);
        *(LAS f32x4*)(ubuf + j * 16 + 4 * q) = f; }
    asm volatile("s_waitcnt lgkmcnt(0)" ::: "memory");
}
__device__ __forceinline__ void s5_bu(const LAS float* up, const float (&bbr)[16], const float (&bbi)[16], float& bur, float& bui, float (&u)[16]) {
#pragma unroll
    for (int q = 0; q < 4; ++q) { const f32x4 t = *(const LAS f32x4*)(up + 4 * q); u[4 * q] = t[0]; u[4 * q + 1] = t[1]; u[4 * q + 2] = t[2]; u[4 * q + 3] = t[3]; }
    bur = 0.f; bui = 0.f;
#pragma unroll
    for (int c = 0; c < 16; ++c) { bur += bbr[c] * u[c]; bui += bbi[c] * u[c]; }
}
__device__ __forceinline__ void s5_pass1(const S5In& P, int l, const bf16_t* U, float* E, LAS unsigned char* lds, int gw, int NGW, int wave, int lane) {
    LAS float* ubuf = (LAS float*)(lds + wave * 16384);
    for (int it = gw; it < 8 * 2 * 64 * NCH; it += NGW) {
        const int k = it % NCH, g = (it / NCH) & 63, d = (it / (NCH * 64)) & 1, b = it / (NCH * 128);
        float ar, ai, bbr[16], bbi[16]; s5_coefs(P, l, d, g, lane, ar, ai, bbr, bbi);
        const int r = (d == 0) ? k : (k < 2 ? 1 - k : 35 - k);
        s5_stage_u(U, s5_range_base(b, r), g, ubuf, lane);
        float xr = 0.f, xi = 0.f;
#pragma unroll 2
        for (int i = 0; i < 128; ++i) { const int j = d ? 127 - i : i; float bur, bui, u[16]; s5_bu(ubuf + j * 16, bbr, bbi, bur, bui, u);
            const float nxr = ar * xr - ai * xi + bur, nxi = ar * xi + ai * xr + bui; xr = nxr; xi = nxi; }
        float2 e; e.x = xr; e.y = xi;
        ((float2*)E)[(size_t)(((b * 2 + d) * 64 + g) * NCH + k) * 64 + lane] = e;
        asm volatile("s_waitcnt lgkmcnt(0)" ::: "memory");
    }
}
__device__ __forceinline__ float reduce16(const float (&p)[16], int lane) {
    const bool b5 = lane & 32, b4 = lane & 16, b3 = lane & 8, b2 = lane & 4;
    float q8[8], q4[4], q2[2];
#pragma unroll
    for (int i = 0; i < 8; ++i) { const float send = b5 ? p[i] : p[i + 8], keep = b5 ? p[i + 8] : p[i]; q8[i] = keep + __shfl_xor(send, 32); }
#pragma unroll
    for (int i = 0; i < 4; ++i) { const float send = b4 ? q8[i] : q8[i + 4], keep = b4 ? q8[i + 4] : q8[i]; q4[i] = keep + __shfl_xor(send, 16); }
#pragma unroll
    for (int i = 0; i < 2; ++i) { const float send = b3 ? q4[i] : q4[i + 2], keep = b3 ? q4[i + 2] : q4[i]; q2[i] = keep + __shfl_xor(send, 8); }
    const float send = b2 ? q2[0] : q2[1], keep = b2 ? q2[1] : q2[0];
    float q1 = keep + __shfl_xor(send, 4);
    q1 += __shfl_xor(q1, 2); q1 += __shfl_xor(q1, 1);
    return q1;
}
__device__ __forceinline__ void s5_pass2(const S5In& P, int l, const bf16_t* U, const float* E, bf16_t* T, LAS unsigned char* lds, int gw, int NGW, int wave, int lane) {
    LAS float* ubuf = (LAS float*)(lds + wave * 16384);
    LAS float* ybuf = ubuf + 2048;
    for (int it = gw; it < 8 * 64 * NCH; it += NGW) {
        const int r = it % NCH, g = (it / NCH) & 63, b = it / (NCH * 64);
        const int base = s5_range_base(b, r);
        s5_stage_u(U, base, g, ubuf, lane);
#pragma unroll 1
        for (int d = 0; d < 2; ++d) {
            float ar, ai, bbr[16], bbi[16]; s5_coefs(P, l, d, g, lane, ar, ai, bbr, bbi);
            float cr[16], ci[16];
            { const size_t cb = (size_t)((l * 2 + d) * 64 + g) * 1024 + lane;
#pragma unroll
              for (int c = 0; c < 16; ++c) { cr[c] = P.c_re[cb + c * 64]; ci[c] = P.c_im[cb + c * 64]; } }
            const int k = (d == 0) ? r : (r < 2 ? 1 - r : 35 - r);
            float tr = ar, ti = ai;
#pragma unroll
            for (int q = 0; q < 7; ++q) { const float n_r = tr * tr - ti * ti, n_i = 2.f * tr * ti; tr = n_r; ti = n_i; }
            float xr = 0.f, xi = 0.f;
            const float2* Ep = (const float2*)E + (size_t)((b * 2 + d) * 64 + g) * NCH * 64 + lane;
            for (int j = 0; j < k; ++j) { const float2 e = Ep[j * 64]; const float nxr = tr * xr - ti * xi + e.x, nxi = tr * xi + ti * xr + e.y; xr = nxr; xi = nxi; }
#pragma unroll 1
            for (int i = 0; i < 128; ++i) { const int j = d ? 127 - i : i; float bur, bui, u[16]; s5_bu(ubuf + j * 16, bbr, bbi, bur, bui, u);
                const float nxr = ar * xr - ai * xi + bur, nxi = ar * xi + ai * xr + bui; xr = nxr; xi = nxi;
                float p[16];
#pragma unroll
                for (int c = 0; c < 16; ++c) p[c] = cr[c] * xr - ci[c] * xi;
                const float y = reduce16(p, lane);
                if ((lane & 3) == 0) { LAS float* yp = ybuf + j * 16 + (lane >> 2); if (d == 0) *yp = y; else *yp += y; }
            }
            asm volatile("s_waitcnt lgkmcnt(0)" ::: "memory");
        }
        const float* dk = P.dsk + l * 1024 + g * 16;
#pragma unroll 4
        for (int i = 0; i < 16; ++i) { const int idx = i * 64 + lane, j = idx >> 3, c0 = (idx & 7) * 2;
            const float y0 = ybuf[j * 16 + c0] + dk[c0] * ubuf[j * 16 + c0], y1 = ybuf[j * 16 + c0 + 1] + dk[c0 + 1] * ubuf[j * 16 + c0 + 1];
            *(unsigned*)(T + (size_t)(base + j) * 1024 + g * 16 + c0) = pk2(gelu_tanh(y0), gelu_tanh(y1)); }
        asm volatile("s_waitcnt lgkmcnt(0)" ::: "memory");
    }
}
__device__ __forceinline__ s16x4 vtr(const LAS unsigned char* p) { return __builtin_bit_cast(s16x4, __builtin_amdgcn_ds_read_tr16_b64_v4i16((LAS s16x4*)p)); }
__device__ __forceinline__ void attn_phase(LAS unsigned char* lds, const bf16_t* Q, const bf16_t* KV, const bf16_t* CQ, bf16_t* O, const int tid) {
    const int lane = tid & 63, wid = __builtin_amdgcn_readfirstlane(tid >> 6), r32 = lane & 31, hi = lane >> 5;
    constexpr int KP = 400, VP = 320, BUFB = 64 * KP + 64 * VP;
    const float C = 0.07216878364870322f * 1.4426950408889634f;
    const int kn_row = tid >> 4, kn_ch = tid & 15, kr_row = tid >> 3, kr_ch = tid & 7;
    for (int ui = 0;; ++ui) {
        const int unit = ui * (int)gridDim.x + (int)blockIdx.x; if (unit >= 1024 + 64) break;
        int b, h, qb;
        if (unit < 1024) { const int bh = unit >> 4; qb = unit & 15; b = bh >> 3; h = bh & 7; } else { const int bh = unit - 1024; qb = 16; b = bh >> 3; h = bh & 7; }
        const int qrow0 = (qb < 16) ? b * 4096 + qb * 256 : R_LAT + b * 256;
        const int NT = (qb < 16) ? 68 : 4;
        const bf16_t* qp = Q + (size_t)(qrow0 + wid * 32 + r32) * 1536;
        bf16x8 qf[12];
#pragma unroll
        for (int s = 0; s < 8; ++s) qf[s] = *(const bf16x8*)(qp + h * 128 + 16 * s + 8 * hi);
#pragma unroll
        for (int s = 0; s < 4; ++s) qf[8 + s] = *(const bf16x8*)(qp + 1024 + h * 64 + 16 * s + 8 * hi);
        u32x4 sk0, sk1, skr, sv0, sv1;
#define ATT_KROW(t) ((qb < 16) ? (((t) < 64) ? b * 4096 + (t) * 64 : R_LAT + b * 256 + ((t) - 64) * 64) : R_LAT + b * 256 + (t) * 64)
#define ATT_LOAD(t) do { const int kr0_ = ATT_KROW(t); const bf16_t* kvp_ = KV + (size_t)(kr0_ + kn_row) * 2048 + h * 256 + kn_ch * 8; \
        sk0 = *(const u32x4*)kvp_; sk1 = *(const u32x4*)(kvp_ + 32 * 2048); sv0 = *(const u32x4*)(kvp_ + 128); sv1 = *(const u32x4*)(kvp_ + 128 + 32 * 2048); \
        skr = *(const u32x4*)(CQ + (size_t)(kr0_ + kr_row) * 768 + 512 + kr_ch * 8); } while (0)
#define ATT_STORE(buf) do { LAS unsigned char* kb_ = lds + (buf) * BUFB; LAS unsigned char* vb_ = kb_ + 64 * KP; \
        *(LAS u32x4*)(kb_ + kn_row * KP + kn_ch * 16) = sk0; *(LAS u32x4*)(kb_ + (kn_row + 32) * KP + kn_ch * 16) = sk1; *(LAS u32x4*)(kb_ + kr_row * KP + 256 + kr_ch * 16) = skr; \
        *(LAS u32x4*)(vb_ + kn_row * VP + kn_ch * 16) = sv0; *(LAS u32x4*)(vb_ + (kn_row + 32) * VP + kn_ch * 16) = sv1; } while (0)
        ATT_LOAD(0); ATT_STORE(0);
        __syncthreads();
        float mrun = -1e30f, lrun = 0.f;
        f32x16 o[4];
#pragma unroll
        for (int d = 0; d < 4; ++d)
#pragma unroll
            for (int r = 0; r < 16; ++r) o[d][r] = 0.f;
        for (int t = 0; t < NT; ++t) {
            const int cur = t & 1;
            if (t + 1 < NT) ATT_LOAD(t + 1);
            f32x16 p0, p1;
#pragma unroll
            for (int r = 0; r < 16; ++r) { p0[r] = 0.f; p1[r] = 0.f; }
            { const LAS unsigned char* kb = lds + cur * BUFB + r32 * KP + hi * 16;
#pragma unroll
              for (int s = 0; s < 12; ++s) { const bf16x8 k0 = *(const LAS bf16x8*)(kb + s * 32), k1 = *(const LAS bf16x8*)(kb + 32 * KP + s * 32);
                  p0 = __builtin_amdgcn_mfma_f32_32x32x16_bf16(k0, qf[s], p0, 0, 0, 0); p1 = __builtin_amdgcn_mfma_f32_32x32x16_bf16(k1, qf[s], p1, 0, 0, 0); } }
            float mx = p0[0];
#pragma unroll
            for (int r = 0; r < 16; ++r) { mx = fmaxf(mx, p0[r]); mx = fmaxf(mx, p1[r]); }
            mx = fmaxf(mx, __shfl_xor(mx, 32));
            const float mn = fmaxf(mrun, mx * C), alpha = __builtin_amdgcn_exp2f(mrun - mn); mrun = mn;
            float rsum = 0.f;
#pragma unroll
            for (int r = 0; r < 16; ++r) { p0[r] = __builtin_amdgcn_exp2f(p0[r] * C - mn); p1[r] = __builtin_amdgcn_exp2f(p1[r] * C - mn); rsum += p0[r] + p1[r]; }
            lrun = lrun * alpha + rsum;
#pragma unroll
            for (int d = 0; d < 4; ++d)
#pragma unroll
                for (int r = 0; r < 16; ++r) o[d][r] *= alpha;
            bf16x8 pf[4];
            { u32x4 w;
              w.x = pk2(p0[0], p0[1]); w.y = pk2(p0[2], p0[3]); w.z = pk2(p0[4], p0[5]); w.w = pk2(p0[6], p0[7]); pf[0] = __builtin_bit_cast(bf16x8, w);
              w.x = pk2(p0[8], p0[9]); w.y = pk2(p0[10], p0[11]); w.z = pk2(p0[12], p0[13]); w.w = pk2(p0[14], p0[15]); pf[1] = __builtin_bit_cast(bf16x8, w);
              w.x = pk2(p1[0], p1[1]); w.y = pk2(p1[2], p1[3]); w.z = pk2(p1[4], p1[5]); w.w = pk2(p1[6], p1[7]); pf[2] = __builtin_bit_cast(bf16x8, w);
              w.x = pk2(p1[8], p1[9]); w.y = pk2(p1[10], p1[11]); w.z = pk2(p1[12], p1[13]); w.w = pk2(p1[14], p1[15]); pf[3] = __builtin_bit_cast(bf16x8, w); }
            { const LAS unsigned char* vb = lds + cur * BUFB + 64 * KP + (4 * hi + ((lane & 15) >> 2)) * VP + (16 * ((lane >> 4) & 1) + 4 * (lane & 3)) * 2;
#pragma unroll
              for (int d = 0; d < 4; ++d)
#pragma unroll
                  for (int s = 0; s < 4; ++s) { const s16x4 lo = vtr(vb + s * 16 * VP + d * 64), hh = vtr(vb + s * 16 * VP + 8 * VP + d * 64);
                      const bf16x8 vf = (bf16x8){lo[0], lo[1], lo[2], lo[3], hh[0], hh[1], hh[2], hh[3]};
                      o[d] = __builtin_amdgcn_mfma_f32_32x32x16_bf16(vf, pf[s], o[d], 0, 0, 0); } }
            if (t + 1 < NT) ATT_STORE(cur ^ 1);
            __syncthreads();
        }
        const float inv = 1.0f / (lrun + __shfl_xor(lrun, 32));
        bf16_t* op = O + (size_t)(qrow0 + wid * 32 + r32) * 1024 + h * 128;
#pragma unroll
        for (int d = 0; d < 4; ++d)
#pragma unroll
            for (int i4 = 0; i4 < 4; ++i4) { u32x2 w; w.x = pk2(o[d][4 * i4] * inv, o[d][4 * i4 + 1] * inv); w.y = pk2(o[d][4 * i4 + 2] * inv, o[d][4 * i4 + 3] * inv);
                *(u32x2*)(op + 32 * d + 8 * i4 + 4 * hi) = w; }
    }
#undef ATT_KROW
#undef ATT_LOAD
#undef ATT_STORE
}
#define DERIVE_PTRS float* MOD = (float*)(ws + WS_MOD); float* ROPE = (float*)(ws + WS_ROPE); float* YSS = (float*)(ws + WS_YSS); float* CSS = (float*)(ws + WS_CSS); float* S5E = (float*)(ws + WS_S5E); float* XC = (float*)(ws + WS_XC); bf16_t* WL = (bf16_t*)(ws + WS_WL); bf16_t* H = (bf16_t*)(ws + WS_H); unsigned char* big = ws + WS_BIG; bf16_t* CQ = (bf16_t*)(big + B_CQ); bf16_t* U = (bf16_t*)(big + B_U); bf16_t* Qb = (bf16_t*)(big + B_Q); bf16_t* KVb = (bf16_t*)(big + B_KV); bf16_t* SG = (bf16_t*)(big + B_SG); bf16_t* ACT = (bf16_t*)(big + B_ACT); bf16_t* Y = (bf16_t*)(big + B_Y); bf16_t* T = (bf16_t*)(big + B_T); bf16_t* Gb = (bf16_t*)(big + B_G); bf16_t* Mb = (bf16_t*)(big + B_M); bf16_t* Ob = H;
constexpr int NSTEPS = 2 + 14 * DEPTH;
struct Args { const float* in[29]; float* out; unsigned char* ws; int ph_lo, ph_hi; };
__global__ void __launch_bounds__(512, 2) mk_fwd(Args a) {
    extern __shared__ __attribute__((aligned(16))) unsigned char lds_raw[];
    cg::grid_group grid = cg::this_grid();
    LAS unsigned char* lds = (LAS unsigned char*)lds_raw;
    const int G = gridDim.x, NGW = G * 8;
    WPtrs WP{a.in[8], a.in[9], a.in[10], a.in[11], a.in[12], a.in[13], a.in[14], a.in[15], a.in[16], a.in[25], a.in[27], a.in[28]};
    S5In SP{a.in[17], a.in[18], a.in[19], a.in[20], a.in[21], a.in[22], a.in[23], a.in[24]};
#pragma unroll 1
    for (int step = a.ph_lo; step < a.ph_hi; ++step) {
        int tid = threadIdx.x; asm volatile("" : "+v"(tid));
        const int lane = tid & 63, wave = __builtin_amdgcn_readfirstlane(tid >> 6), gw = blockIdx.x * 8 + wave;
        unsigned char* ws = a.ws; asm volatile("" : "+s"(ws));
        DERIVE_PTRS
        int l = 0, p = -1;
        if (step >= 2) { l = (step - 2) / 14; p = (step - 2) % 14; }
        if (step == 0) mods_phase(a.in[1], a.in[3], a.in[4], a.in[5], MOD, ROPE, lds, tid);
        if (step == 0 || (p == 13 && l < DEPTH - 1)) conv_layer(WP, step == 0 ? 0 : l + 1, WL, lds, gw, NGW, wave, lane);
        if (step == 1 || p == 2 || p == 10 || p == 13) {
            int s, nl, ns;
            if (step == 1) { s = -1; nl = 0; ns = 0; } else if (p == 2) { s = 0; nl = l; ns = 1; } else if (p == 10) { s = 1; nl = l; ns = 2; } else { s = 2; nl = (l < DEPTH - 1) ? l + 1 : -1; ns = 0; }
            e_phase(a.in[0], a.in[2], a.out, XC, Y, YSS, MOD, a.in[6], a.in[7], H, l, s, nl, ns, gw, NGW, lane);
        }
        if (p == 0 || p == 1 || p == 3 || p == 4 || p == 7 || p == 8 || p == 9 || p == 11 || p == 12) {
            const int ng = (p == 4 || p == 8) ? 2 : 1;
#pragma unroll 1
            for (int gi = 0; gi < ng; ++gi) {
                pg8::Gemm g; Epi E; E.o0 = nullptr; E.o1 = nullptr; E.o2 = nullptr; E.i0 = nullptr; E.i1 = nullptr; E.ss = nullptr; E.css = CSS; E.bias = nullptr; E.rope = ROPE; E.mode = 0;
                g.M = R;
                if (p == 0 || p == 11) { g.A = H; g.Bt = WL + (p == 0 ? W_GUA : W_GUB); g.N = 5632; g.K = 1024; g.lda = 1024; E.mode = 0; E.o0 = ACT; }
                else if (p == 1 || p == 12) { g.A = ACT; g.Bt = WL + (p == 1 ? W_DA : W_DB); g.N = 1024; g.K = FF; g.lda = FF; E.mode = 1; E.o0 = Y; E.ss = YSS; }
                else if (p == 3) { g.A = H; g.Bt = WL + W_IN; g.N = 3840; g.K = 1024; g.lda = 1024; E.mode = 2; E.o0 = CQ; E.o1 = U; E.o2 = SG; E.ss = CSS; }
                else if (p == 4 && gi == 0) { g.A = CQ; g.Bt = WL + W_UQ; g.N = 1536; g.K = 256; g.lda = 768; E.mode = 3; E.o0 = Qb; }
                else if (p == 4) { g.A = CQ + 256; g.Bt = WL + W_UKV; g.N = 2048; g.K = 256; g.lda = 768; E.mode = 4; E.o0 = KVb; }
                else if (p == 7) { g.A = T; g.Bt = WL + W_GLU; g.N = 1024; g.K = 1024; g.lda = 1024; E.mode = 5; E.o0 = Gb; E.i0 = T; E.bias = a.in[26] + l * 1024; }
                else if (p == 8 && gi == 0) { g.A = Ob; g.Bt = WL + W_OMLA; g.N = 1024; g.K = 1024; g.lda = 1024; E.mode = 6; E.o0 = Mb; E.i0 = SG; }
                else if (p == 8) { g.A = Gb; g.Bt = WL + W_OS5; g.N = 1024; g.K = 1024; g.lda = 1024; E.mode = 7; E.o0 = Mb; E.i0 = Mb; E.i1 = SG + 1024; }
                else { g.A = Mb; g.Bt = WL + W_OUT; g.N = 1024; g.K = 1024; g.lda = 1024; E.mode = 1; E.o0 = Y; E.ss = YSS; }
                pg8::StaticOrder S; S.init(R, g.N, G, (int)blockIdx.x);
                pg8::gemm_phase<Epi, pg8::StaticOrder, true, true>(lds, g, S, E, tid);
            }
        }
        if (p == 5) { attn_phase(lds, Qb, KVb, CQ, Ob, tid); s5_pass1(SP, l, U, S5E, lds, gw, NGW, wave, lane); }
        if (p == 6) s5_pass2(SP, l, U, S5E, T, lds, gw, NGW, wave, lane);
        if (step + 1 < a.ph_hi) grid.sync();
    }
}

extern "C" void kernel_launch(void* const* d_in, const int* in_sizes, int n_in, void* d_out, int out_size, void* d_ws, size_t ws_size, hipStream_t stream) {
    static int grid = 0;
    if (grid == 0) {
        if (n_in != 29 || out_size != R_LAT * DM || ws_size < WS_END) { fprintf(stderr, "kernel_launch: unexpected problem (n_in %d out %d ws %zu need %zu)\n", n_in, out_size, ws_size, (size_t)WS_END); grid = -1; return; }
        int dev = 0, cus = 0, per_cu = 0;
        if (hipGetDevice(&dev) != hipSuccess || hipDeviceGetAttribute(&cus, hipDeviceAttributeMultiprocessorCount, dev) != hipSuccess) { grid = -1; return; }
        if (hipFuncSetAttribute((const void*)mk_fwd, hipFuncAttributeMaxDynamicSharedMemorySize, LDS_BYTES) != hipSuccess) { fprintf(stderr, "kernel_launch: hipFuncSetAttribute failed\n"); grid = -1; return; }
        if (hipOccupancyMaxActiveBlocksPerMultiprocessor(&per_cu, (const void*)mk_fwd, 512, LDS_BYTES) != hipSuccess || per_cu < 1) { fprintf(stderr, "kernel_launch: occupancy query says %d\n", per_cu); per_cu = 1; }
        (void)hipGetLastError();
        grid = cus * 1;
    }
    if (grid < 0) return;
    Args a{};
    for (int i = 0; i < 29; ++i) a.in[i] = (const float*)d_in[i];
    a.out = (float*)d_out; a.ws = (unsigned char*)d_ws;
#if MK_MULTI
    for (int s = 0; s < NSTEPS; ++s) { a.ph_lo = s; a.ph_hi = s + 1; void* args[] = {&a};
        hipError_t e = hipLaunchCooperativeKernel((const void*)mk_fwd, dim3(grid), dim3(512), args, LDS_BYTES, stream);
        if (e != hipSuccess) { fprintf(stderr, "cooperative launch %d failed: %s\n", s, hipGetErrorString(e)); break; } }
#else
    a.ph_lo = 0; a.ph_hi = NSTEPS; void* args[] = {&a};
    hipError_t e = hipLaunchCooperativeKernel((const void*)mk_fwd, dim3(grid), dim3(512), args, LDS_BYTES, stream);
    if (e != hipSuccess) fprintf(stderr, "cooperative launch failed: %s (grid %d)\n", hipGetErrorString(e), grid);
#endif
}
```

```cpp
#include <hip/hip_runtime.h>
#include <hip/hip_cooperative_groups.h>
#include <cstdio>
#include <cstdint>
namespace cg = cooperative_groups;
#ifndef MK_MULTI
#define MK_MULTI 0
#endif
#ifndef MK_PROBE
#define MK_PROBE 0
#endif
namespace pg8 {
#define PG8_LAS __attribute__((address_space(3)))
typedef unsigned short bf16_t;
typedef short bf16x8 __attribute__((ext_vector_type(8)));
typedef float f32x4 __attribute__((ext_vector_type(4)));
typedef unsigned u32x4 __attribute__((ext_vector_type(4)));
constexpr int BM = 256, BK = 64, HALF = 128, HTB = HALF * BK * 2  , STAGE_BYTES = 8 * HTB, NXCD = 8, WGM = 8;

__host__ __device__ __forceinline__ int lds_byte(int r, int c) { const int st = (r >> 4) * 2 + (c >> 5), rr = r & 15, cc = c & 31, ob = rr * 64 + cc * 2; return st * 1024 + (ob ^ (((ob >> 9) & 1) << 5)); }
__host__ __device__ __forceinline__ void stage_rc(int b, int& R, int& C) { const int st = b / 1024, sb = b % 1024, swz = sb ^ (((sb >> 9) & 1) << 5); R = (st >> 1) * 16 + swz / 64; C = (st & 1) * 32 + (swz % 64) / 2; }
__host__ __device__ __forceinline__ int perm32(int rho) { const int n = rho >> 4, i = rho & 15; return 8 * (i >> 2) + 4 * n + (i & 3); }

struct Unit { int pm, pn; };
struct Gemm { const bf16_t* A; const bf16_t* Bt; int M, N, K, lda; };

struct StaticOrder {
    int nM, nN, nwg, G, c;
    __host__ __device__ void init(int M, int N, int G_, int c_) { nM = M / BM; nN = N / BM; nwg = nM * nN; G = G_; c = c_; }
    __host__ __device__ bool next(int i, Unit& u) const {
        const long L = (long)i * G + c; if (L >= nwg) return false;
        int wgid = (int)L; { const int q = nwg / NXCD, r = nwg % NXCD, xcd = wgid % NXCD, off = wgid / NXCD; wgid = (xcd < r ? xcd * (q + 1) : r * (q + 1) + (xcd - r) * q) + off; }
        const int nig = WGM * nN, gid = wgid / nig, fm = gid * WGM, gsz = (nM - fm) < WGM ? (nM - fm) : WGM;
        u.pm = fm + ((wgid % nig) % gsz); u.pn = (wgid % nig) / gsz; return true;
    }
    __device__ __forceinline__ void a_ready(const Unit&) const {}
    __device__ __forceinline__ void done(const Unit&) const {}
};

__device__ __forceinline__ unsigned cvt_pk_bf16(float lo, float hi) { unsigned r; asm volatile("v_cvt_pk_bf16_f32 %0, %1, %2" : "=v"(r) : "v"(lo), "v"(hi)); return r; }
template <class Epi, class Sched, bool ALIGN_EPI = false, bool SP2 = false>
__device__ __forceinline__ void gemm_phase(PG8_LAS unsigned char* lds, const Gemm g, const Sched& S, const Epi& E, const int tid) {
    const int wid = __builtin_amdgcn_readfirstlane(tid >> 6), lane = tid & 63, wr = wid >> 2, wc = wid & 3, fr = lane & 15, fq = lane >> 4;
    const int K = g.K, nt = K / BK;
    unsigned voffA[2], voffB[2];
#pragma unroll
    for (int i = 0; i < 2; ++i) { int R, C; stage_rc(tid * 16 + i * 8192, R, C); const int Rb = Epi::PERM ? ((R & ~31) + perm32(R & 31)) : R;
        voffA[i] = (unsigned)(R * g.lda + C) * 2u; voffB[i] = (unsigned)(Rb * K + C) * 2u; }
    const size_t kstep = (size_t)(BK * 2);
    const size_t hstep = (size_t)HALF * K * 2;
    const size_t tstep = 2 * hstep; const size_t hstepA = (size_t)HALF * g.lda * 2, tstepA = 2 * hstepA;
    const unsigned ldsw = (unsigned)wid * 1024u;
    const int aoff = lds_byte(wr * 64 + fr, fq * 8), boff = lds_byte(wc * 32 + fr, fq * 8);
#define PG8_SA(b, h) (((b) * 2 + (h)) * HTB)
#define PG8_SB(b, h) ((4 + (b) * 2 + (h)) * HTB)
#define PG8_STAGE(bufoff, gbase, voff) do { _Pragma("unroll") for (int _i = 0; _i < 2; ++_i) \
        __builtin_amdgcn_global_load_lds((const unsigned*)((const char*)(gbase) + (voff)[_i]), (PG8_LAS unsigned*)(lds + (bufoff) + ldsw + _i * 8192), 16, 0, 0); } while (0)
#define PG8_LDA(dst, b, h) do { _Pragma("unroll") for (int m = 0; m < 4; ++m) _Pragma("unroll") for (int k = 0; k < 2; ++k) dst[m][k] = *(const PG8_LAS bf16x8*)(lds + PG8_SA(b, h) + aoff + m * 2048 + k * 1024); } while (0)
#define PG8_LDB(dst, b, h) do { _Pragma("unroll") for (int n = 0; n < 2; ++n) _Pragma("unroll") for (int k = 0; k < 2; ++k) dst[n][k] = *(const PG8_LAS bf16x8*)(lds + PG8_SB(b, h) + boff + n * 2048 + k * 1024); } while (0)
#define PG8_MMA(ai, bj, At, Bt) do { __builtin_amdgcn_s_setprio(1); _Pragma("unroll") for (int m = 0; m < 4; ++m) _Pragma("unroll") for (int n = 0; n < 2; ++n) _Pragma("unroll") for (int k = 0; k < 2; ++k) \
        acc[ai][bj][m][n] = __builtin_amdgcn_mfma_f32_16x16x32_bf16(Bt[n][k], At[m][k], acc[ai][bj][m][n], 0, 0, 0); __builtin_amdgcn_s_setprio(0); } while (0)
#define PG8_WAIT_V(n) asm volatile("s_waitcnt vmcnt(" #n ")" ::: "memory")
#define PG8_WAIT_L(n) asm volatile("s_waitcnt lgkmcnt(" #n ")" ::: "memory")
#define PG8_BAR __builtin_amdgcn_s_barrier()
#define PG8_SCHED __builtin_amdgcn_sched_barrier(0)
    Unit cur, nxt; int ui = 0;
    if (!S.next(0, cur)) return;
    f32x4 acc[2][2][4][2];
#pragma unroll
    for (int a = 0; a < 2; ++a)
#pragma unroll
        for (int b = 0; b < 2; ++b)
#pragma unroll
            for (int m = 0; m < 4; ++m)
#pragma unroll
                for (int n = 0; n < 2; ++n) acc[a][b][m][n] = (f32x4){0.f, 0.f, 0.f, 0.f};
    bf16x8 At[4][2], B0[2][2], B1[2][2];
    const char* cA = (const char*)g.A + (size_t)cur.pm * tstepA; const char* cB = (const char*)g.Bt + (size_t)cur.pn * tstep;
    S.a_ready(cur);
    if constexpr (SP2) {
        PG8_STAGE(PG8_SB(0, 0), cB, voffB); PG8_STAGE(PG8_SB(0, 1), cB + hstep, voffB); PG8_STAGE(PG8_SA(0, 0), cA, voffA); PG8_STAGE(PG8_SA(0, 1), cA + hstepA, voffA);
        if (wr == 1) PG8_BAR;
        PG8_WAIT_V(2); PG8_BAR;
        PG8_STAGE(PG8_SB(1, 0), cB + kstep, voffB); PG8_STAGE(PG8_SA(1, 0), cA + kstep, voffA); PG8_STAGE(PG8_SB(1, 1), cB + hstep + kstep, voffB);
        PG8_WAIT_V(6); PG8_BAR;
    } else {
        PG8_STAGE(PG8_SB(0, 0), cB, voffB); PG8_STAGE(PG8_SA(0, 0), cA, voffA); PG8_STAGE(PG8_SB(0, 1), cB + hstep, voffB); PG8_STAGE(PG8_SA(0, 1), cA + hstepA, voffA);
        if (wr == 1) PG8_BAR;
        PG8_WAIT_V(4); PG8_BAR;
        PG8_STAGE(PG8_SB(1, 0), cB + kstep, voffB); PG8_STAGE(PG8_SA(1, 0), cA + kstep, voffA); PG8_STAGE(PG8_SB(1, 1), cB + hstep + kstep, voffB);
        PG8_WAIT_V(6); PG8_BAR;
    }
    for (;;) {
        const bool has_next = S.next(ui + 1, nxt);
        const char* nA = has_next ? (const char*)g.A + (size_t)nxt.pm * tstepA : cA; const char* nB = has_next ? (const char*)g.Bt + (size_t)nxt.pn * tstep : cB;
        for (int t = 0; t < nt; t += 2) {
            const bool last = (t == nt - 2);
            const char* a1 = cA + (size_t)(t + 1) * kstep;
            const char* a2 = last ? nA : cA + (size_t)(t + 2) * kstep; const char* b2 = last ? nB : cB + (size_t)(t + 2) * kstep;
            const char* a3 = a2 + kstep; const char* b3 = b2 + kstep;
            if (last && has_next) S.a_ready(nxt);
            if constexpr (SP2) {
            PG8_LDB(B0, 0, 0); PG8_LDB(B1, 0, 1); PG8_SCHED; PG8_LDA(At, 0, 0); PG8_STAGE(PG8_SA(1, 1), a1 + hstepA, voffA);
            PG8_WAIT_V(8); PG8_WAIT_L(0); PG8_BAR; PG8_MMA(0, 0, At, B0); PG8_MMA(0, 1, At, B1); PG8_BAR; PG8_SCHED;
            PG8_LDA(At, 0, 1); PG8_STAGE(PG8_SB(0, 0), b2, voffB); PG8_STAGE(PG8_SB(0, 1), b2 + hstep, voffB); PG8_STAGE(PG8_SA(0, 0), a2, voffA);
            PG8_WAIT_V(8); PG8_WAIT_L(0); PG8_BAR; PG8_MMA(1, 0, At, B0); PG8_MMA(1, 1, At, B1); PG8_BAR; PG8_SCHED;
            PG8_LDB(B0, 1, 0); PG8_LDB(B1, 1, 1); PG8_SCHED; PG8_LDA(At, 1, 0); PG8_STAGE(PG8_SA(0, 1), a2 + hstepA, voffA);
            PG8_WAIT_V(8); PG8_WAIT_L(0); PG8_BAR; PG8_MMA(0, 0, At, B0); PG8_MMA(0, 1, At, B1); PG8_BAR; PG8_SCHED;
            PG8_LDA(At, 1, 1); PG8_STAGE(PG8_SB(1, 0), b3, voffB); PG8_STAGE(PG8_SB(1, 1), b3 + hstep, voffB); PG8_STAGE(PG8_SA(1, 0), a3, voffA);
            PG8_WAIT_V(8); PG8_WAIT_L(0); PG8_BAR; PG8_MMA(1, 0, At, B0); PG8_MMA(1, 1, At, B1); PG8_BAR; PG8_SCHED;
            } else {
            PG8_LDB(B0, 0, 0); PG8_SCHED; PG8_LDA(At, 0, 0); PG8_STAGE(PG8_SA(1, 1), a1 + hstepA, voffA);
            PG8_WAIT_L(8); PG8_BAR; PG8_WAIT_L(0); PG8_MMA(0, 0, At, B0); PG8_BAR; PG8_SCHED;
            PG8_LDB(B1, 0, 1); PG8_STAGE(PG8_SB(0, 0), b2, voffB);
            PG8_BAR; PG8_WAIT_L(0); PG8_MMA(0, 1, At, B1); PG8_BAR;
            PG8_LDA(At, 0, 1); PG8_STAGE(PG8_SA(0, 0), a2, voffA);
            PG8_BAR; PG8_WAIT_L(0); PG8_MMA(1, 0, At, B0); PG8_BAR; PG8_SCHED;
            PG8_STAGE(PG8_SB(0, 1), b2 + hstep, voffB);
            PG8_WAIT_V(6); PG8_BAR; PG8_MMA(1, 1, At, B1); PG8_BAR;
            PG8_LDB(B0, 1, 0); PG8_SCHED; PG8_LDA(At, 1, 0); PG8_STAGE(PG8_SA(0, 1), a2 + hstepA, voffA);
            PG8_WAIT_L(8); PG8_BAR; PG8_WAIT_L(0); PG8_MMA(0, 0, At, B0); PG8_BAR; PG8_SCHED;
            PG8_LDB(B1, 1, 1); PG8_STAGE(PG8_SB(1, 0), b3, voffB);
            PG8_BAR; PG8_WAIT_L(0); PG8_MMA(0, 1, At, B1); PG8_BAR;
            PG8_LDA(At, 1, 1); PG8_STAGE(PG8_SA(1, 0), a3, voffA);
            PG8_BAR; PG8_WAIT_L(0); PG8_MMA(1, 0, At, B0); PG8_BAR; PG8_SCHED;
            PG8_STAGE(PG8_SB(1, 1), b3 + hstep, voffB);
            PG8_WAIT_V(6); PG8_BAR; PG8_MMA(1, 1, At, B1); PG8_BAR;
            }
        }
        if constexpr (ALIGN_EPI) { if (wr == 0) PG8_BAR; }
        if constexpr (!Epi::AFTER_DRAIN) { E(acc, cur, wr, wc, fr, fq); S.done(cur); }
        if (!has_next) break;
#pragma unroll
        for (int a = 0; a < 2; ++a)
#pragma unroll
            for (int b = 0; b < 2; ++b)
#pragma unroll
                for (int m = 0; m < 4; ++m)
#pragma unroll
                    for (int n = 0; n < 2; ++n) acc[a][b][m][n] = (f32x4){0.f, 0.f, 0.f, 0.f};
        cur = nxt; cA = nA; cB = nB; ++ui;
        if constexpr (ALIGN_EPI) { if (wr == 1) PG8_BAR; }
    }
    PG8_WAIT_V(0);
    if constexpr (!ALIGN_EPI) { if (wr == 0) PG8_BAR; }
    PG8_BAR;
    if constexpr (Epi::AFTER_DRAIN) { E.fused(acc, cur, wr, wc, fr, fq, lds, wid, lane); S.done(cur); }
#undef PG8_SA
#undef PG8_SB
#undef PG8_STAGE
#undef PG8_LDA
#undef PG8_LDB
#undef PG8_MMA
#undef PG8_WAIT_V
#undef PG8_WAIT_L
#undef PG8_BAR
#undef PG8_SCHED
}
}
using pg8::bf16_t; using pg8::f32x4; using pg8::u32x4; using pg8::bf16x8; using pg8::Unit;
#define LAS __attribute__((address_space(3)))
typedef float f32x16 __attribute__((ext_vector_type(16)));
typedef unsigned u32x2 __attribute__((ext_vector_type(2)));
typedef short s16x4 __attribute__((ext_vector_type(4)));
constexpr int NB = 8, SEQ = 4096, CTXL = 256, DM = 1024, FF = 2816, DEPTH = 4, NH = 8;
constexpr int R_LAT = NB * SEQ, R_CTX = NB * CTXL, R = R_LAT + R_CTX;
constexpr float EPS = 1e-6f;
constexpr int NCH = 34;
constexpr size_t W_GUA = 0, W_DA = W_GUA + (size_t)5632 * 1024, W_GUB = W_DA + (size_t)1024 * 2816, W_DB = W_GUB + (size_t)5632 * 1024,
                 W_IN = W_DB + (size_t)1024 * 2816, W_UQ = W_IN + (size_t)3840 * 1024, W_UKV = W_UQ + (size_t)1536 * 256, W_OMLA = W_UKV + (size_t)2048 * 256,
                 W_GLU = W_OMLA + (size_t)1024 * 1024, W_OS5 = W_GLU + (size_t)1024 * 1024, W_OUT = W_OS5 + (size_t)1024 * 1024, W_END = W_OUT + (size_t)1024 * 1024;
constexpr size_t al256(size_t x) { return (x + 255) & ~(size_t)255; }
constexpr size_t WS_MOD = 0;
constexpr size_t WS_ROPE = WS_MOD + al256((size_t)4 * 9 * 9216 * 4);
constexpr size_t WS_YSS = WS_ROPE + al256(64 * 16 * 8);
constexpr size_t WS_CSS = WS_YSS + al256((size_t)R * 16 * 4);
constexpr size_t WS_S5E = WS_CSS + al256((size_t)R * 8 * 4);
constexpr size_t S5_WE_BYTES = (size_t)2 * 64 * 128 * 256 * 2, S5_WY_BYTES = (size_t)64 * 256 * 512 * 2;
constexpr size_t WS_XC = WS_S5E + al256(S5_WE_BYTES + S5_WY_BYTES);
constexpr size_t WS_WL = WS_XC + al256((size_t)R_CTX * DM * 4);
constexpr size_t WS_H = WS_WL + al256(W_END * 2);
constexpr size_t WS_BIG = WS_H + al256((size_t)R * DM * 2);
constexpr size_t B_CQ = 0, B_U = B_CQ + (size_t)R * 768 * 2, B_Q = B_U + (size_t)R * 1024 * 2, B_KV = B_Q + (size_t)R * 1536 * 2, B_SG = B_KV + (size_t)R * 2048 * 2, B_END = B_SG + (size_t)R * 2048 * 2;
constexpr size_t B_ACT = 0, B_Y = (size_t)R * FF * 2;
constexpr size_t B_T = B_Q, B_G = B_KV, B_M = B_U;
static_assert(B_Y >= B_T + (size_t)R * 1024 * 2 && B_Y + (size_t)R * 1024 * 2 <= B_SG, "Y overlay");
constexpr size_t WS_END = WS_BIG + B_END;
constexpr int LDS_BYTES = 272 * 528 + 16384 + 256;

__device__ __forceinline__ float bf2f(unsigned h) { return __uint_as_float(h << 16); }
__device__ __forceinline__ unsigned pk2(float lo, float hi) { return pg8::cvt_pk_bf16(lo, hi); }
__device__ __forceinline__ float sigm(float x) { return __builtin_amdgcn_rcpf(1.f + __builtin_amdgcn_exp2f(-1.4426950408889634f * x)); }
__device__ __forceinline__ float gelu_tanh(float x) { return x * sigm(1.5957691216057308f * (x + 0.044715f * x * x * x)); }
__device__ __forceinline__ void unpack8(const u32x4 w, float (&f)[8]) {
    f[0] = bf2f(w.x & 0xffffu); f[1] = __uint_as_float(w.x & 0xffff0000u); f[2] = bf2f(w.y & 0xffffu); f[3] = __uint_as_float(w.y & 0xffff0000u);
    f[4] = bf2f(w.z & 0xffffu); f[5] = __uint_as_float(w.z & 0xffff0000u); f[6] = bf2f(w.w & 0xffffu); f[7] = __uint_as_float(w.w & 0xffff0000u);
}
__device__ __forceinline__ u32x4 pack8(const float (&f)[8]) { u32x4 w; w.x = pk2(f[0], f[1]); w.y = pk2(f[2], f[3]); w.z = pk2(f[4], f[5]); w.w = pk2(f[6], f[7]); return w; }
__device__ __forceinline__ float wave_sum(float v) {
#pragma unroll
    for (int o = 1; o < 64; o <<= 1) v += __shfl_xor(v, o);
    return v;
}
__device__ __forceinline__ void rope8(float (&v)[8], int row, int wc, int fq, const float* tab) {
    const int t = row & 4095, pos = (wc & 1) ? (t & 63) : (t >> 6);
    const f32x4* tp = (const f32x4*)(tab + (pos * 16 + 8 * (fq & 1)) * 2);
    const f32x4 t0 = tp[0], t1 = tp[1], t2 = tp[2], t3 = tp[3];
    const float cs[8] = {t0[0], t0[2], t1[0], t1[2], t2[0], t2[2], t3[0], t3[2]}, sn[8] = {t0[1], t0[3], t1[1], t1[3], t2[1], t2[3], t3[1], t3[3]};
    const float sgn = (fq < 2) ? -1.f : 1.f;
#pragma unroll
    for (int j = 0; j < 8; ++j) { const float p = __shfl_xor(v[j], 32); v[j] = v[j] * cs[j] + sgn * p * sn[j]; }
}

struct Epi {
    static constexpr bool PERM = true, AFTER_DRAIN = false;
    int mode;
    bf16_t* o0; bf16_t* o1; bf16_t* o2; const bf16_t* i0; const bf16_t* i1; float* ss; const float* css; const float* bias; const float* rope;
    __device__ __forceinline__ void operator()(const f32x4 (&acc)[2][2][4][2], const Unit& u, int wr, int wc, int fr, int fq) const {
        const int row0 = u.pm * 256 + wr * 64 + fr, cb = wc * 32 + 8 * fq, pn = u.pn;
        if (mode == 0) {
            bf16_t* base = o0 + (size_t)pn * 128 + cb;
#pragma unroll
            for (int ai = 0; ai < 2; ++ai)
#pragma unroll
                for (int m = 0; m < 4; ++m) { const int row = row0 + ai * 128 + m * 16; float v[8];
#pragma unroll
                    for (int n = 0; n < 2; ++n)
#pragma unroll
                        for (int j = 0; j < 4; ++j) { const float g = acc[ai][0][m][n][j], up = acc[ai][1][m][n][j]; v[4 * n + j] = g * sigm(g) * up; }
                    *(u32x4*)(base + (size_t)row * FF) = pack8(v); }
        } else if (mode == 1) {
            bf16_t* base = o0 + pn * 256 + cb;
#pragma unroll
            for (int ai = 0; ai < 2; ++ai)
#pragma unroll
                for (int m = 0; m < 4; ++m) { const int row = row0 + ai * 128 + m * 16; float s = 0.f;
#pragma unroll
                    for (int bj = 0; bj < 2; ++bj) { float v[8];
#pragma unroll
                        for (int n = 0; n < 2; ++n)
#pragma unroll
                            for (int j = 0; j < 4; ++j) { const float x = acc[ai][bj][m][n][j]; v[4 * n + j] = x; s += x * x; }
                        *(u32x4*)(base + (size_t)row * 1024 + bj * 128) = pack8(v); }
                    s += __shfl_xor(s, 16); s += __shfl_xor(s, 32);
                    if (fq == 0) ss[row * 16 + pn * 4 + wc] = s; }
        } else if (mode == 2) {
            bf16_t* dst; int ldc;
            if (pn < 3) { dst = o0 + pn * 256; ldc = 768; } else if (pn < 7) { dst = o1 + (pn - 3) * 256; ldc = 1024; } else { dst = o2 + (pn - 7) * 256; ldc = 2048; }
            const bool sg = pn >= 7, docss = pn < 2, dorope = (pn == 2) && (u.pm < 128) && (wc < 2);
            dst += cb;
#pragma unroll
            for (int ai = 0; ai < 2; ++ai)
#pragma unroll
                for (int m = 0; m < 4; ++m) { const int row = row0 + ai * 128 + m * 16; float s = 0.f;
#pragma unroll
                    for (int bj = 0; bj < 2; ++bj) { float v[8];
#pragma unroll
                        for (int n = 0; n < 2; ++n)
#pragma unroll
                            for (int j = 0; j < 4; ++j) { float x = acc[ai][bj][m][n][j]; if (sg) x = sigm(x); v[4 * n + j] = x; s += x * x; }
                        if (bj == 0 && dorope) rope8(v, row, wc, fq, rope);
                        *(u32x4*)(dst + (size_t)row * ldc + bj * 128) = pack8(v); }
                    if (docss) { s += __shfl_xor(s, 16); s += __shfl_xor(s, 32); if (fq == 0) ss[row * 8 + pn * 4 + wc] = s; } }
        } else if (mode == 3 || mode == 4) {
            const int ldc = (mode == 3) ? 1536 : 2048; const float* cp = css + ((mode == 3) ? 0 : 4);
            const bool dorope = (mode == 3) && (pn >= 4) && (u.pm < 128);
            bf16_t* dst = o0 + pn * 256 + cb;
#pragma unroll
            for (int ai = 0; ai < 2; ++ai)
#pragma unroll
                for (int m = 0; m < 4; ++m) { const int row = row0 + ai * 128 + m * 16; const f32x4 c4 = *(const f32x4*)(cp + row * 8);
                    const float rs = 1.0f / sqrtf(((c4[0] + c4[1]) + (c4[2] + c4[3])) * (1.0f / 256.0f) + EPS);
#pragma unroll
                    for (int bj = 0; bj < 2; ++bj) { float v[8];
#pragma unroll
                        for (int n = 0; n < 2; ++n)
#pragma unroll
                            for (int j = 0; j < 4; ++j) v[4 * n + j] = acc[ai][bj][m][n][j] * rs;
                        if (dorope) rope8(v, row, wc, fq, rope);
                        *(u32x4*)(dst + (size_t)row * ldc + bj * 128) = pack8(v); } }
        } else {
            const int col = pn * 256 + cb;
#pragma unroll
            for (int ai = 0; ai < 2; ++ai)
#pragma unroll
                for (int m = 0; m < 4; ++m) { const int row = row0 + ai * 128 + m * 16;
#pragma unroll
                    for (int bj = 0; bj < 2; ++bj) { const int c = col + bj * 128; float v[8], a[8], b[8];
#pragma unroll
                        for (int n = 0; n < 2; ++n)
#pragma unroll
                            for (int j = 0; j < 4; ++j) v[4 * n + j] = acc[ai][bj][m][n][j];
                        if (mode == 5) { unpack8(*(const u32x4*)(i0 + (size_t)row * 1024 + c), a); const f32x4 b0 = *(const f32x4*)(bias + c), b1 = *(const f32x4*)(bias + c + 4);
#pragma unroll
                            for (int j = 0; j < 4; ++j) { v[j] = a[j] * sigm(v[j] + b0[j]); v[4 + j] = a[4 + j] * sigm(v[4 + j] + b1[j]); } }
                        else if (mode == 6) { unpack8(*(const u32x4*)(i0 + (size_t)row * 2048 + c), a);
#pragma unroll
                            for (int j = 0; j < 8; ++j) v[j] = a[j] * v[j]; }
                        else { unpack8(*(const u32x4*)(i0 + (size_t)row * 1024 + c), a); unpack8(*(const u32x4*)(i1 + (size_t)row * 2048 + c), b);
#pragma unroll
                            for (int j = 0; j < 8; ++j) v[j] = a[j] + b[j] * v[j]; }
                        *(u32x4*)(o0 + (size_t)row * 1024 + c) = pack8(v); } }
        }
    }
};
__device__ __forceinline__ void conv_item(const float* W, int ldsrc, int srccol, const float* kscale, bf16_t* WT, int K, int n0, int k0, LAS float* scr, int lane) {
    if (srccol >= 0) {
#pragma unroll 8
        for (int i = 0; i < 32; ++i) { const int kk = 2 * i + (lane >> 5); float w = W[(size_t)(k0 + kk) * ldsrc + srccol + (lane & 31)]; if (kscale) w *= kscale[k0 + kk]; scr[kk * 33 + (lane & 31)] = w; }
    } else {
#pragma unroll 8
        for (int i = 0; i < 32; ++i) { const int kk = 2 * i + (lane >> 5); scr[kk * 33 + (lane & 31)] = 0.f; }
    }
    asm volatile("s_waitcnt lgkmcnt(0)" ::: "memory");
    const int c = lane & 7;
#pragma unroll
    for (int j = 0; j < 4; ++j) { const int n = (lane >> 3) + 8 * j; const LAS float* s = scr + (8 * c) * 33 + n;
        u32x4 o; o.x = pk2(s[0 * 33], s[1 * 33]); o.y = pk2(s[2 * 33], s[3 * 33]); o.z = pk2(s[4 * 33], s[5 * 33]); o.w = pk2(s[6 * 33], s[7 * 33]);
        *(u32x4*)(WT + (size_t)(n0 + n) * K + k0 + 8 * c) = o; }
    asm volatile("s_waitcnt lgkmcnt(0)" ::: "memory");
}
struct WPtrs { const float *gate, *up, *down, *win, *qn, *wuq, *kvn, *wukv, *womla, *glu, *wos5, *wout; };
__device__ __forceinline__ void conv_layer(const WPtrs& P, int l, bf16_t* WL, LAS unsigned char* lds, int gw, int NGW, int wave, int lane) {
    LAS float* scr = (LAS float*)(lds + wave * 16384);
    constexpr int I_GU = 16 * 176, I_D = 44 * 32, I_IN = 16 * 120, I_UQ = 4 * 48, I_UKV = 4 * 64, I_SQ = 16 * 32;
    constexpr int NIT = 2 * I_GU + 2 * I_D + I_IN + I_UQ + I_UKV + 4 * I_SQ;
    for (int it = gw; it < NIT; it += NGW) {
        int r = it;
        if (r < 2 * I_GU) { const int f = r / I_GU; r -= f * I_GU; const int nb = r % 176, kb = r / 176, n0 = nb * 32, tile = n0 >> 8, within = n0 & 255, half = within >> 7, ffc = tile * 128 + (within & 127);
            const size_t so = (size_t)(l * 2 + f) * 1024 * FF; bf16_t* dst = WL + (f ? W_GUB : W_GUA);
            if (half) conv_item(P.up + so, FF, ffc, nullptr, dst, 1024, n0, kb * 64, scr, lane); else conv_item(P.gate + so, FF, ffc, nullptr, dst, 1024, n0, kb * 64, scr, lane);
            continue; }
        r -= 2 * I_GU;
        if (r < 2 * I_D) { const int f = r / I_D; r -= f * I_D; const int nb = r % 32, kb = r / 32;
            conv_item(P.down + (size_t)(l * 2 + f) * FF * 1024, 1024, nb * 32, nullptr, WL + (f ? W_DB : W_DA), FF, nb * 32, kb * 64, scr, lane); continue; }
        r -= 2 * I_D;
        if (r < I_IN) { const int nb = r % 120, kb = r / 120, n0 = nb * 32; int sc;
            if (n0 < 512) sc = n0; else if (n0 < 768) sc = (n0 < 576) ? n0 : -1; else sc = n0 - 768 + 576;
            conv_item(P.win + (size_t)l * 1024 * 3648, 3648, sc, nullptr, WL + W_IN, 1024, n0, kb * 64, scr, lane); continue; }
        r -= I_IN;
        if (r < I_UQ) { const int nb = r % 48, kb = r / 48, n0 = nb * 32; int sc;
            if (n0 < 1024) sc = (n0 >> 7) * 192 + (n0 & 127); else { const int rr = n0 - 1024; sc = (rr >> 6) * 192 + 128 + (rr & 63); }
            conv_item(P.wuq + (size_t)l * 256 * 1536, 1536, sc, P.qn + l * 256, WL + W_UQ, 256, n0, kb * 64, scr, lane); continue; }
        r -= I_UQ;
        if (r < I_UKV) { const int nb = r % 64, kb = r / 64;
            conv_item(P.wukv + (size_t)l * 256 * 2048, 2048, nb * 32, P.kvn + l * 256, WL + W_UKV, 256, nb * 32, kb * 64, scr, lane); continue; }
        r -= I_UKV;
        { const int q = r / I_SQ; r -= q * I_SQ; const int nb = r % 32, kb = r / 32; const size_t so = (size_t)l * 1024 * 1024;
          if (q == 0) conv_item(P.womla + so, 1024, nb * 32, nullptr, WL + W_OMLA, 1024, nb * 32, kb * 64, scr, lane);
          else if (q == 1) conv_item(P.glu + so, 1024, nb * 32, nullptr, WL + W_GLU, 1024, nb * 32, kb * 64, scr, lane);
          else if (q == 2) conv_item(P.wos5 + so, 1024, nb * 32, nullptr, WL + W_OS5, 1024, nb * 32, kb * 64, scr, lane);
          else conv_item(P.wout + so, 1024, nb * 32, nullptr, WL + W_OUT, 1024, nb * 32, kb * 64, scr, lane); }
    }
}

__device__ __forceinline__ void mods_phase(const float* c, const float* c_ctx, const float* ada_w, const float* ada_b, float* MOD, float* ROPE, LAS unsigned char* lds, const int tid) {

    LAS float* sc = (LAS float*)lds;
    LAS float* red = (LAS float*)(lds + 9 * 1024 * 4);
    if (blockIdx.x == gridDim.x - 1) {
        for (int e = tid; e < 1024; e += 512) { const int pos = e >> 4, i = e & 15; const float inv = exp2f(-(float)i * (13.287712379549449f / 16.0f)); const float ang = (float)pos * inv;
            float sn_, cs_; sincosf(ang, &sn_, &cs_); ROPE[2 * e] = cs_; ROPE[2 * e + 1] = sn_; }
    }
    bool have = false;
    for (int item = blockIdx.x; item < 576; item += gridDim.x) {
        if (!have) { for (int e = tid; e < 9 * 1024; e += 512) { const float v = (e < 8192) ? c[e] : c_ctx[e - 8192]; sc[e] = v * sigm(v); } have = true; }
        __syncthreads();
        const int l = item / 144, j0 = (item % 144) * 64, ks = tid >> 6, jj = tid & 63;
        const float* w = ada_w + ((size_t)l * 1024 + ks * 128) * 9216 + j0 + jj;
        float a[9];
#pragma unroll
        for (int s = 0; s < 9; ++s) a[s] = 0.f;
#pragma unroll 4
        for (int k = 0; k < 128; ++k) { const float wv = w[(size_t)k * 9216];
#pragma unroll
            for (int s = 0; s < 9; ++s) a[s] += sc[s * 1024 + ks * 128 + k] * wv; }
#pragma unroll
        for (int s = 0; s < 9; ++s) red[(ks * 9 + s) * 64 + jj] = a[s];
        __syncthreads();
        for (int e = tid; e < 576; e += 512) { const int s = e >> 6, j = e & 63; float t = 0.f;
#pragma unroll
            for (int q = 0; q < 8; ++q) t += red[(q * 9 + s) * 64 + j];
            MOD[((size_t)l * 9 + s) * 9216 + j0 + j] = t + ada_b[l * 9216 + j0 + j]; }
    }
    __syncthreads();
}

__device__ __forceinline__ void e_phase(const float* xin, const float* ctxin, float* xl, float* xc, const bf16_t* Y, const float* YSS, const float* MOD,
                                        const float* npre, const float* npost, bf16_t* H, int l, int s, int nl, int ns, int gw, int NGW, int lane) {
    for (int row = gw; row < R; row += NGW) {
        const bool lat = row < R_LAT; const int set = lat ? (row >> 12) : 8;
        float* xr = lat ? xl + (size_t)row * DM : xc + (size_t)(row - R_LAT) * DM;
        const float* xs = (s < 0) ? (lat ? xin + (size_t)row * DM : ctxin + (size_t)(row - R_LAT) * DM) : xr;
        f32x4 v[4];
#pragma unroll
        for (int j = 0; j < 4; ++j) v[j] = ((const f32x4*)xs)[lane + 64 * j];
        if (s >= 0) {
            const float part = (lane < 16) ? YSS[row * 16 + lane] : 0.f;
            const float rs = 1.0f / sqrtf(wave_sum(part) * (1.0f / 1024.0f) + EPS);
            const float wgt = (s == 1) ? 1.0f : 0.5f;
            const float* gate = MOD + ((size_t)(l * 9 + set) * 9 + 3 * s + 2) * 1024; const float* gp = npost + (l * 3 + s) * 1024;
#pragma unroll
            for (int j = 0; j < 4; ++j) { const u32x2 yw = ((const u32x2*)(Y + (size_t)row * DM))[lane + 64 * j];
                const f32x4 g4 = ((const f32x4*)gate)[lane + 64 * j], p4 = ((const f32x4*)gp)[lane + 64 * j];
                f32x4 y4; y4[0] = bf2f(yw.x & 0xffffu); y4[1] = __uint_as_float(yw.x & 0xffff0000u); y4[2] = bf2f(yw.y & 0xffffu); y4[3] = __uint_as_float(yw.y & 0xffff0000u);
                v[j] += (wgt * rs) * g4 * y4 * p4; }
        }
#pragma unroll
        for (int j = 0; j < 4; ++j) ((f32x4*)xr)[lane + 64 * j] = v[j];
        if (nl >= 0) {
            float q = 0.f;
#pragma unroll
            for (int j = 0; j < 4; ++j) q += (v[j][0] * v[j][0] + v[j][1] * v[j][1]) + (v[j][2] * v[j][2] + v[j][3] * v[j][3]);
            const float rs2 = 1.0f / sqrtf(wave_sum(q) * (1.0f / 1024.0f) + EPS);
            const float* mb = MOD + ((size_t)(nl * 9 + set) * 9 + 3 * ns) * 1024; const float* gp = npre + (nl * 3 + ns) * 1024;
#pragma unroll
            for (int j = 0; j < 4; ++j) { const f32x4 sh = ((const f32x4*)mb)[lane + 64 * j], sc = ((const f32x4*)(mb + 1024))[lane + 64 * j], p4 = ((const f32x4*)gp)[lane + 64 * j];
                const f32x4 h = v[j] * rs2 * p4 * (1.0f + sc) + sh;
                u32x2 o; o.x = pk2(h[0], h[1]); o.y = pk2(h[2], h[3]); ((u32x2*)(H + (size_t)row * DM))[lane + 64 * j] = o; }
        }
    }
}
struct S5In { const float *a_re, *a_im, *log_dt, *b_re, *b_im, *c_re, *c_im, *dsk; };
__device__ __forceinline__ void s5_abar(const S5In& P, int idx, int n, float& ar, float& ai, float& cr, float& ci) {
    const float are = P.a_re[idx * 64 + n], aim = P.a_im[idx * 64 + n];
    const float dt = expf(P.log_dt[idx]);
    const float mag = expf(dt * are); float sn, cs; sincosf(dt * aim, &sn, &cs);
    ar = mag * cs; ai = mag * sn;
    const float nr = ar - 1.f, ni = ai, den = 1.0f / (are * are + aim * aim);
    cr = (nr * are + ni * aim) * den; ci = (ni * are - nr * aim) * den;
}
__device__ __forceinline__ void s5_prep(const S5In& P, int l, int g, bf16_t* WEt, bf16_t* WYt, LAS unsigned char* lds, int tid) {
    LAS float* AP = (LAS float*)lds;
    LAS float* BB = AP + 2 * 17 * 64 * 2;
    LAS float* CC = BB + 2 * 64 * 16 * 2;
    LAS float* KL = CC + 2 * 16 * 64 * 2;
    if (tid < 128) { const int d = tid >> 6, n = tid & 63, idx = (l * 2 + d) * 64 + g; float ar, ai, cr, ci; s5_abar(P, idx, n, ar, ai, cr, ci);
        float pr = 1.f, pi = 0.f;
        for (int j = 0; j <= 16; ++j) { AP[((d * 17 + j) * 64 + n) * 2] = pr; AP[((d * 17 + j) * 64 + n) * 2 + 1] = pi; const float t0 = pr * ar - pi * ai, t1 = pr * ai + pi * ar; pr = t0; pi = t1; }
        for (int c = 0; c < 16; ++c) { const float br = P.b_re[(size_t)(idx * 64 + n) * 16 + c], bi = P.b_im[(size_t)(idx * 64 + n) * 16 + c];
            BB[((d * 64 + n) * 16 + c) * 2] = cr * br - ci * bi; BB[((d * 64 + n) * 16 + c) * 2 + 1] = cr * bi + ci * br; } }
    for (int e = tid; e < 2048; e += 512) { const int d = e >> 10, cn = e & 1023; const size_t src = (size_t)((l * 2 + d) * 64 + g) * 1024 + cn; CC[e * 2] = P.c_re[src]; CC[e * 2 + 1] = P.c_im[src]; }
    __syncthreads();
    { const int d = tid >> 8, c = (tid >> 4) & 15, cp = tid & 15; float acc[16];
#pragma unroll
      for (int j = 0; j < 16; ++j) acc[j] = 0.f;
      for (int n = 0; n < 64; ++n) { const float c_r = CC[((d * 16 + c) * 64 + n) * 2], c_i = CC[((d * 16 + c) * 64 + n) * 2 + 1], b_r = BB[((d * 64 + n) * 16 + cp) * 2], b_i = BB[((d * 64 + n) * 16 + cp) * 2 + 1];
          const float zr = c_r * b_r - c_i * b_i, zi = c_r * b_i + c_i * b_r;
#pragma unroll
          for (int j = 0; j < 16; ++j) acc[j] += zr * AP[((d * 17 + j) * 64 + n) * 2] - zi * AP[((d * 17 + j) * 64 + n) * 2 + 1]; }
#pragma unroll
      for (int j = 0; j < 16; ++j) KL[((d * 16 + j) * 16 + c) * 16 + cp] = acc[j]; }
    __syncthreads();
    for (int e = tid; e < 256 * 64; e += 512) { const int row = e >> 6, k8 = (e & 63) * 8, t = row >> 4, c = row & 15; float v[8];
        if (k8 < 256) { const int s = k8 >> 4, c0 = k8 & 15;
#pragma unroll
            for (int j = 0; j < 8; ++j) { const int cp = c0 + j; float val = 0.f;
                if (s <= t) val += KL[(((t - s)) * 16 + c) * 16 + cp];
                if (s >= t) val += KL[((16 + (s - t)) * 16 + c) * 16 + cp];
                if (s == t && cp == c) val += P.dsk[l * 1024 + g * 16 + c];
                v[j] = val; } }
        else { const int kk = k8 - 256, d = kk >> 7, im = (kk >> 6) & 1, n0 = kk & 63, jp = (d == 0) ? t + 1 : 16 - t;
#pragma unroll
            for (int j = 0; j < 8; ++j) { const int n = n0 + j; const float wr = AP[((d * 17 + jp) * 64 + n) * 2], wi = AP[((d * 17 + jp) * 64 + n) * 2 + 1], c_r = CC[((d * 16 + c) * 64 + n) * 2], c_i = CC[((d * 16 + c) * 64 + n) * 2 + 1];
                v[j] = im ? -(c_r * wi + c_i * wr) : (c_r * wr - c_i * wi); } }
        *(u32x4*)(WYt + ((size_t)g * 256 + row) * 512 + k8) = pack8(v); }
    for (int e = tid; e < 2 * 128 * 32; e += 512) { const int d = e >> 12, row = (e >> 5) & 127, k8 = (e & 31) * 8, im = row >> 6, n = row & 63, s = k8 >> 4, c0 = k8 & 15, ex = (d == 0) ? 15 - s : s; float v[8];
        const float wr = AP[((d * 17 + ex) * 64 + n) * 2], wi = AP[((d * 17 + ex) * 64 + n) * 2 + 1];
#pragma unroll
        for (int j = 0; j < 8; ++j) { const float b_r = BB[((d * 64 + n) * 16 + c0 + j) * 2], b_i = BB[((d * 64 + n) * 16 + c0 + j) * 2 + 1]; v[j] = im ? (wr * b_i + wi * b_r) : (wr * b_r - wi * b_i); }
        *(u32x4*)(WEt + ((size_t)(d * 64 + g) * 128 + row) * 256 + k8) = pack8(v); }
    __syncthreads();
}
__device__ __forceinline__ int s5_chunk_row(int b, int ch) { return ch < 16 ? R_LAT + b * 256 + 16 * ch : b * 4096 + 16 * (ch - 16); }
__device__ __forceinline__ void s5_main(const S5In& P, int l, const bf16_t* U, const bf16_t* WEt, const bf16_t* WYt, bf16_t* T, LAS unsigned char* lds, int tid) {
    const int lane = tid & 63, w = __builtin_amdgcn_readfirstlane(tid >> 6), fr = lane & 15, q = lane >> 4;
    constexpr int XP = 528;
    LAS unsigned char* XIN = lds; LAS float* ET = (LAS float*)(lds + 272 * XP);
#define S5_LOADA(dst, tile) do { const int row_ = s5_chunk_row(b, 16 * (tile) + fr); const bf16_t* up_ = U + (size_t)(row_ + (q >> 1)) * 1024 + g * 16 + 8 * (q & 1); \
        _Pragma("unroll") for (int kk = 0; kk < 8; ++kk) dst[kk] = *(const bf16x8*)(up_ + (size_t)(2 * kk) * 1024); } while (0)
    for (int item = blockIdx.x; item < 512; item += gridDim.x) {
        const int g = item & 63, b = item >> 6;
#pragma unroll 1
        for (int d = 0; d < 2; ++d) {
            bf16x8 bw[8];
            { const bf16_t* wp = WEt + ((size_t)(d * 64 + g) * 128 + 16 * w + fr) * 256 + 8 * q;
#pragma unroll
              for (int kk = 0; kk < 8; ++kk) bw[kk] = *(const bf16x8*)(wp + 32 * kk); }
            float tr = 1.f, ti = 0.f, xr = 0.f, xi = 0.f;
            if (w == 0) { float cr, ci; s5_abar(P, (l * 2 + d) * 64 + g, lane, tr, ti, cr, ci);
#pragma unroll
                for (int k = 0; k < 4; ++k) { const float n_r = tr * tr - ti * ti, n_i = 2.f * tr * ti; tr = n_r; ti = n_i; } }
            bf16x8 af[8], an[8];
            S5_LOADA(af, 0);
#pragma unroll 1
            for (int i = 0; i < 17; ++i) {
                const int tile = (d == 0 || i == 0) ? i : 17 - i;
                if (i < 16) { const int tn = (d == 0) ? i + 1 : 16 - i; S5_LOADA(an, tn); }
                f32x4 acc = {0.f, 0.f, 0.f, 0.f};
#pragma unroll
                for (int kk = 0; kk < 8; ++kk) acc = __builtin_amdgcn_mfma_f32_16x16x32_bf16(af[kk], bw[kk], acc, 0, 0, 0);
                LAS float* et = ET + (i & 1) * 2048;
#pragma unroll
                for (int r = 0; r < 4; ++r) et[(4 * q + r) * 128 + 16 * w + fr] = acc[r];
                __syncthreads();
                if (w == 0) {
                    float er[16], ei[16];
#pragma unroll
                    for (int c = 0; c < 16; ++c) { er[c] = et[c * 128 + lane]; ei[c] = et[c * 128 + 64 + lane]; }
#pragma unroll
                    for (int cc = 0; cc < 16; ++cc) { const int c = d ? 15 - cc : cc;
                        LAS bf16_t* xp = (LAS bf16_t*)(XIN + (16 * tile + c) * XP) + d * 128;
                        xp[lane] = (bf16_t)(pk2(xr, 0.f) & 0xffffu); xp[64 + lane] = (bf16_t)(pk2(xi, 0.f) & 0xffffu);
                        const float nxr = tr * xr - ti * xi + er[c], nxi = tr * xi + ti * xr + ei[c]; xr = nxr; xi = nxi; }
                }
#pragma unroll
                for (int kk = 0; kk < 8; ++kk) af[kk] = an[kk];
            }
            __syncthreads();
        }
#pragma unroll 1
        for (int nt = 0; nt < 2; ++nt) {
            bf16x8 by[16];
            { const bf16_t* wp = WYt + ((size_t)g * 256 + 32 * w + 16 * nt + fr) * 512 + 8 * q;
#pragma unroll
              for (int kk = 0; kk < 16; ++kk) by[kk] = *(const bf16x8*)(wp + 32 * kk); }
            bf16x8 af[8], an[8];
            S5_LOADA(af, 0);
#pragma unroll 1
            for (int tile = 0; tile < 17; ++tile) {
                if (tile < 16) S5_LOADA(an, tile + 1);
                f32x4 acc = {0.f, 0.f, 0.f, 0.f};
#pragma unroll
                for (int kk = 0; kk < 8; ++kk) acc = __builtin_amdgcn_mfma_f32_16x16x32_bf16(af[kk], by[kk], acc, 0, 0, 0);
                const LAS unsigned char* xq = XIN + (16 * tile + fr) * XP + 16 * q;
#pragma unroll
                for (int kk = 0; kk < 8; ++kk) { const bf16x8 xf = *(const LAS bf16x8*)(xq + 64 * kk); acc = __builtin_amdgcn_mfma_f32_16x16x32_bf16(xf, by[8 + kk], acc, 0, 0, 0); }
                const int t = 2 * w + nt;
#pragma unroll
                for (int r = 0; r < 4; ++r) { const int row = s5_chunk_row(b, 16 * tile + 4 * q + r) + t;
                    T[(size_t)row * 1024 + g * 16 + fr] = (bf16_t)(pk2(gelu_tanh(acc[r]), 0.f) & 0xffffu); }
#pragma unroll
                for (int kk = 0; kk < 8; ++kk) af[kk] = an[kk];
            }
        }
        __syncthreads();
    }
#undef S5_LOADA
}
__device__ __forceinline__ s16x4 vtr(const LAS unsigned char* p) { return __builtin_bit_cast(s16x4, __builtin_amdgcn_ds_read_tr16_b64_v4i16((LAS s16x4*)p)); }
__device__ __forceinline__ void attn_phase(LAS unsigned char* lds, const bf16_t* Q, const bf16_t* KV, const bf16_t* CQ, bf16_t* O, const int tid) {
    const int lane = tid & 63, wid = __builtin_amdgcn_readfirstlane(tid >> 6), r32 = lane & 31, hi = lane >> 5;
    constexpr int KP = 400, VP = 320, BUFB = 64 * KP + 64 * VP;
    const float C = 0.07216878364870322f * 1.4426950408889634f;
    const int kn_row = tid >> 4, kn_ch = tid & 15, kr_row = tid >> 3, kr_ch = tid & 7;
    for (int ui = 0;; ++ui) {
        const int unit = ui * (int)gridDim.x + (int)blockIdx.x; if (unit >= 1024 + 64) break;
        int b, h, qb;
        if (unit < 1024) { const int bh = unit >> 4; qb = unit & 15; b = bh >> 3; h = bh & 7; } else { const int bh = unit - 1024; qb = 16; b = bh >> 3; h = bh & 7; }
        const int qrow0 = (qb < 16) ? b * 4096 + qb * 256 : R_LAT + b * 256;
        const int NT = (qb < 16) ? 68 : 4;
        const bf16_t* qp = Q + (size_t)(qrow0 + wid * 32 + r32) * 1536;
        bf16x8 qf[12];
#pragma unroll
        for (int s = 0; s < 8; ++s) qf[s] = *(const bf16x8*)(qp + h * 128 + 16 * s + 8 * hi);
#pragma unroll
        for (int s = 0; s < 4; ++s) qf[8 + s] = *(const bf16x8*)(qp + 1024 + h * 64 + 16 * s + 8 * hi);
        u32x4 sk0, sk1, skr, sv0, sv1;
#define ATT_KROW(t) ((qb < 16) ? (((t) < 64) ? b * 4096 + (t) * 64 : R_LAT + b * 256 + ((t) - 64) * 64) : R_LAT + b * 256 + (t) * 64)
#define ATT_LOAD(t) do { const int kr0_ = ATT_KROW(t); const bf16_t* kvp_ = KV + (size_t)(kr0_ + kn_row) * 2048 + h * 256 + kn_ch * 8; \
        sk0 = *(const u32x4*)kvp_; sk1 = *(const u32x4*)(kvp_ + 32 * 2048); sv0 = *(const u32x4*)(kvp_ + 128); sv1 = *(const u32x4*)(kvp_ + 128 + 32 * 2048); \
        skr = *(const u32x4*)(CQ + (size_t)(kr0_ + kr_row) * 768 + 512 + kr_ch * 8); } while (0)
#define ATT_STORE(buf) do { LAS unsigned char* kb_ = lds + (buf) * BUFB; LAS unsigned char* vb_ = kb_ + 64 * KP; \
        *(LAS u32x4*)(kb_ + kn_row * KP + kn_ch * 16) = sk0; *(LAS u32x4*)(kb_ + (kn_row + 32) * KP + kn_ch * 16) = sk1; *(LAS u32x4*)(kb_ + kr_row * KP + 256 + kr_ch * 16) = skr; \
        *(LAS u32x4*)(vb_ + kn_row * VP + kn_ch * 16) = sv0; *(LAS u32x4*)(vb_ + (kn_row + 32) * VP + kn_ch * 16) = sv1; } while (0)
        ATT_LOAD(0); ATT_STORE(0);
        __syncthreads();
        float mrun = -1e30f, lrun = 0.f;
        f32x16 o[4];
#pragma unroll
        for (int d = 0; d < 4; ++d)
#pragma unroll
            for (int r = 0; r < 16; ++r) o[d][r] = 0.f;
        for (int t = 0; t < NT; ++t) {
            const int cur = t & 1;
            if (t + 1 < NT) ATT_LOAD(t + 1);
            f32x16 p0, p1;
#pragma unroll
            for (int r = 0; r < 16; ++r) { p0[r] = 0.f; p1[r] = 0.f; }
            { const LAS unsigned char* kb = lds + cur * BUFB + r32 * KP + hi * 16;
#pragma unroll
              for (int s = 0; s < 12; ++s) { const bf16x8 k0 = *(const LAS bf16x8*)(kb + s * 32), k1 = *(const LAS bf16x8*)(kb + 32 * KP + s * 32);
                  p0 = __builtin_amdgcn_mfma_f32_32x32x16_bf16(k0, qf[s], p0, 0, 0, 0); p1 = __builtin_amdgcn_mfma_f32_32x32x16_bf16(k1, qf[s], p1, 0, 0, 0); } }
            float mx = p0[0];
#pragma unroll
            for (int r = 0; r < 16; ++r) { mx = fmaxf(mx, p0[r]); mx = fmaxf(mx, p1[r]); }
            mx = fmaxf(mx, __shfl_xor(mx, 32));
            const float mn = fmaxf(mrun, mx * C), alpha = __builtin_amdgcn_exp2f(mrun - mn); mrun = mn;
            float rsum = 0.f;
#pragma unroll
            for (int r = 0; r < 16; ++r) { p0[r] = __builtin_amdgcn_exp2f(p0[r] * C - mn); p1[r] = __builtin_amdgcn_exp2f(p1[r] * C - mn); rsum += p0[r] + p1[r]; }
            lrun = lrun * alpha + rsum;
#pragma unroll
            for (int d = 0; d < 4; ++d)
#pragma unroll
                for (int r = 0; r < 16; ++r) o[d][r] *= alpha;
            bf16x8 pf[4];
            { u32x4 w;
              w.x = pk2(p0[0], p0[1]); w.y = pk2(p0[2], p0[3]); w.z = pk2(p0[4], p0[5]); w.w = pk2(p0[6], p0[7]); pf[0] = __builtin_bit_cast(bf16x8, w);
              w.x = pk2(p0[8], p0[9]); w.y = pk2(p0[10], p0[11]); w.z = pk2(p0[12], p0[13]); w.w = pk2(p0[14], p0[15]); pf[1] = __builtin_bit_cast(bf16x8, w);
              w.x = pk2(p1[0], p1[1]); w.y = pk2(p1[2], p1[3]); w.z = pk2(p1[4], p1[5]); w.w = pk2(p1[6], p1[7]); pf[2] = __builtin_bit_cast(bf16x8, w);
              w.x = pk2(p1[8], p1[9]); w.y = pk2(p1[10], p1[11]); w.z = pk2(p1[12], p1[13]); w.w = pk2(p1[14], p1[15]); pf[3] = __builtin_bit_cast(bf16x8, w); }
            { const LAS unsigned char* vb = lds + cur * BUFB + 64 * KP + (4 * hi + ((lane & 15) >> 2)) * VP + (16 * ((lane >> 4) & 1) + 4 * (lane & 3)) * 2;
#pragma unroll
              for (int d = 0; d < 4; ++d)
#pragma unroll
                  for (int s = 0; s < 4; ++s) { const s16x4 lo = vtr(vb + s * 16 * VP + d * 64), hh = vtr(vb + s * 16 * VP + 8 * VP + d * 64);
                      const bf16x8 vf = (bf16x8){lo[0], lo[1], lo[2], lo[3], hh[0], hh[1], hh[2], hh[3]};
                      o[d] = __builtin_amdgcn_mfma_f32_32x32x16_bf16(vf, pf[s], o[d], 0, 0, 0); } }
            if (t + 1 < NT) ATT_STORE(cur ^ 1);
            __syncthreads();
        }
        const float inv = 1.0f / (lrun + __shfl_xor(lrun, 32));
        bf16_t* op = O + (size_t)(qrow0 + wid * 32 + r32) * 1024 + h * 128;
#pragma unroll
        for (int d = 0; d < 4; ++d)
#pragma unroll
            for (int i4 = 0; i4 < 4; ++i4) { u32x2 w; w.x = pk2(o[d][4 * i4] * inv, o[d][4 * i4 + 1] * inv); w.y = pk2(o[d][4 * i4 + 2] * inv, o[d][4 * i4 + 3] * inv);
                *(u32x2*)(op + 32 * d + 8 * i4 + 4 * hi) = w; }
    }
#undef ATT_KROW
#undef ATT_LOAD
#undef ATT_STORE
}
#define DERIVE_PTRS float* MOD = (float*)(ws + WS_MOD); float* ROPE = (float*)(ws + WS_ROPE); float* YSS = (float*)(ws + WS_YSS); float* CSS = (float*)(ws + WS_CSS); bf16_t* WEt = (bf16_t*)(ws + WS_S5E); bf16_t* WYt = (bf16_t*)(ws + WS_S5E + S5_WE_BYTES); float* XC = (float*)(ws + WS_XC); bf16_t* WL = (bf16_t*)(ws + WS_WL); bf16_t* H = (bf16_t*)(ws + WS_H); unsigned char* big = ws + WS_BIG; bf16_t* CQ = (bf16_t*)(big + B_CQ); bf16_t* U = (bf16_t*)(big + B_U); bf16_t* Qb = (bf16_t*)(big + B_Q); bf16_t* KVb = (bf16_t*)(big + B_KV); bf16_t* SG = (bf16_t*)(big + B_SG); bf16_t* ACT = (bf16_t*)(big + B_ACT); bf16_t* Y = (bf16_t*)(big + B_Y); bf16_t* T = (bf16_t*)(big + B_T); bf16_t* Gb = (bf16_t*)(big + B_G); bf16_t* Mb = (bf16_t*)(big + B_M); bf16_t* Ob = H;
constexpr int NSTEPS = 2 + 14 * DEPTH;
struct Args { const float* in[29]; float* out; unsigned char* ws; int ph_lo, ph_hi; };
__global__ void __launch_bounds__(512, 2) mk_fwd(Args a) {
    extern __shared__ __attribute__((aligned(16))) unsigned char lds_raw[];
    cg::grid_group grid = cg::this_grid();
    LAS unsigned char* lds = (LAS unsigned char*)lds_raw;
    const int G = gridDim.x, NGW = G * 8;
    WPtrs WP{a.in[8], a.in[9], a.in[10], a.in[11], a.in[12], a.in[13], a.in[14], a.in[15], a.in[16], a.in[25], a.in[27], a.in[28]};
    S5In SP{a.in[17], a.in[18], a.in[19], a.in[20], a.in[21], a.in[22], a.in[23], a.in[24]};
#pragma unroll 1
    for (int step = a.ph_lo; step < a.ph_hi; ++step) {
        int tid = threadIdx.x; asm volatile("" : "+v"(tid));
        const int lane = tid & 63, wave = __builtin_amdgcn_readfirstlane(tid >> 6), gw = blockIdx.x * 8 + wave;
        unsigned char* ws = a.ws; asm volatile("" : "+s"(ws));
        DERIVE_PTRS
        int l = 0, p = -1;
        if (step >= 2) { l = (step - 2) / 14; p = (step - 2) % 14; }
        if (step == 0) mods_phase(a.in[1], a.in[3], a.in[4], a.in[5], MOD, ROPE, lds, tid);
        if (step == 0 || (p == 13 && l < DEPTH - 1)) conv_layer(WP, step == 0 ? 0 : l + 1, WL, lds, gw, NGW, wave, lane);
        if (p == 2 && blockIdx.x < 64) s5_prep(SP, l, blockIdx.x, WEt, WYt, lds, tid);
        if (step == 1 || p == 2 || p == 10 || p == 13) {
            int s, nl, ns;
            if (step == 1) { s = -1; nl = 0; ns = 0; } else if (p == 2) { s = 0; nl = l; ns = 1; } else if (p == 10) { s = 1; nl = l; ns = 2; } else { s = 2; nl = (l < DEPTH - 1) ? l + 1 : -1; ns = 0; }
            e_phase(a.in[0], a.in[2], a.out, XC, Y, YSS, MOD, a.in[6], a.in[7], H, l, s, nl, ns, gw, NGW, lane);
        }
        if (p == 0 || p == 1 || p == 3 || p == 4 || p == 7 || p == 8 || p == 9 || p == 11 || p == 12) {
            const int ng = (p == 4 || p == 8) ? 2 : 1;
#pragma unroll 1
            for (int gi = 0; gi < ng; ++gi) {
                pg8::Gemm g; Epi E; E.o0 = nullptr; E.o1 = nullptr; E.o2 = nullptr; E.i0 = nullptr; E.i1 = nullptr; E.ss = nullptr; E.css = CSS; E.bias = nullptr; E.rope = ROPE; E.mode = 0;
                g.M = R;
                if (p == 0 || p == 11) { g.A = H; g.Bt = WL + (p == 0 ? W_GUA : W_GUB); g.N = 5632; g.K = 1024; g.lda = 1024; E.mode = 0; E.o0 = ACT; }
                else if (p == 1 || p == 12) { g.A = ACT; g.Bt = WL + (p == 1 ? W_DA : W_DB); g.N = 1024; g.K = FF; g.lda = FF; E.mode = 1; E.o0 = Y; E.ss = YSS; }
                else if (p == 3) { g.A = H; g.Bt = WL + W_IN; g.N = 3840; g.K = 1024; g.lda = 1024; E.mode = 2; E.o0 = CQ; E.o1 = U; E.o2 = SG; E.ss = CSS; }
                else if (p == 4 && gi == 0) { g.A = CQ; g.Bt = WL + W_UQ; g.N = 1536; g.K = 256; g.lda = 768; E.mode = 3; E.o0 = Qb; }
                else if (p == 4) { g.A = CQ + 256; g.Bt = WL + W_UKV; g.N = 2048; g.K = 256; g.lda = 768; E.mode = 4; E.o0 = KVb; }
                else if (p == 7) { g.A = T; g.Bt = WL + W_GLU; g.N = 1024; g.K = 1024; g.lda = 1024; E.mode = 5; E.o0 = Gb; E.i0 = T; E.bias = a.in[26] + l * 1024; }
                else if (p == 8 && gi == 0) { g.A = Ob; g.Bt = WL + W_OMLA; g.N = 1024; g.K = 1024; g.lda = 1024; E.mode = 6; E.o0 = Mb; E.i0 = SG; }
                else if (p == 8) { g.A = Gb; g.Bt = WL + W_OS5; g.N = 1024; g.K = 1024; g.lda = 1024; E.mode = 7; E.o0 = Mb; E.i0 = Mb; E.i1 = SG + 1024; }
                else { g.A = Mb; g.Bt = WL + W_OUT; g.N = 1024; g.K = 1024; g.lda = 1024; E.mode = 1; E.o0 = Y; E.ss = YSS; }
                pg8::StaticOrder S; S.init(R, g.N, G, (int)blockIdx.x);
                pg8::gemm_phase<Epi, pg8::StaticOrder, true, true>(lds, g, S, E, tid);
#if MK_PROBE == 3
                if (p == 0 || p == 11) { __syncthreads(); pg8::gemm_phase<Epi, pg8::StaticOrder, true, true>(lds, g, S, E, tid); }
#endif
            }
        }
        if (p == 5) {
#pragma unroll 1
            for (int rep = 0; rep < (MK_PROBE == 1 ? 2 : 1); ++rep) attn_phase(lds, Qb, KVb, CQ, Ob, tid); }
        if (p == 6) {
#pragma unroll 1
            for (int rep = 0; rep < (MK_PROBE == 2 ? 2 : 1); ++rep) s5_main(SP, l, U, WEt, WYt, T, lds, tid); }
        if (step + 1 < a.ph_hi) { grid.sync();
#if MK_PROBE == 4
            grid.sync(); grid.sync();
#endif
        }
    }
}

extern "C" void kernel_launch(void* const* d_in, const int* in_sizes, int n_in, void* d_out, int out_size, void* d_ws, size_t ws_size, hipStream_t stream) {
    static int grid = 0;
    if (grid == 0) {
        if (n_in != 29 || out_size != R_LAT * DM || ws_size < WS_END) { fprintf(stderr, "kernel_launch: unexpected problem (n_in %d out %d ws %zu need %zu)\n", n_in, out_size, ws_size, (size_t)WS_END); grid = -1; return; }
        int dev = 0, cus = 0, per_cu = 0;
        if (hipGetDevice(&dev) != hipSuccess || hipDeviceGetAttribute(&cus, hipDeviceAttributeMultiprocessorCount, dev) != hipSuccess) { grid = -1; return; }
        if (hipFuncSetAttribute((const void*)mk_fwd, hipFuncAttributeMaxDynamicSharedMemorySize, LDS_BYTES) != hipSuccess) { fprintf(stderr, "kernel_launch: hipFuncSetAttribute failed\n"); grid = -1; return; }
        if (hipOccupancyMaxActiveBlocksPerMultiprocessor(&per_cu, (const void*)mk_fwd, 512, LDS_BYTES) != hipSuccess || per_cu < 1) { fprintf(stderr, "kernel_launch: occupancy query says %d\n", per_cu); per_cu = 1; }
        (void)hipGetLastError();
        grid = cus * 1;
    }
    if (grid < 0) return;
    Args a{};
    for (int i = 0; i < 29; ++i) a.in[i] = (const float*)d_in[i];
    a.out = (float*)d_out; a.ws = (unsigned char*)d_ws;
#if MK_MULTI
    for (int s = 0; s < NSTEPS; ++s) { a.ph_lo = s; a.ph_hi = s + 1; void* args[] = {&a};
        hipError_t e = hipLaunchCooperativeKernel((const void*)mk_fwd, dim3(grid), dim3(512), args, LDS_BYTES, stream);
        if (e != hipSuccess) { fprintf(stderr, "cooperative launch %d failed: %s\n", s, hipGetErrorString(e)); break; } }
#else
    a.ph_lo = 0; a.ph_hi = NSTEPS; void* args[] = {&a};
    hipError_t e = hipLaunchCooperativeKernel((const void*)mk_fwd, dim3(grid), dim3(512), args, LDS_BYTES, stream);
    if (e != hipSuccess) fprintf(stderr, "cooperative launch failed: %s (grid %d)\n", hipGetErrorString(e), grid);
#endif
}
```

```cpp
#include <hip/hip_runtime.h>
#include <hip/hip_cooperative_groups.h>
#include <cstdio>
#include <cstdint>
namespace cg = cooperative_groups;
#ifndef MK_MULTI
#define MK_MULTI 0
#endif
#ifndef MK_PROBE
#define MK_PROBE 0
#endif
namespace pg8 {
#define PG8_LAS __attribute__((address_space(3)))
typedef unsigned short bf16_t;
typedef short bf16x8 __attribute__((ext_vector_type(8)));
typedef float f32x4 __attribute__((ext_vector_type(4)));
typedef unsigned u32x4 __attribute__((ext_vector_type(4)));
constexpr int BM = 256, BK = 64, HALF = 128, HTB = HALF * BK * 2  , STAGE_BYTES = 8 * HTB, NXCD = 8, WGM = 8;

__host__ __device__ __forceinline__ int lds_byte(int r, int c) { const int st = (r >> 4) * 2 + (c >> 5), rr = r & 15, cc = c & 31, ob = rr * 64 + cc * 2; return st * 1024 + (ob ^ (((ob >> 9) & 1) << 5)); }
__host__ __device__ __forceinline__ void stage_rc(int b, int& R, int& C) { const int st = b / 1024, sb = b % 1024, swz = sb ^ (((sb >> 9) & 1) << 5); R = (st >> 1) * 16 + swz / 64; C = (st & 1) * 32 + (swz % 64) / 2; }
__host__ __device__ __forceinline__ int perm32(int rho) { const int n = rho >> 4, i = rho & 15; return 8 * (i >> 2) + 4 * n + (i & 3); }

struct Unit { int pm, pn; };
struct Gemm { const bf16_t* A; const bf16_t* Bt; int M, N, K, lda; };

struct StaticOrder {
    int nM, nN, nwg, G, c;
    __host__ __device__ void init(int M, int N, int G_, int c_) { nM = M / BM; nN = N / BM; nwg = nM * nN; G = G_; c = c_; }
    __host__ __device__ bool next(int i, Unit& u) const {
        const long L = (long)i * G + c; if (L >= nwg) return false;
        int wgid = (int)L; { const int q = nwg / NXCD, r = nwg % NXCD, xcd = wgid % NXCD, off = wgid / NXCD; wgid = (xcd < r ? xcd * (q + 1) : r * (q + 1) + (xcd - r) * q) + off; }
        const int nig = WGM * nN, gid = wgid / nig, fm = gid * WGM, gsz = (nM - fm) < WGM ? (nM - fm) : WGM;
        u.pm = fm + ((wgid % nig) % gsz); u.pn = (wgid % nig) / gsz; return true;
    }
    __device__ __forceinline__ void a_ready(const Unit&) const {}
    __device__ __forceinline__ void done(const Unit&) const {}
};

__device__ __forceinline__ unsigned cvt_pk_bf16(float lo, float hi) { unsigned r; asm volatile("v_cvt_pk_bf16_f32 %0, %1, %2" : "=v"(r) : "v"(lo), "v"(hi)); return r; }
template <class Epi, class Sched, bool ALIGN_EPI = false, bool SP2 = false>
__device__ __forceinline__ void gemm_phase(PG8_LAS unsigned char* lds, const Gemm g, const Sched& S, const Epi& E, const int tid) {
    const int wid = __builtin_amdgcn_readfirstlane(tid >> 6), lane = tid & 63, wr = wid >> 2, wc = wid & 3, fr = lane & 15, fq = lane >> 4;
    const int K = g.K, nt = K / BK;
    unsigned voffA[2], voffB[2];
#pragma unroll
    for (int i = 0; i < 2; ++i) { int R, C; stage_rc(tid * 16 + i * 8192, R, C); const int Rb = Epi::PERM ? ((R & ~31) + perm32(R & 31)) : R;
        voffA[i] = (unsigned)(R * g.lda + C) * 2u; voffB[i] = (unsigned)(Rb * K + C) * 2u; }
    const size_t kstep = (size_t)(BK * 2);
    const size_t hstep = (size_t)HALF * K * 2;
    const size_t tstep = 2 * hstep; const size_t hstepA = (size_t)HALF * g.lda * 2, tstepA = 2 * hstepA;
    const unsigned ldsw = (unsigned)wid * 1024u;
    const int aoff = lds_byte(wr * 64 + fr, fq * 8), boff = lds_byte(wc * 32 + fr, fq * 8);
#define PG8_SA(b, h) (((b) * 2 + (h)) * HTB)
#define PG8_SB(b, h) ((4 + (b) * 2 + (h)) * HTB)
#define PG8_STAGE(bufoff, gbase, voff) do { _Pragma("unroll") for (int _i = 0; _i < 2; ++_i) \
        __builtin_amdgcn_global_load_lds((const unsigned*)((const char*)(gbase) + (voff)[_i]), (PG8_LAS unsigned*)(lds + (bufoff) + ldsw + _i * 8192), 16, 0, 0); } while (0)
#define PG8_LDA(dst, b, h) do { _Pragma("unroll") for (int m = 0; m < 4; ++m) _Pragma("unroll") for (int k = 0; k < 2; ++k) dst[m][k] = *(const PG8_LAS bf16x8*)(lds + PG8_SA(b, h) + aoff + m * 2048 + k * 1024); } while (0)
#define PG8_LDB(dst, b, h) do { _Pragma("unroll") for (int n = 0; n < 2; ++n) _Pragma("unroll") for (int k = 0; k < 2; ++k) dst[n][k] = *(const PG8_LAS bf16x8*)(lds + PG8_SB(b, h) + boff + n * 2048 + k * 1024); } while (0)
#define PG8_MMA(ai, bj, At, Bt) do { __builtin_amdgcn_s_setprio(1); _Pragma("unroll") for (int m = 0; m < 4; ++m) _Pragma("unroll") for (int n = 0; n < 2; ++n) _Pragma("unroll") for (int k = 0; k < 2; ++k) \
        acc[ai][bj][m][n] = __builtin_amdgcn_mfma_f32_16x16x32_bf16(Bt[n][k], At[m][k], acc[ai][bj][m][n], 0, 0, 0); __builtin_amdgcn_s_setprio(0); } while (0)
#define PG8_WAIT_V(n) asm volatile("s_waitcnt vmcnt(" #n ")" ::: "memory")
#define PG8_WAIT_L(n) asm volatile("s_waitcnt lgkmcnt(" #n ")" ::: "memory")
#define PG8_BAR __builtin_amdgcn_s_barrier()
#define PG8_SCHED __builtin_amdgcn_sched_barrier(0)
    Unit cur, nxt; int ui = 0;
    if (!S.next(0, cur)) return;
    f32x4 acc[2][2][4][2];
#pragma unroll
    for (int a = 0; a < 2; ++a)
#pragma unroll
        for (int b = 0; b < 2; ++b)
#pragma unroll
            for (int m = 0; m < 4; ++m)
#pragma unroll
                for (int n = 0; n < 2; ++n) acc[a][b][m][n] = (f32x4){0.f, 0.f, 0.f, 0.f};
    bf16x8 At[4][2], B0[2][2], B1[2][2];
    const char* cA = (const char*)g.A + (size_t)cur.pm * tstepA; const char* cB = (const char*)g.Bt + (size_t)cur.pn * tstep;
    S.a_ready(cur);
    if constexpr (SP2) {
        PG8_STAGE(PG8_SB(0, 0), cB, voffB); PG8_STAGE(PG8_SB(0, 1), cB + hstep, voffB); PG8_STAGE(PG8_SA(0, 0), cA, voffA); PG8_STAGE(PG8_SA(0, 1), cA + hstepA, voffA);
        if (wr == 1) PG8_BAR;
        PG8_WAIT_V(2); PG8_BAR;
        PG8_STAGE(PG8_SB(1, 0), cB + kstep, voffB); PG8_STAGE(PG8_SA(1, 0), cA + kstep, voffA); PG8_STAGE(PG8_SB(1, 1), cB + hstep + kstep, voffB);
        PG8_WAIT_V(6); PG8_BAR;
    } else {
        PG8_STAGE(PG8_SB(0, 0), cB, voffB); PG8_STAGE(PG8_SA(0, 0), cA, voffA); PG8_STAGE(PG8_SB(0, 1), cB + hstep, voffB); PG8_STAGE(PG8_SA(0, 1), cA + hstepA, voffA);
        if (wr == 1) PG8_BAR;
        PG8_WAIT_V(4); PG8_BAR;
        PG8_STAGE(PG8_SB(1, 0), cB + kstep, voffB); PG8_STAGE(PG8_SA(1, 0), cA + kstep, voffA); PG8_STAGE(PG8_SB(1, 1), cB + hstep + kstep, voffB);
        PG8_WAIT_V(6); PG8_BAR;
    }
    for (;;) {
        const bool has_next = S.next(ui + 1, nxt);
        const char* nA = has_next ? (const char*)g.A + (size_t)nxt.pm * tstepA : cA; const char* nB = has_next ? (const char*)g.Bt + (size_t)nxt.pn * tstep : cB;
        for (int t = 0; t < nt; t += 2) {
            const bool last = (t == nt - 2);
            const char* a1 = cA + (size_t)(t + 1) * kstep;
            const char* a2 = last ? nA : cA + (size_t)(t + 2) * kstep; const char* b2 = last ? nB : cB + (size_t)(t + 2) * kstep;
            const char* a3 = a2 + kstep; const char* b3 = b2 + kstep;
            if (last && has_next) S.a_ready(nxt);
            if constexpr (SP2) {
            PG8_LDB(B0, 0, 0); PG8_LDB(B1, 0, 1); PG8_SCHED; PG8_LDA(At, 0, 0); PG8_STAGE(PG8_SA(1, 1), a1 + hstepA, voffA);
            PG8_WAIT_V(8); PG8_WAIT_L(0); PG8_BAR; PG8_MMA(0, 0, At, B0); PG8_MMA(0, 1, At, B1); PG8_BAR; PG8_SCHED;
            PG8_LDA(At, 0, 1); PG8_STAGE(PG8_SB(0, 0), b2, voffB); PG8_STAGE(PG8_SB(0, 1), b2 + hstep, voffB); PG8_STAGE(PG8_SA(0, 0), a2, voffA);
            PG8_WAIT_V(8); PG8_WAIT_L(0); PG8_BAR; PG8_MMA(1, 0, At, B0); PG8_MMA(1, 1, At, B1); PG8_BAR; PG8_SCHED;
            PG8_LDB(B0, 1, 0); PG8_LDB(B1, 1, 1); PG8_SCHED; PG8_LDA(At, 1, 0); PG8_STAGE(PG8_SA(0, 1), a2 + hstepA, voffA);
            PG8_WAIT_V(8); PG8_WAIT_L(0); PG8_BAR; PG8_MMA(0, 0, At, B0); PG8_MMA(0, 1, At, B1); PG8_BAR; PG8_SCHED;
            PG8_LDA(At, 1, 1); PG8_STAGE(PG8_SB(1, 0), b3, voffB); PG8_STAGE(PG8_SB(1, 1), b3 + hstep, voffB); PG8_STAGE(PG8_SA(1, 0), a3, voffA);
            PG8_WAIT_V(8); PG8_WAIT_L(0); PG8_BAR; PG8_MMA(1, 0, At, B0); PG8_MMA(1, 1, At, B1); PG8_BAR; PG8_SCHED;
            } else {
            PG8_LDB(B0, 0, 0); PG8_SCHED; PG8_LDA(At, 0, 0); PG8_STAGE(PG8_SA(1, 1), a1 + hstepA, voffA);
            PG8_WAIT_L(8); PG8_BAR; PG8_WAIT_L(0); PG8_MMA(0, 0, At, B0); PG8_BAR; PG8_SCHED;
            PG8_LDB(B1, 0, 1); PG8_STAGE(PG8_SB(0, 0), b2, voffB);
            PG8_BAR; PG8_WAIT_L(0); PG8_MMA(0, 1, At, B1); PG8_BAR;
            PG8_LDA(At, 0, 1); PG8_STAGE(PG8_SA(0, 0), a2, voffA);
            PG8_BAR; PG8_WAIT_L(0); PG8_MMA(1, 0, At, B0); PG8_BAR; PG8_SCHED;
            PG8_STAGE(PG8_SB(0, 1), b2 + hstep, voffB);
            PG8_WAIT_V(6); PG8_BAR; PG8_MMA(1, 1, At, B1); PG8_BAR;
            PG8_LDB(B0, 1, 0); PG8_SCHED; PG8_LDA(At, 1, 0); PG8_STAGE(PG8_SA(0, 1), a2 + hstepA, voffA);
            PG8_WAIT_L(8); PG8_BAR; PG8_WAIT_L(0); PG8_MMA(0, 0, At, B0); PG8_BAR; PG8_SCHED;
            PG8_LDB(B1, 1, 1); PG8_STAGE(PG8_SB(1, 0), b3, voffB);
            PG8_BAR; PG8_WAIT_L(0); PG8_MMA(0, 1, At, B1); PG8_BAR;
            PG8_LDA(At, 1, 1); PG8_STAGE(PG8_SA(1, 0), a3, voffA);
            PG8_BAR; PG8_WAIT_L(0); PG8_MMA(1, 0, At, B0); PG8_BAR; PG8_SCHED;
            PG8_STAGE(PG8_SB(1, 1), b3 + hstep, voffB);
            PG8_WAIT_V(6); PG8_BAR; PG8_MMA(1, 1, At, B1); PG8_BAR;
            }
        }
        if constexpr (ALIGN_EPI) { if (wr == 0) PG8_BAR; }
        if constexpr (!Epi::AFTER_DRAIN) { E(acc, cur, wr, wc, fr, fq); S.done(cur); }
        if (!has_next) break;
#pragma unroll
        for (int a = 0; a < 2; ++a)
#pragma unroll
            for (int b = 0; b < 2; ++b)
#pragma unroll
                for (int m = 0; m < 4; ++m)
#pragma unroll
                    for (int n = 0; n < 2; ++n) acc[a][b][m][n] = (f32x4){0.f, 0.f, 0.f, 0.f};
        cur = nxt; cA = nA; cB = nB; ++ui;
        if constexpr (ALIGN_EPI) { if (wr == 1) PG8_BAR; }
    }
    PG8_WAIT_V(0);
    if constexpr (!ALIGN_EPI) { if (wr == 0) PG8_BAR; }
    PG8_BAR;
    if constexpr (Epi::AFTER_DRAIN) { E.fused(acc, cur, wr, wc, fr, fq, lds, wid, lane); S.done(cur); }
#undef PG8_SA
#undef PG8_SB
#undef PG8_STAGE
#undef PG8_LDA
#undef PG8_LDB
#undef PG8_MMA
#undef PG8_WAIT_V
#undef PG8_WAIT_L
#undef PG8_BAR
#undef PG8_SCHED
}
}
using pg8::bf16_t; using pg8::f32x4; using pg8::u32x4; using pg8::bf16x8; using pg8::Unit;
#define LAS __attribute__((address_space(3)))
typedef float f32x16 __attribute__((ext_vector_type(16)));
typedef unsigned u32x2 __attribute__((ext_vector_type(2)));
typedef short s16x4 __attribute__((ext_vector_type(4)));
constexpr int NB = 8, SEQ = 4096, CTXL = 256, DM = 1024, FF = 2816, DEPTH = 4, NH = 8;
constexpr int R_LAT = NB * SEQ, R_CTX = NB * CTXL, R = R_LAT + R_CTX;
constexpr float EPS = 1e-6f;
constexpr int NCH = 34;
constexpr size_t W_GUA = 0, W_DA = W_GUA + (size_t)5632 * 1024, W_GUB = W_DA + (size_t)1024 * 2816, W_DB = W_GUB + (size_t)5632 * 1024,
                 W_IN = W_DB + (size_t)1024 * 2816, W_UQ = W_IN + (size_t)3840 * 1024, W_UKV = W_UQ + (size_t)1536 * 256, W_OMLA = W_UKV + (size_t)2048 * 256,
                 W_GLU = W_OMLA + (size_t)1024 * 1024, W_OS5 = W_GLU + (size_t)1024 * 1024, W_OUT = W_OS5 + (size_t)1024 * 1024, W_END = W_OUT + (size_t)1024 * 1024;
constexpr size_t al256(size_t x) { return (x + 255) & ~(size_t)255; }
constexpr size_t WS_CTL = 0, CTL_BYTES = 16384;
constexpr size_t WS_MOD = WS_CTL + CTL_BYTES;
constexpr size_t WS_ROPE = WS_MOD + al256((size_t)4 * 9 * 9216 * 4);
constexpr size_t WS_YSS = WS_ROPE + al256(64 * 16 * 8);
constexpr size_t WS_CSS = WS_YSS + al256((size_t)R * 16 * 4);
constexpr size_t WS_S5E = WS_CSS + al256((size_t)R * 8 * 4);
constexpr size_t S5_WE_BYTES = (size_t)2 * 64 * 128 * 256 * 2, S5_WY_BYTES = (size_t)64 * 256 * 512 * 2;
constexpr size_t WS_XC = WS_S5E + al256(S5_WE_BYTES + S5_WY_BYTES);
constexpr size_t WS_WL = WS_XC + al256((size_t)R_CTX * DM * 4);
constexpr size_t WS_H = WS_WL + al256(W_END * 2);
constexpr size_t WS_BIG = WS_H + al256((size_t)R * DM * 2);
constexpr size_t B_CQ = 0, B_U = B_CQ + (size_t)R * 768 * 2, B_Q = B_U + (size_t)R * 1024 * 2, B_KV = B_Q + (size_t)R * 1536 * 2, B_SG = B_KV + (size_t)R * 2048 * 2, B_END = B_SG + (size_t)R * 2048 * 2;
constexpr size_t B_ACT = 0, B_Y = (size_t)R * FF * 2;
constexpr size_t B_T = B_Q, B_G = B_KV, B_M = B_U;
static_assert(B_Y >= B_T + (size_t)R * 1024 * 2 && B_Y + (size_t)R * 1024 * 2 <= B_SG, "Y overlay");
constexpr size_t WS_END = WS_BIG + B_END;
constexpr int LDS_BYTES = 272 * 528 + 16384 + 256;

__device__ __forceinline__ float bf2f(unsigned h) { return __uint_as_float(h << 16); }
__device__ __forceinline__ unsigned pk2(float lo, float hi) { return pg8::cvt_pk_bf16(lo, hi); }
__device__ __forceinline__ float sigm(float x) { return __builtin_amdgcn_rcpf(1.f + __builtin_amdgcn_exp2f(-1.4426950408889634f * x)); }
__device__ __forceinline__ float gelu_tanh(float x) { return x * sigm(1.5957691216057308f * (x + 0.044715f * x * x * x)); }
__device__ __forceinline__ void unpack8(const u32x4 w, float (&f)[8]) {
    f[0] = bf2f(w.x & 0xffffu); f[1] = __uint_as_float(w.x & 0xffff0000u); f[2] = bf2f(w.y & 0xffffu); f[3] = __uint_as_float(w.y & 0xffff0000u);
    f[4] = bf2f(w.z & 0xffffu); f[5] = __uint_as_float(w.z & 0xffff0000u); f[6] = bf2f(w.w & 0xffffu); f[7] = __uint_as_float(w.w & 0xffff0000u);
}
__device__ __forceinline__ u32x4 pack8(const float (&f)[8]) { u32x4 w; w.x = pk2(f[0], f[1]); w.y = pk2(f[2], f[3]); w.z = pk2(f[4], f[5]); w.w = pk2(f[6], f[7]); return w; }
__device__ __forceinline__ float wave_sum(float v) {
#pragma unroll
    for (int o = 1; o < 64; o <<= 1) v += __shfl_xor(v, o);
    return v;
}
__device__ __forceinline__ void rope8(float (&v)[8], int row, int wc, int fq, const float* tab) {
    const int t = row & 4095, pos = (wc & 1) ? (t & 63) : (t >> 6);
    const f32x4* tp = (const f32x4*)(tab + (pos * 16 + 8 * (fq & 1)) * 2);
    const f32x4 t0 = tp[0], t1 = tp[1], t2 = tp[2], t3 = tp[3];
    const float cs[8] = {t0[0], t0[2], t1[0], t1[2], t2[0], t2[2], t3[0], t3[2]}, sn[8] = {t0[1], t0[3], t1[1], t1[3], t2[1], t2[3], t3[1], t3[3]};
    const float sgn = (fq < 2) ? -1.f : 1.f;
#pragma unroll
    for (int j = 0; j < 8; ++j) { const float p = __shfl_xor(v[j], 32); v[j] = v[j] * cs[j] + sgn * p * sn[j]; }
}

struct Epi {
    static constexpr bool PERM = true, AFTER_DRAIN = false;
    int mode;
    bf16_t* o0; bf16_t* o1; bf16_t* o2; const bf16_t* i0; const bf16_t* i1; float* ss; const float* css; const float* bias; const float* rope;
    __device__ __forceinline__ void operator()(const f32x4 (&acc)[2][2][4][2], const Unit& u, int wr, int wc, int fr, int fq) const {
        const int row0 = u.pm * 256 + wr * 64 + fr, cb = wc * 32 + 8 * fq, pn = u.pn;
        if (mode == 0) {
            bf16_t* base = o0 + (size_t)pn * 128 + cb;
#pragma unroll
            for (int ai = 0; ai < 2; ++ai)
#pragma unroll
                for (int m = 0; m < 4; ++m) { const int row = row0 + ai * 128 + m * 16; float v[8];
#pragma unroll
                    for (int n = 0; n < 2; ++n)
#pragma unroll
                        for (int j = 0; j < 4; ++j) { const float g = acc[ai][0][m][n][j], up = acc[ai][1][m][n][j]; v[4 * n + j] = g * sigm(g) * up; }
                    *(u32x4*)(base + (size_t)row * FF) = pack8(v); }
        } else if (mode == 1) {
            bf16_t* base = o0 + pn * 256 + cb;
#pragma unroll
            for (int ai = 0; ai < 2; ++ai)
#pragma unroll
                for (int m = 0; m < 4; ++m) { const int row = row0 + ai * 128 + m * 16; float s = 0.f;
#pragma unroll
                    for (int bj = 0; bj < 2; ++bj) { float v[8];
#pragma unroll
                        for (int n = 0; n < 2; ++n)
#pragma unroll
                            for (int j = 0; j < 4; ++j) { const float x = acc[ai][bj][m][n][j]; v[4 * n + j] = x; s += x * x; }
                        *(u32x4*)(base + (size_t)row * 1024 + bj * 128) = pack8(v); }
                    s += __shfl_xor(s, 16); s += __shfl_xor(s, 32);
                    if (fq == 0) ss[row * 16 + pn * 4 + wc] = s; }
        } else if (mode == 2) {
            bf16_t* dst; int ldc;
            if (pn < 3) { dst = o0 + pn * 256; ldc = 768; } else if (pn < 7) { dst = o1 + (pn - 3) * 256; ldc = 1024; } else { dst = o2 + (pn - 7) * 256; ldc = 2048; }
            const bool sg = pn >= 7, docss = pn < 2, dorope = (pn == 2) && (u.pm < 128) && (wc < 2);
            dst += cb;
#pragma unroll
            for (int ai = 0; ai < 2; ++ai)
#pragma unroll
                for (int m = 0; m < 4; ++m) { const int row = row0 + ai * 128 + m * 16; float s = 0.f;
#pragma unroll
                    for (int bj = 0; bj < 2; ++bj) { float v[8];
#pragma unroll
                        for (int n = 0; n < 2; ++n)
#pragma unroll
                            for (int j = 0; j < 4; ++j) { float x = acc[ai][bj][m][n][j]; if (sg) x = sigm(x); v[4 * n + j] = x; s += x * x; }
                        if (bj == 0 && dorope) rope8(v, row, wc, fq, rope);
                        *(u32x4*)(dst + (size_t)row * ldc + bj * 128) = pack8(v); }
                    if (docss) { s += __shfl_xor(s, 16); s += __shfl_xor(s, 32); if (fq == 0) ss[row * 8 + pn * 4 + wc] = s; } }
        } else if (mode == 3 || mode == 4) {
            const int ldc = (mode == 3) ? 1536 : 2048; const float* cp = css + ((mode == 3) ? 0 : 4);
            const bool dorope = (mode == 3) && (pn >= 4) && (u.pm < 128);
            bf16_t* dst = o0 + pn * 256 + cb;
#pragma unroll
            for (int ai = 0; ai < 2; ++ai)
#pragma unroll
                for (int m = 0; m < 4; ++m) { const int row = row0 + ai * 128 + m * 16; const f32x4 c4 = *(const f32x4*)(cp + row * 8);
                    const float rs = 1.0f / sqrtf(((c4[0] + c4[1]) + (c4[2] + c4[3])) * (1.0f / 256.0f) + EPS);
#pragma unroll
                    for (int bj = 0; bj < 2; ++bj) { float v[8];
#pragma unroll
                        for (int n = 0; n < 2; ++n)
#pragma unroll
                            for (int j = 0; j < 4; ++j) v[4 * n + j] = acc[ai][bj][m][n][j] * rs;
                        if (dorope) rope8(v, row, wc, fq, rope);
                        *(u32x4*)(dst + (size_t)row * ldc + bj * 128) = pack8(v); } }
        } else {
            const int col = pn * 256 + cb;
#pragma unroll
            for (int ai = 0; ai < 2; ++ai)
#pragma unroll
                for (int m = 0; m < 4; ++m) { const int row = row0 + ai * 128 + m * 16;
#pragma unroll
                    for (int bj = 0; bj < 2; ++bj) { const int c = col + bj * 128; float v[8], a[8], b[8];
#pragma unroll
                        for (int n = 0; n < 2; ++n)
#pragma unroll
                            for (int j = 0; j < 4; ++j) v[4 * n + j] = acc[ai][bj][m][n][j];
                        if (mode == 5) { unpack8(*(const u32x4*)(i0 + (size_t)row * 1024 + c), a); const f32x4 b0 = *(const f32x4*)(bias + c), b1 = *(const f32x4*)(bias + c + 4);
#pragma unroll
                            for (int j = 0; j < 4; ++j) { v[j] = a[j] * sigm(v[j] + b0[j]); v[4 + j] = a[4 + j] * sigm(v[4 + j] + b1[j]); } }
                        else if (mode == 6) { unpack8(*(const u32x4*)(i0 + (size_t)row * 2048 + c), a);
#pragma unroll
                            for (int j = 0; j < 8; ++j) v[j] = a[j] * v[j]; }
                        else { unpack8(*(const u32x4*)(i0 + (size_t)row * 1024 + c), a); unpack8(*(const u32x4*)(i1 + (size_t)row * 2048 + c), b);
#pragma unroll
                            for (int j = 0; j < 8; ++j) v[j] = a[j] + b[j] * v[j]; }
                        *(u32x4*)(o0 + (size_t)row * 1024 + c) = pack8(v); } }
        }
    }
};
__device__ __forceinline__ void conv_item(const float* W, int ldsrc, int srccol, const float* kscale, bf16_t* WT, int K, int n0, int k0, LAS float* scr, int lane) {
    if (srccol >= 0) {
#pragma unroll 8
        for (int i = 0; i < 32; ++i) { const int kk = 2 * i + (lane >> 5); float w = W[(size_t)(k0 + kk) * ldsrc + srccol + (lane & 31)]; if (kscale) w *= kscale[k0 + kk]; scr[kk * 33 + (lane & 31)] = w; }
    } else {
#pragma unroll 8
        for (int i = 0; i < 32; ++i) { const int kk = 2 * i + (lane >> 5); scr[kk * 33 + (lane & 31)] = 0.f; }
    }
    asm volatile("s_waitcnt lgkmcnt(0)" ::: "memory");
    const int c = lane & 7;
#pragma unroll
    for (int j = 0; j < 4; ++j) { const int n = (lane >> 3) + 8 * j; const LAS float* s = scr + (8 * c) * 33 + n;
        u32x4 o; o.x = pk2(s[0 * 33], s[1 * 33]); o.y = pk2(s[2 * 33], s[3 * 33]); o.z = pk2(s[4 * 33], s[5 * 33]); o.w = pk2(s[6 * 33], s[7 * 33]);
        *(u32x4*)(WT + (size_t)(n0 + n) * K + k0 + 8 * c) = o; }
    asm volatile("s_waitcnt lgkmcnt(0)" ::: "memory");
}
struct WPtrs { const float *gate, *up, *down, *win, *qn, *wuq, *kvn, *wukv, *womla, *glu, *wos5, *wout; };
__device__ __forceinline__ void conv_layer(const WPtrs& P, int l, bf16_t* WL, LAS unsigned char* lds, int gw, int NGW, int wave, int lane) {
    LAS float* scr = (LAS float*)(lds + wave * 16384);
    constexpr int I_GU = 16 * 176, I_D = 44 * 32, I_IN = 16 * 120, I_UQ = 4 * 48, I_UKV = 4 * 64, I_SQ = 16 * 32;
    constexpr int NIT = 2 * I_GU + 2 * I_D + I_IN + I_UQ + I_UKV + 4 * I_SQ;
    for (int it = gw; it < NIT; it += NGW) {
        int r = it;
        if (r < 2 * I_GU) { const int f = r / I_GU; r -= f * I_GU; const int nb = r % 176, kb = r / 176, n0 = nb * 32, tile = n0 >> 8, within = n0 & 255, half = within >> 7, ffc = tile * 128 + (within & 127);
            const size_t so = (size_t)(l * 2 + f) * 1024 * FF; bf16_t* dst = WL + (f ? W_GUB : W_GUA);
            if (half) conv_item(P.up + so, FF, ffc, nullptr, dst, 1024, n0, kb * 64, scr, lane); else conv_item(P.gate + so, FF, ffc, nullptr, dst, 1024, n0, kb * 64, scr, lane);
            continue; }
        r -= 2 * I_GU;
        if (r < 2 * I_D) { const int f = r / I_D; r -= f * I_D; const int nb = r % 32, kb = r / 32;
            conv_item(P.down + (size_t)(l * 2 + f) * FF * 1024, 1024, nb * 32, nullptr, WL + (f ? W_DB : W_DA), FF, nb * 32, kb * 64, scr, lane); continue; }
        r -= 2 * I_D;
        if (r < I_IN) { const int nb = r % 120, kb = r / 120, n0 = nb * 32; int sc;
            if (n0 < 512) sc = n0; else if (n0 < 768) sc = (n0 < 576) ? n0 : -1; else sc = n0 - 768 + 576;
            conv_item(P.win + (size_t)l * 1024 * 3648, 3648, sc, nullptr, WL + W_IN, 1024, n0, kb * 64, scr, lane); continue; }
        r -= I_IN;
        if (r < I_UQ) { const int nb = r % 48, kb = r / 48, n0 = nb * 32; int sc;
            if (n0 < 1024) sc = (n0 >> 7) * 192 + (n0 & 127); else { const int rr = n0 - 1024; sc = (rr >> 6) * 192 + 128 + (rr & 63); }
            conv_item(P.wuq + (size_t)l * 256 * 1536, 1536, sc, P.qn + l * 256, WL + W_UQ, 256, n0, kb * 64, scr, lane); continue; }
        r -= I_UQ;
        if (r < I_UKV) { const int nb = r % 64, kb = r / 64;
            conv_item(P.wukv + (size_t)l * 256 * 2048, 2048, nb * 32, P.kvn + l * 256, WL + W_UKV, 256, nb * 32, kb * 64, scr, lane); continue; }
        r -= I_UKV;
        { const int q = r / I_SQ; r -= q * I_SQ; const int nb = r % 32, kb = r / 32; const size_t so = (size_t)l * 1024 * 1024;
          if (q == 0) conv_item(P.womla + so, 1024, nb * 32, nullptr, WL + W_OMLA, 1024, nb * 32, kb * 64, scr, lane);
          else if (q == 1) conv_item(P.glu + so, 1024, nb * 32, nullptr, WL + W_GLU, 1024, nb * 32, kb * 64, scr, lane);
          else if (q == 2) conv_item(P.wos5 + so, 1024, nb * 32, nullptr, WL + W_OS5, 1024, nb * 32, kb * 64, scr, lane);
          else conv_item(P.wout + so, 1024, nb * 32, nullptr, WL + W_OUT, 1024, nb * 32, kb * 64, scr, lane); }
    }
}

__device__ __forceinline__ void mods_phase(const float* c, const float* c_ctx, const float* ada_w, const float* ada_b, float* MOD, float* ROPE, LAS unsigned char* lds, const int tid) {

    LAS float* sc = (LAS float*)lds;
    LAS float* red = (LAS float*)(lds + 9 * 1024 * 4);
    if (blockIdx.x == gridDim.x - 1) {
        for (int e = tid; e < 1024; e += 512) { const int pos = e >> 4, i = e & 15; const float inv = exp2f(-(float)i * (13.287712379549449f / 16.0f)); const float ang = (float)pos * inv;
            float sn_, cs_; sincosf(ang, &sn_, &cs_); ROPE[2 * e] = cs_; ROPE[2 * e + 1] = sn_; }
    }
    bool have = false;
    for (int item = blockIdx.x; item < 576; item += gridDim.x) {
        if (!have) { for (int e = tid; e < 9 * 1024; e += 512) { const float v = (e < 8192) ? c[e] : c_ctx[e - 8192]; sc[e] = v * sigm(v); } have = true; }
        __syncthreads();
        const int l = item / 144, j0 = (item % 144) * 64, ks = tid >> 6, jj = tid & 63;
        const float* w = ada_w + ((size_t)l * 1024 + ks * 128) * 9216 + j0 + jj;
        float a[9];
#pragma unroll
        for (int s = 0; s < 9; ++s) a[s] = 0.f;
#pragma unroll 4
        for (int k = 0; k < 128; ++k) { const float wv = w[(size_t)k * 9216];
#pragma unroll
            for (int s = 0; s < 9; ++s) a[s] += sc[s * 1024 + ks * 128 + k] * wv; }
#pragma unroll
        for (int s = 0; s < 9; ++s) red[(ks * 9 + s) * 64 + jj] = a[s];
        __syncthreads();
        for (int e = tid; e < 576; e += 512) { const int s = e >> 6, j = e & 63; float t = 0.f;
#pragma unroll
            for (int q = 0; q < 8; ++q) t += red[(q * 9 + s) * 64 + j];
            MOD[((size_t)l * 9 + s) * 9216 + j0 + j] = t + ada_b[l * 9216 + j0 + j]; }
    }
    __syncthreads();
}

__device__ __forceinline__ void e_phase(const float* xin, const float* ctxin, float* xl, float* xc, const bf16_t* Y, const float* YSS, const float* MOD,
                                        const float* npre, const float* npost, bf16_t* H, int l, int s, int nl, int ns, int gw, int NGW, int lane) {
    for (int row = gw; row < R; row += NGW) {
        const bool lat = row < R_LAT; const int set = lat ? (row >> 12) : 8;
        float* xr = lat ? xl + (size_t)row * DM : xc + (size_t)(row - R_LAT) * DM;
        const float* xs = (s < 0) ? (lat ? xin + (size_t)row * DM : ctxin + (size_t)(row - R_LAT) * DM) : xr;
        f32x4 v[4];
#pragma unroll
        for (int j = 0; j < 4; ++j) v[j] = ((const f32x4*)xs)[lane + 64 * j];
        if (s >= 0) {
            const float part = (lane < 16) ? YSS[row * 16 + lane] : 0.f;
            const float rs = 1.0f / sqrtf(wave_sum(part) * (1.0f / 1024.0f) + EPS);
            const float wgt = (s == 1) ? 1.0f : 0.5f;
            const float* gate = MOD + ((size_t)(l * 9 + set) * 9 + 3 * s + 2) * 1024; const float* gp = npost + (l * 3 + s) * 1024;
#pragma unroll
            for (int j = 0; j < 4; ++j) { const u32x2 yw = ((const u32x2*)(Y + (size_t)row * DM))[lane + 64 * j];
                const f32x4 g4 = ((const f32x4*)gate)[lane + 64 * j], p4 = ((const f32x4*)gp)[lane + 64 * j];
                f32x4 y4; y4[0] = bf2f(yw.x & 0xffffu); y4[1] = __uint_as_float(yw.x & 0xffff0000u); y4[2] = bf2f(yw.y & 0xffffu); y4[3] = __uint_as_float(yw.y & 0xffff0000u);
                v[j] += (wgt * rs) * g4 * y4 * p4; }
        }
#pragma unroll
        for (int j = 0; j < 4; ++j) ((f32x4*)xr)[lane + 64 * j] = v[j];
        if (nl >= 0) {
            float q = 0.f;
#pragma unroll
            for (int j = 0; j < 4; ++j) q += (v[j][0] * v[j][0] + v[j][1] * v[j][1]) + (v[j][2] * v[j][2] + v[j][3] * v[j][3]);
            const float rs2 = 1.0f / sqrtf(wave_sum(q) * (1.0f / 1024.0f) + EPS);
            const float* mb = MOD + ((size_t)(nl * 9 + set) * 9 + 3 * ns) * 1024; const float* gp = npre + (nl * 3 + ns) * 1024;
#pragma unroll
            for (int j = 0; j < 4; ++j) { const f32x4 sh = ((const f32x4*)mb)[lane + 64 * j], sc = ((const f32x4*)(mb + 1024))[lane + 64 * j], p4 = ((const f32x4*)gp)[lane + 64 * j];
                const f32x4 h = v[j] * rs2 * p4 * (1.0f + sc) + sh;
                u32x2 o; o.x = pk2(h[0], h[1]); o.y = pk2(h[2], h[3]); ((u32x2*)(H + (size_t)row * DM))[lane + 64 * j] = o; }
        }
    }
}
struct S5In { const float *a_re, *a_im, *log_dt, *b_re, *b_im, *c_re, *c_im, *dsk; };
__device__ __forceinline__ void s5_abar(const S5In& P, int idx, int n, float& ar, float& ai, float& cr, float& ci) {
    const float are = P.a_re[idx * 64 + n], aim = P.a_im[idx * 64 + n];
    const float dt = expf(P.log_dt[idx]);
    const float mag = expf(dt * are); float sn, cs; sincosf(dt * aim, &sn, &cs);
    ar = mag * cs; ai = mag * sn;
    const float nr = ar - 1.f, ni = ai, den = 1.0f / (are * are + aim * aim);
    cr = (nr * are + ni * aim) * den; ci = (ni * are - nr * aim) * den;
}
__device__ __forceinline__ void s5_prep(const S5In& P, int l, int g, bf16_t* WEt, bf16_t* WYt, LAS unsigned char* lds, int tid) {
    LAS float* AP = (LAS float*)lds;
    LAS float* BB = AP + 2 * 17 * 64 * 2;
    LAS float* CC = BB + 2 * 64 * 16 * 2;
    LAS float* KL = CC + 2 * 16 * 64 * 2;
    if (tid < 128) { const int d = tid >> 6, n = tid & 63, idx = (l * 2 + d) * 64 + g; float ar, ai, cr, ci; s5_abar(P, idx, n, ar, ai, cr, ci);
        float pr = 1.f, pi = 0.f;
        for (int j = 0; j <= 16; ++j) { AP[((d * 17 + j) * 64 + n) * 2] = pr; AP[((d * 17 + j) * 64 + n) * 2 + 1] = pi; const float t0 = pr * ar - pi * ai, t1 = pr * ai + pi * ar; pr = t0; pi = t1; }
        for (int c = 0; c < 16; ++c) { const float br = P.b_re[(size_t)(idx * 64 + n) * 16 + c], bi = P.b_im[(size_t)(idx * 64 + n) * 16 + c];
            BB[((d * 64 + n) * 16 + c) * 2] = cr * br - ci * bi; BB[((d * 64 + n) * 16 + c) * 2 + 1] = cr * bi + ci * br; } }
    for (int e = tid; e < 2048; e += 512) { const int d = e >> 10, cn = e & 1023; const size_t src = (size_t)((l * 2 + d) * 64 + g) * 1024 + cn; CC[e * 2] = P.c_re[src]; CC[e * 2 + 1] = P.c_im[src]; }
    __syncthreads();
    { const int d = tid >> 8, c = (tid >> 4) & 15, cp = tid & 15; float acc[16];
#pragma unroll
      for (int j = 0; j < 16; ++j) acc[j] = 0.f;
      for (int n = 0; n < 64; ++n) { const float c_r = CC[((d * 16 + c) * 64 + n) * 2], c_i = CC[((d * 16 + c) * 64 + n) * 2 + 1], b_r = BB[((d * 64 + n) * 16 + cp) * 2], b_i = BB[((d * 64 + n) * 16 + cp) * 2 + 1];
          const float zr = c_r * b_r - c_i * b_i, zi = c_r * b_i + c_i * b_r;
#pragma unroll
          for (int j = 0; j < 16; ++j) acc[j] += zr * AP[((d * 17 + j) * 64 + n) * 2] - zi * AP[((d * 17 + j) * 64 + n) * 2 + 1]; }
#pragma unroll
      for (int j = 0; j < 16; ++j) KL[((d * 16 + j) * 16 + c) * 16 + cp] = acc[j]; }
    __syncthreads();
    for (int e = tid; e < 256 * 64; e += 512) { const int row = e >> 6, k8 = (e & 63) * 8, t = row >> 4, c = row & 15; float v[8];
        if (k8 < 256) { const int s = k8 >> 4, c0 = k8 & 15;
#pragma unroll
            for (int j = 0; j < 8; ++j) { const int cp = c0 + j; float val = 0.f;
                if (s <= t) val += KL[(((t - s)) * 16 + c) * 16 + cp];
                if (s >= t) val += KL[((16 + (s - t)) * 16 + c) * 16 + cp];
                if (s == t && cp == c) val += P.dsk[l * 1024 + g * 16 + c];
                v[j] = val; } }
        else { const int kk = k8 - 256, d = kk >> 7, im = (kk >> 6) & 1, n0 = kk & 63, jp = (d == 0) ? t + 1 : 16 - t;
#pragma unroll
            for (int j = 0; j < 8; ++j) { const int n = n0 + j; const float wr = AP[((d * 17 + jp) * 64 + n) * 2], wi = AP[((d * 17 + jp) * 64 + n) * 2 + 1], c_r = CC[((d * 16 + c) * 64 + n) * 2], c_i = CC[((d * 16 + c) * 64 + n) * 2 + 1];
                v[j] = im ? -(c_r * wi + c_i * wr) : (c_r * wr - c_i * wi); } }
        *(u32x4*)(WYt + ((size_t)g * 256 + row) * 512 + k8) = pack8(v); }
    for (int e = tid; e < 2 * 128 * 32; e += 512) { const int d = e >> 12, row = (e >> 5) & 127, k8 = (e & 31) * 8, im = row >> 6, n = row & 63, s = k8 >> 4, c0 = k8 & 15, ex = (d == 0) ? 15 - s : s; float v[8];
        const float wr = AP[((d * 17 + ex) * 64 + n) * 2], wi = AP[((d * 17 + ex) * 64 + n) * 2 + 1];
#pragma unroll
        for (int j = 0; j < 8; ++j) { const float b_r = BB[((d * 64 + n) * 16 + c0 + j) * 2], b_i = BB[((d * 64 + n) * 16 + c0 + j) * 2 + 1]; v[j] = im ? (wr * b_i + wi * b_r) : (wr * b_r - wi * b_i); }
        *(u32x4*)(WEt + ((size_t)(d * 64 + g) * 128 + row) * 256 + k8) = pack8(v); }
    __syncthreads();
}
__device__ __forceinline__ int s5_chunk_row(int b, int ch) { return ch < 16 ? R_LAT + b * 256 + 16 * ch : b * 4096 + 16 * (ch - 16); }
__device__ __forceinline__ void s5_main(const S5In& P, int l, const bf16_t* U, const bf16_t* WEt, const bf16_t* WYt, bf16_t* T, LAS unsigned char* lds, int tid) {
    const int lane = tid & 63, w = __builtin_amdgcn_readfirstlane(tid >> 6), fr = lane & 15, q = lane >> 4;
    constexpr int XP = 528;
    LAS unsigned char* XIN = lds; LAS float* ET = (LAS float*)(lds + 272 * XP);
#define S5_LOADA(dst, tile) do { const int row_ = s5_chunk_row(b, 16 * (tile) + fr); const bf16_t* up_ = U + (size_t)(row_ + (q >> 1)) * 1024 + g * 16 + 8 * (q & 1); \
        _Pragma("unroll") for (int kk = 0; kk < 8; ++kk) dst[kk] = *(const bf16x8*)(up_ + (size_t)(2 * kk) * 1024); } while (0)
    for (int item = blockIdx.x; item < 512; item += gridDim.x) {
        const int g = item & 63, b = item >> 6;
#pragma unroll 1
        for (int d = 0; d < 2; ++d) {
            bf16x8 bw[8];
            { const bf16_t* wp = WEt + ((size_t)(d * 64 + g) * 128 + 16 * w + fr) * 256 + 8 * q;
#pragma unroll
              for (int kk = 0; kk < 8; ++kk) bw[kk] = *(const bf16x8*)(wp + 32 * kk); }
            float tr = 1.f, ti = 0.f, xr = 0.f, xi = 0.f;
            if (w == 0) { float cr, ci; s5_abar(P, (l * 2 + d) * 64 + g, lane, tr, ti, cr, ci);
#pragma unroll
                for (int k = 0; k < 4; ++k) { const float n_r = tr * tr - ti * ti, n_i = 2.f * tr * ti; tr = n_r; ti = n_i; } }
            bf16x8 af[8], an[8];
            S5_LOADA(af, 0);
#pragma unroll 1
            for (int i = 0; i < 17; ++i) {
                const int tile = (d == 0 || i == 0) ? i : 17 - i;
                if (i < 16) { const int tn = (d == 0) ? i + 1 : 16 - i; S5_LOADA(an, tn); }
                f32x4 acc = {0.f, 0.f, 0.f, 0.f};
#pragma unroll
                for (int kk = 0; kk < 8; ++kk) acc = __builtin_amdgcn_mfma_f32_16x16x32_bf16(af[kk], bw[kk], acc, 0, 0, 0);
                LAS float* et = ET + (i & 1) * 2048;
#pragma unroll
                for (int r = 0; r < 4; ++r) et[(4 * q + r) * 128 + 16 * w + fr] = acc[r];
                __syncthreads();
                if (w == 0) {
                    float er[16], ei[16];
#pragma unroll
                    for (int c = 0; c < 16; ++c) { er[c] = et[c * 128 + lane]; ei[c] = et[c * 128 + 64 + lane]; }
#pragma unroll
                    for (int cc = 0; cc < 16; ++cc) { const int c = d ? 15 - cc : cc;
                        LAS bf16_t* xp = (LAS bf16_t*)(XIN + (16 * tile + c) * XP) + d * 128;
                        xp[lane] = (bf16_t)(pk2(xr, 0.f) & 0xffffu); xp[64 + lane] = (bf16_t)(pk2(xi, 0.f) & 0xffffu);
                        const float nxr = tr * xr - ti * xi + er[c], nxi = tr * xi + ti * xr + ei[c]; xr = nxr; xi = nxi; }
                }
#pragma unroll
                for (int kk = 0; kk < 8; ++kk) af[kk] = an[kk];
            }
            __syncthreads();
        }
#pragma unroll 1
        for (int nt = 0; nt < 2; ++nt) {
            bf16x8 by[16];
            { const bf16_t* wp = WYt + ((size_t)g * 256 + 32 * w + 16 * nt + fr) * 512 + 8 * q;
#pragma unroll
              for (int kk = 0; kk < 16; ++kk) by[kk] = *(const bf16x8*)(wp + 32 * kk); }
            bf16x8 af[8], an[8];
            S5_LOADA(af, 0);
#pragma unroll 1
            for (int tile = 0; tile < 17; ++tile) {
                if (tile < 16) S5_LOADA(an, tile + 1);
                f32x4 acc = {0.f, 0.f, 0.f, 0.f};
#pragma unroll
                for (int kk = 0; kk < 8; ++kk) acc = __builtin_amdgcn_mfma_f32_16x16x32_bf16(af[kk], by[kk], acc, 0, 0, 0);
                const LAS unsigned char* xq = XIN + (16 * tile + fr) * XP + 16 * q;
#pragma unroll
                for (int kk = 0; kk < 8; ++kk) { const bf16x8 xf = *(const LAS bf16x8*)(xq + 64 * kk); acc = __builtin_amdgcn_mfma_f32_16x16x32_bf16(xf, by[8 + kk], acc, 0, 0, 0); }
                const int t = 2 * w + nt;
#pragma unroll
                for (int r = 0; r < 4; ++r) { const int row = s5_chunk_row(b, 16 * tile + 4 * q + r) + t;
                    T[(size_t)row * 1024 + g * 16 + fr] = (bf16_t)(pk2(gelu_tanh(acc[r]), 0.f) & 0xffffu); }
#pragma unroll
                for (int kk = 0; kk < 8; ++kk) af[kk] = an[kk];
            }
        }
        __syncthreads();
    }
#undef S5_LOADA
}
__device__ __forceinline__ s16x4 vtr(const LAS unsigned char* p) { return __builtin_bit_cast(s16x4, __builtin_amdgcn_ds_read_tr16_b64_v4i16((LAS s16x4*)p)); }
__device__ __forceinline__ void attn_phase(LAS unsigned char* lds, const bf16_t* Q, const bf16_t* KV, const bf16_t* CQ, bf16_t* O, const int tid) {
    const int lane = tid & 63, wid = __builtin_amdgcn_readfirstlane(tid >> 6), r32 = lane & 31, hi = lane >> 5;
    constexpr int KP = 400, VP = 320, BUFB = 64 * KP + 64 * VP;
    const float C = 0.07216878364870322f * 1.4426950408889634f;
    const int kn_row = tid >> 4, kn_ch = tid & 15, kr_row = tid >> 3, kr_ch = tid & 7;
    for (int ui = 0;; ++ui) {
        const int unit = ui * (int)gridDim.x + (int)blockIdx.x; if (unit >= 1024 + 64) break;
        int b, h, qb;
        if (unit < 1024) { const int bh = unit >> 4; qb = unit & 15; b = bh >> 3; h = bh & 7; } else { const int bh = unit - 1024; qb = 16; b = bh >> 3; h = bh & 7; }
        const int qrow0 = (qb < 16) ? b * 4096 + qb * 256 : R_LAT + b * 256;
        const int NT = (qb < 16) ? 68 : 4;
        const bf16_t* qp = Q + (size_t)(qrow0 + wid * 32 + r32) * 1536;
        bf16x8 qf[12];
#pragma unroll
        for (int s = 0; s < 8; ++s) qf[s] = *(const bf16x8*)(qp + h * 128 + 16 * s + 8 * hi);
#pragma unroll
        for (int s = 0; s < 4; ++s) qf[8 + s] = *(const bf16x8*)(qp + 1024 + h * 64 + 16 * s + 8 * hi);
        u32x4 sk0, sk1, skr, sv0, sv1;
#define ATT_KROW(t) ((qb < 16) ? (((t) < 64) ? b * 4096 + (t) * 64 : R_LAT + b * 256 + ((t) - 64) * 64) : R_LAT + b * 256 + (t) * 64)
#define ATT_LOAD(t) do { const int kr0_ = ATT_KROW(t); const bf16_t* kvp_ = KV + (size_t)(kr0_ + kn_row) * 2048 + h * 256 + kn_ch * 8; \
        sk0 = *(const u32x4*)kvp_; sk1 = *(const u32x4*)(kvp_ + 32 * 2048); sv0 = *(const u32x4*)(kvp_ + 128); sv1 = *(const u32x4*)(kvp_ + 128 + 32 * 2048); \
        skr = *(const u32x4*)(CQ + (size_t)(kr0_ + kr_row) * 768 + 512 + kr_ch * 8); } while (0)
#define ATT_STORE(buf) do { LAS unsigned char* kb_ = lds + (buf) * BUFB; LAS unsigned char* vb_ = kb_ + 64 * KP; \
        *(LAS u32x4*)(kb_ + kn_row * KP + kn_ch * 16) = sk0; *(LAS u32x4*)(kb_ + (kn_row + 32) * KP + kn_ch * 16) = sk1; *(LAS u32x4*)(kb_ + kr_row * KP + 256 + kr_ch * 16) = skr; \
        *(LAS u32x4*)(vb_ + kn_row * VP + kn_ch * 16) = sv0; *(LAS u32x4*)(vb_ + (kn_row + 32) * VP + kn_ch * 16) = sv1; } while (0)
        ATT_LOAD(0); ATT_STORE(0);
        __syncthreads();
        float mrun = -1e30f, lrun = 0.f;
        f32x16 o[4];
#pragma unroll
        for (int d = 0; d < 4; ++d)
#pragma unroll
            for (int r = 0; r < 16; ++r) o[d][r] = 0.f;
        for (int t = 0; t < NT; ++t) {
            const int cur = t & 1;
            if (t + 1 < NT) ATT_LOAD(t + 1);
            f32x16 p0, p1;
#pragma unroll
            for (int r = 0; r < 16; ++r) { p0[r] = 0.f; p1[r] = 0.f; }
            { const LAS unsigned char* kb = lds + cur * BUFB + r32 * KP + hi * 16;
#pragma unroll
              for (int s = 0; s < 12; ++s) { const bf16x8 k0 = *(const LAS bf16x8*)(kb + s * 32), k1 = *(const LAS bf16x8*)(kb + 32 * KP + s * 32);
                  p0 = __builtin_amdgcn_mfma_f32_32x32x16_bf16(k0, qf[s], p0, 0, 0, 0); p1 = __builtin_amdgcn_mfma_f32_32x32x16_bf16(k1, qf[s], p1, 0, 0, 0); } }
            float mx = p0[0];
#pragma unroll
            for (int r = 0; r < 16; ++r) { mx = fmaxf(mx, p0[r]); mx = fmaxf(mx, p1[r]); }
            mx = fmaxf(mx, __shfl_xor(mx, 32));
            const float mn = fmaxf(mrun, mx * C), alpha = __builtin_amdgcn_exp2f(mrun - mn); mrun = mn;
            float rsum = 0.f;
#pragma unroll
            for (int r = 0; r < 16; ++r) { p0[r] = __builtin_amdgcn_exp2f(p0[r] * C - mn); p1[r] = __builtin_amdgcn_exp2f(p1[r] * C - mn); rsum += p0[r] + p1[r]; }
            lrun = lrun * alpha + rsum;
#pragma unroll
            for (int d = 0; d < 4; ++d)
#pragma unroll
                for (int r = 0; r < 16; ++r) o[d][r] *= alpha;
            bf16x8 pf[4];
            { u32x4 w;
              w.x = pk2(p0[0], p0[1]); w.y = pk2(p0[2], p0[3]); w.z = pk2(p0[4], p0[5]); w.w = pk2(p0[6], p0[7]); pf[0] = __builtin_bit_cast(bf16x8, w);
              w.x = pk2(p0[8], p0[9]); w.y = pk2(p0[10], p0[11]); w.z = pk2(p0[12], p0[13]); w.w = pk2(p0[14], p0[15]); pf[1] = __builtin_bit_cast(bf16x8, w);
              w.x = pk2(p1[0], p1[1]); w.y = pk2(p1[2], p1[3]); w.z = pk2(p1[4], p1[5]); w.w = pk2(p1[6], p1[7]); pf[2] = __builtin_bit_cast(bf16x8, w);
              w.x = pk2(p1[8], p1[9]); w.y = pk2(p1[10], p1[11]); w.z = pk2(p1[12], p1[13]); w.w = pk2(p1[14], p1[15]); pf[3] = __builtin_bit_cast(bf16x8, w); }
            { const LAS unsigned char* vb = lds + cur * BUFB + 64 * KP + (4 * hi + ((lane & 15) >> 2)) * VP + (16 * ((lane >> 4) & 1) + 4 * (lane & 3)) * 2;
#pragma unroll
              for (int d = 0; d < 4; ++d)
#pragma unroll
                  for (int s = 0; s < 4; ++s) { const s16x4 lo = vtr(vb + s * 16 * VP + d * 64), hh = vtr(vb + s * 16 * VP + 8 * VP + d * 64);
                      const bf16x8 vf = (bf16x8){lo[0], lo[1], lo[2], lo[3], hh[0], hh[1], hh[2], hh[3]};
                      o[d] = __builtin_amdgcn_mfma_f32_32x32x16_bf16(vf, pf[s], o[d], 0, 0, 0); } }
            if (t + 1 < NT) ATT_STORE(cur ^ 1);
            __syncthreads();
        }
        const float inv = 1.0f / (lrun + __shfl_xor(lrun, 32));
        bf16_t* op = O + (size_t)(qrow0 + wid * 32 + r32) * 1024 + h * 128;
#pragma unroll
        for (int d = 0; d < 4; ++d)
#pragma unroll
            for (int i4 = 0; i4 < 4; ++i4) { u32x2 w; w.x = pk2(o[d][4 * i4] * inv, o[d][4 * i4 + 1] * inv); w.y = pk2(o[d][4 * i4 + 2] * inv, o[d][4 * i4 + 3] * inv);
                *(u32x2*)(op + 32 * d + 8 * i4 + 4 * hi) = w; }
    }
#undef ATT_KROW
#undef ATT_LOAD
#undef ATT_STORE
}
#define XB_TMO      128
#define XB_XCNT(j)  (256  + 64 * (j))
#define XB_XSUB(j)  (1280 + 64 * (j))
#define XB_XGEN(j)  (2304 + 64 * (j))
#define XB_TOP      3328
#define XB_TOPGEN   3392
#define XCD_BAR_WORDS 3456
#define XB_SPIN_CAP (1u << 18)

__device__ __forceinline__ unsigned xb_ld(unsigned* p)              { return __hip_atomic_load(p, __ATOMIC_RELAXED, __HIP_MEMORY_SCOPE_AGENT); }
__device__ __forceinline__ unsigned xb_add(unsigned* p, unsigned v) { return __hip_atomic_fetch_add(p, v, __ATOMIC_RELAXED, __HIP_MEMORY_SCOPE_AGENT); }
__device__ __forceinline__ unsigned xb_xcc_id() { return (unsigned)__builtin_amdgcn_s_getreg((3 << 11) | 20) & 0xFu; }
#define XB_SPIN(cond, bar) do { unsigned _sp = 0; while (cond) { __builtin_amdgcn_s_sleep(1); \
    if ((++_sp & 255u) == 0u) { if (xb_ld(&(bar)[XB_TMO])) break; if (_sp > XB_SPIN_CAP) { atomicAdd(&(bar)[XB_TMO], 1u); break; } } } } while (0)

struct XcdBarrier {
    unsigned* bar; unsigned x;
    volatile LAS unsigned* st;
};

__device__ __forceinline__ XcdBarrier xcd_barrier_post(unsigned* bar, volatile LAS unsigned* st) {
    XcdBarrier b; b.bar = bar; b.x = xb_xcc_id(); b.st = st;
    if (threadIdx.x == 0) (void)xb_add(&bar[XB_XCNT(b.x)], 1u);
    return b;
}
__device__ __forceinline__ void xcd_barrier_complete(unsigned* bar, unsigned x, unsigned& nloc, unsigned& nx) {
    const unsigned G = gridDim.x * gridDim.y * gridDim.z;
    unsigned sum, cnt, mine, sp = 0u;
    for (;;) {
        sum = 0u; cnt = 0u; mine = 0u;
#pragma unroll
        for (unsigned j = 0; j < 16; ++j) { const unsigned c = xb_ld(&bar[XB_XCNT(j)]); sum += c; cnt += (c > 0u) ? 1u : 0u; mine = (j == x) ? c : mine; }
        if (sum == G) break;
        __builtin_amdgcn_s_sleep(1);
        if ((++sp & 255u) == 0u) { if (xb_ld(&bar[XB_TMO])) break; if (sp > XB_SPIN_CAP) { atomicAdd(&bar[XB_TMO], 1u); break; } }
    }
    nloc = mine > 0u ? mine : 1u; nx = cnt > 0u ? cnt : 1u;
}

__device__ __forceinline__ void xcd_barrier(const XcdBarrier& b) {
    asm volatile("s_waitcnt vmcnt(0)" ::: "memory");
    __syncthreads();
    if (threadIdx.x == 0) {
        unsigned* bar = b.bar;
        __builtin_amdgcn_s_waitcnt(0);
        unsigned nloc = b.st[0], nx = b.st[1];
        if (nloc == 0u) { xcd_barrier_complete(bar, b.x, nloc, nx); b.st[0] = nloc; b.st[1] = nx; }
        const unsigned old = xb_add(&bar[XB_XSUB(b.x)], 1u);
        const unsigned gen = old / nloc;
        if (old + 1u == (gen + 1u) * nloc) {
            __builtin_amdgcn_fence(__ATOMIC_RELEASE, "agent");
            asm volatile("s_waitcnt vmcnt(0)" ::: "memory");
            const unsigned og = xb_add(&bar[XB_TOP], 1u);
            const unsigned tg = og / nx;
            if (og + 1u == (tg + 1u) * nx) xb_add(&bar[XB_TOPGEN], 1u);
            else XB_SPIN(xb_ld(&bar[XB_TOPGEN]) == tg, bar);
            __builtin_amdgcn_fence(__ATOMIC_ACQUIRE, "agent");
            xb_add(&bar[XB_XGEN(b.x)], 1u);
            asm volatile("s_waitcnt vmcnt(0)" ::: "memory");
        } else {
            XB_SPIN(xb_ld(&bar[XB_XGEN(b.x)]) == gen, bar);
            __builtin_amdgcn_fence(__ATOMIC_ACQUIRE, "agent");
            asm volatile("s_waitcnt vmcnt(0)" ::: "memory");
        }
    }
    __syncthreads();
}

#define DERIVE_PTRS float* MOD = (float*)(ws + WS_MOD); float* ROPE = (float*)(ws + WS_ROPE); float* YSS = (float*)(ws + WS_YSS); float* CSS = (float*)(ws + WS_CSS); bf16_t* WEt = (bf16_t*)(ws + WS_S5E); bf16_t* WYt = (bf16_t*)(ws + WS_S5E + S5_WE_BYTES); float* XC = (float*)(ws + WS_XC); bf16_t* WL = (bf16_t*)(ws + WS_WL); bf16_t* H = (bf16_t*)(ws + WS_H); unsigned char* big = ws + WS_BIG; bf16_t* CQ = (bf16_t*)(big + B_CQ); bf16_t* U = (bf16_t*)(big + B_U); bf16_t* Qb = (bf16_t*)(big + B_Q); bf16_t* KVb = (bf16_t*)(big + B_KV); bf16_t* SG = (bf16_t*)(big + B_SG); bf16_t* ACT = (bf16_t*)(big + B_ACT); bf16_t* Y = (bf16_t*)(big + B_Y); bf16_t* T = (bf16_t*)(big + B_T); bf16_t* Gb = (bf16_t*)(big + B_G); bf16_t* Mb = (bf16_t*)(big + B_M); bf16_t* Ob = H;
constexpr int NSTEPS = 2 + 14 * DEPTH;
struct Args { const float* in[29]; float* out; unsigned char* ws; int ph_lo, ph_hi; };
__global__ void __launch_bounds__(512, 2) mk_fwd(Args a) {
    extern __shared__ __attribute__((aligned(16))) unsigned char lds_raw[];
    cg::grid_group grid = cg::this_grid();
    LAS unsigned char* lds = (LAS unsigned char*)lds_raw;
    const int G = gridDim.x, NGW = G * 8;
    volatile LAS unsigned* xst = (volatile LAS unsigned*)(lds + LDS_BYTES - 64);
    if (threadIdx.x < 2) xst[threadIdx.x] = 0u;
    __syncthreads();
    XcdBarrier xbar; xbar.bar = (unsigned*)(a.ws + WS_CTL); xbar.x = 0; xbar.st = xst;
    if (a.ph_hi - a.ph_lo > 1) xbar = xcd_barrier_post((unsigned*)(a.ws + WS_CTL), xst);
    WPtrs WP{a.in[8], a.in[9], a.in[10], a.in[11], a.in[12], a.in[13], a.in[14], a.in[15], a.in[16], a.in[25], a.in[27], a.in[28]};
    S5In SP{a.in[17], a.in[18], a.in[19], a.in[20], a.in[21], a.in[22], a.in[23], a.in[24]};
#pragma unroll 1
    for (int step = a.ph_lo; step < a.ph_hi; ++step) {
        int tid = threadIdx.x; asm volatile("" : "+v"(tid));
        const int lane = tid & 63, wave = __builtin_amdgcn_readfirstlane(tid >> 6), gw = blockIdx.x * 8 + wave;
        unsigned char* ws = a.ws; asm volatile("" : "+s"(ws));
        DERIVE_PTRS
        int l = 0, p = -1;
        if (step >= 2) { l = (step - 2) / 14; p = (step - 2) % 14; }
        if (step == 0) mods_phase(a.in[1], a.in[3], a.in[4], a.in[5], MOD, ROPE, lds, tid);
        if (step == 0 || (p == 13 && l < DEPTH - 1)) conv_layer(WP, step == 0 ? 0 : l + 1, WL, lds, gw, NGW, wave, lane);
        if (p == 2 && blockIdx.x < 64) s5_prep(SP, l, blockIdx.x, WEt, WYt, lds, tid);
        if (step == 1 || p == 2 || p == 10 || p == 13) {
            int s, nl, ns;
            if (step == 1) { s = -1; nl = 0; ns = 0; } else if (p == 2) { s = 0; nl = l; ns = 1; } else if (p == 10) { s = 1; nl = l; ns = 2; } else { s = 2; nl = (l < DEPTH - 1) ? l + 1 : -1; ns = 0; }
            e_phase(a.in[0], a.in[2], a.out, XC, Y, YSS, MOD, a.in[6], a.in[7], H, l, s, nl, ns, gw, NGW, lane);
        }
        if (p == 0 || p == 1 || p == 3 || p == 4 || p == 7 || p == 8 || p == 9 || p == 11 || p == 12) {
            const int ng = (p == 4 || p == 8) ? 2 : 1;
#pragma unroll 1
            for (int gi = 0; gi < ng; ++gi) {
                pg8::Gemm g; Epi E; E.o0 = nullptr; E.o1 = nullptr; E.o2 = nullptr; E.i0 = nullptr; E.i1 = nullptr; E.ss = nullptr; E.css = CSS; E.bias = nullptr; E.rope = ROPE; E.mode = 0;
                g.M = R;
                if (p == 0 || p == 11) { g.A = H; g.Bt = WL + (p == 0 ? W_GUA : W_GUB); g.N = 5632; g.K = 1024; g.lda = 1024; E.mode = 0; E.o0 = ACT; }
                else if (p == 1 || p == 12) { g.A = ACT; g.Bt = WL + (p == 1 ? W_DA : W_DB); g.N = 1024; g.K = FF; g.lda = FF; E.mode = 1; E.o0 = Y; E.ss = YSS; }
                else if (p == 3) { g.A = H; g.Bt = WL + W_IN; g.N = 3840; g.K = 1024; g.lda = 1024; E.mode = 2; E.o0 = CQ; E.o1 = U; E.o2 = SG; E.ss = CSS; }
                else if (p == 4 && gi == 0) { g.A = CQ; g.Bt = WL + W_UQ; g.N = 1536; g.K = 256; g.lda = 768; E.mode = 3; E.o0 = Qb; }
                else if (p == 4) { g.A = CQ + 256; g.Bt = WL + W_UKV; g.N = 2048; g.K = 256; g.lda = 768; E.mode = 4; E.o0 = KVb; }
                else if (p == 7) { g.A = T; g.Bt = WL + W_GLU; g.N = 1024; g.K = 1024; g.lda = 1024; E.mode = 5; E.o0 = Gb; E.i0 = T; E.bias = a.in[26] + l * 1024; }
                else if (p == 8 && gi == 0) { g.A = Ob; g.Bt = WL + W_OMLA; g.N = 1024; g.K = 1024; g.lda = 1024; E.mode = 6; E.o0 = Mb; E.i0 = SG; }
                else if (p == 8) { g.A = Gb; g.Bt = WL + W_OS5; g.N = 1024; g.K = 1024; g.lda = 1024; E.mode = 7; E.o0 = Mb; E.i0 = Mb; E.i1 = SG + 1024; }
                else { g.A = Mb; g.Bt = WL + W_OUT; g.N = 1024; g.K = 1024; g.lda = 1024; E.mode = 1; E.o0 = Y; E.ss = YSS; }
                pg8::StaticOrder S; S.init(R, g.N, G, (int)blockIdx.x);
                pg8::gemm_phase<Epi, pg8::StaticOrder, true, true>(lds, g, S, E, tid);
#if MK_PROBE == 3
                if (p == 0 || p == 11) { __syncthreads(); pg8::gemm_phase<Epi, pg8::StaticOrder, true, true>(lds, g, S, E, tid); }
#endif
            }
        }
        if (p == 5) {
#pragma unroll 1
            for (int rep = 0; rep < (MK_PROBE == 1 ? 2 : 1); ++rep) attn_phase(lds, Qb, KVb, CQ, Ob, tid); }
        if (p == 6) {
#pragma unroll 1
            for (int rep = 0; rep < (MK_PROBE == 2 ? 2 : 1); ++rep) s5_main(SP, l, U, WEt, WYt, T, lds, tid); }
        if (step + 1 < a.ph_hi) {
            if (step == a.ph_lo) grid.sync(); else xcd_barrier(xbar);
#if MK_PROBE == 4
            xcd_barrier(xbar); xcd_barrier(xbar);
#endif
        }
    }
}

extern "C" void kernel_launch(void* const* d_in, const int* in_sizes, int n_in, void* d_out, int out_size, void* d_ws, size_t ws_size, hipStream_t stream) {
    static int grid = 0;
    if (grid == 0) {
        if (n_in != 29 || out_size != R_LAT * DM || ws_size < WS_END) { fprintf(stderr, "kernel_launch: unexpected problem (n_in %d out %d ws %zu need %zu)\n", n_in, out_size, ws_size, (size_t)WS_END); grid = -1; return; }
        int dev = 0, cus = 0, per_cu = 0;
        if (hipGetDevice(&dev) != hipSuccess || hipDeviceGetAttribute(&cus, hipDeviceAttributeMultiprocessorCount, dev) != hipSuccess) { grid = -1; return; }
        if (hipFuncSetAttribute((const void*)mk_fwd, hipFuncAttributeMaxDynamicSharedMemorySize, LDS_BYTES) != hipSuccess) { fprintf(stderr, "kernel_launch: hipFuncSetAttribute failed\n"); grid = -1; return; }
        if (hipOccupancyMaxActiveBlocksPerMultiprocessor(&per_cu, (const void*)mk_fwd, 512, LDS_BYTES) != hipSuccess || per_cu < 1) { fprintf(stderr, "kernel_launch: occupancy query says %d\n", per_cu); per_cu = 1; }
        (void)hipGetLastError();
        grid = cus * 1;
    }
    if (grid < 0) return;
    if (hipMemsetAsync((char*)d_ws + WS_CTL, 0, CTL_BYTES, stream) != hipSuccess) { fprintf(stderr, "kernel_launch: memset failed\n"); return; }
    Args a{};
    for (int i = 0; i < 29; ++i) a.in[i] = (const float*)d_in[i];
    a.out = (float*)d_out; a.ws = (unsigned char*)d_ws;
#if MK_MULTI
    for (int s = 0; s < NSTEPS; ++s) { a.ph_lo = s; a.ph_hi = s + 1; void* args[] = {&a};
        hipError_t e = hipLaunchCooperativeKernel((const void*)mk_fwd, dim3(grid), dim3(512), args, LDS_BYTES, stream);
        if (e != hipSuccess) { fprintf(stderr, "cooperative launch %d failed: %s\n", s, hipGetErrorString(e)); break; } }
#else
    a.ph_lo = 0; a.ph_hi = NSTEPS; void* args[] = {&a};
    hipError_t e = hipLaunchCooperativeKernel((const void*)mk_fwd, dim3(grid), dim3(512), args, LDS_BYTES, stream);
    if (e != hipSuccess) fprintf(stderr, "cooperative launch failed: %s (grid %d)\n", hipGetErrorString(e), grid);
#endif
}
```

```cpp
#include <hip/hip_runtime.h>
#include <hip/hip_cooperative_groups.h>
#include <cstdio>
#include <cstdint>
namespace cg = cooperative_groups;
#ifndef MK_MULTI
#define MK_MULTI 0
#endif
#ifndef MK_PROBE
#define MK_PROBE 0
#endif
namespace pg8 {
#define PG8_LAS __attribute__((address_space(3)))
typedef unsigned short bf16_t;
typedef short bf16x8 __attribute__((ext_vector_type(8)));
typedef float f32x4 __attribute__((ext_vector_type(4)));
typedef unsigned u32x4 __attribute__((ext_vector_type(4)));
constexpr int BM = 256, BK = 64, HALF = 128, HTB = HALF * BK * 2  , STAGE_BYTES = 8 * HTB, NXCD = 8, WGM = 8;

__host__ __device__ __forceinline__ int lds_byte(int r, int c) { const int st = (r >> 4) * 2 + (c >> 5), rr = r & 15, cc = c & 31, ob = rr * 64 + cc * 2; return st * 1024 + (ob ^ (((ob >> 9) & 1) << 5)); }
__host__ __device__ __forceinline__ void stage_rc(int b, int& R, int& C) { const int st = b / 1024, sb = b % 1024, swz = sb ^ (((sb >> 9) & 1) << 5); R = (st >> 1) * 16 + swz / 64; C = (st & 1) * 32 + (swz % 64) / 2; }
__host__ __device__ __forceinline__ int perm32(int rho) { const int n = rho >> 4, i = rho & 15; return 8 * (i >> 2) + 4 * n + (i & 3); }

struct Unit { int pm, pn; };
struct Gemm { const bf16_t* A; const bf16_t* Bt; int M, N, K, lda; };

struct StaticOrder {
    int nM, nN, nwg, G, c;
    __host__ __device__ void init(int M, int N, int G_, int c_) { nM = M / BM; nN = N / BM; nwg = nM * nN; G = G_; c = c_; }
    __host__ __device__ bool next(int i, Unit& u) const {
        const long L = (long)i * G + c; if (L >= nwg) return false;
        int wgid = (int)L; { const int q = nwg / NXCD, r = nwg % NXCD, xcd = wgid % NXCD, off = wgid / NXCD; wgid = (xcd < r ? xcd * (q + 1) : r * (q + 1) + (xcd - r) * q) + off; }
        const int nig = WGM * nN, gid = wgid / nig, fm = gid * WGM, gsz = (nM - fm) < WGM ? (nM - fm) : WGM;
        u.pm = fm + ((wgid % nig) % gsz); u.pn = (wgid % nig) / gsz; return true;
    }
    __device__ __forceinline__ void a_ready(const Unit&) const {}
    __device__ __forceinline__ void done(const Unit&) const {}
};

__device__ __forceinline__ unsigned cvt_pk_bf16(float lo, float hi) { unsigned r; asm volatile("v_cvt_pk_bf16_f32 %0, %1, %2" : "=v"(r) : "v"(lo), "v"(hi)); return r; }
template <class Epi, class Sched, bool ALIGN_EPI = false, bool SP2 = false>
__device__ __forceinline__ void gemm_phase(PG8_LAS unsigned char* lds, const Gemm g, const Sched& S, const Epi& E, const int tid) {
    const int wid = __builtin_amdgcn_readfirstlane(tid >> 6), lane = tid & 63, wr = wid >> 2, wc = wid & 3, fr = lane & 15, fq = lane >> 4;
    const int K = g.K, nt = K / BK;
    unsigned voffA[2], voffB[2];
#pragma unroll
    for (int i = 0; i < 2; ++i) { int R, C; stage_rc(tid * 16 + i * 8192, R, C); const int Rb = Epi::PERM ? ((R & ~31) + perm32(R & 31)) : R;
        voffA[i] = (unsigned)(R * g.lda + C) * 2u; voffB[i] = (unsigned)(Rb * K + C) * 2u; }
    const size_t kstep = (size_t)(BK * 2);
    const size_t hstep = (size_t)HALF * K * 2;
    const size_t tstep = 2 * hstep; const size_t hstepA = (size_t)HALF * g.lda * 2, tstepA = 2 * hstepA;
    const unsigned ldsw = (unsigned)wid * 1024u;
    const int aoff = lds_byte(wr * 64 + fr, fq * 8), boff = lds_byte(wc * 32 + fr, fq * 8);
#define PG8_SA(b, h) (((b) * 2 + (h)) * HTB)
#define PG8_SB(b, h) ((4 + (b) * 2 + (h)) * HTB)
#define PG8_STAGE(bufoff, gbase, voff) do { _Pragma("unroll") for (int _i = 0; _i < 2; ++_i) \
        __builtin_amdgcn_global_load_lds((const unsigned*)((const char*)(gbase) + (voff)[_i]), (PG8_LAS unsigned*)(lds + (bufoff) + ldsw + _i * 8192), 16, 0, 0); } while (0)
#define PG8_LDA(dst, b, h) do { _Pragma("unroll") for (int m = 0; m < 4; ++m) _Pragma("unroll") for (int k = 0; k < 2; ++k) dst[m][k] = *(const PG8_LAS bf16x8*)(lds + PG8_SA(b, h) + aoff + m * 2048 + k * 1024); } while (0)
#define PG8_LDB(dst, b, h) do { _Pragma("unroll") for (int n = 0; n < 2; ++n) _Pragma("unroll") for (int k = 0; k < 2; ++k) dst[n][k] = *(const PG8_LAS bf16x8*)(lds + PG8_SB(b, h) + boff + n * 2048 + k * 1024); } while (0)
#define PG8_MMA(ai, bj, At, Bt) do { __builtin_amdgcn_s_setprio(1); _Pragma("unroll") for (int m = 0; m < 4; ++m) _Pragma("unroll") for (int n = 0; n < 2; ++n) _Pragma("unroll") for (int k = 0; k < 2; ++k) \
        acc[ai][bj][m][n] = __builtin_amdgcn_mfma_f32_16x16x32_bf16(Bt[n][k], At[m][k], acc[ai][bj][m][n], 0, 0, 0); __builtin_amdgcn_s_setprio(0); } while (0)
#define PG8_WAIT_V(n) asm volatile("s_waitcnt vmcnt(" #n ")" ::: "memory")
#define PG8_WAIT_L(n) asm volatile("s_waitcnt lgkmcnt(" #n ")" ::: "memory")
#define PG8_BAR __builtin_amdgcn_s_barrier()
#define PG8_SCHED __builtin_amdgcn_sched_barrier(0)
    Unit cur, nxt; int ui = 0;
    if (!S.next(0, cur)) return;
    f32x4 acc[2][2][4][2];
#pragma unroll
    for (int a = 0; a < 2; ++a)
#pragma unroll
        for (int b = 0; b < 2; ++b)
#pragma unroll
            for (int m = 0; m < 4; ++m)
#pragma unroll
                for (int n = 0; n < 2; ++n) acc[a][b][m][n] = (f32x4){0.f, 0.f, 0.f, 0.f};
    bf16x8 At[4][2], B0[2][2], B1[2][2];
    const char* cA = (const char*)g.A + (size_t)cur.pm * tstepA; const char* cB = (const char*)g.Bt + (size_t)cur.pn * tstep;
    S.a_ready(cur);
    if constexpr (SP2) {
        PG8_STAGE(PG8_SB(0, 0), cB, voffB); PG8_STAGE(PG8_SB(0, 1), cB + hstep, voffB); PG8_STAGE(PG8_SA(0, 0), cA, voffA); PG8_STAGE(PG8_SA(0, 1), cA + hstepA, voffA);
        if (wr == 1) PG8_BAR;
        PG8_WAIT_V(2); PG8_BAR;
        PG8_STAGE(PG8_SB(1, 0), cB + kstep, voffB); PG8_STAGE(PG8_SA(1, 0), cA + kstep, voffA); PG8_STAGE(PG8_SB(1, 1), cB + hstep + kstep, voffB);
        PG8_WAIT_V(6); PG8_BAR;
    } else {
        PG8_STAGE(PG8_SB(0, 0), cB, voffB); PG8_STAGE(PG8_SA(0, 0), cA, voffA); PG8_STAGE(PG8_SB(0, 1), cB + hstep, voffB); PG8_STAGE(PG8_SA(0, 1), cA + hstepA, voffA);
        if (wr == 1) PG8_BAR;
        PG8_WAIT_V(4); PG8_BAR;
        PG8_STAGE(PG8_SB(1, 0), cB + kstep, voffB); PG8_STAGE(PG8_SA(1, 0), cA + kstep, voffA); PG8_STAGE(PG8_SB(1, 1), cB + hstep + kstep, voffB);
        PG8_WAIT_V(6); PG8_BAR;
    }
    for (;;) {
        const bool has_next = S.next(ui + 1, nxt);
        const char* nA = has_next ? (const char*)g.A + (size_t)nxt.pm * tstepA : cA; const char* nB = has_next ? (const char*)g.Bt + (size_t)nxt.pn * tstep : cB;
        for (int t = 0; t < nt; t += 2) {
            const bool last = (t == nt - 2);
            const char* a1 = cA + (size_t)(t + 1) * kstep;
            const char* a2 = last ? nA : cA + (size_t)(t + 2) * kstep; const char* b2 = last ? nB : cB + (size_t)(t + 2) * kstep;
            const char* a3 = a2 + kstep; const char* b3 = b2 + kstep;
            if (last && has_next) S.a_ready(nxt);
            if constexpr (SP2) {
            PG8_LDB(B0, 0, 0); PG8_LDB(B1, 0, 1); PG8_SCHED; PG8_LDA(At, 0, 0); PG8_STAGE(PG8_SA(1, 1), a1 + hstepA, voffA);
            PG8_WAIT_V(8); PG8_WAIT_L(0); PG8_BAR; PG8_MMA(0, 0, At, B0); PG8_MMA(0, 1, At, B1); PG8_BAR; PG8_SCHED;
            PG8_LDA(At, 0, 1); PG8_STAGE(PG8_SB(0, 0), b2, voffB); PG8_STAGE(PG8_SB(0, 1), b2 + hstep, voffB); PG8_STAGE(PG8_SA(0, 0), a2, voffA);
            PG8_WAIT_V(8); PG8_WAIT_L(0); PG8_BAR; PG8_MMA(1, 0, At, B0); PG8_MMA(1, 1, At, B1); PG8_BAR; PG8_SCHED;
            PG8_LDB(B0, 1, 0); PG8_LDB(B1, 1, 1); PG8_SCHED; PG8_LDA(At, 1, 0); PG8_STAGE(PG8_SA(0, 1), a2 + hstepA, voffA);
            PG8_WAIT_V(8); PG8_WAIT_L(0); PG8_BAR; PG8_MMA(0, 0, At, B0); PG8_MMA(0, 1, At, B1); PG8_BAR; PG8_SCHED;
            PG8_LDA(At, 1, 1); PG8_STAGE(PG8_SB(1, 0), b3, voffB); PG8_STAGE(PG8_SB(1, 1), b3 + hstep, voffB); PG8_STAGE(PG8_SA(1, 0), a3, voffA);
            PG8_WAIT_V(8); PG8_WAIT_L(0); PG8_BAR; PG8_MMA(1, 0, At, B0); PG8_MMA(1, 1, At, B1); PG8_BAR; PG8_SCHED;
            } else {
            PG8_LDB(B0, 0, 0); PG8_SCHED; PG8_LDA(At, 0, 0); PG8_STAGE(PG8_SA(1, 1), a1 + hstepA, voffA);
            PG8_WAIT_L(8); PG8_BAR; PG8_WAIT_L(0); PG8_MMA(0, 0, At, B0); PG8_BAR; PG8_SCHED;
            PG8_LDB(B1, 0, 1); PG8_STAGE(PG8_SB(0, 0), b2, voffB);
            PG8_BAR; PG8_WAIT_L(0); PG8_MMA(0, 1, At, B1); PG8_BAR;
            PG8_LDA(At, 0, 1); PG8_STAGE(PG8_SA(0, 0), a2, voffA);
            PG8_BAR; PG8_WAIT_L(0); PG8_MMA(1, 0, At, B0); PG8_BAR; PG8_SCHED;
            PG8_STAGE(PG8_SB(0, 1), b2 + hstep, voffB);
            PG8_WAIT_V(6); PG8_BAR; PG8_MMA(1, 1, At, B1); PG8_BAR;
            PG8_LDB(B0, 1, 0); PG8_SCHED; PG8_LDA(At, 1, 0); PG8_STAGE(PG8_SA(0, 1), a2 + hstepA, voffA);
            PG8_WAIT_L(8); PG8_BAR; PG8_WAIT_L(0); PG8_MMA(0, 0, At, B0); PG8_BAR; PG8_SCHED;
            PG8_LDB(B1, 1, 1); PG8_STAGE(PG8_SB(1, 0), b3, voffB);
            PG8_BAR; PG8_WAIT_L(0); PG8_MMA(0, 1, At, B1); PG8_BAR;
            PG8_LDA(At, 1, 1); PG8_STAGE(PG8_SA(1, 0), a3, voffA);
            PG8_BAR; PG8_WAIT_L(0); PG8_MMA(1, 0, At, B0); PG8_BAR; PG8_SCHED;
            PG8_STAGE(PG8_SB(1, 1), b3 + hstep, voffB);
            PG8_WAIT_V(6); PG8_BAR; PG8_MMA(1, 1, At, B1); PG8_BAR;
            }
        }
        if constexpr (ALIGN_EPI) { if (wr == 0) PG8_BAR; }
        if constexpr (!Epi::AFTER_DRAIN) { E(acc, cur, wr, wc, fr, fq); S.done(cur); }
        if (!has_next) break;
#pragma unroll
        for (int a = 0; a < 2; ++a)
#pragma unroll
            for (int b = 0; b < 2; ++b)
#pragma unroll
                for (int m = 0; m < 4; ++m)
#pragma unroll
                    for (int n = 0; n < 2; ++n) acc[a][b][m][n] = (f32x4){0.f, 0.f, 0.f, 0.f};
        cur = nxt; cA = nA; cB = nB; ++ui;
        if constexpr (ALIGN_EPI) { if (wr == 1) PG8_BAR; }
    }
    PG8_WAIT_V(0);
    if constexpr (!ALIGN_EPI) { if (wr == 0) PG8_BAR; }
    PG8_BAR;
    if constexpr (Epi::AFTER_DRAIN) { E.fused(acc, cur, wr, wc, fr, fq, lds, wid, lane); S.done(cur); }
#undef PG8_SA
#undef PG8_SB
#undef PG8_STAGE
#undef PG8_LDA
#undef PG8_LDB
#undef PG8_MMA
#undef PG8_WAIT_V
#undef PG8_WAIT_L
#undef PG8_BAR
#undef PG8_SCHED
}
}
using pg8::bf16_t; using pg8::f32x4; using pg8::u32x4; using pg8::bf16x8; using pg8::Unit;
#define LAS __attribute__((address_space(3)))
typedef float f32x16 __attribute__((ext_vector_type(16)));
typedef unsigned u32x2 __attribute__((ext_vector_type(2)));
typedef short s16x4 __attribute__((ext_vector_type(4)));
constexpr int NB = 8, SEQ = 4096, CTXL = 256, DM = 1024, FF = 2816, DEPTH = 4, NH = 8;
constexpr int R_LAT = NB * SEQ, R_CTX = NB * CTXL, R = R_LAT + R_CTX;
constexpr float EPS = 1e-6f;
constexpr int NCH = 34;
constexpr size_t W_GUA = 0, W_DA = W_GUA + (size_t)5632 * 1024, W_GUB = W_DA + (size_t)1024 * 2816, W_DB = W_GUB + (size_t)5632 * 1024,
                 W_IN = W_DB + (size_t)1024 * 2816, W_UQ = W_IN + (size_t)3840 * 1024, W_UKV = W_UQ + (size_t)1536 * 256, W_OMLA = W_UKV + (size_t)2048 * 256,
                 W_GLU = W_OMLA + (size_t)1024 * 1024, W_OS5 = W_GLU + (size_t)1024 * 1024, W_OUT = W_OS5 + (size_t)1024 * 1024, W_END = W_OUT + (size_t)1024 * 1024;
constexpr size_t al256(size_t x) { return (x + 255) & ~(size_t)255; }
constexpr size_t WS_CTL = 0, CTL_BYTES = 16384;
constexpr size_t WS_MOD = WS_CTL + CTL_BYTES;
constexpr size_t WS_ROPE = WS_MOD + al256((size_t)4 * 9 * 9216 * 4);
constexpr size_t WS_YSS = WS_ROPE + al256(64 * 16 * 8);
constexpr size_t WS_CSS = WS_YSS + al256((size_t)R * 16 * 4);
constexpr size_t WS_S5E = WS_CSS + al256((size_t)R * 8 * 4);
constexpr size_t S5_WE_BYTES = (size_t)2 * 64 * 128 * 256 * 2, S5_WY_BYTES = (size_t)64 * 256 * 512 * 2;
constexpr size_t WS_XC = WS_S5E + al256(S5_WE_BYTES + S5_WY_BYTES);
constexpr size_t WS_WL = WS_XC + al256((size_t)R_CTX * DM * 4);
constexpr size_t WS_H = WS_WL + al256(W_END * 2);
constexpr size_t WS_BIG = WS_H + al256((size_t)R * DM * 2);
constexpr size_t B_CQ = 0, B_U = B_CQ + (size_t)R * 768 * 2, B_Q = B_U + (size_t)R * 1024 * 2, B_KV = B_Q + (size_t)R * 1536 * 2, B_SG = B_KV + (size_t)R * 2048 * 2, B_END = B_SG + (size_t)R * 2048 * 2;
constexpr size_t B_ACT = 0, B_Y = (size_t)R * FF * 2;
constexpr size_t B_T = B_Q, B_G = B_KV, B_M = B_U;
static_assert(B_Y >= B_T + (size_t)R * 1024 * 2 && B_Y + (size_t)R * 1024 * 2 <= B_SG, "Y overlay");
constexpr size_t WS_END = WS_BIG + B_END;
constexpr int LDS_BYTES = 272 * 528 + 8192 + 16 * 528 + 256;

__device__ __forceinline__ float bf2f(unsigned h) { return __uint_as_float(h << 16); }
__device__ __forceinline__ unsigned pk2(float lo, float hi) { return pg8::cvt_pk_bf16(lo, hi); }
__device__ __forceinline__ float sigm(float x) { return __builtin_amdgcn_rcpf(1.f + __builtin_amdgcn_exp2f(-1.4426950408889634f * x)); }
__device__ __forceinline__ float gelu_tanh(float x) { return x * sigm(1.5957691216057308f * (x + 0.044715f * x * x * x)); }
__device__ __forceinline__ void unpack8(const u32x4 w, float (&f)[8]) {
    f[0] = bf2f(w.x & 0xffffu); f[1] = __uint_as_float(w.x & 0xffff0000u); f[2] = bf2f(w.y & 0xffffu); f[3] = __uint_as_float(w.y & 0xffff0000u);
    f[4] = bf2f(w.z & 0xffffu); f[5] = __uint_as_float(w.z & 0xffff0000u); f[6] = bf2f(w.w & 0xffffu); f[7] = __uint_as_float(w.w & 0xffff0000u);
}
__device__ __forceinline__ u32x4 pack8(const float (&f)[8]) { u32x4 w; w.x = pk2(f[0], f[1]); w.y = pk2(f[2], f[3]); w.z = pk2(f[4], f[5]); w.w = pk2(f[6], f[7]); return w; }
__device__ __forceinline__ float wave_sum(float v) {
#pragma unroll
    for (int o = 1; o < 64; o <<= 1) v += __shfl_xor(v, o);
    return v;
}
__device__ __forceinline__ void rope8(float (&v)[8], int row, int wc, int fq, const float* tab) {
    const int t = row & 4095, pos = (wc & 1) ? (t & 63) : (t >> 6);
    const f32x4* tp = (const f32x4*)(tab + (pos * 16 + 8 * (fq & 1)) * 2);
    const f32x4 t0 = tp[0], t1 = tp[1], t2 = tp[2], t3 = tp[3];
    const float cs[8] = {t0[0], t0[2], t1[0], t1[2], t2[0], t2[2], t3[0], t3[2]}, sn[8] = {t0[1], t0[3], t1[1], t1[3], t2[1], t2[3], t3[1], t3[3]};
    const float sgn = (fq < 2) ? -1.f : 1.f;
#pragma unroll
    for (int j = 0; j < 8; ++j) { const float p = __shfl_xor(v[j], 32); v[j] = v[j] * cs[j] + sgn * p * sn[j]; }
}

struct Epi {
    static constexpr bool PERM = true, AFTER_DRAIN = false;
    int mode;
    bf16_t* o0; bf16_t* o1; bf16_t* o2; const bf16_t* i0; const bf16_t* i1; float* ss; const float* css; const float* bias; const float* rope;
    __device__ __forceinline__ void operator()(const f32x4 (&acc)[2][2][4][2], const Unit& u, int wr, int wc, int fr, int fq) const {
        const int row0 = u.pm * 256 + wr * 64 + fr, cb = wc * 32 + 8 * fq, pn = u.pn;
        if (mode == 0) {
            bf16_t* base = o0 + (size_t)pn * 128 + cb;
#pragma unroll
            for (int ai = 0; ai < 2; ++ai)
#pragma unroll
                for (int m = 0; m < 4; ++m) { const int row = row0 + ai * 128 + m * 16; float v[8];
#pragma unroll
                    for (int n = 0; n < 2; ++n)
#pragma unroll
                        for (int j = 0; j < 4; ++j) { const float g = acc[ai][0][m][n][j], up = acc[ai][1][m][n][j]; v[4 * n + j] = g * sigm(g) * up; }
                    *(u32x4*)(base + (size_t)row * FF) = pack8(v); }
        } else if (mode == 1) {
            bf16_t* base = o0 + pn * 256 + cb;
#pragma unroll
            for (int ai = 0; ai < 2; ++ai)
#pragma unroll
                for (int m = 0; m < 4; ++m) { const int row = row0 + ai * 128 + m * 16; float s = 0.f;
#pragma unroll
                    for (int bj = 0; bj < 2; ++bj) { float v[8];
#pragma unroll
                        for (int n = 0; n < 2; ++n)
#pragma unroll
                            for (int j = 0; j < 4; ++j) { const float x = acc[ai][bj][m][n][j]; v[4 * n + j] = x; s += x * x; }
                        *(u32x4*)(base + (size_t)row * 1024 + bj * 128) = pack8(v); }
                    s += __shfl_xor(s, 16); s += __shfl_xor(s, 32);
                    if (fq == 0) ss[row * 16 + pn * 4 + wc] = s; }
        } else if (mode == 2) {
            bf16_t* dst; int ldc;
            if (pn < 3) { dst = o0 + pn * 256; ldc = 768; } else if (pn < 7) { dst = o1 + (pn - 3) * 256; ldc = 1024; } else { dst = o2 + (pn - 7) * 256; ldc = 2048; }
            const bool sg = pn >= 7, docss = pn < 2, dorope = (pn == 2) && (u.pm < 128) && (wc < 2);
            dst += cb;
#pragma unroll
            for (int ai = 0; ai < 2; ++ai)
#pragma unroll
                for (int m = 0; m < 4; ++m) { const int row = row0 + ai * 128 + m * 16; float s = 0.f;
#pragma unroll
                    for (int bj = 0; bj < 2; ++bj) { float v[8];
#pragma unroll
                        for (int n = 0; n < 2; ++n)
#pragma unroll
                            for (int j = 0; j < 4; ++j) { float x = acc[ai][bj][m][n][j]; if (sg) x = sigm(x); v[4 * n + j] = x; s += x * x; }
                        if (bj == 0 && dorope) rope8(v, row, wc, fq, rope);
                        *(u32x4*)(dst + (size_t)row * ldc + bj * 128) = pack8(v); }
                    if (docss) { s += __shfl_xor(s, 16); s += __shfl_xor(s, 32); if (fq == 0) ss[row * 8 + pn * 4 + wc] = s; } }
        } else if (mode == 3 || mode == 4) {
            const int ldc = (mode == 3) ? 1536 : 2048; const float* cp = css + ((mode == 3) ? 0 : 4);
            const bool dorope = (mode == 3) && (pn >= 4) && (u.pm < 128);
            bf16_t* dst = o0 + pn * 256 + cb;
#pragma unroll
            for (int ai = 0; ai < 2; ++ai)
#pragma unroll
                for (int m = 0; m < 4; ++m) { const int row = row0 + ai * 128 + m * 16; const f32x4 c4 = *(const f32x4*)(cp + row * 8);
                    const float rs = 1.0f / sqrtf(((c4[0] + c4[1]) + (c4[2] + c4[3])) * (1.0f / 256.0f) + EPS);
#pragma unroll
                    for (int bj = 0; bj < 2; ++bj) { float v[8];
#pragma unroll
                        for (int n = 0; n < 2; ++n)
#pragma unroll
                            for (int j = 0; j < 4; ++j) v[4 * n + j] = acc[ai][bj][m][n][j] * rs;
                        if (dorope) rope8(v, row, wc, fq, rope);
                        *(u32x4*)(dst + (size_t)row * ldc + bj * 128) = pack8(v); } }
        } else {
            const int col = pn * 256 + cb;
#pragma unroll
            for (int ai = 0; ai < 2; ++ai)
#pragma unroll
                for (int m = 0; m < 4; ++m) { const int row = row0 + ai * 128 + m * 16;
#pragma unroll
                    for (int bj = 0; bj < 2; ++bj) { const int c = col + bj * 128; float v[8], a[8], b[8];
#pragma unroll
                        for (int n = 0; n < 2; ++n)
#pragma unroll
                            for (int j = 0; j < 4; ++j) v[4 * n + j] = acc[ai][bj][m][n][j];
                        if (mode == 5) { unpack8(*(const u32x4*)(i0 + (size_t)row * 1024 + c), a); const f32x4 b0 = *(const f32x4*)(bias + c), b1 = *(const f32x4*)(bias + c + 4);
#pragma unroll
                            for (int j = 0; j < 4; ++j) { v[j] = a[j] * sigm(v[j] + b0[j]); v[4 + j] = a[4 + j] * sigm(v[4 + j] + b1[j]); } }
                        else if (mode == 6) { unpack8(*(const u32x4*)(i0 + (size_t)row * 2048 + c), a);
#pragma unroll
                            for (int j = 0; j < 8; ++j) v[j] = a[j] * v[j]; }
                        else { unpack8(*(const u32x4*)(i0 + (size_t)row * 1024 + c), a); unpack8(*(const u32x4*)(i1 + (size_t)row * 2048 + c), b);
#pragma unroll
                            for (int j = 0; j < 8; ++j) v[j] = a[j] + b[j] * v[j]; }
                        *(u32x4*)(o0 + (size_t)row * 1024 + c) = pack8(v); } }
        }
    }
};
__device__ __forceinline__ void conv_item(const float* W, int ldsrc, int srccol, const float* kscale, bf16_t* WT, int K, int n0, int k0, LAS float* scr, int lane) {
    if (srccol >= 0) {
#pragma unroll 8
        for (int i = 0; i < 32; ++i) { const int kk = 2 * i + (lane >> 5); float w = W[(size_t)(k0 + kk) * ldsrc + srccol + (lane & 31)]; if (kscale) w *= kscale[k0 + kk]; scr[kk * 33 + (lane & 31)] = w; }
    } else {
#pragma unroll 8
        for (int i = 0; i < 32; ++i) { const int kk = 2 * i + (lane >> 5); scr[kk * 33 + (lane & 31)] = 0.f; }
    }
    asm volatile("s_waitcnt lgkmcnt(0)" ::: "memory");
    const int c = lane & 7;
#pragma unroll
    for (int j = 0; j < 4; ++j) { const int n = (lane >> 3) + 8 * j; const LAS float* s = scr + (8 * c) * 33 + n;
        u32x4 o; o.x = pk2(s[0 * 33], s[1 * 33]); o.y = pk2(s[2 * 33], s[3 * 33]); o.z = pk2(s[4 * 33], s[5 * 33]); o.w = pk2(s[6 * 33], s[7 * 33]);
        *(u32x4*)(WT + (size_t)(n0 + n) * K + k0 + 8 * c) = o; }
    asm volatile("s_waitcnt lgkmcnt(0)" ::: "memory");
}
struct WPtrs { const float *gate, *up, *down, *win, *qn, *wuq, *kvn, *wukv, *womla, *glu, *wos5, *wout; };
__device__ __forceinline__ void conv_layer(const WPtrs& P, int l, bf16_t* WL, LAS unsigned char* lds, int gw, int NGW, int wave, int lane) {
    LAS float* scr = (LAS float*)(lds + wave * 16384);
    constexpr int I_GU = 16 * 176, I_D = 44 * 32, I_IN = 16 * 120, I_UQ = 4 * 48, I_UKV = 4 * 64, I_SQ = 16 * 32;
    constexpr int NIT = 2 * I_GU + 2 * I_D + I_IN + I_UQ + I_UKV + 4 * I_SQ;
    for (int it = gw; it < NIT; it += NGW) {
        int r = it;
        if (r < 2 * I_GU) { const int f = r / I_GU; r -= f * I_GU; const int nb = r % 176, kb = r / 176, n0 = nb * 32, tile = n0 >> 8, within = n0 & 255, half = within >> 7, ffc = tile * 128 + (within & 127);
            const size_t so = (size_t)(l * 2 + f) * 1024 * FF; bf16_t* dst = WL + (f ? W_GUB : W_GUA);
            if (half) conv_item(P.up + so, FF, ffc, nullptr, dst, 1024, n0, kb * 64, scr, lane); else conv_item(P.gate + so, FF, ffc, nullptr, dst, 1024, n0, kb * 64, scr, lane);
            continue; }
        r -= 2 * I_GU;
        if (r < 2 * I_D) { const int f = r / I_D; r -= f * I_D; const int nb = r % 32, kb = r / 32;
            conv_item(P.down + (size_t)(l * 2 + f) * FF * 1024, 1024, nb * 32, nullptr, WL + (f ? W_DB : W_DA), FF, nb * 32, kb * 64, scr, lane); continue; }
        r -= 2 * I_D;
        if (r < I_IN) { const int nb = r % 120, kb = r / 120, n0 = nb * 32; int sc;
            if (n0 < 512) sc = n0; else if (n0 < 768) sc = (n0 < 576) ? n0 : -1; else sc = n0 - 768 + 576;
            conv_item(P.win + (size_t)l * 1024 * 3648, 3648, sc, nullptr, WL + W_IN, 1024, n0, kb * 64, scr, lane); continue; }
        r -= I_IN;
        if (r < I_UQ) { const int nb = r % 48, kb = r / 48, n0 = nb * 32; int sc;
            if (n0 < 1024) sc = (n0 >> 7) * 192 + (n0 & 127); else { const int rr = n0 - 1024; sc = (rr >> 6) * 192 + 128 + (rr & 63); }
            conv_item(P.wuq + (size_t)l * 256 * 1536, 1536, sc, P.qn + l * 256, WL + W_UQ, 256, n0, kb * 64, scr, lane); continue; }
        r -= I_UQ;
        if (r < I_UKV) { const int nb = r % 64, kb = r / 64;
            conv_item(P.wukv + (size_t)l * 256 * 2048, 2048, nb * 32, P.kvn + l * 256, WL + W_UKV, 256, nb * 32, kb * 64, scr, lane); continue; }
        r -= I_UKV;
        { const int q = r / I_SQ; r -= q * I_SQ; const int nb = r % 32, kb = r / 32; const size_t so = (size_t)l * 1024 * 1024;
          if (q == 0) conv_item(P.womla + so, 1024, nb * 32, nullptr, WL + W_OMLA, 1024, nb * 32, kb * 64, scr, lane);
          else if (q == 1) conv_item(P.glu + so, 1024, nb * 32, nullptr, WL + W_GLU, 1024, nb * 32, kb * 64, scr, lane);
          else if (q == 2) conv_item(P.wos5 + so, 1024, nb * 32, nullptr, WL + W_OS5, 1024, nb * 32, kb * 64, scr, lane);
          else conv_item(P.wout + so, 1024, nb * 32, nullptr, WL + W_OUT, 1024, nb * 32, kb * 64, scr, lane); }
    }
}

__device__ __forceinline__ void mods_phase(const float* c, const float* c_ctx, const float* ada_w, const float* ada_b, float* MOD, float* ROPE, LAS unsigned char* lds, const int tid) {

    LAS float* sc = (LAS float*)lds;
    LAS float* red = (LAS float*)(lds + 9 * 1024 * 4);
    if (blockIdx.x == gridDim.x - 1) {
        for (int e = tid; e < 1024; e += 512) { const int pos = e >> 4, i = e & 15; const float inv = exp2f(-(float)i * (13.287712379549449f / 16.0f)); const float ang = (float)pos * inv;
            float sn_, cs_; sincosf(ang, &sn_, &cs_); ROPE[2 * e] = cs_; ROPE[2 * e + 1] = sn_; }
    }
    bool have = false;
    for (int item = blockIdx.x; item < 576; item += gridDim.x) {
        if (!have) { for (int e = tid; e < 9 * 1024; e += 512) { const float v = (e < 8192) ? c[e] : c_ctx[e - 8192]; sc[e] = v * sigm(v); } have = true; }
        __syncthreads();
        const int l = item / 144, j0 = (item % 144) * 64, ks = tid >> 6, jj = tid & 63;
        const float* w = ada_w + ((size_t)l * 1024 + ks * 128) * 9216 + j0 + jj;
        float a[9];
#pragma unroll
        for (int s = 0; s < 9; ++s) a[s] = 0.f;
#pragma unroll 4
        for (int k = 0; k < 128; ++k) { const float wv = w[(size_t)k * 9216];
#pragma unroll
            for (int s = 0; s < 9; ++s) a[s] += sc[s * 1024 + ks * 128 + k] * wv; }
#pragma unroll
        for (int s = 0; s < 9; ++s) red[(ks * 9 + s) * 64 + jj] = a[s];
        __syncthreads();
        for (int e = tid; e < 576; e += 512) { const int s = e >> 6, j = e & 63; float t = 0.f;
#pragma unroll
            for (int q = 0; q < 8; ++q) t += red[(q * 9 + s) * 64 + j];
            MOD[((size_t)l * 9 + s) * 9216 + j0 + j] = t + ada_b[l * 9216 + j0 + j]; }
    }
    __syncthreads();
}

__device__ __forceinline__ void e_phase(const float* xin, const float* ctxin, float* xl, float* xc, const bf16_t* Y, const float* YSS, const float* MOD,
                                        const float* npre, const float* npost, bf16_t* H, int l, int s, int nl, int ns, int gw, int NGW, int lane, float wmul, int nrows) {
    for (int row = gw; row < nrows; row += NGW) {
        const bool lat = row < R_LAT; const int set = lat ? (row >> 12) : 8;
        float* xr = lat ? xl + (size_t)row * DM : xc + (size_t)(row - R_LAT) * DM;
        const float* xs = (s < 0) ? (lat ? xin + (size_t)row * DM : ctxin + (size_t)(row - R_LAT) * DM) : xr;
        f32x4 v[4];
#pragma unroll
        for (int j = 0; j < 4; ++j) v[j] = ((const f32x4*)xs)[lane + 64 * j];
        if (s >= 0) {
            const float part = (lane < 16) ? YSS[row * 16 + lane] : 0.f;
            const float rs = 1.0f / sqrtf(wave_sum(part) * (1.0f / 1024.0f) + EPS);
            const float wgt = ((s == 1) ? 1.0f : 0.5f) * wmul;
            const float* gate = MOD + ((size_t)(l * 9 + set) * 9 + 3 * s + 2) * 1024; const float* gp = npost + (l * 3 + s) * 1024;
#pragma unroll
            for (int j = 0; j < 4; ++j) { const u32x2 yw = ((const u32x2*)(Y + (size_t)row * DM))[lane + 64 * j];
                const f32x4 g4 = ((const f32x4*)gate)[lane + 64 * j], p4 = ((const f32x4*)gp)[lane + 64 * j];
                f32x4 y4; y4[0] = bf2f(yw.x & 0xffffu); y4[1] = __uint_as_float(yw.x & 0xffff0000u); y4[2] = bf2f(yw.y & 0xffffu); y4[3] = __uint_as_float(yw.y & 0xffff0000u);
                v[j] += (wgt * rs) * g4 * y4 * p4; }
        }
#pragma unroll
        for (int j = 0; j < 4; ++j) ((f32x4*)xr)[lane + 64 * j] = v[j];
        if (nl >= 0) {
            float q = 0.f;
#pragma unroll
            for (int j = 0; j < 4; ++j) q += (v[j][0] * v[j][0] + v[j][1] * v[j][1]) + (v[j][2] * v[j][2] + v[j][3] * v[j][3]);
            const float rs2 = 1.0f / sqrtf(wave_sum(q) * (1.0f / 1024.0f) + EPS);
            const float* mb = MOD + ((size_t)(nl * 9 + set) * 9 + 3 * ns) * 1024; const float* gp = npre + (nl * 3 + ns) * 1024;
#pragma unroll
            for (int j = 0; j < 4; ++j) { const f32x4 sh = ((const f32x4*)mb)[lane + 64 * j], sc = ((const f32x4*)(mb + 1024))[lane + 64 * j], p4 = ((const f32x4*)gp)[lane + 64 * j];
                const f32x4 h = v[j] * rs2 * p4 * (1.0f + sc) + sh;
                u32x2 o; o.x = pk2(h[0], h[1]); o.y = pk2(h[2], h[3]); ((u32x2*)(H + (size_t)row * DM))[lane + 64 * j] = o; }
        }
    }
}
struct S5In { const float *a_re, *a_im, *log_dt, *b_re, *b_im, *c_re, *c_im, *dsk; };
__device__ __forceinline__ void s5_abar(const S5In& P, int idx, int n, float& ar, float& ai, float& cr, float& ci) {
    const float are = P.a_re[idx * 64 + n], aim = P.a_im[idx * 64 + n];
    const float dt = expf(P.log_dt[idx]);
    const float mag = expf(dt * are); float sn, cs; sincosf(dt * aim, &sn, &cs);
    ar = mag * cs; ai = mag * sn;
    const float nr = ar - 1.f, ni = ai, den = 1.0f / (are * are + aim * aim);
    cr = (nr * are + ni * aim) * den; ci = (ni * are - nr * aim) * den;
}
__device__ __forceinline__ void s5_prep(const S5In& P, int l, int g, bf16_t* WEt, bf16_t* WYt, LAS unsigned char* lds, int tid) {
    LAS float* AP = (LAS float*)lds;
    LAS float* BB = AP + 2 * 17 * 64 * 2;
    LAS float* CC = BB + 2 * 64 * 16 * 2;
    LAS float* KL = CC + 2 * 16 * 64 * 2;
    if (tid < 128) { const int d = tid >> 6, n = tid & 63, idx = (l * 2 + d) * 64 + g; float ar, ai, cr, ci; s5_abar(P, idx, n, ar, ai, cr, ci);
        float pr = 1.f, pi = 0.f;
        for (int j = 0; j <= 16; ++j) { AP[((d * 17 + j) * 64 + n) * 2] = pr; AP[((d * 17 + j) * 64 + n) * 2 + 1] = pi; const float t0 = pr * ar - pi * ai, t1 = pr * ai + pi * ar; pr = t0; pi = t1; }
        for (int c = 0; c < 16; ++c) { const float br = P.b_re[(size_t)(idx * 64 + n) * 16 + c], bi = P.b_im[(size_t)(idx * 64 + n) * 16 + c];
            BB[((d * 64 + n) * 16 + c) * 2] = cr * br - ci * bi; BB[((d * 64 + n) * 16 + c) * 2 + 1] = cr * bi + ci * br; } }
    for (int e = tid; e < 2048; e += 512) { const int d = e >> 10, cn = e & 1023; const size_t src = (size_t)((l * 2 + d) * 64 + g) * 1024 + cn; CC[e * 2] = P.c_re[src]; CC[e * 2 + 1] = P.c_im[src]; }
    __syncthreads();
    { const int d = tid >> 8, c = (tid >> 4) & 15, cp = tid & 15; float acc[16];
#pragma unroll
      for (int j = 0; j < 16; ++j) acc[j] = 0.f;
      for (int n = 0; n < 64; ++n) { const float c_r = CC[((d * 16 + c) * 64 + n) * 2], c_i = CC[((d * 16 + c) * 64 + n) * 2 + 1], b_r = BB[((d * 64 + n) * 16 + cp) * 2], b_i = BB[((d * 64 + n) * 16 + cp) * 2 + 1];
          const float zr = c_r * b_r - c_i * b_i, zi = c_r * b_i + c_i * b_r;
#pragma unroll
          for (int j = 0; j < 16; ++j) acc[j] += zr * AP[((d * 17 + j) * 64 + n) * 2] - zi * AP[((d * 17 + j) * 64 + n) * 2 + 1]; }
#pragma unroll
      for (int j = 0; j < 16; ++j) KL[((d * 16 + j) * 16 + c) * 16 + cp] = acc[j]; }
    __syncthreads();
    for (int e = tid; e < 256 * 64; e += 512) { const int row = e >> 6, k8 = (e & 63) * 8, t = row >> 4, c = row & 15; float v[8];
        if (k8 < 256) { const int s = k8 >> 4, c0 = k8 & 15;
#pragma unroll
            for (int j = 0; j < 8; ++j) { const int cp = c0 + j; float val = 0.f;
                if (s <= t) val += KL[(((t - s)) * 16 + c) * 16 + cp];
                if (s >= t) val += KL[((16 + (s - t)) * 16 + c) * 16 + cp];
                if (s == t && cp == c) val += P.dsk[l * 1024 + g * 16 + c];
                v[j] = val; } }
        else { const int kk = k8 - 256, d = kk >> 7, im = (kk >> 6) & 1, n0 = kk & 63, jp = (d == 0) ? t + 1 : 16 - t;
#pragma unroll
            for (int j = 0; j < 8; ++j) { const int n = n0 + j; const float wr = AP[((d * 17 + jp) * 64 + n) * 2], wi = AP[((d * 17 + jp) * 64 + n) * 2 + 1], c_r = CC[((d * 16 + c) * 64 + n) * 2], c_i = CC[((d * 16 + c) * 64 + n) * 2 + 1];
                v[j] = im ? -(c_r * wi + c_i * wr) : (c_r * wr - c_i * wi); } }
        *(u32x4*)(WYt + ((size_t)g * 256 + row) * 512 + k8) = pack8(v); }
    for (int e = tid; e < 2 * 128 * 32; e += 512) { const int d = e >> 12, row = (e >> 5) & 127, k8 = (e & 31) * 8, im = row >> 6, n = row & 63, s = k8 >> 4, c0 = k8 & 15, ex = (d == 0) ? 15 - s : s; float v[8];
        const float wr = AP[((d * 17 + ex) * 64 + n) * 2], wi = AP[((d * 17 + ex) * 64 + n) * 2 + 1];
#pragma unroll
        for (int j = 0; j < 8; ++j) { const float b_r = BB[((d * 64 + n) * 16 + c0 + j) * 2], b_i = BB[((d * 64 + n) * 16 + c0 + j) * 2 + 1]; v[j] = im ? (wr * b_i + wi * b_r) : (wr * b_r - wi * b_i); }
        *(u32x4*)(WEt + ((size_t)(d * 64 + g) * 128 + row) * 256 + k8) = pack8(v); }
    __syncthreads();
}
__device__ __forceinline__ int s5_chunk_row(int b, int ch) { return ch < 16 ? R_LAT + b * 256 + 16 * ch : b * 4096 + 16 * (ch - 16); }
__device__ __forceinline__ void s5_main(const S5In& P, int l, const bf16_t* U, const bf16_t* WEt, const bf16_t* WYt, bf16_t* T, LAS unsigned char* lds, int tid) {
    const int lane = tid & 63, w = __builtin_amdgcn_readfirstlane(tid >> 6), fr = lane & 15, q = lane >> 4;
    constexpr int XP = 528;
    LAS unsigned char* XIN = lds; LAS float* ET = (LAS float*)(lds + 272 * XP); LAS unsigned char* UC = lds + 272 * XP + 8192;
    const int uc_chunk = tid >> 5, uc_piece = tid & 31;
    LAS u32x4* uc_dst = (LAS u32x4*)(UC + uc_chunk * XP + uc_piece * 16);
    const LAS unsigned char* uc_a = UC + fr * XP + 16 * q;
#define S5_GLOAD(tile) (*(const u32x4*)(U + (size_t)(s5_chunk_row(b, 16 * (tile) + uc_chunk) + (uc_piece >> 1)) * 1024 + g * 16 + 8 * (uc_piece & 1)))
    for (int item = blockIdx.x; item < 512; item += gridDim.x) {
        const int g = item & 63, b = item >> 6;
#pragma unroll 1
        for (int d = 0; d < 2; ++d) {
            bf16x8 bw[8];
            { const bf16_t* wp = WEt + ((size_t)(d * 64 + g) * 128 + 16 * w + fr) * 256 + 8 * q;
#pragma unroll
              for (int kk = 0; kk < 8; ++kk) bw[kk] = *(const bf16x8*)(wp + 32 * kk); }
            float tr = 1.f, ti = 0.f, xr = 0.f, xi = 0.f;
            if (w == 0) { float cr, ci; s5_abar(P, (l * 2 + d) * 64 + g, lane, tr, ti, cr, ci);
#pragma unroll
                for (int k = 0; k < 4; ++k) { const float n_r = tr * tr - ti * ti, n_i = 2.f * tr * ti; tr = n_r; ti = n_i; } }
#define S5_TILE(i) (((d == 0) || (i) == 0) ? (i) : 17 - (i))
            u32x4 u0 = S5_GLOAD(S5_TILE(0)), u1 = S5_GLOAD(S5_TILE(1));
            *uc_dst = u0; u0 = u1; u1 = S5_GLOAD(S5_TILE(2));
            __syncthreads();
#pragma unroll 1
            for (int i = 0; i < 17; ++i) {
                const int tile = S5_TILE(i);
                f32x4 acc = {0.f, 0.f, 0.f, 0.f};
#pragma unroll
                for (int kk = 0; kk < 8; ++kk) { const bf16x8 af = *(const LAS bf16x8*)(uc_a + 64 * kk); acc = __builtin_amdgcn_mfma_f32_16x16x32_bf16(af, bw[kk], acc, 0, 0, 0); }
#pragma unroll
                for (int r = 0; r < 4; ++r) ET[(4 * q + r) * 128 + 16 * w + fr] = acc[r];
                __syncthreads();
                if (i < 16) { *uc_dst = u0; u0 = u1; if (i + 3 <= 16) u1 = S5_GLOAD(S5_TILE(i + 3)); }
                if (w == 0) {
                    float er[16], ei[16];
#pragma unroll
                    for (int c = 0; c < 16; ++c) { er[c] = ET[c * 128 + lane]; ei[c] = ET[c * 128 + 64 + lane]; }
#pragma unroll
                    for (int cc = 0; cc < 16; ++cc) { const int c = d ? 15 - cc : cc;
                        LAS bf16_t* xp = (LAS bf16_t*)(XIN + (16 * tile + c) * XP) + d * 128;
                        xp[lane] = (bf16_t)(pk2(xr, 0.f) & 0xffffu); xp[64 + lane] = (bf16_t)(pk2(xi, 0.f) & 0xffffu);
                        const float nxr = tr * xr - ti * xi + er[c], nxi = tr * xi + ti * xr + ei[c]; xr = nxr; xi = nxi; }
                }
                __syncthreads();
            }
#undef S5_TILE
        }
#pragma unroll 1
        for (int nt = 0; nt < 2; ++nt) {
            bf16x8 by[16];
            { const bf16_t* wp = WYt + ((size_t)g * 256 + 32 * w + 16 * nt + fr) * 512 + 8 * q;
#pragma unroll
              for (int kk = 0; kk < 16; ++kk) by[kk] = *(const bf16x8*)(wp + 32 * kk); }
            u32x4 u0 = S5_GLOAD(0), u1 = S5_GLOAD(1);
            *uc_dst = u0; u0 = u1; u1 = S5_GLOAD(2);
            __syncthreads();
#pragma unroll 1
            for (int tile = 0; tile < 17; ++tile) {
                f32x4 acc = {0.f, 0.f, 0.f, 0.f};
#pragma unroll
                for (int kk = 0; kk < 8; ++kk) { const bf16x8 af = *(const LAS bf16x8*)(uc_a + 64 * kk); acc = __builtin_amdgcn_mfma_f32_16x16x32_bf16(af, by[kk], acc, 0, 0, 0); }
                const LAS unsigned char* xq = XIN + (16 * tile + fr) * XP + 16 * q;
#pragma unroll
                for (int kk = 0; kk < 8; ++kk) { const bf16x8 xf = *(const LAS bf16x8*)(xq + 64 * kk); acc = __builtin_amdgcn_mfma_f32_16x16x32_bf16(xf, by[8 + kk], acc, 0, 0, 0); }
                const int t = 2 * w + nt;
#pragma unroll
                for (int r = 0; r < 4; ++r) { const int row = s5_chunk_row(b, 16 * tile + 4 * q + r) + t;
                    T[(size_t)row * 1024 + g * 16 + fr] = (bf16_t)(pk2(gelu_tanh(acc[r]), 0.f) & 0xffffu); }
                __syncthreads();
                if (tile < 16) { *uc_dst = u0; u0 = u1; if (tile + 3 <= 16) u1 = S5_GLOAD(tile + 3); }
                __syncthreads();
            }
        }
    }
#undef S5_GLOAD
}
__device__ __forceinline__ s16x4 vtr(const LAS unsigned char* p) { return __builtin_bit_cast(s16x4, __builtin_amdgcn_ds_read_tr16_b64_v4i16((LAS s16x4*)p)); }
__device__ __forceinline__ void attn_phase(LAS unsigned char* lds, const bf16_t* Q, const bf16_t* KV, const bf16_t* CQ, bf16_t* O, const int tid, const int nunits) {
    const int lane = tid & 63, wid = __builtin_amdgcn_readfirstlane(tid >> 6), r32 = lane & 31, hi = lane >> 5;
    constexpr int KP = 400, VP = 320, BUFB = 64 * KP + 64 * VP;
    const float C = 0.07216878364870322f * 1.4426950408889634f;
    const int kn_row = tid >> 4, kn_ch = tid & 15, kr_row = tid >> 3, kr_ch = tid & 7;
    for (int ui = 0;; ++ui) {
        const int unit = ui * (int)gridDim.x + (int)blockIdx.x; if (unit >= nunits) break;
        int b, h, qb;
        if (unit < 1024) { const int bh = unit >> 4; qb = unit & 15; b = bh >> 3; h = bh & 7; } else { const int bh = unit - 1024; qb = 16; b = bh >> 3; h = bh & 7; }
        const int qrow0 = (qb < 16) ? b * 4096 + qb * 256 : R_LAT + b * 256;
        const int NT = (qb < 16) ? 68 : 4;
        const bf16_t* qp = Q + (size_t)(qrow0 + wid * 32 + r32) * 1536;
        bf16x8 qf[12];
#pragma unroll
        for (int s = 0; s < 8; ++s) qf[s] = *(const bf16x8*)(qp + h * 128 + 16 * s + 8 * hi);
#pragma unroll
        for (int s = 0; s < 4; ++s) qf[8 + s] = *(const bf16x8*)(qp + 1024 + h * 64 + 16 * s + 8 * hi);
        u32x4 sk0, sk1, skr, sv0, sv1;
#define ATT_KROW(t) ((qb < 16) ? (((t) < 64) ? b * 4096 + (t) * 64 : R_LAT + b * 256 + ((t) - 64) * 64) : R_LAT + b * 256 + (t) * 64)
#define ATT_LOAD(t) do { const int kr0_ = ATT_KROW(t); const bf16_t* kvp_ = KV + (size_t)(kr0_ + kn_row) * 2048 + h * 256 + kn_ch * 8; \
        sk0 = *(const u32x4*)kvp_; sk1 = *(const u32x4*)(kvp_ + 32 * 2048); sv0 = *(const u32x4*)(kvp_ + 128); sv1 = *(const u32x4*)(kvp_ + 128 + 32 * 2048); \
        skr = *(const u32x4*)(CQ + (size_t)(kr0_ + kr_row) * 768 + 512 + kr_ch * 8); } while (0)
#define ATT_STORE(buf) do { LAS unsigned char* kb_ = lds + (buf) * BUFB; LAS unsigned char* vb_ = kb_ + 64 * KP; \
        *(LAS u32x4*)(kb_ + kn_row * KP + kn_ch * 16) = sk0; *(LAS u32x4*)(kb_ + (kn_row + 32) * KP + kn_ch * 16) = sk1; *(LAS u32x4*)(kb_ + kr_row * KP + 256 + kr_ch * 16) = skr; \
        *(LAS u32x4*)(vb_ + kn_row * VP + kn_ch * 16) = sv0; *(LAS u32x4*)(vb_ + (kn_row + 32) * VP + kn_ch * 16) = sv1; } while (0)
        ATT_LOAD(0); ATT_STORE(0);
        __syncthreads();
        float mrun = -1e30f, lrun = 0.f;
        f32x16 o[4];
#pragma unroll
        for (int d = 0; d < 4; ++d)
#pragma unroll
            for (int r = 0; r < 16; ++r) o[d][r] = 0.f;
        for (int t = 0; t < NT; ++t) {
            const int cur = t & 1;
            if (t + 1 < NT) ATT_LOAD(t + 1);
            f32x16 p0, p1;
#pragma unroll
            for (int r = 0; r < 16; ++r) { p0[r] = 0.f; p1[r] = 0.f; }
            __builtin_amdgcn_s_setprio(1);
            { const LAS unsigned char* kb = lds + cur * BUFB + r32 * KP + hi * 16;
#pragma unroll
              for (int s = 0; s < 12; ++s) { const bf16x8 k0 = *(const LAS bf16x8*)(kb + s * 32), k1 = *(const LAS bf16x8*)(kb + 32 * KP + s * 32);
                  p0 = __builtin_amdgcn_mfma_f32_32x32x16_bf16(k0, qf[s], p0, 0, 0, 0); p1 = __builtin_amdgcn_mfma_f32_32x32x16_bf16(k1, qf[s], p1, 0, 0, 0); } }
            __builtin_amdgcn_s_setprio(0);
            float mx = p0[0];
#pragma unroll
            for (int r = 0; r < 16; ++r) { mx = fmaxf(mx, p0[r]); mx = fmaxf(mx, p1[r]); }
            mx = fmaxf(mx, __shfl_xor(mx, 32)) * C;
            if (__any(mx > mrun + 8.0f)) {
                const float mn = fmaxf(mrun, mx), alpha = __builtin_amdgcn_exp2f(mrun - mn); mrun = mn; lrun *= alpha;
#pragma unroll
                for (int d = 0; d < 4; ++d)
#pragma unroll
                    for (int r = 0; r < 16; ++r) o[d][r] *= alpha;
            }
            float rsum = 0.f;
#pragma unroll
            for (int r = 0; r < 16; ++r) { p0[r] = __builtin_amdgcn_exp2f(p0[r] * C - mrun); p1[r] = __builtin_amdgcn_exp2f(p1[r] * C - mrun); rsum += p0[r] + p1[r]; }
            lrun += rsum;
            bf16x8 pf[4];
            { u32x4 w;
              w.x = pk2(p0[0], p0[1]); w.y = pk2(p0[2], p0[3]); w.z = pk2(p0[4], p0[5]); w.w = pk2(p0[6], p0[7]); pf[0] = __builtin_bit_cast(bf16x8, w);
              w.x = pk2(p0[8], p0[9]); w.y = pk2(p0[10], p0[11]); w.z = pk2(p0[12], p0[13]); w.w = pk2(p0[14], p0[15]); pf[1] = __builtin_bit_cast(bf16x8, w);
              w.x = pk2(p1[0], p1[1]); w.y = pk2(p1[2], p1[3]); w.z = pk2(p1[4], p1[5]); w.w = pk2(p1[6], p1[7]); pf[2] = __builtin_bit_cast(bf16x8, w);
              w.x = pk2(p1[8], p1[9]); w.y = pk2(p1[10], p1[11]); w.z = pk2(p1[12], p1[13]); w.w = pk2(p1[14], p1[15]); pf[3] = __builtin_bit_cast(bf16x8, w); }
            __builtin_amdgcn_s_setprio(1);
            { const LAS unsigned char* vb = lds + cur * BUFB + 64 * KP + (4 * hi + ((lane & 15) >> 2)) * VP + (16 * ((lane >> 4) & 1) + 4 * (lane & 3)) * 2;
#pragma unroll
              for (int d = 0; d < 4; ++d)
#pragma unroll
                  for (int s = 0; s < 4; ++s) { const s16x4 lo = vtr(vb + s * 16 * VP + d * 64), hh = vtr(vb + s * 16 * VP + 8 * VP + d * 64);
                      const bf16x8 vf = (bf16x8){lo[0], lo[1], lo[2], lo[3], hh[0], hh[1], hh[2], hh[3]};
                      o[d] = __builtin_amdgcn_mfma_f32_32x32x16_bf16(vf, pf[s], o[d], 0, 0, 0); } }
            __builtin_amdgcn_s_setprio(0);
            if (t + 1 < NT) ATT_STORE(cur ^ 1);
            __syncthreads();
        }
        const float inv = 1.0f / (lrun + __shfl_xor(lrun, 32));
        bf16_t* op = O + (size_t)(qrow0 + wid * 32 + r32) * 1024 + h * 128;
#pragma unroll
        for (int d = 0; d < 4; ++d)
#pragma unroll
            for (int i4 = 0; i4 < 4; ++i4) { u32x2 w; w.x = pk2(o[d][4 * i4] * inv, o[d][4 * i4 + 1] * inv); w.y = pk2(o[d][4 * i4 + 2] * inv, o[d][4 * i4 + 3] * inv);
                *(u32x2*)(op + 32 * d + 8 * i4 + 4 * hi) = w; }
    }
#undef ATT_KROW
#undef ATT_LOAD
#undef ATT_STORE
}
#define XB_TMO      128
#define XB_XCNT(j)  (256  + 64 * (j))
#define XB_XSUB(j)  (1280 + 64 * (j))
#define XB_XGEN(j)  (2304 + 64 * (j))
#define XB_TOP      3328
#define XB_TOPGEN   3392
#define XCD_BAR_WORDS 3456
#define XB_SPIN_CAP (1u << 18)

__device__ __forceinline__ unsigned xb_ld(unsigned* p)              { return __hip_atomic_load(p, __ATOMIC_RELAXED, __HIP_MEMORY_SCOPE_AGENT); }
__device__ __forceinline__ unsigned xb_add(unsigned* p, unsigned v) { return __hip_atomic_fetch_add(p, v, __ATOMIC_RELAXED, __HIP_MEMORY_SCOPE_AGENT); }
__device__ __forceinline__ unsigned xb_xcc_id() { return (unsigned)__builtin_amdgcn_s_getreg((3 << 11) | 20) & 0xFu; }
#define XB_SPIN(cond, bar) do { unsigned _sp = 0; while (cond) { __builtin_amdgcn_s_sleep(1); \
    if ((++_sp & 255u) == 0u) { if (xb_ld(&(bar)[XB_TMO])) break; if (_sp > XB_SPIN_CAP) { atomicAdd(&(bar)[XB_TMO], 1u); break; } } } } while (0)

struct XcdBarrier {
    unsigned* bar; unsigned x;
    volatile LAS unsigned* st;
};

__device__ __forceinline__ XcdBarrier xcd_barrier_post(unsigned* bar, volatile LAS unsigned* st) {
    XcdBarrier b; b.bar = bar; b.x = xb_xcc_id(); b.st = st;
    if (threadIdx.x == 0) (void)xb_add(&bar[XB_XCNT(b.x)], 1u);
    return b;
}
__device__ __forceinline__ void xcd_barrier_complete(unsigned* bar, unsigned x, unsigned& nloc, unsigned& nx) {
    const unsigned G = gridDim.x * gridDim.y * gridDim.z;
    unsigned sum, cnt, mine, sp = 0u;
    for (;;) {
        sum = 0u; cnt = 0u; mine = 0u;
#pragma unroll
        for (unsigned j = 0; j < 16; ++j) { const unsigned c = xb_ld(&bar[XB_XCNT(j)]); sum += c; cnt += (c > 0u) ? 1u : 0u; mine = (j == x) ? c : mine; }
        if (sum == G) break;
        __builtin_amdgcn_s_sleep(1);
        if ((++sp & 255u) == 0u) { if (xb_ld(&bar[XB_TMO])) break; if (sp > XB_SPIN_CAP) { atomicAdd(&bar[XB_TMO], 1u); break; } }
    }
    nloc = mine > 0u ? mine : 1u; nx = cnt > 0u ? cnt : 1u;
}

__device__ __forceinline__ void xcd_barrier(const XcdBarrier& b) {
    asm volatile("s_waitcnt vmcnt(0)" ::: "memory");
    __syncthreads();
    if (threadIdx.x == 0) {
        unsigned* bar = b.bar;
        __builtin_amdgcn_s_waitcnt(0);
        unsigned nloc = b.st[0], nx = b.st[1];
        if (nloc == 0u) { xcd_barrier_complete(bar, b.x, nloc, nx); b.st[0] = nloc; b.st[1] = nx; }
        const unsigned old = xb_add(&bar[XB_XSUB(b.x)], 1u);
        const unsigned gen = old / nloc;
        if (old + 1u == (gen + 1u) * nloc) {
            __builtin_amdgcn_fence(__ATOMIC_RELEASE, "agent");
            asm volatile("s_waitcnt vmcnt(0)" ::: "memory");
            const unsigned og = xb_add(&bar[XB_TOP], 1u);
            const unsigned tg = og / nx;
            if (og + 1u == (tg + 1u) * nx) xb_add(&bar[XB_TOPGEN], 1u);
            else XB_SPIN(xb_ld(&bar[XB_TOPGEN]) == tg, bar);
            __builtin_amdgcn_fence(__ATOMIC_ACQUIRE, "agent");
            xb_add(&bar[XB_XGEN(b.x)], 1u);
            asm volatile("s_waitcnt vmcnt(0)" ::: "memory");
        } else {
            XB_SPIN(xb_ld(&bar[XB_XGEN(b.x)]) == gen, bar);
            __builtin_amdgcn_fence(__ATOMIC_ACQUIRE, "agent");
            asm volatile("s_waitcnt vmcnt(0)" ::: "memory");
        }
    }
    __syncthreads();
}

#define DERIVE_PTRS float* MOD = (float*)(ws + WS_MOD); float* ROPE = (float*)(ws + WS_ROPE); float* YSS = (float*)(ws + WS_YSS); float* CSS = (float*)(ws + WS_CSS); bf16_t* WEt = (bf16_t*)(ws + WS_S5E); bf16_t* WYt = (bf16_t*)(ws + WS_S5E + S5_WE_BYTES); float* XC = (float*)(ws + WS_XC); bf16_t* WL = (bf16_t*)(ws + WS_WL); bf16_t* H = (bf16_t*)(ws + WS_H); unsigned char* big = ws + WS_BIG; bf16_t* CQ = (bf16_t*)(big + B_CQ); bf16_t* U = (bf16_t*)(big + B_U); bf16_t* Qb = (bf16_t*)(big + B_Q); bf16_t* KVb = (bf16_t*)(big + B_KV); bf16_t* SG = (bf16_t*)(big + B_SG); bf16_t* ACT = (bf16_t*)(big + B_ACT); bf16_t* Y = (bf16_t*)(big + B_Y); bf16_t* T = (bf16_t*)(big + B_T); bf16_t* Gb = (bf16_t*)(big + B_G); bf16_t* Mb = (bf16_t*)(big + B_M); bf16_t* Ob = H;
constexpr int NSTEPS = 2 + 14 * DEPTH;
struct Args { const float* in[29]; float* out; unsigned char* ws; int ph_lo, ph_hi; };
__global__ void __launch_bounds__(512, 2) mk_fwd(Args a) {
    extern __shared__ __attribute__((aligned(16))) unsigned char lds_raw[];
    cg::grid_group grid = cg::this_grid();
    LAS unsigned char* lds = (LAS unsigned char*)lds_raw;
    const int G = gridDim.x, NGW = G * 8;
    volatile LAS unsigned* xst = (volatile LAS unsigned*)(lds + LDS_BYTES - 64);
    if (threadIdx.x < 2) xst[threadIdx.x] = 0u;
    __syncthreads();
    XcdBarrier xbar; xbar.bar = (unsigned*)(a.ws + WS_CTL); xbar.x = 0; xbar.st = xst;
    if (a.ph_hi - a.ph_lo > 1) xbar = xcd_barrier_post((unsigned*)(a.ws + WS_CTL), xst);
    WPtrs WP{a.in[8], a.in[9], a.in[10], a.in[11], a.in[12], a.in[13], a.in[14], a.in[15], a.in[16], a.in[25], a.in[27], a.in[28]};
    S5In SP{a.in[17], a.in[18], a.in[19], a.in[20], a.in[21], a.in[22], a.in[23], a.in[24]};
#pragma unroll 1
    for (int step = a.ph_lo; step < a.ph_hi; ++step) {
        int tid = threadIdx.x; asm volatile("" : "+v"(tid));
        const int lane = tid & 63, wave = __builtin_amdgcn_readfirstlane(tid >> 6), gw = blockIdx.x * 8 + wave;
        unsigned char* ws = a.ws; asm volatile("" : "+s"(ws));
        DERIVE_PTRS
        int l = 0, p = -1;
        if (step >= 2) { l = (step - 2) / 14; p = (step - 2) % 14; }
        if (step == 0) mods_phase(a.in[1], a.in[3], a.in[4], a.in[5], MOD, ROPE, lds, tid);
        if (step == 0 || (p == 13 && l < DEPTH - 1)) conv_layer(WP, step == 0 ? 0 : l + 1, WL, lds, gw, NGW, wave, lane);
        if (p == 2 && blockIdx.x < 64) s5_prep(SP, l, blockIdx.x, WEt, WYt, lds, tid);
        if (step == 1 || p == 2 || p == 10 || p == 13) {
            int s, nl, ns;
            if (step == 1) { s = -1; nl = 0; ns = 0; } else if (p == 2) { s = 0; nl = l; ns = 1; } else if (p == 10) { s = 1; nl = l; ns = 2; } else { s = 2; nl = (l < DEPTH - 1) ? l + 1 : -1; ns = 0; }
            e_phase(a.in[0], a.in[2], a.out, XC, Y, YSS, MOD, a.in[6], a.in[7], H, l, s, nl, ns, gw, NGW, lane, 1.0f, (l == DEPTH - 1 && p >= 10) ? R_LAT : R);
#if MK_PROBE == 5
            if (s >= 0) { __syncthreads(); e_phase(a.in[0], a.in[2], a.out, XC, Y, YSS, MOD, a.in[6], a.in[7], H, l, s, nl, ns, gw, NGW, lane, 0.0f, R); }
#endif
        }
        if (p == 0 || p == 1 || p == 3 || p == 4 || p == 7 || p == 8 || p == 9 || p == 11 || p == 12) {
            const int ng = (p == 4 || p == 8) ? 2 : 1;
#pragma unroll 1
            for (int gi = 0; gi < ng; ++gi) {
                pg8::Gemm g; Epi E; E.o0 = nullptr; E.o1 = nullptr; E.o2 = nullptr; E.i0 = nullptr; E.i1 = nullptr; E.ss = nullptr; E.css = CSS; E.bias = nullptr; E.rope = ROPE; E.mode = 0;
                g.M = R;
                if (p == 0 || p == 11) { g.A = H; g.Bt = WL + (p == 0 ? W_GUA : W_GUB); g.N = 5632; g.K = 1024; g.lda = 1024; E.mode = 0; E.o0 = ACT; }
                else if (p == 1 || p == 12) { g.A = ACT; g.Bt = WL + (p == 1 ? W_DA : W_DB); g.N = 1024; g.K = FF; g.lda = FF; E.mode = 1; E.o0 = Y; E.ss = YSS; }
                else if (p == 3) { g.A = H; g.Bt = WL + W_IN; g.N = 3840; g.K = 1024; g.lda = 1024; E.mode = 2; E.o0 = CQ; E.o1 = U; E.o2 = SG; E.ss = CSS; }
                else if (p == 4 && gi == 0) { g.A = CQ; g.Bt = WL + W_UQ; g.N = 1536; g.K = 256; g.lda = 768; E.mode = 3; E.o0 = Qb; }
                else if (p == 4) { g.A = CQ + 256; g.Bt = WL + W_UKV; g.N = 2048; g.K = 256; g.lda = 768; E.mode = 4; E.o0 = KVb; }
                else if (p == 7) { g.A = T; g.Bt = WL + W_GLU; g.N = 1024; g.K = 1024; g.lda = 1024; E.mode = 5; E.o0 = Gb; E.i0 = T; E.bias = a.in[26] + l * 1024; }
                else if (p == 8 && gi == 0) { g.A = Ob; g.Bt = WL + W_OMLA; g.N = 1024; g.K = 1024; g.lda = 1024; E.mode = 6; E.o0 = Mb; E.i0 = SG; }
                else if (p == 8) { g.A = Gb; g.Bt = WL + W_OS5; g.N = 1024; g.K = 1024; g.lda = 1024; E.mode = 7; E.o0 = Mb; E.i0 = Mb; E.i1 = SG + 1024; }
                else { g.A = Mb; g.Bt = WL + W_OUT; g.N = 1024; g.K = 1024; g.lda = 1024; E.mode = 1; E.o0 = Y; E.ss = YSS; }
                const int Mrows = (l == DEPTH - 1 && (p >= 7 || (p == 4 && gi == 0))) ? R_LAT : R;
                pg8::StaticOrder S; S.init(Mrows, g.N, G, (int)blockIdx.x);
                pg8::gemm_phase<Epi, pg8::StaticOrder, true, true>(lds, g, S, E, tid);
#if MK_PROBE == 3
                if (p == 0 || p == 11) { __syncthreads(); pg8::gemm_phase<Epi, pg8::StaticOrder, true, true>(lds, g, S, E, tid); }
#endif
            }
        }
        if (p == 5) {
#pragma unroll 1
            for (int rep = 0; rep < (MK_PROBE == 1 ? 2 : 1); ++rep) attn_phase(lds, Qb, KVb, CQ, Ob, tid, (l == DEPTH - 1) ? 1024 : 1024 + 64); }
        if (p == 6) {
#pragma unroll 1
            for (int rep = 0; rep < (MK_PROBE == 2 ? 2 : 1); ++rep) s5_main(SP, l, U, WEt, WYt, T, lds, tid); }
        if (step + 1 < a.ph_hi) {
            if (step == a.ph_lo) grid.sync(); else xcd_barrier(xbar);
#if MK_PROBE == 4
            xcd_barrier(xbar); xcd_barrier(xbar);
#endif
        }
    }
}

extern "C" void kernel_launch(void* const* d_in, const int* in_sizes, int n_in, void* d_out, int out_size, void* d_ws, size_t ws_size, hipStream_t stream) {
    static int grid = 0;
    if (grid == 0) {
        if (n_in != 29 || out_size != R_LAT * DM || ws_size < WS_END) { fprintf(stderr, "kernel_launch: unexpected problem (n_in %d out %d ws %zu need %zu)\n", n_in, out_size, ws_size, (size_t)WS_END); grid = -1; return; }
        int dev = 0, cus = 0, per_cu = 0;
        if (hipGetDevice(&dev) != hipSuccess || hipDeviceGetAttribute(&cus, hipDeviceAttributeMultiprocessorCount, dev) != hipSuccess) { grid = -1; return; }
        if (hipFuncSetAttribute((const void*)mk_fwd, hipFuncAttributeMaxDynamicSharedMemorySize, LDS_BYTES) != hipSuccess) { fprintf(stderr, "kernel_launch: hipFuncSetAttribute failed\n"); grid = -1; return; }
        if (hipOccupancyMaxActiveBlocksPerMultiprocessor(&per_cu, (const void*)mk_fwd, 512, LDS_BYTES) != hipSuccess || per_cu < 1) { fprintf(stderr, "kernel_launch: occupancy query says %d\n", per_cu); per_cu = 1; }
        (void)hipGetLastError();
        grid = cus * 1;
    }
    if (grid < 0) return;
    if (hipMemsetAsync((char*)d_ws + WS_CTL, 0, CTL_BYTES, stream) != hipSuccess) { fprintf(stderr, "kernel_launch: memset failed\n"); return; }
    Args a{};
    for (int i = 0; i < 29; ++i) a.in[i] = (const float*)d_in[i];
    a.out = (float*)d_out; a.ws = (unsigned char*)d_ws;
#if MK_MULTI
    for (int s = 0; s < NSTEPS; ++s) { a.ph_lo = s; a.ph_hi = s + 1; void* args[] = {&a};
        hipError_t e = hipLaunchCooperativeKernel((const void*)mk_fwd, dim3(grid), dim3(512), args, LDS_BYTES, stream);
        if (e != hipSuccess) { fprintf(stderr, "cooperative launch %d failed: %s\n", s, hipGetErrorString(e)); break; } }
#else
    a.ph_lo = 0; a.ph_hi = NSTEPS; void* args[] = {&a};
    hipError_t e = hipLaunchCooperativeKernel((const void*)mk_fwd, dim3(grid), dim3(512), args, LDS_BYTES, stream);
    if (e != hipSuccess) fprintf(stderr, "cooperative launch failed: %s (grid %d)\n", hipGetErrorString(e), grid);
#endif
}
```

```cpp
#include <hip/hip_runtime.h>
#include <hip/hip_cooperative_groups.h>
#include <cstdio>
#include <cstdint>
namespace cg = cooperative_groups;
#ifndef MK_MULTI
#define MK_MULTI 0
#endif
#ifndef MK_PROBE
#define MK_PROBE 0
#endif
#ifndef MK_TIME
#define MK_TIME -1
#endif
#ifndef MK_TIME_BLOCK
#define MK_TIME_BLOCK 128
#endif
namespace pg8 {
#define PG8_LAS __attribute__((address_space(3)))
typedef unsigned short bf16_t;
typedef short bf16x8 __attribute__((ext_vector_type(8)));
typedef float f32x4 __attribute__((ext_vector_type(4)));
typedef unsigned u32x4 __attribute__((ext_vector_type(4)));
constexpr int BM = 256, BK = 64, HALF = 128, HTB = HALF * BK * 2  , STAGE_BYTES = 8 * HTB, NXCD = 8, WGM = 8;

__host__ __device__ __forceinline__ int lds_byte(int r, int c) { const int st = (r >> 4) * 2 + (c >> 5), rr = r & 15, cc = c & 31, ob = rr * 64 + cc * 2; return st * 1024 + (ob ^ (((ob >> 9) & 1) << 5)); }
__host__ __device__ __forceinline__ void stage_rc(int b, int& R, int& C) { const int st = b / 1024, sb = b % 1024, swz = sb ^ (((sb >> 9) & 1) << 5); R = (st >> 1) * 16 + swz / 64; C = (st & 1) * 32 + (swz % 64) / 2; }
__host__ __device__ __forceinline__ int perm32(int rho) { const int n = rho >> 4, i = rho & 15; return 8 * (i >> 2) + 4 * n + (i & 3); }

struct Unit { int pm, pn; };
struct Gemm { const bf16_t* A; const bf16_t* Bt; int M, N, K, lda; };

struct StaticOrder {
    int nM, nN, nwg, G, c;
    __host__ __device__ void init(int M, int N, int G_, int c_) { nM = M / BM; nN = N / BM; nwg = nM * nN; G = G_; c = c_; }
    __host__ __device__ bool next(int i, Unit& u) const {
        const long L = (long)i * G + c; if (L >= nwg) return false;
        int wgid = (int)L; { const int q = nwg / NXCD, r = nwg % NXCD, xcd = wgid % NXCD, off = wgid / NXCD; wgid = (xcd < r ? xcd * (q + 1) : r * (q + 1) + (xcd - r) * q) + off; }
        const int nig = WGM * nN, gid = wgid / nig, fm = gid * WGM, gsz = (nM - fm) < WGM ? (nM - fm) : WGM;
        u.pm = fm + ((wgid % nig) % gsz); u.pn = (wgid % nig) / gsz; return true;
    }
    __device__ __forceinline__ void a_ready(const Unit&) const {}
    __device__ __forceinline__ void done(const Unit&) const {}
};

__device__ __forceinline__ unsigned cvt_pk_bf16(float lo, float hi) { unsigned r; asm volatile("v_cvt_pk_bf16_f32 %0, %1, %2" : "=v"(r) : "v"(lo), "v"(hi)); return r; }
template <class Epi, class Sched, bool ALIGN_EPI = false, bool SP2 = false>
__device__ __forceinline__ void gemm_phase(PG8_LAS unsigned char* lds, const Gemm g, const Sched& S, const Epi& E, const int tid) {
    const int wid = __builtin_amdgcn_readfirstlane(tid >> 6), lane = tid & 63, wr = wid >> 2, wc = wid & 3, fr = lane & 15, fq = lane >> 4;
    const int K = g.K, nt = K / BK;
    unsigned voffA[2], voffB[2];
#pragma unroll
    for (int i = 0; i < 2; ++i) { int R, C; stage_rc(tid * 16 + i * 8192, R, C); const int Rb = Epi::PERM ? ((R & ~31) + perm32(R & 31)) : R;
        voffA[i] = (unsigned)(R * g.lda + C) * 2u; voffB[i] = (unsigned)(Rb * K + C) * 2u; }
    const size_t kstep = (size_t)(BK * 2);
    const size_t hstep = (size_t)HALF * K * 2;
    const size_t tstep = 2 * hstep; const size_t hstepA = (size_t)HALF * g.lda * 2, tstepA = 2 * hstepA;
    const unsigned ldsw = (unsigned)wid * 1024u;
    const int aoff = lds_byte(wr * 64 + fr, fq * 8), boff = lds_byte(wc * 32 + fr, fq * 8);
#define PG8_SA(b, h) (((b) * 2 + (h)) * HTB)
#define PG8_SB(b, h) ((4 + (b) * 2 + (h)) * HTB)
#define PG8_STAGE(bufoff, gbase, voff) do { _Pragma("unroll") for (int _i = 0; _i < 2; ++_i) \
        __builtin_amdgcn_global_load_lds((const unsigned*)((const char*)(gbase) + (voff)[_i]), (PG8_LAS unsigned*)(lds + (bufoff) + ldsw + _i * 8192), 16, 0, 0); } while (0)
#define PG8_LDA(dst, b, h) do { _Pragma("unroll") for (int m = 0; m < 4; ++m) _Pragma("unroll") for (int k = 0; k < 2; ++k) dst[m][k] = *(const PG8_LAS bf16x8*)(lds + PG8_SA(b, h) + aoff + m * 2048 + k * 1024); } while (0)
#define PG8_LDB(dst, b, h) do { _Pragma("unroll") for (int n = 0; n < 2; ++n) _Pragma("unroll") for (int k = 0; k < 2; ++k) dst[n][k] = *(const PG8_LAS bf16x8*)(lds + PG8_SB(b, h) + boff + n * 2048 + k * 1024); } while (0)
#define PG8_MMA(ai, bj, At, Bt) do { __builtin_amdgcn_s_setprio(1); _Pragma("unroll") for (int m = 0; m < 4; ++m) _Pragma("unroll") for (int n = 0; n < 2; ++n) _Pragma("unroll") for (int k = 0; k < 2; ++k) \
        acc[ai][bj][m][n] = __builtin_amdgcn_mfma_f32_16x16x32_bf16(Bt[n][k], At[m][k], acc[ai][bj][m][n], 0, 0, 0); __builtin_amdgcn_s_setprio(0); } while (0)
#define PG8_WAIT_V(n) asm volatile("s_waitcnt vmcnt(" #n ")" ::: "memory")
#define PG8_WAIT_L(n) asm volatile("s_waitcnt lgkmcnt(" #n ")" ::: "memory")
#define PG8_BAR __builtin_amdgcn_s_barrier()
#define PG8_SCHED __builtin_amdgcn_sched_barrier(0)
    Unit cur, nxt; int ui = 0;
    if (!S.next(0, cur)) return;
    f32x4 acc[2][2][4][2];
#pragma unroll
    for (int a = 0; a < 2; ++a)
#pragma unroll
        for (int b = 0; b < 2; ++b)
#pragma unroll
            for (int m = 0; m < 4; ++m)
#pragma unroll
                for (int n = 0; n < 2; ++n) acc[a][b][m][n] = (f32x4){0.f, 0.f, 0.f, 0.f};
    bf16x8 At[4][2], B0[2][2], B1[2][2];
    const char* cA = (const char*)g.A + (size_t)cur.pm * tstepA; const char* cB = (const char*)g.Bt + (size_t)cur.pn * tstep;
    S.a_ready(cur);
    if constexpr (SP2) {
        PG8_STAGE(PG8_SB(0, 0), cB, voffB); PG8_STAGE(PG8_SB(0, 1), cB + hstep, voffB); PG8_STAGE(PG8_SA(0, 0), cA, voffA); PG8_STAGE(PG8_SA(0, 1), cA + hstepA, voffA);
        if (wr == 1) PG8_BAR;
        PG8_WAIT_V(2); PG8_BAR;
        PG8_STAGE(PG8_SB(1, 0), cB + kstep, voffB); PG8_STAGE(PG8_SA(1, 0), cA + kstep, voffA); PG8_STAGE(PG8_SB(1, 1), cB + hstep + kstep, voffB);
        PG8_WAIT_V(6); PG8_BAR;
    } else {
        PG8_STAGE(PG8_SB(0, 0), cB, voffB); PG8_STAGE(PG8_SA(0, 0), cA, voffA); PG8_STAGE(PG8_SB(0, 1), cB + hstep, voffB); PG8_STAGE(PG8_SA(0, 1), cA + hstepA, voffA);
        if (wr == 1) PG8_BAR;
        PG8_WAIT_V(4); PG8_BAR;
        PG8_STAGE(PG8_SB(1, 0), cB + kstep, voffB); PG8_STAGE(PG8_SA(1, 0), cA + kstep, voffA); PG8_STAGE(PG8_SB(1, 1), cB + hstep + kstep, voffB);
        PG8_WAIT_V(6); PG8_BAR;
    }
    for (;;) {
        const bool has_next = S.next(ui + 1, nxt);
        const char* nA = has_next ? (const char*)g.A + (size_t)nxt.pm * tstepA : cA; const char* nB = has_next ? (const char*)g.Bt + (size_t)nxt.pn * tstep : cB;
        for (int t = 0; t < nt; t += 2) {
            const bool last = (t == nt - 2);
            const char* a1 = cA + (size_t)(t + 1) * kstep;
            const char* a2 = last ? nA : cA + (size_t)(t + 2) * kstep; const char* b2 = last ? nB : cB + (size_t)(t + 2) * kstep;
            const char* a3 = a2 + kstep; const char* b3 = b2 + kstep;
            if (last && has_next) S.a_ready(nxt);
            if constexpr (SP2) {
            PG8_LDB(B0, 0, 0); PG8_LDB(B1, 0, 1); PG8_SCHED; PG8_LDA(At, 0, 0); PG8_STAGE(PG8_SA(1, 1), a1 + hstepA, voffA);
            PG8_WAIT_V(8); PG8_WAIT_L(0); PG8_BAR; PG8_MMA(0, 0, At, B0); PG8_MMA(0, 1, At, B1); PG8_BAR; PG8_SCHED;
            PG8_LDA(At, 0, 1); PG8_STAGE(PG8_SB(0, 0), b2, voffB); PG8_STAGE(PG8_SB(0, 1), b2 + hstep, voffB); PG8_STAGE(PG8_SA(0, 0), a2, voffA);
            PG8_WAIT_V(8); PG8_WAIT_L(0); PG8_BAR; PG8_MMA(1, 0, At, B0); PG8_MMA(1, 1, At, B1); PG8_BAR; PG8_SCHED;
            PG8_LDB(B0, 1, 0); PG8_LDB(B1, 1, 1); PG8_SCHED; PG8_LDA(At, 1, 0); PG8_STAGE(PG8_SA(0, 1), a2 + hstepA, voffA);
            PG8_WAIT_V(8); PG8_WAIT_L(0); PG8_BAR; PG8_MMA(0, 0, At, B0); PG8_MMA(0, 1, At, B1); PG8_BAR; PG8_SCHED;
            PG8_LDA(At, 1, 1); PG8_STAGE(PG8_SB(1, 0), b3, voffB); PG8_STAGE(PG8_SB(1, 1), b3 + hstep, voffB); PG8_STAGE(PG8_SA(1, 0), a3, voffA);
            PG8_WAIT_V(8); PG8_WAIT_L(0); PG8_BAR; PG8_MMA(1, 0, At, B0); PG8_MMA(1, 1, At, B1); PG8_BAR; PG8_SCHED;
            } else {
            PG8_LDB(B0, 0, 0); PG8_SCHED; PG8_LDA(At, 0, 0); PG8_STAGE(PG8_SA(1, 1), a1 + hstepA, voffA);
            PG8_WAIT_L(8); PG8_BAR; PG8_WAIT_L(0); PG8_MMA(0, 0, At, B0); PG8_BAR; PG8_SCHED;
            PG8_LDB(B1, 0, 1); PG8_STAGE(PG8_SB(0, 0), b2, voffB);
            PG8_BAR; PG8_WAIT_L(0); PG8_MMA(0, 1, At, B1); PG8_BAR;
            PG8_LDA(At, 0, 1); PG8_STAGE(PG8_SA(0, 0), a2, voffA);
            PG8_BAR; PG8_WAIT_L(0); PG8_MMA(1, 0, At, B0); PG8_BAR; PG8_SCHED;
            PG8_STAGE(PG8_SB(0, 1), b2 + hstep, voffB);
            PG8_WAIT_V(6); PG8_BAR; PG8_MMA(1, 1, At, B1); PG8_BAR;
            PG8_LDB(B0, 1, 0); PG8_SCHED; PG8_LDA(At, 1, 0); PG8_STAGE(PG8_SA(0, 1), a2 + hstepA, voffA);
            PG8_WAIT_L(8); PG8_BAR; PG8_WAIT_L(0); PG8_MMA(0, 0, At, B0); PG8_BAR; PG8_SCHED;
            PG8_LDB(B1, 1, 1); PG8_STAGE(PG8_SB(1, 0), b3, voffB);
            PG8_BAR; PG8_WAIT_L(0); PG8_MMA(0, 1, At, B1); PG8_BAR;
            PG8_LDA(At, 1, 1); PG8_STAGE(PG8_SA(1, 0), a3, voffA);
            PG8_BAR; PG8_WAIT_L(0); PG8_MMA(1, 0, At, B0); PG8_BAR; PG8_SCHED;
            PG8_STAGE(PG8_SB(1, 1), b3 + hstep, voffB);
            PG8_WAIT_V(6); PG8_BAR; PG8_MMA(1, 1, At, B1); PG8_BAR;
            }
        }
        if constexpr (ALIGN_EPI) { if (wr == 0) PG8_BAR; }
        if constexpr (!Epi::AFTER_DRAIN) { E(acc, cur, wr, wc, fr, fq); S.done(cur); }
        if (!has_next) break;
#pragma unroll
        for (int a = 0; a < 2; ++a)
#pragma unroll
            for (int b = 0; b < 2; ++b)
#pragma unroll
                for (int m = 0; m < 4; ++m)
#pragma unroll
                    for (int n = 0; n < 2; ++n) acc[a][b][m][n] = (f32x4){0.f, 0.f, 0.f, 0.f};
        cur = nxt; cA = nA; cB = nB; ++ui;
        if constexpr (ALIGN_EPI) { if (wr == 1) PG8_BAR; }
    }
    PG8_WAIT_V(0);
    if constexpr (!ALIGN_EPI) { if (wr == 0) PG8_BAR; }
    PG8_BAR;
    if constexpr (Epi::AFTER_DRAIN) { E.fused(acc, cur, wr, wc, fr, fq, lds, wid, lane); S.done(cur); }
#undef PG8_SA
#undef PG8_SB
#undef PG8_STAGE
#undef PG8_LDA
#undef PG8_LDB
#undef PG8_MMA
#undef PG8_WAIT_V
#undef PG8_WAIT_L
#undef PG8_BAR
#undef PG8_SCHED
}
}
using pg8::bf16_t; using pg8::f32x4; using pg8::u32x4; using pg8::bf16x8; using pg8::Unit;
#define LAS __attribute__((address_space(3)))
typedef float f32x16 __attribute__((ext_vector_type(16)));
typedef unsigned u32x2 __attribute__((ext_vector_type(2)));
typedef short s16x4 __attribute__((ext_vector_type(4)));
constexpr int NB = 8, SEQ = 4096, CTXL = 256, DM = 1024, FF = 2816, DEPTH = 4, NH = 8;
constexpr int R_LAT = NB * SEQ, R_CTX = NB * CTXL, R = R_LAT + R_CTX;
constexpr float EPS = 1e-6f;
constexpr int NCH = 34;
constexpr size_t W_GUA = 0, W_DA = W_GUA + (size_t)5632 * 1024, W_GUB = W_DA + (size_t)1024 * 2816, W_DB = W_GUB + (size_t)5632 * 1024,
                 W_IN = W_DB + (size_t)1024 * 2816, W_UQ = W_IN + (size_t)3840 * 1024, W_UKV = W_UQ + (size_t)1536 * 256, W_OMLA = W_UKV + (size_t)2048 * 256,
                 W_GLU = W_OMLA + (size_t)1024 * 1024, W_OS5 = W_GLU + (size_t)1024 * 1024, W_OUT = W_OS5 + (size_t)1024 * 1024, W_END = W_OUT + (size_t)1024 * 1024;
constexpr size_t al256(size_t x) { return (x + 255) & ~(size_t)255; }
constexpr size_t WS_CTL = 0, CTL_BYTES = 16384;
constexpr size_t WS_MOD = WS_CTL + CTL_BYTES;
constexpr size_t WS_ROPE = WS_MOD + al256((size_t)4 * 9 * 9216 * 4);
constexpr size_t WS_YSS = WS_ROPE + al256(64 * 16 * 8);
constexpr size_t WS_CSS = WS_YSS + al256((size_t)R * 16 * 4);
constexpr size_t WS_S5E = WS_CSS + al256((size_t)R * 8 * 4);
constexpr size_t S5_WE_BYTES = (size_t)2 * 64 * 128 * 256 * 2, S5_WY_BYTES = (size_t)64 * 256 * 512 * 2;
constexpr size_t WS_XC = WS_S5E + al256(S5_WE_BYTES + S5_WY_BYTES);
constexpr size_t WS_WL = WS_XC + al256((size_t)R_CTX * DM * 4);
constexpr size_t WS_H = WS_WL + al256(W_END * 2);
constexpr size_t WS_BIG = WS_H + al256((size_t)R * DM * 2);
constexpr size_t B_CQ = 0, B_U = B_CQ + (size_t)R * 768 * 2, B_Q = B_U + (size_t)R * 1024 * 2, B_KV = B_Q + (size_t)R * 1536 * 2, B_SG = B_KV + (size_t)R * 2048 * 2, B_END = B_SG + (size_t)R * 2048 * 2;
constexpr size_t B_ACT = 0, B_Y = (size_t)R * FF * 2;
constexpr size_t B_T = B_U, B_G = B_KV, B_M = B_Q;
static_assert(B_Y >= B_M + (size_t)R * 1024 * 2 && B_Y + (size_t)R * 1024 * 2 <= B_SG, "Y overlay");
constexpr size_t WS_END = WS_BIG + B_END;
constexpr int LDS_BYTES = 272 * 528 + 8192 + 16 * 528 + 256;

__device__ __forceinline__ float bf2f(unsigned h) { return __uint_as_float(h << 16); }
__device__ __forceinline__ unsigned pk2(float lo, float hi) { return pg8::cvt_pk_bf16(lo, hi); }
__device__ __forceinline__ float sigm(float x) { return __builtin_amdgcn_rcpf(1.f + __builtin_amdgcn_exp2f(-1.4426950408889634f * x)); }
__device__ __forceinline__ float gelu_tanh(float x) { return x * sigm(1.5957691216057308f * (x + 0.044715f * x * x * x)); }
__device__ __forceinline__ void unpack8(const u32x4 w, float (&f)[8]) {
    f[0] = bf2f(w.x & 0xffffu); f[1] = __uint_as_float(w.x & 0xffff0000u); f[2] = bf2f(w.y & 0xffffu); f[3] = __uint_as_float(w.y & 0xffff0000u);
    f[4] = bf2f(w.z & 0xffffu); f[5] = __uint_as_float(w.z & 0xffff0000u); f[6] = bf2f(w.w & 0xffffu); f[7] = __uint_as_float(w.w & 0xffff0000u);
}
__device__ __forceinline__ u32x4 pack8(const float (&f)[8]) { u32x4 w; w.x = pk2(f[0], f[1]); w.y = pk2(f[2], f[3]); w.z = pk2(f[4], f[5]); w.w = pk2(f[6], f[7]); return w; }
__device__ __forceinline__ float wave_sum(float v) {
#pragma unroll
    for (int o = 1; o < 64; o <<= 1) v += __shfl_xor(v, o);
    return v;
}
__device__ __forceinline__ void rope8(float (&v)[8], int row, int wc, int fq, const float* tab) {
    const int t = row & 4095, pos = (wc & 1) ? (t & 63) : (t >> 6);
    const f32x4* tp = (const f32x4*)(tab + (pos * 16 + 8 * (fq & 1)) * 2);
    const f32x4 t0 = tp[0], t1 = tp[1], t2 = tp[2], t3 = tp[3];
    const float cs[8] = {t0[0], t0[2], t1[0], t1[2], t2[0], t2[2], t3[0], t3[2]}, sn[8] = {t0[1], t0[3], t1[1], t1[3], t2[1], t2[3], t3[1], t3[3]};
    const float sgn = (fq < 2) ? -1.f : 1.f;
#pragma unroll
    for (int j = 0; j < 8; ++j) { const float p = __shfl_xor(v[j], 32); v[j] = v[j] * cs[j] + sgn * p * sn[j]; }
}

struct Epi {
    static constexpr bool PERM = true, AFTER_DRAIN = false;
    int mode;
    bf16_t* o0; bf16_t* o1; bf16_t* o2; const bf16_t* i0; const bf16_t* i1; float* ss; const float* css; const float* bias; const float* rope;
    __device__ __forceinline__ void operator()(const f32x4 (&acc)[2][2][4][2], const Unit& u, int wr, int wc, int fr, int fq) const {
        const int row0 = u.pm * 256 + wr * 64 + fr, cb = wc * 32 + 8 * fq, pn = u.pn;
        if (mode == 0) {
            bf16_t* base = o0 + (size_t)pn * 128 + cb;
#pragma unroll
            for (int ai = 0; ai < 2; ++ai)
#pragma unroll
                for (int m = 0; m < 4; ++m) { const int row = row0 + ai * 128 + m * 16; float v[8];
#pragma unroll
                    for (int n = 0; n < 2; ++n)
#pragma unroll
                        for (int j = 0; j < 4; ++j) { const float g = acc[ai][0][m][n][j], up = acc[ai][1][m][n][j]; v[4 * n + j] = g * sigm(g) * up; }
                    *(u32x4*)(base + (size_t)row * FF) = pack8(v); }
        } else if (mode == 1) {
            bf16_t* base = o0 + pn * 256 + cb;
#pragma unroll
            for (int ai = 0; ai < 2; ++ai)
#pragma unroll
                for (int m = 0; m < 4; ++m) { const int row = row0 + ai * 128 + m * 16; float s = 0.f;
#pragma unroll
                    for (int bj = 0; bj < 2; ++bj) { float v[8];
#pragma unroll
                        for (int n = 0; n < 2; ++n)
#pragma unroll
                            for (int j = 0; j < 4; ++j) { const float x = acc[ai][bj][m][n][j]; v[4 * n + j] = x; s += x * x; }
                        *(u32x4*)(base + (size_t)row * 1024 + bj * 128) = pack8(v); }
                    s += __shfl_xor(s, 16); s += __shfl_xor(s, 32);
                    if (fq == 0) ss[row * 16 + pn * 4 + wc] = s; }
        } else if (mode == 2) {
            bf16_t* dst; int ldc;
            if (pn < 3) { dst = o0 + pn * 256; ldc = 768; } else if (pn < 7) { dst = o1 + (pn - 3) * 256; ldc = 1024; } else { dst = o2 + (pn - 7) * 256; ldc = 2048; }
            const bool sg = pn >= 7, docss = pn < 2, dorope = (pn == 2) && (u.pm < 128) && (wc < 2);
            dst += cb;
#pragma unroll
            for (int ai = 0; ai < 2; ++ai)
#pragma unroll
                for (int m = 0; m < 4; ++m) { const int row = row0 + ai * 128 + m * 16; float s = 0.f;
#pragma unroll
                    for (int bj = 0; bj < 2; ++bj) { float v[8];
#pragma unroll
                        for (int n = 0; n < 2; ++n)
#pragma unroll
                            for (int j = 0; j < 4; ++j) { float x = acc[ai][bj][m][n][j]; if (sg) x = sigm(x); v[4 * n + j] = x; s += x * x; }
                        if (bj == 0 && dorope) rope8(v, row, wc, fq, rope);
                        *(u32x4*)(dst + (size_t)row * ldc + bj * 128) = pack8(v); }
                    if (docss) { s += __shfl_xor(s, 16); s += __shfl_xor(s, 32); if (fq == 0) ss[row * 8 + pn * 4 + wc] = s; } }
        } else if (mode == 3 || mode == 4) {
            const int ldc = (mode == 3) ? 1536 : 2048; const float* cp = css + ((mode == 3) ? 0 : 4);
            const bool dorope = (mode == 3) && (pn >= 4) && (u.pm < 128);
            bf16_t* dst = o0 + pn * 256 + cb;
#pragma unroll
            for (int ai = 0; ai < 2; ++ai)
#pragma unroll
                for (int m = 0; m < 4; ++m) { const int row = row0 + ai * 128 + m * 16; const f32x4 c4 = *(const f32x4*)(cp + row * 8);
                    const float rs = 1.0f / sqrtf(((c4[0] + c4[1]) + (c4[2] + c4[3])) * (1.0f / 256.0f) + EPS);
#pragma unroll
                    for (int bj = 0; bj < 2; ++bj) { float v[8];
#pragma unroll
                        for (int n = 0; n < 2; ++n)
#pragma unroll
                            for (int j = 0; j < 4; ++j) v[4 * n + j] = acc[ai][bj][m][n][j] * rs;
                        if (dorope) rope8(v, row, wc, fq, rope);
                        *(u32x4*)(dst + (size_t)row * ldc + bj * 128) = pack8(v); } }
        } else {
            const int col = pn * 256 + cb;
#pragma unroll
            for (int ai = 0; ai < 2; ++ai)
#pragma unroll
                for (int m = 0; m < 4; ++m) { const int row = row0 + ai * 128 + m * 16;
#pragma unroll
                    for (int bj = 0; bj < 2; ++bj) { const int c = col + bj * 128; float v[8], a[8], b[8];
#pragma unroll
                        for (int n = 0; n < 2; ++n)
#pragma unroll
                            for (int j = 0; j < 4; ++j) v[4 * n + j] = acc[ai][bj][m][n][j];
                        if (mode == 5) { unpack8(*(const u32x4*)(i0 + (size_t)row * 1024 + c), a); const f32x4 b0 = *(const f32x4*)(bias + c), b1 = *(const f32x4*)(bias + c + 4);
#pragma unroll
                            for (int j = 0; j < 4; ++j) { v[j] = a[j] * sigm(v[j] + b0[j]); v[4 + j] = a[4 + j] * sigm(v[4 + j] + b1[j]); } }
                        else if (mode == 6) { unpack8(*(const u32x4*)(i0 + (size_t)row * 2048 + c), a);
#pragma unroll
                            for (int j = 0; j < 8; ++j) v[j] = a[j] * v[j]; }
                        else { unpack8(*(const u32x4*)(i0 + (size_t)row * 1024 + c), a); unpack8(*(const u32x4*)(i1 + (size_t)row * 2048 + c), b);
#pragma unroll
                            for (int j = 0; j < 8; ++j) v[j] = a[j] + b[j] * v[j]; }
                        *(u32x4*)(o0 + (size_t)row * 1024 + c) = pack8(v); } }
        }
    }
};
__device__ __forceinline__ void conv_item(const float* W, int ldsrc, int srccol, const float* kscale, bf16_t* WT, int K, int n0, int k0, LAS float* scr, int lane) {
    if (srccol >= 0) {
#pragma unroll 8
        for (int i = 0; i < 32; ++i) { const int kk = 2 * i + (lane >> 5); float w = W[(size_t)(k0 + kk) * ldsrc + srccol + (lane & 31)]; if (kscale) w *= kscale[k0 + kk]; scr[kk * 33 + (lane & 31)] = w; }
    } else {
#pragma unroll 8
        for (int i = 0; i < 32; ++i) { const int kk = 2 * i + (lane >> 5); scr[kk * 33 + (lane & 31)] = 0.f; }
    }
    asm volatile("s_waitcnt lgkmcnt(0)" ::: "memory");
    const int c = lane & 7;
#pragma unroll
    for (int j = 0; j < 4; ++j) { const int n = (lane >> 3) + 8 * j; const LAS float* s = scr + (8 * c) * 33 + n;
        u32x4 o; o.x = pk2(s[0 * 33], s[1 * 33]); o.y = pk2(s[2 * 33], s[3 * 33]); o.z = pk2(s[4 * 33], s[5 * 33]); o.w = pk2(s[6 * 33], s[7 * 33]);
        *(u32x4*)(WT + (size_t)(n0 + n) * K + k0 + 8 * c) = o; }
    asm volatile("s_waitcnt lgkmcnt(0)" ::: "memory");
}
struct WPtrs { const float *gate, *up, *down, *win, *qn, *wuq, *kvn, *wukv, *womla, *glu, *wos5, *wout; };
__device__ __forceinline__ void conv_layer(const WPtrs& P, int l, bf16_t* WL, LAS unsigned char* lds, int gw, int NGW, int wave, int lane, int it_lo, int it_hi) {
    LAS float* scr = (LAS float*)(lds + wave * 16384);
    constexpr int I_GU = 16 * 176, I_D = 44 * 32, I_IN = 16 * 120, I_UQ = 4 * 48, I_UKV = 4 * 64, I_SQ = 16 * 32;
    constexpr int NIT = 2 * I_GU + 2 * I_D + I_IN + I_UQ + I_UKV + 4 * I_SQ;
    static_assert(NIT == 12864, "conv items");
    for (int it = it_lo + gw; it < it_hi; it += NGW) {
        int r = it;
        if (r < 2 * I_GU) { const int f = r / I_GU; r -= f * I_GU; const int nb = r % 176, kb = r / 176, n0 = nb * 32, tile = n0 >> 8, within = n0 & 255, half = within >> 7, ffc = tile * 128 + (within & 127);
            const size_t so = (size_t)(l * 2 + f) * 1024 * FF; bf16_t* dst = WL + (f ? W_GUB : W_GUA);
            if (half) conv_item(P.up + so, FF, ffc, nullptr, dst, 1024, n0, kb * 64, scr, lane); else conv_item(P.gate + so, FF, ffc, nullptr, dst, 1024, n0, kb * 64, scr, lane);
            continue; }
        r -= 2 * I_GU;
        if (r < 2 * I_D) { const int f = r / I_D; r -= f * I_D; const int nb = r % 32, kb = r / 32;
            conv_item(P.down + (size_t)(l * 2 + f) * FF * 1024, 1024, nb * 32, nullptr, WL + (f ? W_DB : W_DA), FF, nb * 32, kb * 64, scr, lane); continue; }
        r -= 2 * I_D;
        if (r < I_IN) { const int nb = r % 120, kb = r / 120, n0 = nb * 32; int sc;
            if (n0 < 512) sc = n0; else if (n0 < 768) sc = (n0 < 576) ? n0 : -1; else sc = n0 - 768 + 576;
            conv_item(P.win + (size_t)l * 1024 * 3648, 3648, sc, nullptr, WL + W_IN, 1024, n0, kb * 64, scr, lane); continue; }
        r -= I_IN;
        if (r < I_UQ) { const int nb = r % 48, kb = r / 48, n0 = nb * 32; int sc;
            if (n0 < 1024) sc = (n0 >> 7) * 192 + (n0 & 127); else { const int rr = n0 - 1024; sc = (rr >> 6) * 192 + 128 + (rr & 63); }
            conv_item(P.wuq + (size_t)l * 256 * 1536, 1536, sc, P.qn + l * 256, WL + W_UQ, 256, n0, kb * 64, scr, lane); continue; }
        r -= I_UQ;
        if (r < I_UKV) { const int nb = r % 64, kb = r / 64;
            conv_item(P.wukv + (size_t)l * 256 * 2048, 2048, nb * 32, P.kvn + l * 256, WL + W_UKV, 256, nb * 32, kb * 64, scr, lane); continue; }
        r -= I_UKV;
        { const int q = r / I_SQ; r -= q * I_SQ; const int nb = r % 32, kb = r / 32; const size_t so = (size_t)l * 1024 * 1024;
          if (q == 0) conv_item(P.womla + so, 1024, nb * 32, nullptr, WL + W_OMLA, 1024, nb * 32, kb * 64, scr, lane);
          else if (q == 1) conv_item(P.glu + so, 1024, nb * 32, nullptr, WL + W_GLU, 1024, nb * 32, kb * 64, scr, lane);
          else if (q == 2) conv_item(P.wos5 + so, 1024, nb * 32, nullptr, WL + W_OS5, 1024, nb * 32, kb * 64, scr, lane);
          else conv_item(P.wout + so, 1024, nb * 32, nullptr, WL + W_OUT, 1024, nb * 32, kb * 64, scr, lane); }
    }
}

__device__ __forceinline__ void mods_phase(const float* c, const float* c_ctx, const float* ada_w, const float* ada_b, float* MOD, float* ROPE, LAS unsigned char* lds, const int tid) {

    LAS float* sc = (LAS float*)lds;
    LAS float* red = (LAS float*)(lds + 9 * 1024 * 4);
    if (blockIdx.x == gridDim.x - 1) {
        for (int e = tid; e < 1024; e += 512) { const int pos = e >> 4, i = e & 15; const float inv = exp2f(-(float)i * (13.287712379549449f / 16.0f)); const float ang = (float)pos * inv;
            float sn_, cs_; sincosf(ang, &sn_, &cs_); ROPE[2 * e] = cs_; ROPE[2 * e + 1] = sn_; }
    }
    bool have = false;
    for (int item = blockIdx.x; item < 576; item += gridDim.x) {
        if (!have) { for (int e = tid; e < 9 * 1024; e += 512) { const float v = (e < 8192) ? c[e] : c_ctx[e - 8192]; sc[e] = v * sigm(v); } have = true; }
        __syncthreads();
        const int l = item / 144, j0 = (item % 144) * 64, ks = tid >> 6, jj = tid & 63;
        const float* w = ada_w + ((size_t)l * 1024 + ks * 128) * 9216 + j0 + jj;
        float a[9];
#pragma unroll
        for (int s = 0; s < 9; ++s) a[s] = 0.f;
#pragma unroll 16
        for (int k = 0; k < 128; ++k) { const float wv = w[(size_t)k * 9216];
#pragma unroll
            for (int s = 0; s < 9; ++s) a[s] += sc[s * 1024 + ks * 128 + k] * wv; }
#pragma unroll
        for (int s = 0; s < 9; ++s) red[(ks * 9 + s) * 64 + jj] = a[s];
        __syncthreads();
        for (int e = tid; e < 576; e += 512) { const int s = e >> 6, j = e & 63; float t = 0.f;
#pragma unroll
            for (int q = 0; q < 8; ++q) t += red[(q * 9 + s) * 64 + j];
            MOD[((size_t)l * 9 + s) * 9216 + j0 + j] = t + ada_b[l * 9216 + j0 + j]; }
    }
    __syncthreads();
}

__device__ __forceinline__ void e_phase(const float* xin, const float* ctxin, float* xl, float* xc, const bf16_t* Y, const float* YSS, const float* MOD,
                                        const float* npre, const float* npost, bf16_t* H, int l, int s, int nl, int ns, int gw, int NGW, int lane, float wmul, int nrows) {
    for (int row = gw; row < nrows; row += NGW) {
        const bool lat = row < R_LAT; const int set = lat ? (row >> 12) : 8;
        float* xr = lat ? xl + (size_t)row * DM : xc + (size_t)(row - R_LAT) * DM;
        const float* xs = (s < 0) ? (lat ? xin + (size_t)row * DM : ctxin + (size_t)(row - R_LAT) * DM) : xr;
        f32x4 v[4];
#pragma unroll
        for (int j = 0; j < 4; ++j) v[j] = ((const f32x4*)xs)[lane + 64 * j];
        if (s >= 0) {
            const float part = (lane < 16) ? YSS[row * 16 + lane] : 0.f;
            const float rs = 1.0f / sqrtf(wave_sum(part) * (1.0f / 1024.0f) + EPS);
            const float wgt = ((s == 1) ? 1.0f : 0.5f) * wmul;
            const float* gate = MOD + ((size_t)(l * 9 + set) * 9 + 3 * s + 2) * 1024; const float* gp = npost + (l * 3 + s) * 1024;
#pragma unroll
            for (int j = 0; j < 4; ++j) { const u32x2 yw = ((const u32x2*)(Y + (size_t)row * DM))[lane + 64 * j];
                const f32x4 g4 = ((const f32x4*)gate)[lane + 64 * j], p4 = ((const f32x4*)gp)[lane + 64 * j];
                f32x4 y4; y4[0] = bf2f(yw.x & 0xffffu); y4[1] = __uint_as_float(yw.x & 0xffff0000u); y4[2] = bf2f(yw.y & 0xffffu); y4[3] = __uint_as_float(yw.y & 0xffff0000u);
                v[j] += (wgt * rs) * g4 * y4 * p4; }
        }
#pragma unroll
        for (int j = 0; j < 4; ++j) ((f32x4*)xr)[lane + 64 * j] = v[j];
        if (nl >= 0) {
            float q = 0.f;
#pragma unroll
            for (int j = 0; j < 4; ++j) q += (v[j][0] * v[j][0] + v[j][1] * v[j][1]) + (v[j][2] * v[j][2] + v[j][3] * v[j][3]);
            const float rs2 = 1.0f / sqrtf(wave_sum(q) * (1.0f / 1024.0f) + EPS);
            const float* mb = MOD + ((size_t)(nl * 9 + set) * 9 + 3 * ns) * 1024; const float* gp = npre + (nl * 3 + ns) * 1024;
#pragma unroll
            for (int j = 0; j < 4; ++j) { const f32x4 sh = ((const f32x4*)mb)[lane + 64 * j], sc = ((const f32x4*)(mb + 1024))[lane + 64 * j], p4 = ((const f32x4*)gp)[lane + 64 * j];
                const f32x4 h = v[j] * rs2 * p4 * (1.0f + sc) + sh;
                u32x2 o; o.x = pk2(h[0], h[1]); o.y = pk2(h[2], h[3]); ((u32x2*)(H + (size_t)row * DM))[lane + 64 * j] = o; }
        }
    }
}
struct S5In { const float *a_re, *a_im, *log_dt, *b_re, *b_im, *c_re, *c_im, *dsk; };
__device__ __forceinline__ void s5_abar(const S5In& P, int idx, int n, float& ar, float& ai, float& cr, float& ci) {
    const float are = P.a_re[idx * 64 + n], aim = P.a_im[idx * 64 + n];
    const float dt = expf(P.log_dt[idx]);
    const float mag = expf(dt * are); float sn, cs; sincosf(dt * aim, &sn, &cs);
    ar = mag * cs; ai = mag * sn;
    const float nr = ar - 1.f, ni = ai, den = 1.0f / (are * are + aim * aim);
    cr = (nr * are + ni * aim) * den; ci = (ni * are - nr * aim) * den;
}
__device__ __forceinline__ void s5_prep(const S5In& P, int l, int g, bf16_t* WEt, bf16_t* WYt, LAS unsigned char* lds, int tid) {
    LAS float* AP = (LAS float*)lds;
    LAS float* BB = AP + 2 * 17 * 64 * 2;
    LAS float* CC = BB + 2 * 64 * 16 * 2;
    LAS float* KL = CC + 2 * 16 * 64 * 2;
    if (tid < 128) { const int d = tid >> 6, n = tid & 63, idx = (l * 2 + d) * 64 + g; float ar, ai, cr, ci; s5_abar(P, idx, n, ar, ai, cr, ci);
        float pr = 1.f, pi = 0.f;
        for (int j = 0; j <= 16; ++j) { AP[((d * 17 + j) * 64 + n) * 2] = pr; AP[((d * 17 + j) * 64 + n) * 2 + 1] = pi; const float t0 = pr * ar - pi * ai, t1 = pr * ai + pi * ar; pr = t0; pi = t1; }
        for (int c = 0; c < 16; ++c) { const float br = P.b_re[(size_t)(idx * 64 + n) * 16 + c], bi = P.b_im[(size_t)(idx * 64 + n) * 16 + c];
            BB[((d * 64 + n) * 16 + c) * 2] = cr * br - ci * bi; BB[((d * 64 + n) * 16 + c) * 2 + 1] = cr * bi + ci * br; } }
    for (int e = tid; e < 2048; e += 512) { const int d = e >> 10, cn = e & 1023; const size_t src = (size_t)((l * 2 + d) * 64 + g) * 1024 + cn; CC[e * 2] = P.c_re[src]; CC[e * 2 + 1] = P.c_im[src]; }
    __syncthreads();
    { const int d = tid >> 8, c = (tid >> 4) & 15, cp = tid & 15; float acc[16];
#pragma unroll
      for (int j = 0; j < 16; ++j) acc[j] = 0.f;
      for (int n = 0; n < 64; ++n) { const float c_r = CC[((d * 16 + c) * 64 + n) * 2], c_i = CC[((d * 16 + c) * 64 + n) * 2 + 1], b_r = BB[((d * 64 + n) * 16 + cp) * 2], b_i = BB[((d * 64 + n) * 16 + cp) * 2 + 1];
          const float zr = c_r * b_r - c_i * b_i, zi = c_r * b_i + c_i * b_r;
#pragma unroll
          for (int j = 0; j < 16; ++j) acc[j] += zr * AP[((d * 17 + j) * 64 + n) * 2] - zi * AP[((d * 17 + j) * 64 + n) * 2 + 1]; }
#pragma unroll
      for (int j = 0; j < 16; ++j) KL[((d * 16 + j) * 16 + c) * 16 + cp] = acc[j]; }
    __syncthreads();
    for (int e = tid; e < 256 * 64; e += 512) { const int row = e >> 6, k8 = (e & 63) * 8, t = row >> 4, c = row & 15; float v[8];
        if (k8 < 256) { const int s = k8 >> 4, c0 = k8 & 15;
#pragma unroll
            for (int j = 0; j < 8; ++j) { const int cp = c0 + j; float val = 0.f;
                if (s <= t) val += KL[(((t - s)) * 16 + c) * 16 + cp];
                if (s >= t) val += KL[((16 + (s - t)) * 16 + c) * 16 + cp];
                if (s == t && cp == c) val += P.dsk[l * 1024 + g * 16 + c];
                v[j] = val; } }
        else { const int kk = k8 - 256, d = kk >> 7, im = (kk >> 6) & 1, n0 = kk & 63, jp = (d == 0) ? t + 1 : 16 - t;
#pragma unroll
            for (int j = 0; j < 8; ++j) { const int n = n0 + j; const float wr = AP[((d * 17 + jp) * 64 + n) * 2], wi = AP[((d * 17 + jp) * 64 + n) * 2 + 1], c_r = CC[((d * 16 + c) * 64 + n) * 2], c_i = CC[((d * 16 + c) * 64 + n) * 2 + 1];
                v[j] = im ? -(c_r * wi + c_i * wr) : (c_r * wr - c_i * wi); } }
        *(u32x4*)(WYt + ((size_t)g * 256 + row) * 512 + k8) = pack8(v); }
    for (int e = tid; e < 2 * 128 * 32; e += 512) { const int d = e >> 12, row = (e >> 5) & 127, k8 = (e & 31) * 8, im = row >> 6, n = row & 63, s = k8 >> 4, c0 = k8 & 15, ex = (d == 0) ? 15 - s : s; float v[8];
        const float wr = AP[((d * 17 + ex) * 64 + n) * 2], wi = AP[((d * 17 + ex) * 64 + n) * 2 + 1];
#pragma unroll
        for (int j = 0; j < 8; ++j) { const float b_r = BB[((d * 64 + n) * 16 + c0 + j) * 2], b_i = BB[((d * 64 + n) * 16 + c0 + j) * 2 + 1]; v[j] = im ? (wr * b_i + wi * b_r) : (wr * b_r - wi * b_i); }
        *(u32x4*)(WEt + ((size_t)(d * 64 + g) * 128 + row) * 256 + k8) = pack8(v); }
    __syncthreads();
}
__device__ __forceinline__ int s5_chunk_row(int b, int ch) { return ch < 16 ? R_LAT + b * 256 + 16 * ch : b * 4096 + 16 * (ch - 16); }
__device__ __forceinline__ void s5_main(const S5In& P, int l, const bf16_t* U, const bf16_t* WEt, const bf16_t* WYt, bf16_t* T, LAS unsigned char* lds, int tid) {
    const int lane = tid & 63, w = __builtin_amdgcn_readfirstlane(tid >> 6), fr = lane & 15, q = lane >> 4;
    constexpr int XP = 528;
    LAS unsigned char* XIN = lds; LAS float* ET = (LAS float*)(lds + 272 * XP); LAS unsigned char* UC = lds + 272 * XP + 8192;
    const int uc_chunk = tid >> 5, uc_piece = tid & 31;
    LAS u32x4* uc_dst = (LAS u32x4*)(UC + uc_chunk * XP + uc_piece * 16);
    const LAS unsigned char* uc_a = UC + fr * XP + 16 * q;
#define S5_GLOAD(tile) (*(const u32x4*)(U + (size_t)(s5_chunk_row(b, 16 * (tile) + uc_chunk) + (uc_piece >> 1)) * 1024 + g * 16 + 8 * (uc_piece & 1)))
    for (int item = blockIdx.x; item < 512; item += gridDim.x) {
        const int g = item & 63, b = item >> 6;
#pragma unroll 1
        for (int d = 0; d < 2; ++d) {
            bf16x8 bw[8];
            { const bf16_t* wp = WEt + ((size_t)(d * 64 + g) * 128 + 16 * w + fr) * 256 + 8 * q;
#pragma unroll
              for (int kk = 0; kk < 8; ++kk) bw[kk] = *(const bf16x8*)(wp + 32 * kk); }
            float tr = 1.f, ti = 0.f, xr = 0.f, xi = 0.f;
            if (w == 0) { float cr, ci; s5_abar(P, (l * 2 + d) * 64 + g, lane, tr, ti, cr, ci);
#pragma unroll
                for (int k = 0; k < 4; ++k) { const float n_r = tr * tr - ti * ti, n_i = 2.f * tr * ti; tr = n_r; ti = n_i; } }
#define S5_TILE(i) (((d == 0) || (i) == 0) ? (i) : 17 - (i))
            u32x4 u0 = S5_GLOAD(S5_TILE(0)), u1 = S5_GLOAD(S5_TILE(1));
            *uc_dst = u0; u0 = u1; u1 = S5_GLOAD(S5_TILE(2));
            __syncthreads();
#pragma unroll 1
            for (int i = 0; i < 17; ++i) {
                const int tile = S5_TILE(i);
                f32x4 acc = {0.f, 0.f, 0.f, 0.f};
#pragma unroll
                for (int kk = 0; kk < 8; ++kk) { const bf16x8 af = *(const LAS bf16x8*)(uc_a + 64 * kk); acc = __builtin_amdgcn_mfma_f32_16x16x32_bf16(af, bw[kk], acc, 0, 0, 0); }
#pragma unroll
                for (int r = 0; r < 4; ++r) ET[(4 * q + r) * 128 + 16 * w + fr] = acc[r];
                __syncthreads();
                if (i < 16) { *uc_dst = u0; u0 = u1; if (i + 3 <= 16) u1 = S5_GLOAD(S5_TILE(i + 3)); }
                if (w == 0) {
                    float er[16], ei[16];
#pragma unroll
                    for (int c = 0; c < 16; ++c) { er[c] = ET[c * 128 + lane]; ei[c] = ET[c * 128 + 64 + lane]; }
#pragma unroll
                    for (int cc = 0; cc < 16; ++cc) { const int c = d ? 15 - cc : cc;
                        LAS bf16_t* xp = (LAS bf16_t*)(XIN + (16 * tile + c) * XP) + d * 128;
                        xp[lane] = (bf16_t)(pk2(xr, 0.f) & 0xffffu); xp[64 + lane] = (bf16_t)(pk2(xi, 0.f) & 0xffffu);
                        const float nxr = tr * xr - ti * xi + er[c], nxi = tr * xi + ti * xr + ei[c]; xr = nxr; xi = nxi; }
                }
                __syncthreads();
            }
#undef S5_TILE
        }
        {
            bf16x8 by[2][16];
#pragma unroll
            for (int nt = 0; nt < 2; ++nt) { const bf16_t* wp = WYt + ((size_t)g * 256 + 32 * w + 16 * nt + fr) * 512 + 8 * q;
#pragma unroll
                for (int kk = 0; kk < 16; ++kk) by[nt][kk] = *(const bf16x8*)(wp + 32 * kk); }
            u32x4 u0 = S5_GLOAD(0), u1 = S5_GLOAD(1);
            *uc_dst = u0; u0 = u1; u1 = S5_GLOAD(2);
            __syncthreads();
#pragma unroll 1
            for (int tile = 0; tile < 17; ++tile) {
                f32x4 acc0 = {0.f, 0.f, 0.f, 0.f}, acc1 = {0.f, 0.f, 0.f, 0.f};
#pragma unroll
                for (int kk = 0; kk < 8; ++kk) { const bf16x8 af = *(const LAS bf16x8*)(uc_a + 64 * kk);
                    acc0 = __builtin_amdgcn_mfma_f32_16x16x32_bf16(af, by[0][kk], acc0, 0, 0, 0); acc1 = __builtin_amdgcn_mfma_f32_16x16x32_bf16(af, by[1][kk], acc1, 0, 0, 0); }
                const LAS unsigned char* xq = XIN + (16 * tile + fr) * XP + 16 * q;
#pragma unroll
                for (int kk = 0; kk < 8; ++kk) { const bf16x8 xf = *(const LAS bf16x8*)(xq + 64 * kk);
                    acc0 = __builtin_amdgcn_mfma_f32_16x16x32_bf16(xf, by[0][8 + kk], acc0, 0, 0, 0); acc1 = __builtin_amdgcn_mfma_f32_16x16x32_bf16(xf, by[1][8 + kk], acc1, 0, 0, 0); }
                __syncthreads();
                if (tile < 16) { *uc_dst = u0; u0 = u1; if (tile + 3 <= 16) u1 = S5_GLOAD(tile + 3); }
#pragma unroll
                for (int r = 0; r < 4; ++r) { const int row = s5_chunk_row(b, 16 * tile + 4 * q + r) + 2 * w;
                    T[(size_t)row * 1024 + g * 16 + fr] = (bf16_t)(pk2(gelu_tanh(acc0[r]), 0.f) & 0xffffu);
                    T[(size_t)(row + 1) * 1024 + g * 16 + fr] = (bf16_t)(pk2(gelu_tanh(acc1[r]), 0.f) & 0xffffu); }
                __syncthreads();
            }
        }
    }
#undef S5_GLOAD
}
__device__ __forceinline__ s16x4 vtr(const LAS unsigned char* p) { return __builtin_bit_cast(s16x4, __builtin_amdgcn_ds_read_tr16_b64_v4i16((LAS s16x4*)p)); }
__device__ __forceinline__ void attn_phase(LAS unsigned char* lds, const bf16_t* Q, const bf16_t* KV, const bf16_t* CQ, bf16_t* O, const int tid, const int nunits) {
    const int lane = tid & 63, wid = __builtin_amdgcn_readfirstlane(tid >> 6), r32 = lane & 31, hi = lane >> 5;
    constexpr int KP = 400, VP = 320, BUFB = 64 * KP + 64 * VP;
    const float C = 0.07216878364870322f * 1.4426950408889634f;
    const int kn_row = tid >> 4, kn_ch = tid & 15, kr_row = tid >> 3, kr_ch = tid & 7;
    for (int ui = 0;; ++ui) {
        const int unit = ui * (int)gridDim.x + (int)blockIdx.x; if (unit >= nunits) break;
        int b, h, qb;
        if (unit < 1024) { const int bh = unit >> 4; qb = unit & 15; b = bh >> 3; h = bh & 7; } else { const int bh = unit - 1024; qb = 16; b = bh >> 3; h = bh & 7; }
        const int qrow0 = (qb < 16) ? b * 4096 + qb * 256 : R_LAT + b * 256;
        const int NT = (qb < 16) ? 68 : 4;
        const bf16_t* qp = Q + (size_t)(qrow0 + wid * 32 + r32) * 1536;
        bf16x8 qf[12];
#pragma unroll
        for (int s = 0; s < 8; ++s) qf[s] = *(const bf16x8*)(qp + h * 128 + 16 * s + 8 * hi);
#pragma unroll
        for (int s = 0; s < 4; ++s) qf[8 + s] = *(const bf16x8*)(qp + 1024 + h * 64 + 16 * s + 8 * hi);
        u32x4 sk0, sk1, skr, sv0, sv1;
#define ATT_KROW(t) ((qb < 16) ? (((t) < 64) ? b * 4096 + (t) * 64 : R_LAT + b * 256 + ((t) - 64) * 64) : R_LAT + b * 256 + (t) * 64)
#define ATT_LOAD(t) do { const int kr0_ = ATT_KROW(t); const bf16_t* kvp_ = KV + (size_t)(kr0_ + kn_row) * 2048 + h * 256 + kn_ch * 8; \
        sk0 = *(const u32x4*)kvp_; sk1 = *(const u32x4*)(kvp_ + 32 * 2048); sv0 = *(const u32x4*)(kvp_ + 128); sv1 = *(const u32x4*)(kvp_ + 128 + 32 * 2048); \
        skr = *(const u32x4*)(CQ + (size_t)(kr0_ + kr_row) * 768 + 512 + kr_ch * 8); } while (0)
#define ATT_STORE(buf) do { LAS unsigned char* kb_ = lds + (buf) * BUFB; LAS unsigned char* vb_ = kb_ + 64 * KP; \
        *(LAS u32x4*)(kb_ + kn_row * KP + kn_ch * 16) = sk0; *(LAS u32x4*)(kb_ + (kn_row + 32) * KP + kn_ch * 16) = sk1; *(LAS u32x4*)(kb_ + kr_row * KP + 256 + kr_ch * 16) = skr; \
        *(LAS u32x4*)(vb_ + kn_row * VP + kn_ch * 16) = sv0; *(LAS u32x4*)(vb_ + (kn_row + 32) * VP + kn_ch * 16) = sv1; } while (0)
        ATT_LOAD(0); ATT_STORE(0);
        __syncthreads();
        float mrun = -1e30f, lrun = 0.f;
        f32x16 o[4];
#pragma unroll
        for (int d = 0; d < 4; ++d)
#pragma unroll
            for (int r = 0; r < 16; ++r) o[d][r] = 0.f;
        for (int t = 0; t < NT; ++t) {
            const int cur = t & 1;
            if (t + 1 < NT) ATT_LOAD(t + 1);
            f32x16 p0, p1;
#pragma unroll
            for (int r = 0; r < 16; ++r) { p0[r] = 0.f; p1[r] = 0.f; }
            __builtin_amdgcn_s_setprio(1);
            { const LAS unsigned char* kb = lds + cur * BUFB + r32 * KP + hi * 16;
#pragma unroll
              for (int s = 0; s < 12; ++s) { const bf16x8 k0 = *(const LAS bf16x8*)(kb + s * 32), k1 = *(const LAS bf16x8*)(kb + 32 * KP + s * 32);
                  p0 = __builtin_amdgcn_mfma_f32_32x32x16_bf16(k0, qf[s], p0, 0, 0, 0); p1 = __builtin_amdgcn_mfma_f32_32x32x16_bf16(k1, qf[s], p1, 0, 0, 0); } }
            __builtin_amdgcn_s_setprio(0);
            float mx = p0[0];
#pragma unroll
            for (int r = 0; r < 16; ++r) { mx = fmaxf(mx, p0[r]); mx = fmaxf(mx, p1[r]); }
            mx = fmaxf(mx, __shfl_xor(mx, 32)) * C;
            if (__any(mx > mrun + 8.0f)) {
                const float mn = fmaxf(mrun, mx), alpha = __builtin_amdgcn_exp2f(mrun - mn); mrun = mn; lrun *= alpha;
#pragma unroll
                for (int d = 0; d < 4; ++d)
#pragma unroll
                    for (int r = 0; r < 16; ++r) o[d][r] *= alpha;
            }
            float rsum = 0.f;
#pragma unroll
            for (int r = 0; r < 16; ++r) { p0[r] = __builtin_amdgcn_exp2f(p0[r] * C - mrun); p1[r] = __builtin_amdgcn_exp2f(p1[r] * C - mrun); rsum += p0[r] + p1[r]; }
            lrun += rsum;
            bf16x8 pf[4];
            { u32x4 w;
              w.x = pk2(p0[0], p0[1]); w.y = pk2(p0[2], p0[3]); w.z = pk2(p0[4], p0[5]); w.w = pk2(p0[6], p0[7]); pf[0] = __builtin_bit_cast(bf16x8, w);
              w.x = pk2(p0[8], p0[9]); w.y = pk2(p0[10], p0[11]); w.z = pk2(p0[12], p0[13]); w.w = pk2(p0[14], p0[15]); pf[1] = __builtin_bit_cast(bf16x8, w);
              w.x = pk2(p1[0], p1[1]); w.y = pk2(p1[2], p1[3]); w.z = pk2(p1[4], p1[5]); w.w = pk2(p1[6], p1[7]); pf[2] = __builtin_bit_cast(bf16x8, w);
              w.x = pk2(p1[8], p1[9]); w.y = pk2(p1[10], p1[11]); w.z = pk2(p1[12], p1[13]); w.w = pk2(p1[14], p1[15]); pf[3] = __builtin_bit_cast(bf16x8, w); }
            __builtin_amdgcn_s_setprio(1);
            { const LAS unsigned char* vb = lds + cur * BUFB + 64 * KP + (4 * hi + ((lane & 15) >> 2)) * VP + (16 * ((lane >> 4) & 1) + 4 * (lane & 3)) * 2;
#pragma unroll
              for (int d = 0; d < 4; ++d)
#pragma unroll
                  for (int s = 0; s < 4; ++s) { const s16x4 lo = vtr(vb + s * 16 * VP + d * 64), hh = vtr(vb + s * 16 * VP + 8 * VP + d * 64);
                      const bf16x8 vf = (bf16x8){lo[0], lo[1], lo[2], lo[3], hh[0], hh[1], hh[2], hh[3]};
                      o[d] = __builtin_amdgcn_mfma_f32_32x32x16_bf16(vf, pf[s], o[d], 0, 0, 0); } }
            __builtin_amdgcn_s_setprio(0);
            if (t + 1 < NT) ATT_STORE(cur ^ 1);
            __syncthreads();
        }
        const float inv = 1.0f / (lrun + __shfl_xor(lrun, 32));
        bf16_t* op = O + (size_t)(qrow0 + wid * 32 + r32) * 1024 + h * 128;
#pragma unroll
        for (int d = 0; d < 4; ++d)
#pragma unroll
            for (int i4 = 0; i4 < 4; ++i4) { u32x2 w; w.x = pk2(o[d][4 * i4] * inv, o[d][4 * i4 + 1] * inv); w.y = pk2(o[d][4 * i4 + 2] * inv, o[d][4 * i4 + 3] * inv);
                *(u32x2*)(op + 32 * d + 8 * i4 + 4 * hi) = w; }
    }
#undef ATT_KROW
#undef ATT_LOAD
#undef ATT_STORE
}
#define XB_TMO      128
#define XB_XCNT(j)  (256  + 64 * (j))
#define XB_XSUB(j)  (1280 + 64 * (j))
#define XB_XGEN(j)  (2304 + 64 * (j))
#define XB_TOP      3328
#define XB_TOPGEN   3392
#define XCD_BAR_WORDS 3456
#define XB_SPIN_CAP (1u << 18)

__device__ __forceinline__ unsigned xb_ld(unsigned* p)              { return __hip_atomic_load(p, __ATOMIC_RELAXED, __HIP_MEMORY_SCOPE_AGENT); }
__device__ __forceinline__ unsigned xb_add(unsigned* p, unsigned v) { return __hip_atomic_fetch_add(p, v, __ATOMIC_RELAXED, __HIP_MEMORY_SCOPE_AGENT); }
__device__ __forceinline__ unsigned xb_xcc_id() { return (unsigned)__builtin_amdgcn_s_getreg((3 << 11) | 20) & 0xFu; }
#define XB_SPIN(cond, bar) do { unsigned _sp = 0; while (cond) { __builtin_amdgcn_s_sleep(1); \
    if ((++_sp & 255u) == 0u) { if (xb_ld(&(bar)[XB_TMO])) break; if (_sp > XB_SPIN_CAP) { atomicAdd(&(bar)[XB_TMO], 1u); break; } } } } while (0)

struct XcdBarrier {
    unsigned* bar; unsigned x;
    volatile LAS unsigned* st;
};

__device__ __forceinline__ XcdBarrier xcd_barrier_post(unsigned* bar, volatile LAS unsigned* st) {
    XcdBarrier b; b.bar = bar; b.x = xb_xcc_id(); b.st = st;
    if (threadIdx.x == 0) (void)xb_add(&bar[XB_XCNT(b.x)], 1u);
    return b;
}
__device__ __forceinline__ void xcd_barrier_complete(unsigned* bar, unsigned x, unsigned& nloc, unsigned& nx) {
    const unsigned G = gridDim.x * gridDim.y * gridDim.z;
    unsigned sum, cnt, mine, sp = 0u;
    for (;;) {
        sum = 0u; cnt = 0u; mine = 0u;
#pragma unroll
        for (unsigned j = 0; j < 16; ++j) { const unsigned c = xb_ld(&bar[XB_XCNT(j)]); sum += c; cnt += (c > 0u) ? 1u : 0u; mine = (j == x) ? c : mine; }
        if (sum == G) break;
        __builtin_amdgcn_s_sleep(1);
        if ((++sp & 255u) == 0u) { if (xb_ld(&bar[XB_TMO])) break; if (sp > XB_SPIN_CAP) { atomicAdd(&bar[XB_TMO], 1u); break; } }
    }
    nloc = mine > 0u ? mine : 1u; nx = cnt > 0u ? cnt : 1u;
}

__device__ __forceinline__ void xcd_barrier(const XcdBarrier& b) {
    asm volatile("s_waitcnt vmcnt(0)" ::: "memory");
    __syncthreads();
    if (threadIdx.x == 0) {
        unsigned* bar = b.bar;
        __builtin_amdgcn_s_waitcnt(0);
        unsigned nloc = b.st[0], nx = b.st[1];
        if (nloc == 0u) { xcd_barrier_complete(bar, b.x, nloc, nx); b.st[0] = nloc; b.st[1] = nx; }
        const unsigned old = xb_add(&bar[XB_XSUB(b.x)], 1u);
        const unsigned gen = old / nloc;
        if (old + 1u == (gen + 1u) * nloc) {
            __builtin_amdgcn_fence(__ATOMIC_RELEASE, "agent");
            asm volatile("s_waitcnt vmcnt(0)" ::: "memory");
            const unsigned og = xb_add(&bar[XB_TOP], 1u);
            const unsigned tg = og / nx;
            if (og + 1u == (tg + 1u) * nx) xb_add(&bar[XB_TOPGEN], 1u);
            else XB_SPIN(xb_ld(&bar[XB_TOPGEN]) == tg, bar);
            __builtin_amdgcn_fence(__ATOMIC_ACQUIRE, "agent");
            xb_add(&bar[XB_XGEN(b.x)], 1u);
            asm volatile("s_waitcnt vmcnt(0)" ::: "memory");
        } else {
            XB_SPIN(xb_ld(&bar[XB_XGEN(b.x)]) == gen, bar);
            __builtin_amdgcn_fence(__ATOMIC_ACQUIRE, "agent");
            asm volatile("s_waitcnt vmcnt(0)" ::: "memory");
        }
    }
    __syncthreads();
}

#define DERIVE_PTRS float* MOD = (float*)(ws + WS_MOD); float* ROPE = (float*)(ws + WS_ROPE); float* YSS = (float*)(ws + WS_YSS); float* CSS = (float*)(ws + WS_CSS); bf16_t* WEt = (bf16_t*)(ws + WS_S5E); bf16_t* WYt = (bf16_t*)(ws + WS_S5E + S5_WE_BYTES); float* XC = (float*)(ws + WS_XC); bf16_t* WL = (bf16_t*)(ws + WS_WL); bf16_t* H = (bf16_t*)(ws + WS_H); unsigned char* big = ws + WS_BIG; bf16_t* CQ = (bf16_t*)(big + B_CQ); bf16_t* U = (bf16_t*)(big + B_U); bf16_t* Qb = (bf16_t*)(big + B_Q); bf16_t* KVb = (bf16_t*)(big + B_KV); bf16_t* SG = (bf16_t*)(big + B_SG); bf16_t* ACT = (bf16_t*)(big + B_ACT); bf16_t* Y = (bf16_t*)(big + B_Y); bf16_t* T = (bf16_t*)(big + B_T); bf16_t* Gb = (bf16_t*)(big + B_G); bf16_t* Mb = (bf16_t*)(big + B_M); bf16_t* Ob = H;
constexpr int PPL = 13;
constexpr int NSTEPS = 2 + PPL * DEPTH;
struct Args { const float* in[29]; float* out; unsigned char* ws; int ph_lo, ph_hi; };
__global__ void __launch_bounds__(512, 2) mk_fwd(Args a) {
    extern __shared__ __attribute__((aligned(16))) unsigned char lds_raw[];
    cg::grid_group grid = cg::this_grid();
    LAS unsigned char* lds = (LAS unsigned char*)lds_raw;
    const int G = gridDim.x, NGW = G * 8;
    volatile LAS unsigned* xst = (volatile LAS unsigned*)(lds + LDS_BYTES - 64);
    if (threadIdx.x < 2) xst[threadIdx.x] = 0u;
    __syncthreads();
    XcdBarrier xbar; xbar.bar = (unsigned*)(a.ws + WS_CTL); xbar.x = 0; xbar.st = xst;
    if (a.ph_hi - a.ph_lo > 1) xbar = xcd_barrier_post((unsigned*)(a.ws + WS_CTL), xst);
    WPtrs WP{a.in[8], a.in[9], a.in[10], a.in[11], a.in[12], a.in[13], a.in[14], a.in[15], a.in[16], a.in[25], a.in[27], a.in[28]};
    S5In SP{a.in[17], a.in[18], a.in[19], a.in[20], a.in[21], a.in[22], a.in[23], a.in[24]};
#if MK_TIME >= 0
    unsigned long long tacc = 0ull;
#endif
#pragma unroll 1
    for (int step = a.ph_lo; step < a.ph_hi; ++step) {
#if MK_TIME >= 0
        const unsigned long long tph0 = __builtin_amdgcn_s_memrealtime();
#endif
        int tid = threadIdx.x; asm volatile("" : "+v"(tid));
        const int lane = tid & 63, wave = __builtin_amdgcn_readfirstlane(tid >> 6), gw = blockIdx.x * 8 + wave;
        unsigned char* ws = a.ws; asm volatile("" : "+s"(ws));
        DERIVE_PTRS
        int l = 0, p = -1;
        if (step >= 2) { l = (step - 2) / PPL; p = (step - 2) % PPL; if (p >= 6) ++p; }
        if (step == 0) mods_phase(a.in[1], a.in[3], a.in[4], a.in[5], MOD, ROPE, lds, tid);
        if (step == 0) conv_layer(WP, 0, WL, lds, gw, NGW, wave, lane, 0, 12864);
#if MK_PROBE == 9
        if (step == 0) { __syncthreads(); mods_phase(a.in[1], a.in[3], a.in[4], a.in[5], MOD, ROPE, lds, tid); conv_layer(WP, 0, WL, lds, gw, NGW, wave, lane, 0, 12864); }
#endif
        if (p == 13 && l < DEPTH - 1) conv_layer(WP, l + 1, WL, lds, gw, NGW, wave, lane, 7040, 8448);
        if (step == 1 || p == 2 || p == 10 || p == 13) {
            int s, nl, ns;
            if (step == 1) { s = -1; nl = 0; ns = 0; } else if (p == 2) { s = 0; nl = l; ns = 1; } else if (p == 10) { s = 1; nl = l; ns = 2; } else { s = 2; nl = (l < DEPTH - 1) ? l + 1 : -1; ns = 0; }
            e_phase(a.in[0], a.in[2], a.out, XC, Y, YSS, MOD, a.in[6], a.in[7], H, l, s, nl, ns, gw, NGW, lane, 1.0f, (l == DEPTH - 1 && p >= 10) ? R_LAT : R);
#if MK_PROBE == 5
            if (s >= 0) { __syncthreads(); e_phase(a.in[0], a.in[2], a.out, XC, Y, YSS, MOD, a.in[6], a.in[7], H, l, s, nl, ns, gw, NGW, lane, 0.0f, R); }
#endif
        }
        if (p == 0 || p == 1 || p == 3 || p == 4 || p == 7 || p == 8 || p == 9 || p == 11 || p == 12) {
            const int ng = (p == 4 || p == 7) ? 2 : 1;
#pragma unroll 1
            for (int gi = 0; gi < ng; ++gi) {
                pg8::Gemm g; Epi E; E.o0 = nullptr; E.o1 = nullptr; E.o2 = nullptr; E.i0 = nullptr; E.i1 = nullptr; E.ss = nullptr; E.css = CSS; E.bias = nullptr; E.rope = ROPE; E.mode = 0;
                g.M = R;
                if (p == 0 || p == 11) { g.A = H; g.Bt = WL + (p == 0 ? W_GUA : W_GUB); g.N = 5632; g.K = 1024; g.lda = 1024; E.mode = 0; E.o0 = ACT; }
                else if (p == 1 || p == 12) { g.A = ACT; g.Bt = WL + (p == 1 ? W_DA : W_DB); g.N = 1024; g.K = FF; g.lda = FF; E.mode = 1; E.o0 = Y; E.ss = YSS; }
                else if (p == 3) { g.A = H; g.Bt = WL + W_IN; g.N = 3840; g.K = 1024; g.lda = 1024; E.mode = 2; E.o0 = CQ; E.o1 = U; E.o2 = SG; E.ss = CSS; }
                else if (p == 4 && gi == 0) { g.A = CQ; g.Bt = WL + W_UQ; g.N = 1536; g.K = 256; g.lda = 768; E.mode = 3; E.o0 = Qb; }
                else if (p == 4) { g.A = CQ + 256; g.Bt = WL + W_UKV; g.N = 2048; g.K = 256; g.lda = 768; E.mode = 4; E.o0 = KVb; }
                else if (p == 7 && gi == 0) { g.A = T; g.Bt = WL + W_GLU; g.N = 1024; g.K = 1024; g.lda = 1024; E.mode = 5; E.o0 = Gb; E.i0 = T; E.bias = a.in[26] + l * 1024; }
                else if (p == 7) { g.A = Ob; g.Bt = WL + W_OMLA; g.N = 1024; g.K = 1024; g.lda = 1024; E.mode = 6; E.o0 = Mb; E.i0 = SG; }
                else if (p == 8) { g.A = Gb; g.Bt = WL + W_OS5; g.N = 1024; g.K = 1024; g.lda = 1024; E.mode = 7; E.o0 = Mb; E.i0 = Mb; E.i1 = SG + 1024; }
                else { g.A = Mb; g.Bt = WL + W_OUT; g.N = 1024; g.K = 1024; g.lda = 1024; E.mode = 1; E.o0 = Y; E.ss = YSS; }
                const int Mrows = (l == DEPTH - 1 && (p >= 7 || (p == 4 && gi == 0))) ? R_LAT : R;
                pg8::StaticOrder S; S.init(Mrows, g.N, G, (gi == 0) ? (int)blockIdx.x : (int)((blockIdx.x + (G >> 1)) % G));
                pg8::gemm_phase<Epi, pg8::StaticOrder, true, true>(lds, g, S, E, tid);
#if MK_PROBE == 3 || MK_PROBE == 6 || MK_PROBE == 7 || MK_PROBE == 8 || MK_PROBE == 10
                if ((MK_PROBE == 3 && (p == 0 || p == 11)) || (MK_PROBE == 6 && p == 9) || (MK_PROBE == 7 && (p == 1 || p == 12)) || (MK_PROBE == 8 && p == 4) || (MK_PROBE == 10 && p == 3)) { __syncthreads(); pg8::gemm_phase<Epi, pg8::StaticOrder, true, true>(lds, g, S, E, tid); }
#endif
            }
        }
        if (p == 4) {
#pragma unroll 1
            for (int rep = 0; rep < (MK_PROBE == 2 ? 2 : 1); ++rep) s5_main(SP, l, U, WEt, WYt, T, lds, tid); }
        if (G == 256) {
            const int bx = blockIdx.x;
            if (p == 1 && bx >= 32 && bx < 96) s5_prep(SP, l, bx - 32, WEt, WYt, lds, tid);
            if (l < DEPTH - 1 && bx >= 32) {
                const int vgw = (bx - 32) * 8 + wave, VNGW = 224 * 8;
                if (p == 7 && (bx < 128 || bx >= 160)) { const int v7 = ((bx < 128) ? bx - 32 : bx - 64) * 8 + wave;
                    conv_layer(WP, l + 1, WL, lds, v7, 192 * 8, wave, lane, 0, 2816); conv_layer(WP, l + 1, WL, lds, v7, 192 * 8, wave, lane, 5632, 7040); }
                if (p == 8) { conv_layer(WP, l + 1, WL, lds, vgw, VNGW, wave, lane, 8448, 11840); }
                if (p == 9) { conv_layer(WP, l + 1, WL, lds, vgw, VNGW, wave, lane, 11840, 12352); }
                if (p == 12) { conv_layer(WP, l + 1, WL, lds, vgw, VNGW, wave, lane, 12352, 12864); conv_layer(WP, l + 1, WL, lds, vgw, VNGW, wave, lane, 2816, 5632); }
            }
        }
        if (G != 256) {
            if (p == 2 && blockIdx.x < 64) s5_prep(SP, l, blockIdx.x, WEt, WYt, lds, tid);
            if (p == 13 && l < DEPTH - 1) { conv_layer(WP, l + 1, WL, lds, gw, NGW, wave, lane, 0, 7040); conv_layer(WP, l + 1, WL, lds, gw, NGW, wave, lane, 8448, 12864); }
        }
        if (p == 5) {
#pragma unroll 1
            for (int rep = 0; rep < (MK_PROBE == 1 ? 2 : 1); ++rep) attn_phase(lds, Qb, KVb, CQ, Ob, tid, (l == DEPTH - 1) ? 1024 : 1024 + 64); }
#if MK_TIME >= 0
        const unsigned long long tb0 = __builtin_amdgcn_s_memrealtime();
#endif
        if (step + 1 < a.ph_hi) {
            if (step == a.ph_lo) grid.sync(); else xcd_barrier(xbar);
#if MK_PROBE == 4
            xcd_barrier(xbar); xcd_barrier(xbar);
#endif
        }
#if MK_TIME >= 0
        { const unsigned long long tb1 = __builtin_amdgcn_s_memrealtime();
          const int cls = (step == 0) ? 10 : (step == 1 || p == 2 || p == 10 || p == 13) ? 2 : (p == 0 || p == 11) ? 0 : (p == 1 || p == 12) ? 1 : (p == 3) ? 3 : (p == 4) ? 4 : (p == 5) ? 5 : (p == 7) ? 6 : (p == 8) ? 7 : 8;
          if (MK_TIME == 99) tacc += tb1 - tb0; else if (cls == MK_TIME) tacc += tb1 - tph0; }
#endif
    }
#if MK_TIME >= 0
    if (blockIdx.x == MK_TIME_BLOCK) { const unsigned long long te = __builtin_amdgcn_s_memrealtime(); while (__builtin_amdgcn_s_memrealtime() - te < tacc) __builtin_amdgcn_s_sleep(16); }
#endif
}

extern "C" void kernel_launch(void* const* d_in, const int* in_sizes, int n_in, void* d_out, int out_size, void* d_ws, size_t ws_size, hipStream_t stream) {
    static int grid = 0;
    if (grid == 0) {
        if (n_in != 29 || out_size != R_LAT * DM || ws_size < WS_END) { fprintf(stderr, "kernel_launch: unexpected problem (n_in %d out %d ws %zu need %zu)\n", n_in, out_size, ws_size, (size_t)WS_END); grid = -1; return; }
        int dev = 0, cus = 0, per_cu = 0;
        if (hipGetDevice(&dev) != hipSuccess || hipDeviceGetAttribute(&cus, hipDeviceAttributeMultiprocessorCount, dev) != hipSuccess) { grid = -1; return; }
        if (hipFuncSetAttribute((const void*)mk_fwd, hipFuncAttributeMaxDynamicSharedMemorySize, LDS_BYTES) != hipSuccess) { fprintf(stderr, "kernel_launch: hipFuncSetAttribute failed\n"); grid = -1; return; }
        if (hipOccupancyMaxActiveBlocksPerMultiprocessor(&per_cu, (const void*)mk_fwd, 512, LDS_BYTES) != hipSuccess || per_cu < 1) { fprintf(stderr, "kernel_launch: occupancy query says %d\n", per_cu); per_cu = 1; }
        (void)hipGetLastError();
        grid = cus * 1;
    }
    if (grid < 0) return;
    if (hipMemsetAsync((char*)d_ws + WS_CTL, 0, CTL_BYTES, stream) != hipSuccess) { fprintf(stderr, "kernel_launch: memset failed\n"); return; }
    Args a{};
    for (int i = 0; i < 29; ++i) a.in[i] = (const float*)d_in[i];
    a.out = (float*)d_out; a.ws = (unsigned char*)d_ws;
#if MK_MULTI
    for (int s = 0; s < NSTEPS; ++s) { a.ph_lo = s; a.ph_hi = s + 1; void* args[] = {&a};
        hipError_t e = hipLaunchCooperativeKernel((const void*)mk_fwd, dim3(grid), dim3(512), args, LDS_BYTES, stream);
        if (e != hipSuccess) { fprintf(stderr, "cooperative launch %d failed: %s\n", s, hipGetErrorString(e)); break; } }
#else
    a.ph_lo = 0; a.ph_hi = NSTEPS; void* args[] = {&a};
    hipError_t e = hipLaunchCooperativeKernel((const void*)mk_fwd, dim3(grid), dim3(512), args, LDS_BYTES, stream);
    if (e != hipSuccess) fprintf(stderr, "cooperative launch failed: %s (grid %d)\n", hipGetErrorString(e), grid);
#endif
}
```

```cpp
#include <hip/hip_runtime.h>
#include <hip/hip_cooperative_groups.h>
#include <cstdio>
#include <cstdint>
namespace cg = cooperative_groups;
#ifndef MK_MULTI
#define MK_MULTI 0
#endif
#ifndef MK_PROBE
#define MK_PROBE 0
#endif
#ifndef MK_TIME
#define MK_TIME -1
#endif
#ifndef MK_TIME_BLOCK
#define MK_TIME_BLOCK 128
#endif
namespace pg8 {
#define PG8_LAS __attribute__((address_space(3)))
typedef unsigned short bf16_t;
typedef short bf16x8 __attribute__((ext_vector_type(8)));
typedef float f32x4 __attribute__((ext_vector_type(4)));
typedef unsigned u32x4 __attribute__((ext_vector_type(4)));
constexpr int BM = 256, BK = 64, HALF = 128, HTB = HALF * BK * 2  , STAGE_BYTES = 8 * HTB, NXCD = 8, WGM = 8;

__host__ __device__ __forceinline__ int lds_byte(int r, int c) { const int st = (r >> 4) * 2 + (c >> 5), rr = r & 15, cc = c & 31, ob = rr * 64 + cc * 2; return st * 1024 + (ob ^ (((ob >> 9) & 1) << 5)); }
__host__ __device__ __forceinline__ void stage_rc(int b, int& R, int& C) { const int st = b / 1024, sb = b % 1024, swz = sb ^ (((sb >> 9) & 1) << 5); R = (st >> 1) * 16 + swz / 64; C = (st & 1) * 32 + (swz % 64) / 2; }
__host__ __device__ __forceinline__ int perm32(int rho) { const int n = rho >> 4, i = rho & 15; return 8 * (i >> 2) + 4 * n + (i & 3); }

struct Unit { int pm, pn; };
struct Gemm { const bf16_t* A; const bf16_t* Bt; int M, N, K, lda; };

struct StaticOrder {
    int nM, nN, nwg, G, c;
    __host__ __device__ void init(int M, int N, int G_, int c_) { nM = M / BM; nN = N / BM; nwg = nM * nN; G = G_; c = c_; }
    __host__ __device__ bool next(int i, Unit& u) const {
        const long L = (long)i * G + c; if (L >= nwg) return false;
        int wgid = (int)L; { const int q = nwg / NXCD, r = nwg % NXCD, xcd = wgid % NXCD, off = wgid / NXCD; wgid = (xcd < r ? xcd * (q + 1) : r * (q + 1) + (xcd - r) * q) + off; }
        const int nig = WGM * nN, gid = wgid / nig, fm = gid * WGM, gsz = (nM - fm) < WGM ? (nM - fm) : WGM;
        u.pm = fm + ((wgid % nig) % gsz); u.pn = (wgid % nig) / gsz; return true;
    }
    __device__ __forceinline__ void a_ready(const Unit&) const {}
    __device__ __forceinline__ void done(const Unit&) const {}
};

__device__ __forceinline__ unsigned cvt_pk_bf16(float lo, float hi) { unsigned r; asm volatile("v_cvt_pk_bf16_f32 %0, %1, %2" : "=v"(r) : "v"(lo), "v"(hi)); return r; }
template <class Epi, class Sched, bool ALIGN_EPI = false, bool SP2 = false>
__device__ __forceinline__ void gemm_phase(PG8_LAS unsigned char* lds, const Gemm g, const Sched& S, const Epi& E, const int tid) {
    const int wid = __builtin_amdgcn_readfirstlane(tid >> 6), lane = tid & 63, wr = wid >> 2, wc = wid & 3, fr = lane & 15, fq = lane >> 4;
    const int K = g.K, nt = K / BK;
    unsigned voffA[2], voffB[2];
#pragma unroll
    for (int i = 0; i < 2; ++i) { int R, C; stage_rc(tid * 16 + i * 8192, R, C); const int Rb = Epi::PERM ? ((R & ~31) + perm32(R & 31)) : R;
        voffA[i] = (unsigned)(R * g.lda + C) * 2u; voffB[i] = (unsigned)(Rb * K + C) * 2u; }
    const size_t kstep = (size_t)(BK * 2);
    const size_t hstep = (size_t)HALF * K * 2;
    const size_t tstep = 2 * hstep; const size_t hstepA = (size_t)HALF * g.lda * 2, tstepA = 2 * hstepA;
    const unsigned ldsw = (unsigned)wid * 1024u;
    const int aoff = lds_byte(wr * 64 + fr, fq * 8), boff = lds_byte(wc * 32 + fr, fq * 8);
#define PG8_SA(b, h) (((b) * 2 + (h)) * HTB)
#define PG8_SB(b, h) ((4 + (b) * 2 + (h)) * HTB)
#define PG8_STAGE(bufoff, gbase, voff) do { _Pragma("unroll") for (int _i = 0; _i < 2; ++_i) \
        __builtin_amdgcn_global_load_lds((const unsigned*)((const char*)(gbase) + (voff)[_i]), (PG8_LAS unsigned*)(lds + (bufoff) + ldsw + _i * 8192), 16, 0, 0); } while (0)
#define PG8_LDA(dst, b, h) do { _Pragma("unroll") for (int m = 0; m < 4; ++m) _Pragma("unroll") for (int k = 0; k < 2; ++k) dst[m][k] = *(const PG8_LAS bf16x8*)(lds + PG8_SA(b, h) + aoff + m * 2048 + k * 1024); } while (0)
#define PG8_LDB(dst, b, h) do { _Pragma("unroll") for (int n = 0; n < 2; ++n) _Pragma("unroll") for (int k = 0; k < 2; ++k) dst[n][k] = *(const PG8_LAS bf16x8*)(lds + PG8_SB(b, h) + boff + n * 2048 + k * 1024); } while (0)
#define PG8_MMA(ai, bj, At, Bt) do { __builtin_amdgcn_s_setprio(1); _Pragma("unroll") for (int m = 0; m < 4; ++m) _Pragma("unroll") for (int n = 0; n < 2; ++n) _Pragma("unroll") for (int k = 0; k < 2; ++k) \
        acc[ai][bj][m][n] = __builtin_amdgcn_mfma_f32_16x16x32_bf16(Bt[n][k], At[m][k], acc[ai][bj][m][n], 0, 0, 0); __builtin_amdgcn_s_setprio(0); } while (0)
#define PG8_WAIT_V(n) asm volatile("s_waitcnt vmcnt(" #n ")" ::: "memory")
#define PG8_WAIT_L(n) asm volatile("s_waitcnt lgkmcnt(" #n ")" ::: "memory")
#define PG8_BAR __builtin_amdgcn_s_barrier()
#define PG8_SCHED __builtin_amdgcn_sched_barrier(0)
    Unit cur, nxt; int ui = 0;
    if (!S.next(0, cur)) return;
    f32x4 acc[2][2][4][2];
#pragma unroll
    for (int a = 0; a < 2; ++a)
#pragma unroll
        for (int b = 0; b < 2; ++b)
#pragma unroll
            for (int m = 0; m < 4; ++m)
#pragma unroll
                for (int n = 0; n < 2; ++n) acc[a][b][m][n] = (f32x4){0.f, 0.f, 0.f, 0.f};
    bf16x8 At[4][2], B0[2][2], B1[2][2];
    const char* cA = (const char*)g.A + (size_t)cur.pm * tstepA; const char* cB = (const char*)g.Bt + (size_t)cur.pn * tstep;
    S.a_ready(cur);
    if constexpr (SP2) {
        PG8_STAGE(PG8_SB(0, 0), cB, voffB); PG8_STAGE(PG8_SB(0, 1), cB + hstep, voffB); PG8_STAGE(PG8_SA(0, 0), cA, voffA); PG8_STAGE(PG8_SA(0, 1), cA + hstepA, voffA);
        if (wr == 1) PG8_BAR;
        PG8_WAIT_V(2); PG8_BAR;
        PG8_STAGE(PG8_SB(1, 0), cB + kstep, voffB); PG8_STAGE(PG8_SA(1, 0), cA + kstep, voffA); PG8_STAGE(PG8_SB(1, 1), cB + hstep + kstep, voffB);
        PG8_WAIT_V(6); PG8_BAR;
    } else {
        PG8_STAGE(PG8_SB(0, 0), cB, voffB); PG8_STAGE(PG8_SA(0, 0), cA, voffA); PG8_STAGE(PG8_SB(0, 1), cB + hstep, voffB); PG8_STAGE(PG8_SA(0, 1), cA + hstepA, voffA);
        if (wr == 1) PG8_BAR;
        PG8_WAIT_V(4); PG8_BAR;
        PG8_STAGE(PG8_SB(1, 0), cB + kstep, voffB); PG8_STAGE(PG8_SA(1, 0), cA + kstep, voffA); PG8_STAGE(PG8_SB(1, 1), cB + hstep + kstep, voffB);
        PG8_WAIT_V(6); PG8_BAR;
    }
    for (;;) {
        const bool has_next = S.next(ui + 1, nxt);
        const char* nA = has_next ? (const char*)g.A + (size_t)nxt.pm * tstepA : cA; const char* nB = has_next ? (const char*)g.Bt + (size_t)nxt.pn * tstep : cB;
        for (int t = 0; t < nt; t += 2) {
            const bool last = (t == nt - 2);
            const char* a1 = cA + (size_t)(t + 1) * kstep;
            const char* a2 = last ? nA : cA + (size_t)(t + 2) * kstep; const char* b2 = last ? nB : cB + (size_t)(t + 2) * kstep;
            const char* a3 = a2 + kstep; const char* b3 = b2 + kstep;
            if (last && has_next) S.a_ready(nxt);
            if constexpr (SP2) {
            PG8_LDB(B0, 0, 0); PG8_LDB(B1, 0, 1); PG8_SCHED; PG8_LDA(At, 0, 0); PG8_STAGE(PG8_SA(1, 1), a1 + hstepA, voffA);
            PG8_WAIT_V(8); PG8_WAIT_L(0); PG8_BAR; PG8_MMA(0, 0, At, B0); PG8_MMA(0, 1, At, B1); PG8_BAR; PG8_SCHED;
            PG8_LDA(At, 0, 1); PG8_STAGE(PG8_SB(0, 0), b2, voffB); PG8_STAGE(PG8_SB(0, 1), b2 + hstep, voffB); PG8_STAGE(PG8_SA(0, 0), a2, voffA);
            PG8_WAIT_V(8); PG8_WAIT_L(0); PG8_BAR; PG8_MMA(1, 0, At, B0); PG8_MMA(1, 1, At, B1); PG8_BAR; PG8_SCHED;
            PG8_LDB(B0, 1, 0); PG8_LDB(B1, 1, 1); PG8_SCHED; PG8_LDA(At, 1, 0); PG8_STAGE(PG8_SA(0, 1), a2 + hstepA, voffA);
            PG8_WAIT_V(8); PG8_WAIT_L(0); PG8_BAR; PG8_MMA(0, 0, At, B0); PG8_MMA(0, 1, At, B1); PG8_BAR; PG8_SCHED;
            PG8_LDA(At, 1, 1); PG8_STAGE(PG8_SB(1, 0), b3, voffB); PG8_STAGE(PG8_SB(1, 1), b3 + hstep, voffB); PG8_STAGE(PG8_SA(1, 0), a3, voffA);
            PG8_WAIT_V(8); PG8_WAIT_L(0); PG8_BAR; PG8_MMA(1, 0, At, B0); PG8_MMA(1, 1, At, B1); PG8_BAR; PG8_SCHED;
            } else {
            PG8_LDB(B0, 0, 0); PG8_SCHED; PG8_LDA(At, 0, 0); PG8_STAGE(PG8_SA(1, 1), a1 + hstepA, voffA);
            PG8_WAIT_L(8); PG8_BAR; PG8_WAIT_L(0); PG8_MMA(0, 0, At, B0); PG8_BAR; PG8_SCHED;
            PG8_LDB(B1, 0, 1); PG8_STAGE(PG8_SB(0, 0), b2, voffB);
            PG8_BAR; PG8_WAIT_L(0); PG8_MMA(0, 1, At, B1); PG8_BAR;
            PG8_LDA(At, 0, 1); PG8_STAGE(PG8_SA(0, 0), a2, voffA);
            PG8_BAR; PG8_WAIT_L(0); PG8_MMA(1, 0, At, B0); PG8_BAR; PG8_SCHED;
            PG8_STAGE(PG8_SB(0, 1), b2 + hstep, voffB);
            PG8_WAIT_V(6); PG8_BAR; PG8_MMA(1, 1, At, B1); PG8_BAR;
            PG8_LDB(B0, 1, 0); PG8_SCHED; PG8_LDA(At, 1, 0); PG8_STAGE(PG8_SA(0, 1), a2 + hstepA, voffA);
            PG8_WAIT_L(8); PG8_BAR; PG8_WAIT_L(0); PG8_MMA(0, 0, At, B0); PG8_BAR; PG8_SCHED;
            PG8_LDB(B1, 1, 1); PG8_STAGE(PG8_SB(1, 0), b3, voffB);
            PG8_BAR; PG8_WAIT_L(0); PG8_MMA(0, 1, At, B1); PG8_BAR;
            PG8_LDA(At, 1, 1); PG8_STAGE(PG8_SA(1, 0), a3, voffA);
            PG8_BAR; PG8_WAIT_L(0); PG8_MMA(1, 0, At, B0); PG8_BAR; PG8_SCHED;
            PG8_STAGE(PG8_SB(1, 1), b3 + hstep, voffB);
            PG8_WAIT_V(6); PG8_BAR; PG8_MMA(1, 1, At, B1); PG8_BAR;
            }
        }
        if constexpr (ALIGN_EPI) { if (wr == 0) PG8_BAR; }
        if constexpr (!Epi::AFTER_DRAIN) { E(acc, cur, wr, wc, fr, fq); S.done(cur); }
        if (!has_next) break;
#pragma unroll
        for (int a = 0; a < 2; ++a)
#pragma unroll
            for (int b = 0; b < 2; ++b)
#pragma unroll
                for (int m = 0; m < 4; ++m)
#pragma unroll
                    for (int n = 0; n < 2; ++n) acc[a][b][m][n] = (f32x4){0.f, 0.f, 0.f, 0.f};
        cur = nxt; cA = nA; cB = nB; ++ui;
        if constexpr (ALIGN_EPI) { if (wr == 1) PG8_BAR; }
    }
    PG8_WAIT_V(0);
    if constexpr (!ALIGN_EPI) { if (wr == 0) PG8_BAR; }
    PG8_BAR;
    if constexpr (Epi::AFTER_DRAIN) { E.fused(acc, cur, wr, wc, fr, fq, lds, wid, lane); S.done(cur); }
#undef PG8_SA
#undef PG8_SB
#undef PG8_STAGE
#undef PG8_LDA
#undef PG8_LDB
#undef PG8_MMA
#undef PG8_WAIT_V
#undef PG8_WAIT_L
#undef PG8_BAR
#undef PG8_SCHED
}
}
using pg8::bf16_t; using pg8::f32x4; using pg8::u32x4; using pg8::bf16x8; using pg8::Unit;
#define LAS __attribute__((address_space(3)))
typedef float f32x16 __attribute__((ext_vector_type(16)));
typedef unsigned u32x2 __attribute__((ext_vector_type(2)));
typedef short s16x4 __attribute__((ext_vector_type(4)));
constexpr int NB = 8, SEQ = 4096, CTXL = 256, DM = 1024, FF = 2816, DEPTH = 4, NH = 8;
constexpr int R_LAT = NB * SEQ, R_CTX = NB * CTXL, R = R_LAT + R_CTX;
constexpr float EPS = 1e-6f;
constexpr int NCH = 34;
constexpr size_t W_GUA = 0, W_DA = W_GUA + (size_t)5632 * 1024, W_GUB = W_DA + (size_t)1024 * 2816, W_DB = W_GUB + (size_t)5632 * 1024,
                 W_IN = W_DB + (size_t)1024 * 2816, W_UQ = W_IN + (size_t)3840 * 1024, W_UKV = W_UQ + (size_t)1536 * 256, W_OMLA = W_UKV + (size_t)2048 * 256,
                 W_GLU = W_OMLA + (size_t)1024 * 1024, W_OS5 = W_GLU + (size_t)1024 * 1024, W_OUT = W_OS5 + (size_t)1024 * 1024, W_END = W_OUT + (size_t)1024 * 1024;
constexpr size_t al256(size_t x) { return (x + 255) & ~(size_t)255; }
constexpr size_t WS_CTL = 0, CTL_BYTES = 16384;
constexpr size_t WS_MOD = WS_CTL + CTL_BYTES;
constexpr size_t WS_ROPE = WS_MOD + al256((size_t)4 * 9 * 9216 * 4);
constexpr size_t WS_YSS = WS_ROPE + al256(64 * 16 * 8);
constexpr size_t WS_CSS = WS_YSS + al256((size_t)R * 16 * 4);
constexpr size_t WS_S5E = WS_CSS + al256((size_t)R * 8 * 4);
constexpr size_t S5_WE_BYTES = (size_t)2 * 64 * 128 * 256 * 2, S5_WY_BYTES = (size_t)64 * 256 * 512 * 2;
constexpr size_t WS_XC = WS_S5E + al256(S5_WE_BYTES + S5_WY_BYTES);
constexpr size_t WS_WL = WS_XC + al256((size_t)R_CTX * DM * 4);
constexpr size_t WS_H = WS_WL + al256(W_END * 2);
constexpr size_t WS_BIG = WS_H + al256((size_t)R * DM * 2);
constexpr size_t B_CQ = 0, B_U = B_CQ + (size_t)R * 768 * 2, B_Q = B_U + (size_t)R * 1024 * 2, B_KV = B_Q + (size_t)R * 1536 * 2, B_SG = B_KV + (size_t)R * 2048 * 2, B_END = B_SG + (size_t)R * 2048 * 2;
constexpr size_t B_ACT = 0, B_Y = (size_t)R * FF * 2;
constexpr size_t B_T = B_U, B_G = B_KV, B_M = B_Q;
static_assert(B_Y >= B_M + (size_t)R * 1024 * 2 && B_Y + (size_t)R * 1024 * 2 <= B_SG, "Y overlay");
constexpr size_t WS_END = WS_BIG + B_END;
constexpr int LDS_BYTES = 272 * 528 + 8192 + 16 * 528 + 256;

__device__ __forceinline__ float bf2f(unsigned h) { return __uint_as_float(h << 16); }
__device__ __forceinline__ unsigned pk2(float lo, float hi) { return pg8::cvt_pk_bf16(lo, hi); }
__device__ __forceinline__ float sigm(float x) { return __builtin_amdgcn_rcpf(1.f + __builtin_amdgcn_exp2f(-1.4426950408889634f * x)); }
__device__ __forceinline__ float gelu_tanh(float x) { return x * sigm(1.5957691216057308f * (x + 0.044715f * x * x * x)); }
__device__ __forceinline__ void unpack8(const u32x4 w, float (&f)[8]) {
    f[0] = bf2f(w.x & 0xffffu); f[1] = __uint_as_float(w.x & 0xffff0000u); f[2] = bf2f(w.y & 0xffffu); f[3] = __uint_as_float(w.y & 0xffff0000u);
    f[4] = bf2f(w.z & 0xffffu); f[5] = __uint_as_float(w.z & 0xffff0000u); f[6] = bf2f(w.w & 0xffffu); f[7] = __uint_as_float(w.w & 0xffff0000u);
}
__device__ __forceinline__ u32x4 pack8(const float (&f)[8]) { u32x4 w; w.x = pk2(f[0], f[1]); w.y = pk2(f[2], f[3]); w.z = pk2(f[4], f[5]); w.w = pk2(f[6], f[7]); return w; }
__device__ __forceinline__ float wave_sum(float v) {
#pragma unroll
    for (int o = 1; o < 64; o <<= 1) v += __shfl_xor(v, o);
    return v;
}
__device__ __forceinline__ void rope8(float (&v)[8], int row, int wc, int fq, const float* tab) {
    const int t = row & 4095, pos = (wc & 1) ? (t & 63) : (t >> 6);
    const f32x4* tp = (const f32x4*)(tab + (pos * 16 + 8 * (fq & 1)) * 2);
    const f32x4 t0 = tp[0], t1 = tp[1], t2 = tp[2], t3 = tp[3];
    const float cs[8] = {t0[0], t0[2], t1[0], t1[2], t2[0], t2[2], t3[0], t3[2]}, sn[8] = {t0[1], t0[3], t1[1], t1[3], t2[1], t2[3], t3[1], t3[3]};
    const float sgn = (fq < 2) ? -1.f : 1.f;
#pragma unroll
    for (int j = 0; j < 8; ++j) { const float p = __shfl_xor(v[j], 32); v[j] = v[j] * cs[j] + sgn * p * sn[j]; }
}

struct Epi {
    static constexpr bool PERM = true, AFTER_DRAIN = false;
    int mode;
    bf16_t* o0; bf16_t* o1; bf16_t* o2; const bf16_t* i0; const bf16_t* i1; float* ss; const float* css; const float* bias; const float* rope;
    __device__ __forceinline__ void operator()(const f32x4 (&acc)[2][2][4][2], const Unit& u, int wr, int wc, int fr, int fq) const {
        const int row0 = u.pm * 256 + wr * 64 + fr, cb = wc * 32 + 8 * fq, pn = u.pn;
        if (mode == 0) {
            bf16_t* base = o0 + (size_t)pn * 128 + cb;
#pragma unroll
            for (int ai = 0; ai < 2; ++ai)
#pragma unroll
                for (int m = 0; m < 4; ++m) { const int row = row0 + ai * 128 + m * 16; float v[8];
#pragma unroll
                    for (int n = 0; n < 2; ++n)
#pragma unroll
                        for (int j = 0; j < 4; ++j) { const float g = acc[ai][0][m][n][j], up = acc[ai][1][m][n][j]; v[4 * n + j] = g * sigm(g) * up; }
                    *(u32x4*)(base + (size_t)row * FF) = pack8(v); }
        } else if (mode == 1) {
            bf16_t* base = o0 + pn * 256 + cb;
#pragma unroll
            for (int ai = 0; ai < 2; ++ai)
#pragma unroll
                for (int m = 0; m < 4; ++m) { const int row = row0 + ai * 128 + m * 16; float s = 0.f;
#pragma unroll
                    for (int bj = 0; bj < 2; ++bj) { float v[8];
#pragma unroll
                        for (int n = 0; n < 2; ++n)
#pragma unroll
                            for (int j = 0; j < 4; ++j) { const float x = acc[ai][bj][m][n][j]; v[4 * n + j] = x; s += x * x; }
                        *(u32x4*)(base + (size_t)row * 1024 + bj * 128) = pack8(v); }
                    s += __shfl_xor(s, 16); s += __shfl_xor(s, 32);
                    if (fq == 0) ss[row * 16 + pn * 4 + wc] = s; }
        } else if (mode == 2) {
            bf16_t* dst; int ldc;
            if (pn < 3) { dst = o0 + pn * 256; ldc = 768; } else if (pn < 7) { dst = o1 + (pn - 3) * 256; ldc = 1024; } else { dst = o2 + (pn - 7) * 256; ldc = 2048; }
            const bool sg = pn >= 7, docss = pn < 2, dorope = (pn == 2) && (u.pm < 128) && (wc < 2);
            dst += cb;
#pragma unroll
            for (int ai = 0; ai < 2; ++ai)
#pragma unroll
                for (int m = 0; m < 4; ++m) { const int row = row0 + ai * 128 + m * 16; float s = 0.f;
#pragma unroll
                    for (int bj = 0; bj < 2; ++bj) { float v[8];
#pragma unroll
                        for (int n = 0; n < 2; ++n)
#pragma unroll
                            for (int j = 0; j < 4; ++j) { float x = acc[ai][bj][m][n][j]; if (sg) x = sigm(x); v[4 * n + j] = x; s += x * x; }
                        if (bj == 0 && dorope) rope8(v, row, wc, fq, rope);
                        *(u32x4*)(dst + (size_t)row * ldc + bj * 128) = pack8(v); }
                    if (docss) { s += __shfl_xor(s, 16); s += __shfl_xor(s, 32); if (fq == 0) ss[row * 8 + pn * 4 + wc] = s; } }
        } else if (mode == 3 || mode == 4) {
            const int ldc = (mode == 3) ? 1536 : 2048; const float* cp = css + ((mode == 3) ? 0 : 4);
            const bool dorope = (mode == 3) && (pn >= 4) && (u.pm < 128);
            bf16_t* dst = o0 + pn * 256 + cb;
#pragma unroll
            for (int ai = 0; ai < 2; ++ai)
#pragma unroll
                for (int m = 0; m < 4; ++m) { const int row = row0 + ai * 128 + m * 16; const f32x4 c4 = *(const f32x4*)(cp + row * 8);
                    const float rs = 1.0f / sqrtf(((c4[0] + c4[1]) + (c4[2] + c4[3])) * (1.0f / 256.0f) + EPS);
#pragma unroll
                    for (int bj = 0; bj < 2; ++bj) { float v[8];
#pragma unroll
                        for (int n = 0; n < 2; ++n)
#pragma unroll
                            for (int j = 0; j < 4; ++j) v[4 * n + j] = acc[ai][bj][m][n][j] * rs;
                        if (dorope) rope8(v, row, wc, fq, rope);
                        *(u32x4*)(dst + (size_t)row * ldc + bj * 128) = pack8(v); } }
        } else {
            const int col = pn * 256 + cb;
#pragma unroll
            for (int ai = 0; ai < 2; ++ai)
#pragma unroll
                for (int m = 0; m < 4; ++m) { const int row = row0 + ai * 128 + m * 16;
#pragma unroll
                    for (int bj = 0; bj < 2; ++bj) { const int c = col + bj * 128; float v[8], a[8], b[8];
#pragma unroll
                        for (int n = 0; n < 2; ++n)
#pragma unroll
                            for (int j = 0; j < 4; ++j) v[4 * n + j] = acc[ai][bj][m][n][j];
                        if (mode == 5) { unpack8(*(const u32x4*)(i0 + (size_t)row * 1024 + c), a); const f32x4 b0 = *(const f32x4*)(bias + c), b1 = *(const f32x4*)(bias + c + 4);
#pragma unroll
                            for (int j = 0; j < 4; ++j) { v[j] = a[j] * sigm(v[j] + b0[j]); v[4 + j] = a[4 + j] * sigm(v[4 + j] + b1[j]); } }
                        else if (mode == 6) { unpack8(*(const u32x4*)(i0 + (size_t)row * 2048 + c), a);
#pragma unroll
                            for (int j = 0; j < 8; ++j) v[j] = a[j] * v[j]; }
                        else { unpack8(*(const u32x4*)(i0 + (size_t)row * 1024 + c), a); unpack8(*(const u32x4*)(i1 + (size_t)row * 2048 + c), b);
#pragma unroll
                            for (int j = 0; j < 8; ++j) v[j] = a[j] + b[j] * v[j]; }
                        *(u32x4*)(o0 + (size_t)row * 1024 + c) = pack8(v); } }
        }
    }
};
__device__ __forceinline__ void conv_item(const float* W, int ldsrc, int srccol, const float* kscale, bf16_t* WT, int K, int n0, int k0, LAS float* scr, int lane) {
    if (srccol >= 0) {
#pragma unroll 8
        for (int i = 0; i < 32; ++i) { const int kk = 2 * i + (lane >> 5); float w = W[(size_t)(k0 + kk) * ldsrc + srccol + (lane & 31)]; if (kscale) w *= kscale[k0 + kk]; scr[kk * 33 + (lane & 31)] = w; }
    } else {
#pragma unroll 8
        for (int i = 0; i < 32; ++i) { const int kk = 2 * i + (lane >> 5); scr[kk * 33 + (lane & 31)] = 0.f; }
    }
    asm volatile("s_waitcnt lgkmcnt(0)" ::: "memory");
    const int c = lane & 7;
#pragma unroll
    for (int j = 0; j < 4; ++j) { const int n = (lane >> 3) + 8 * j; const LAS float* s = scr + (8 * c) * 33 + n;
        u32x4 o; o.x = pk2(s[0 * 33], s[1 * 33]); o.y = pk2(s[2 * 33], s[3 * 33]); o.z = pk2(s[4 * 33], s[5 * 33]); o.w = pk2(s[6 * 33], s[7 * 33]);
        *(u32x4*)(WT + (size_t)(n0 + n) * K + k0 + 8 * c) = o; }
    asm volatile("s_waitcnt lgkmcnt(0)" ::: "memory");
}
struct WPtrs { const float *gate, *up, *down, *win, *qn, *wuq, *kvn, *wukv, *womla, *glu, *wos5, *wout; };
__device__ __forceinline__ void conv_layer(const WPtrs& P, int l, bf16_t* WL, LAS unsigned char* lds, int gw, int NGW, int wave, int lane, int it_lo, int it_hi) {
    LAS float* scr = (LAS float*)(lds + wave * 16384);
    constexpr int I_GU = 16 * 176, I_D = 44 * 32, I_IN = 16 * 120, I_UQ = 4 * 48, I_UKV = 4 * 64, I_SQ = 16 * 32;
    constexpr int NIT = 2 * I_GU + 2 * I_D + I_IN + I_UQ + I_UKV + 4 * I_SQ;
    static_assert(NIT == 12864, "conv items");
    for (int it = it_lo + gw; it < it_hi; it += NGW) {
        int r = it;
        if (r < 2 * I_GU) { const int f = r / I_GU; r -= f * I_GU; const int nb = r % 176, kb = r / 176, n0 = nb * 32, tile = n0 >> 8, within = n0 & 255, half = within >> 7, ffc = tile * 128 + (within & 127);
            const size_t so = (size_t)(l * 2 + f) * 1024 * FF; bf16_t* dst = WL + (f ? W_GUB : W_GUA);
            if (half) conv_item(P.up + so, FF, ffc, nullptr, dst, 1024, n0, kb * 64, scr, lane); else conv_item(P.gate + so, FF, ffc, nullptr, dst, 1024, n0, kb * 64, scr, lane);
            continue; }
        r -= 2 * I_GU;
        if (r < 2 * I_D) { const int f = r / I_D; r -= f * I_D; const int nb = r % 32, kb = r / 32;
            conv_item(P.down + (size_t)(l * 2 + f) * FF * 1024, 1024, nb * 32, nullptr, WL + (f ? W_DB : W_DA), FF, nb * 32, kb * 64, scr, lane); continue; }
        r -= 2 * I_D;
        if (r < I_IN) { const int nb = r % 120, kb = r / 120, n0 = nb * 32; int sc;
            if (n0 < 512) sc = n0; else if (n0 < 768) sc = (n0 < 576) ? n0 : -1; else sc = n0 - 768 + 576;
            conv_item(P.win + (size_t)l * 1024 * 3648, 3648, sc, nullptr, WL + W_IN, 1024, n0, kb * 64, scr, lane); continue; }
        r -= I_IN;
        if (r < I_UQ) { const int nb = r % 48, kb = r / 48, n0 = nb * 32; int sc;
            if (n0 < 1024) sc = (n0 >> 7) * 192 + (n0 & 127); else { const int rr = n0 - 1024; sc = (rr >> 6) * 192 + 128 + (rr & 63); }
            conv_item(P.wuq + (size_t)l * 256 * 1536, 1536, sc, P.qn + l * 256, WL + W_UQ, 256, n0, kb * 64, scr, lane); continue; }
        r -= I_UQ;
        if (r < I_UKV) { const int nb = r % 64, kb = r / 64;
            conv_item(P.wukv + (size_t)l * 256 * 2048, 2048, nb * 32, P.kvn + l * 256, WL + W_UKV, 256, nb * 32, kb * 64, scr, lane); continue; }
        r -= I_UKV;
        { const int q = r / I_SQ; r -= q * I_SQ; const int nb = r % 32, kb = r / 32; const size_t so = (size_t)l * 1024 * 1024;
          if (q == 0) conv_item(P.womla + so, 1024, nb * 32, nullptr, WL + W_OMLA, 1024, nb * 32, kb * 64, scr, lane);
          else if (q == 1) conv_item(P.glu + so, 1024, nb * 32, nullptr, WL + W_GLU, 1024, nb * 32, kb * 64, scr, lane);
          else if (q == 2) conv_item(P.wos5 + so, 1024, nb * 32, nullptr, WL + W_OS5, 1024, nb * 32, kb * 64, scr, lane);
          else conv_item(P.wout + so, 1024, nb * 32, nullptr, WL + W_OUT, 1024, nb * 32, kb * 64, scr, lane); }
    }
}

__device__ __forceinline__ void mods_phase(const float* c, const float* c_ctx, const float* ada_w, const float* ada_b, float* MOD, float* ROPE, LAS unsigned char* lds, const int tid) {

    LAS float* sc = (LAS float*)lds;
    LAS float* red = (LAS float*)(lds + 9 * 1024 * 4);
    if (blockIdx.x == gridDim.x - 1) {
        for (int e = tid; e < 1024; e += 512) { const int pos = e >> 4, i = e & 15; const float inv = exp2f(-(float)i * (13.287712379549449f / 16.0f)); const float ang = (float)pos * inv;
            float sn_, cs_; sincosf(ang, &sn_, &cs_); ROPE[2 * e] = cs_; ROPE[2 * e + 1] = sn_; }
    }
    bool have = false;
    for (int item = blockIdx.x; item < 576; item += gridDim.x) {
        if (!have) { for (int e = tid; e < 9 * 1024; e += 512) { const float v = (e < 8192) ? c[e] : c_ctx[e - 8192]; sc[e] = v * sigm(v); } have = true; }
        __syncthreads();
        const int l = item / 144, j0 = (item % 144) * 64, ks = tid >> 6, jj = tid & 63;
        const float* w = ada_w + ((size_t)l * 1024 + ks * 128) * 9216 + j0 + jj;
        float a[9];
#pragma unroll
        for (int s = 0; s < 9; ++s) a[s] = 0.f;
#pragma unroll 16
        for (int k = 0; k < 128; ++k) { const float wv = w[(size_t)k * 9216];
#pragma unroll
            for (int s = 0; s < 9; ++s) a[s] += sc[s * 1024 + ks * 128 + k] * wv; }
#pragma unroll
        for (int s = 0; s < 9; ++s) red[(ks * 9 + s) * 64 + jj] = a[s];
        __syncthreads();
        for (int e = tid; e < 576; e += 512) { const int s = e >> 6, j = e & 63; float t = 0.f;
#pragma unroll
            for (int q = 0; q < 8; ++q) t += red[(q * 9 + s) * 64 + j];
            MOD[((size_t)l * 9 + s) * 9216 + j0 + j] = t + ada_b[l * 9216 + j0 + j]; }
    }
    __syncthreads();
}

__device__ __forceinline__ void e_phase(const float* xin, const float* ctxin, float* xl, float* xc, const bf16_t* Y, const float* YSS, const float* MOD,
                                        const float* npre, const float* npost, bf16_t* H, int l, int s, int nl, int ns, int gw, int NGW, int lane, float wmul, int nrows) {
    for (int row = gw; row < nrows; row += NGW) {
        const bool lat = row < R_LAT; const int set = lat ? (row >> 12) : 8;
        float* xr = lat ? xl + (size_t)row * DM : xc + (size_t)(row - R_LAT) * DM;
        const float* xs = (s < 0) ? (lat ? xin + (size_t)row * DM : ctxin + (size_t)(row - R_LAT) * DM) : xr;
        f32x4 v[4];
#pragma unroll
        for (int j = 0; j < 4; ++j) v[j] = ((const f32x4*)xs)[lane + 64 * j];
        if (s >= 0) {
            const float part = (lane < 16) ? YSS[row * 16 + lane] : 0.f;
            const float rs = 1.0f / sqrtf(wave_sum(part) * (1.0f / 1024.0f) + EPS);
            const float wgt = ((s == 1) ? 1.0f : 0.5f) * wmul;
            const float* gate = MOD + ((size_t)(l * 9 + set) * 9 + 3 * s + 2) * 1024; const float* gp = npost + (l * 3 + s) * 1024;
#pragma unroll
            for (int j = 0; j < 4; ++j) { const u32x2 yw = ((const u32x2*)(Y + (size_t)row * DM))[lane + 64 * j];
                const f32x4 g4 = ((const f32x4*)gate)[lane + 64 * j], p4 = ((const f32x4*)gp)[lane + 64 * j];
                f32x4 y4; y4[0] = bf2f(yw.x & 0xffffu); y4[1] = __uint_as_float(yw.x & 0xffff0000u); y4[2] = bf2f(yw.y & 0xffffu); y4[3] = __uint_as_float(yw.y & 0xffff0000u);
                v[j] += (wgt * rs) * g4 * y4 * p4; }
        }
#pragma unroll
        for (int j = 0; j < 4; ++j) ((f32x4*)xr)[lane + 64 * j] = v[j];
        if (nl >= 0) {
            float q = 0.f;
#pragma unroll
            for (int j = 0; j < 4; ++j) q += (v[j][0] * v[j][0] + v[j][1] * v[j][1]) + (v[j][2] * v[j][2] + v[j][3] * v[j][3]);
            const float rs2 = 1.0f / sqrtf(wave_sum(q) * (1.0f / 1024.0f) + EPS);
            const float* mb = MOD + ((size_t)(nl * 9 + set) * 9 + 3 * ns) * 1024; const float* gp = npre + (nl * 3 + ns) * 1024;
#pragma unroll
            for (int j = 0; j < 4; ++j) { const f32x4 sh = ((const f32x4*)mb)[lane + 64 * j], sc = ((const f32x4*)(mb + 1024))[lane + 64 * j], p4 = ((const f32x4*)gp)[lane + 64 * j];
                const f32x4 h = v[j] * rs2 * p4 * (1.0f + sc) + sh;
                u32x2 o; o.x = pk2(h[0], h[1]); o.y = pk2(h[2], h[3]); ((u32x2*)(H + (size_t)row * DM))[lane + 64 * j] = o; }
        }
    }
}
struct S5In { const float *a_re, *a_im, *log_dt, *b_re, *b_im, *c_re, *c_im, *dsk; };
__device__ __forceinline__ void s5_abar(const S5In& P, int idx, int n, float& ar, float& ai, float& cr, float& ci) {
    const float are = P.a_re[idx * 64 + n], aim = P.a_im[idx * 64 + n];
    const float dt = expf(P.log_dt[idx]);
    const float mag = expf(dt * are); float sn, cs; sincosf(dt * aim, &sn, &cs);
    ar = mag * cs; ai = mag * sn;
    const float nr = ar - 1.f, ni = ai, den = 1.0f / (are * are + aim * aim);
    cr = (nr * are + ni * aim) * den; ci = (ni * are - nr * aim) * den;
}
__device__ __forceinline__ void s5_prep(const S5In& P, int l, int g, bf16_t* WEt, bf16_t* WYt, LAS unsigned char* lds, int tid) {
    LAS float* AP = (LAS float*)lds;
    LAS float* BB = AP + 2 * 17 * 64 * 2;
    LAS float* CC = BB + 2 * 64 * 16 * 2;
    LAS float* KL = CC + 2 * 16 * 64 * 2;
    if (tid < 128) { const int d = tid >> 6, n = tid & 63, idx = (l * 2 + d) * 64 + g; float ar, ai, cr, ci; s5_abar(P, idx, n, ar, ai, cr, ci);
        float pr = 1.f, pi = 0.f;
        for (int j = 0; j <= 16; ++j) { AP[((d * 17 + j) * 64 + n) * 2] = pr; AP[((d * 17 + j) * 64 + n) * 2 + 1] = pi; const float t0 = pr * ar - pi * ai, t1 = pr * ai + pi * ar; pr = t0; pi = t1; }
        for (int c = 0; c < 16; ++c) { const float br = P.b_re[(size_t)(idx * 64 + n) * 16 + c], bi = P.b_im[(size_t)(idx * 64 + n) * 16 + c];
            BB[((d * 64 + n) * 16 + c) * 2] = cr * br - ci * bi; BB[((d * 64 + n) * 16 + c) * 2 + 1] = cr * bi + ci * br; } }
    for (int e = tid; e < 2048; e += 512) { const int d = e >> 10, cn = e & 1023; const size_t src = (size_t)((l * 2 + d) * 64 + g) * 1024 + cn; CC[e * 2] = P.c_re[src]; CC[e * 2 + 1] = P.c_im[src]; }
    __syncthreads();
    { const int d = tid >> 8, c = (tid >> 4) & 15, cp = tid & 15; float acc[16];
#pragma unroll
      for (int j = 0; j < 16; ++j) acc[j] = 0.f;
      for (int n = 0; n < 64; ++n) { const float c_r = CC[((d * 16 + c) * 64 + n) * 2], c_i = CC[((d * 16 + c) * 64 + n) * 2 + 1], b_r = BB[((d * 64 + n) * 16 + cp) * 2], b_i = BB[((d * 64 + n) * 16 + cp) * 2 + 1];
          const float zr = c_r * b_r - c_i * b_i, zi = c_r * b_i + c_i * b_r;
#pragma unroll
          for (int j = 0; j < 16; ++j) acc[j] += zr * AP[((d * 17 + j) * 64 + n) * 2] - zi * AP[((d * 17 + j) * 64 + n) * 2 + 1]; }
#pragma unroll
      for (int j = 0; j < 16; ++j) KL[((d * 16 + j) * 16 + c) * 16 + cp] = acc[j]; }
    __syncthreads();
    for (int e = tid; e < 256 * 64; e += 512) { const int row = e >> 6, k8 = (e & 63) * 8, t = row >> 4, c = row & 15; float v[8];
        if (k8 < 256) { const int s = k8 >> 4, c0 = k8 & 15;
#pragma unroll
            for (int j = 0; j < 8; ++j) { const int cp = c0 + j; float val = 0.f;
                if (s <= t) val += KL[(((t - s)) * 16 + c) * 16 + cp];
                if (s >= t) val += KL[((16 + (s - t)) * 16 + c) * 16 + cp];
                if (s == t && cp == c) val += P.dsk[l * 1024 + g * 16 + c];
                v[j] = val; } }
        else { const int kk = k8 - 256, d = kk >> 7, im = (kk >> 6) & 1, n0 = kk & 63, jp = (d == 0) ? t + 1 : 16 - t;
#pragma unroll
            for (int j = 0; j < 8; ++j) { const int n = n0 + j; const float wr = AP[((d * 17 + jp) * 64 + n) * 2], wi = AP[((d * 17 + jp) * 64 + n) * 2 + 1], c_r = CC[((d * 16 + c) * 64 + n) * 2], c_i = CC[((d * 16 + c) * 64 + n) * 2 + 1];
                v[j] = im ? -(c_r * wi + c_i * wr) : (c_r * wr - c_i * wi); } }
        *(u32x4*)(WYt + ((size_t)g * 256 + row) * 512 + k8) = pack8(v); }
    for (int e = tid; e < 2 * 128 * 32; e += 512) { const int d = e >> 12, row = (e >> 5) & 127, k8 = (e & 31) * 8, im = row >> 6, n = row & 63, s = k8 >> 4, c0 = k8 & 15, ex = (d == 0) ? 15 - s : s; float v[8];
        const float wr = AP[((d * 17 + ex) * 64 + n) * 2], wi = AP[((d * 17 + ex) * 64 + n) * 2 + 1];
#pragma unroll
        for (int j = 0; j < 8; ++j) { const float b_r = BB[((d * 64 + n) * 16 + c0 + j) * 2], b_i = BB[((d * 64 + n) * 16 + c0 + j) * 2 + 1]; v[j] = im ? (wr * b_i + wi * b_r) : (wr * b_r - wi * b_i); }
        *(u32x4*)(WEt + ((size_t)(d * 64 + g) * 128 + row) * 256 + k8) = pack8(v); }
    __syncthreads();
}
__device__ __forceinline__ int s5_chunk_row(int b, int ch) { return ch < 16 ? R_LAT + b * 256 + 16 * ch : b * 4096 + 16 * (ch - 16); }
#define S5_BAR() do { asm volatile("s_waitcnt lgkmcnt(0)" ::: "memory"); __builtin_amdgcn_s_barrier(); asm volatile("" ::: "memory"); } while (0)
__device__ __forceinline__ void s5_main(const S5In& P, int l, const bf16_t* U, const bf16_t* WEt, const bf16_t* WYt, bf16_t* T, LAS unsigned char* lds, int tid) {
    const int lane = tid & 63, w = __builtin_amdgcn_readfirstlane(tid >> 6), fr = lane & 15, q = lane >> 4;
    constexpr int XP = 528;
    LAS unsigned char* XIN = lds; LAS float* ET = (LAS float*)(lds + 272 * XP); LAS unsigned char* UC = lds + 272 * XP + 8192;
    const int uc_chunk = tid >> 5, uc_piece = tid & 31;
    LAS u32x4* uc_dst = (LAS u32x4*)(UC + uc_chunk * XP + uc_piece * 16);
    const LAS unsigned char* uc_a = UC + fr * XP + 16 * q;
#define S5_GLOAD(tile) (*(const u32x4*)(U + (size_t)(s5_chunk_row(b, 16 * (tile) + uc_chunk) + (uc_piece >> 1)) * 1024 + g * 16 + 8 * (uc_piece & 1)))
    for (int item = blockIdx.x; item < 512; item += gridDim.x) {
        const int g = item & 63, b = item >> 6;
#pragma unroll 1
        for (int d = 0; d < 2; ++d) {
            bf16x8 bw[8];
            { const bf16_t* wp = WEt + ((size_t)(d * 64 + g) * 128 + 16 * w + fr) * 256 + 8 * q;
#pragma unroll
              for (int kk = 0; kk < 8; ++kk) bw[kk] = *(const bf16x8*)(wp + 32 * kk); }
            float tr = 1.f, ti = 0.f, xr = 0.f, xi = 0.f;
            if (w == 0) { float cr, ci; s5_abar(P, (l * 2 + d) * 64 + g, lane, tr, ti, cr, ci);
#pragma unroll
                for (int k = 0; k < 4; ++k) { const float n_r = tr * tr - ti * ti, n_i = 2.f * tr * ti; tr = n_r; ti = n_i; } }
#define S5_TILE(i) (((d == 0) || (i) == 0) ? (i) : 17 - (i))
            u32x4 u0 = S5_GLOAD(S5_TILE(0)), u1 = S5_GLOAD(S5_TILE(1)), u2 = S5_GLOAD(S5_TILE(2)), u3 = S5_GLOAD(S5_TILE(3)), u4 = S5_GLOAD(S5_TILE(4));
            *uc_dst = u0; u0 = u1; u1 = u2; u2 = u3; u3 = u4;
            S5_BAR();
#pragma unroll 1
            for (int i = 0; i < 17; ++i) {
                const int tile = S5_TILE(i);
                f32x4 acc = {0.f, 0.f, 0.f, 0.f};
#pragma unroll
                for (int kk = 0; kk < 8; ++kk) { const bf16x8 af = *(const LAS bf16x8*)(uc_a + 64 * kk); acc = __builtin_amdgcn_mfma_f32_16x16x32_bf16(af, bw[kk], acc, 0, 0, 0); }
#pragma unroll
                for (int r = 0; r < 4; ++r) ET[(4 * q + r) * 128 + 16 * w + fr] = acc[r];
                S5_BAR();
                if (i < 16) { *uc_dst = u0; u0 = u1; u1 = u2; u2 = u3; if (i + 5 <= 16) u3 = S5_GLOAD(S5_TILE(i + 5)); }
                if (w == 0) {
                    float er[16], ei[16];
#pragma unroll
                    for (int c = 0; c < 16; ++c) { er[c] = ET[c * 128 + lane]; ei[c] = ET[c * 128 + 64 + lane]; }
#pragma unroll
                    for (int cc = 0; cc < 16; ++cc) { const int c = d ? 15 - cc : cc;
                        LAS bf16_t* xp = (LAS bf16_t*)(XIN + (16 * tile + c) * XP) + d * 128;
                        xp[lane] = (bf16_t)(pk2(xr, 0.f) & 0xffffu); xp[64 + lane] = (bf16_t)(pk2(xi, 0.f) & 0xffffu);
                        const float nxr = tr * xr - ti * xi + er[c], nxi = tr * xi + ti * xr + ei[c]; xr = nxr; xi = nxi; }
                }
                S5_BAR();
            }
#undef S5_TILE
        }
        {
            bf16x8 by[2][16];
#pragma unroll
            for (int nt = 0; nt < 2; ++nt) { const bf16_t* wp = WYt + ((size_t)g * 256 + 32 * w + 16 * nt + fr) * 512 + 8 * q;
#pragma unroll
                for (int kk = 0; kk < 16; ++kk) by[nt][kk] = *(const bf16x8*)(wp + 32 * kk); }
            u32x4 u0 = S5_GLOAD(0), u1 = S5_GLOAD(1), u2 = S5_GLOAD(2), u3 = S5_GLOAD(3), u4 = S5_GLOAD(4);
            *uc_dst = u0; u0 = u1; u1 = u2; u2 = u3; u3 = u4;
            S5_BAR();
#pragma unroll 1
            for (int tile = 0; tile < 17; ++tile) {
                f32x4 acc0 = {0.f, 0.f, 0.f, 0.f}, acc1 = {0.f, 0.f, 0.f, 0.f};
#pragma unroll
                for (int kk = 0; kk < 8; ++kk) { const bf16x8 af = *(const LAS bf16x8*)(uc_a + 64 * kk);
                    acc0 = __builtin_amdgcn_mfma_f32_16x16x32_bf16(af, by[0][kk], acc0, 0, 0, 0); acc1 = __builtin_amdgcn_mfma_f32_16x16x32_bf16(af, by[1][kk], acc1, 0, 0, 0); }
                const LAS unsigned char* xq = XIN + (16 * tile + fr) * XP + 16 * q;
#pragma unroll
                for (int kk = 0; kk < 8; ++kk) { const bf16x8 xf = *(const LAS bf16x8*)(xq + 64 * kk);
                    acc0 = __builtin_amdgcn_mfma_f32_16x16x32_bf16(xf, by[0][8 + kk], acc0, 0, 0, 0); acc1 = __builtin_amdgcn_mfma_f32_16x16x32_bf16(xf, by[1][8 + kk], acc1, 0, 0, 0); }
                S5_BAR();
                if (tile < 16) { *uc_dst = u0; u0 = u1; u1 = u2; u2 = u3; if (tile + 5 <= 16) u3 = S5_GLOAD(tile + 5); }
#pragma unroll
                for (int r = 0; r < 4; ++r) { const int row = s5_chunk_row(b, 16 * tile + 4 * q + r) + 2 * w;
                    T[(size_t)row * 1024 + g * 16 + fr] = (bf16_t)(pk2(gelu_tanh(acc0[r]), 0.f) & 0xffffu);
                    T[(size_t)(row + 1) * 1024 + g * 16 + fr] = (bf16_t)(pk2(gelu_tanh(acc1[r]), 0.f) & 0xffffu); }
                S5_BAR();
            }
        }
    }
#undef S5_GLOAD
#undef S5_BAR
}
__device__ __forceinline__ s16x4 vtr(const LAS unsigned char* p) { return __builtin_bit_cast(s16x4, __builtin_amdgcn_ds_read_tr16_b64_v4i16((LAS s16x4*)p)); }
__device__ __forceinline__ void attn_phase(LAS unsigned char* lds, const bf16_t* Q, const bf16_t* KV, const bf16_t* CQ, bf16_t* O, const int tid, const int nunits) {
    const int lane = tid & 63, wid = __builtin_amdgcn_readfirstlane(tid >> 6), r32 = lane & 31, hi = lane >> 5;
    constexpr int KP = 400, VP = 320, BUFB = 64 * KP + 64 * VP;
    const float C = 0.07216878364870322f * 1.4426950408889634f;
    const int kn_row = tid >> 4, kn_ch = tid & 15, kr_row = tid >> 3, kr_ch = tid & 7;
    for (int ui = 0;; ++ui) {
        const int unit = ui * (int)gridDim.x + (int)blockIdx.x; if (unit >= nunits) break;
        int b, h, qb;
        if (unit < 1024) { const int bh = unit >> 4; qb = unit & 15; b = bh >> 3; h = bh & 7; } else { const int bh = unit - 1024; qb = 16; b = bh >> 3; h = bh & 7; }
        const int qrow0 = (qb < 16) ? b * 4096 + qb * 256 : R_LAT + b * 256;
        const int NT = (qb < 16) ? 68 : 4;
        const bf16_t* qp = Q + (size_t)(qrow0 + wid * 32 + r32) * 1536;
        bf16x8 qf[12];
#pragma unroll
        for (int s = 0; s < 8; ++s) qf[s] = *(const bf16x8*)(qp + h * 128 + 16 * s + 8 * hi);
#pragma unroll
        for (int s = 0; s < 4; ++s) qf[8 + s] = *(const bf16x8*)(qp + 1024 + h * 64 + 16 * s + 8 * hi);
        u32x4 sk0, sk1, skr, sv0, sv1;
#define ATT_KROW(t) ((qb < 16) ? (((t) < 64) ? b * 4096 + (t) * 64 : R_LAT + b * 256 + ((t) - 64) * 64) : R_LAT + b * 256 + (t) * 64)
#define ATT_LOAD(t) do { const int kr0_ = ATT_KROW(t); const bf16_t* kvp_ = KV + (size_t)(kr0_ + kn_row) * 2048 + h * 256 + kn_ch * 8; \
        sk0 = *(const u32x4*)kvp_; sk1 = *(const u32x4*)(kvp_ + 32 * 2048); sv0 = *(const u32x4*)(kvp_ + 128); sv1 = *(const u32x4*)(kvp_ + 128 + 32 * 2048); \
        skr = *(const u32x4*)(CQ + (size_t)(kr0_ + kr_row) * 768 + 512 + kr_ch * 8); } while (0)
#define ATT_STORE(buf) do { LAS unsigned char* kb_ = lds + (buf) * BUFB; LAS unsigned char* vb_ = kb_ + 64 * KP; \
        *(LAS u32x4*)(kb_ + kn_row * KP + kn_ch * 16) = sk0; *(LAS u32x4*)(kb_ + (kn_row + 32) * KP + kn_ch * 16) = sk1; *(LAS u32x4*)(kb_ + kr_row * KP + 256 + kr_ch * 16) = skr; \
        *(LAS u32x4*)(vb_ + kn_row * VP + kn_ch * 16) = sv0; *(LAS u32x4*)(vb_ + (kn_row + 32) * VP + kn_ch * 16) = sv1; } while (0)
        ATT_LOAD(0); ATT_STORE(0);
        __syncthreads();
        float mrun = -1e30f, lrun = 0.f;
        f32x16 o[4];
#pragma unroll
        for (int d = 0; d < 4; ++d)
#pragma unroll
            for (int r = 0; r < 16; ++r) o[d][r] = 0.f;
        for (int t = 0; t < NT; ++t) {
            const int cur = t & 1;
            if (t + 1 < NT) ATT_LOAD(t + 1);
            f32x16 p0, p1;
#pragma unroll
            for (int r = 0; r < 16; ++r) { p0[r] = 0.f; p1[r] = 0.f; }
            __builtin_amdgcn_s_setprio(1);
            { const LAS unsigned char* kb = lds + cur * BUFB + r32 * KP + hi * 16;
#pragma unroll
              for (int s = 0; s < 12; ++s) { const bf16x8 k0 = *(const LAS bf16x8*)(kb + s * 32), k1 = *(const LAS bf16x8*)(kb + 32 * KP + s * 32);
                  p0 = __builtin_amdgcn_mfma_f32_32x32x16_bf16(k0, qf[s], p0, 0, 0, 0); p1 = __builtin_amdgcn_mfma_f32_32x32x16_bf16(k1, qf[s], p1, 0, 0, 0); } }
            __builtin_amdgcn_s_setprio(0);
            float mx = p0[0];
#pragma unroll
            for (int r = 0; r < 16; ++r) { mx = fmaxf(mx, p0[r]); mx = fmaxf(mx, p1[r]); }
            mx = fmaxf(mx, __shfl_xor(mx, 32)) * C;
            if (__any(mx > mrun + 8.0f)) {
                const float mn = fmaxf(mrun, mx), alpha = __builtin_amdgcn_exp2f(mrun - mn); mrun = mn; lrun *= alpha;
#pragma unroll
                for (int d = 0; d < 4; ++d)
#pragma unroll
                    for (int r = 0; r < 16; ++r) o[d][r] *= alpha;
            }
            float rsum = 0.f;
#pragma unroll
            for (int r = 0; r < 16; ++r) { p0[r] = __builtin_amdgcn_exp2f(p0[r] * C - mrun); p1[r] = __builtin_amdgcn_exp2f(p1[r] * C - mrun); rsum += p0[r] + p1[r]; }
            lrun += rsum;
            bf16x8 pf[4];
            { u32x4 w;
              w.x = pk2(p0[0], p0[1]); w.y = pk2(p0[2], p0[3]); w.z = pk2(p0[4], p0[5]); w.w = pk2(p0[6], p0[7]); pf[0] = __builtin_bit_cast(bf16x8, w);
              w.x = pk2(p0[8], p0[9]); w.y = pk2(p0[10], p0[11]); w.z = pk2(p0[12], p0[13]); w.w = pk2(p0[14], p0[15]); pf[1] = __builtin_bit_cast(bf16x8, w);
              w.x = pk2(p1[0], p1[1]); w.y = pk2(p1[2], p1[3]); w.z = pk2(p1[4], p1[5]); w.w = pk2(p1[6], p1[7]); pf[2] = __builtin_bit_cast(bf16x8, w);
              w.x = pk2(p1[8], p1[9]); w.y = pk2(p1[10], p1[11]); w.z = pk2(p1[12], p1[13]); w.w = pk2(p1[14], p1[15]); pf[3] = __builtin_bit_cast(bf16x8, w); }
            __builtin_amdgcn_s_setprio(1);
            { const LAS unsigned char* vb = lds + cur * BUFB + 64 * KP + (4 * hi + ((lane & 15) >> 2)) * VP + (16 * ((lane >> 4) & 1) + 4 * (lane & 3)) * 2;
#pragma unroll
              for (int d = 0; d < 4; ++d)
#pragma unroll
                  for (int s = 0; s < 4; ++s) { const s16x4 lo = vtr(vb + s * 16 * VP + d * 64), hh = vtr(vb + s * 16 * VP + 8 * VP + d * 64);
                      const bf16x8 vf = (bf16x8){lo[0], lo[1], lo[2], lo[3], hh[0], hh[1], hh[2], hh[3]};
                      o[d] = __builtin_amdgcn_mfma_f32_32x32x16_bf16(vf, pf[s], o[d], 0, 0, 0); } }
            __builtin_amdgcn_s_setprio(0);
            if (t + 1 < NT) ATT_STORE(cur ^ 1);
            __syncthreads();
        }
        const float inv = 1.0f / (lrun + __shfl_xor(lrun, 32));
        bf16_t* op = O + (size_t)(qrow0 + wid * 32 + r32) * 1024 + h * 128;
#pragma unroll
        for (int d = 0; d < 4; ++d)
#pragma unroll
            for (int i4 = 0; i4 < 4; ++i4) { u32x2 w; w.x = pk2(o[d][4 * i4] * inv, o[d][4 * i4 + 1] * inv); w.y = pk2(o[d][4 * i4 + 2] * inv, o[d][4 * i4 + 3] * inv);
                *(u32x2*)(op + 32 * d + 8 * i4 + 4 * hi) = w; }
    }
#undef ATT_KROW
#undef ATT_LOAD
#undef ATT_STORE
}
#define XB_TMO      128
#define XB_XCNT(j)  (256  + 64 * (j))
#define XB_XSUB(j)  (1280 + 64 * (j))
#define XB_XGEN(j)  (2304 + 64 * (j))
#define XB_TOP      3328
#define XB_TOPGEN   3392
#define XCD_BAR_WORDS 3456
#define XB_SPIN_CAP (1u << 18)

__device__ __forceinline__ unsigned xb_ld(unsigned* p)              { return __hip_atomic_load(p, __ATOMIC_RELAXED, __HIP_MEMORY_SCOPE_AGENT); }
__device__ __forceinline__ unsigned xb_add(unsigned* p, unsigned v) { return __hip_atomic_fetch_add(p, v, __ATOMIC_RELAXED, __HIP_MEMORY_SCOPE_AGENT); }
__device__ __forceinline__ unsigned xb_xcc_id() { return (unsigned)__builtin_amdgcn_s_getreg((3 << 11) | 20) & 0xFu; }
#define XB_SPIN(cond, bar) do { unsigned _sp = 0; while (cond) { __builtin_amdgcn_s_sleep(1); \
    if ((++_sp & 255u) == 0u) { if (xb_ld(&(bar)[XB_TMO])) break; if (_sp > XB_SPIN_CAP) { atomicAdd(&(bar)[XB_TMO], 1u); break; } } } } while (0)

struct XcdBarrier {
    unsigned* bar; unsigned x;
    volatile LAS unsigned* st;
};

__device__ __forceinline__ XcdBarrier xcd_barrier_post(unsigned* bar, volatile LAS unsigned* st) {
    XcdBarrier b; b.bar = bar; b.x = xb_xcc_id(); b.st = st;
    if (threadIdx.x == 0) (void)xb_add(&bar[XB_XCNT(b.x)], 1u);
    return b;
}
__device__ __forceinline__ void xcd_barrier_complete(unsigned* bar, unsigned x, unsigned& nloc, unsigned& nx) {
    const unsigned G = gridDim.x * gridDim.y * gridDim.z;
    unsigned sum, cnt, mine, sp = 0u;
    for (;;) {
        sum = 0u; cnt = 0u; mine = 0u;
#pragma unroll
        for (unsigned j = 0; j < 16; ++j) { const unsigned c = xb_ld(&bar[XB_XCNT(j)]); sum += c; cnt += (c > 0u) ? 1u : 0u; mine = (j == x) ? c : mine; }
        if (sum == G) break;
        __builtin_amdgcn_s_sleep(1);
        if ((++sp & 255u) == 0u) { if (xb_ld(&bar[XB_TMO])) break; if (sp > XB_SPIN_CAP) { atomicAdd(&bar[XB_TMO], 1u); break; } }
    }
    nloc = mine > 0u ? mine : 1u; nx = cnt > 0u ? cnt : 1u;
}

__device__ __forceinline__ void xcd_barrier(const XcdBarrier& b) {
    asm volatile("s_waitcnt vmcnt(0)" ::: "memory");
    __syncthreads();
    if (threadIdx.x == 0) {
        unsigned* bar = b.bar;
        __builtin_amdgcn_s_waitcnt(0);
        unsigned nloc = b.st[0], nx = b.st[1];
        if (nloc == 0u) { xcd_barrier_complete(bar, b.x, nloc, nx); b.st[0] = nloc; b.st[1] = nx; }
        const unsigned old = xb_add(&bar[XB_XSUB(b.x)], 1u);
        const unsigned gen = old / nloc;
        if (old + 1u == (gen + 1u) * nloc) {
            __builtin_amdgcn_fence(__ATOMIC_RELEASE, "agent");
            asm volatile("s_waitcnt vmcnt(0)" ::: "memory");
            const unsigned og = xb_add(&bar[XB_TOP], 1u);
            const unsigned tg = og / nx;
            if (og + 1u == (tg + 1u) * nx) xb_add(&bar[XB_TOPGEN], 1u);
            else XB_SPIN(xb_ld(&bar[XB_TOPGEN]) == tg, bar);
            __builtin_amdgcn_fence(__ATOMIC_ACQUIRE, "agent");
            xb_add(&bar[XB_XGEN(b.x)], 1u);
            asm volatile("s_waitcnt vmcnt(0)" ::: "memory");
        } else {
            XB_SPIN(xb_ld(&bar[XB_XGEN(b.x)]) == gen, bar);
            __builtin_amdgcn_fence(__ATOMIC_ACQUIRE, "agent");
            asm volatile("s_waitcnt vmcnt(0)" ::: "memory");
        }
    }
    __syncthreads();
}

#define DERIVE_PTRS float* MOD = (float*)(ws + WS_MOD); float* ROPE = (float*)(ws + WS_ROPE); float* YSS = (float*)(ws + WS_YSS); float* CSS = (float*)(ws + WS_CSS); bf16_t* WEt = (bf16_t*)(ws + WS_S5E); bf16_t* WYt = (bf16_t*)(ws + WS_S5E + S5_WE_BYTES); float* XC = (float*)(ws + WS_XC); bf16_t* WL = (bf16_t*)(ws + WS_WL); bf16_t* H = (bf16_t*)(ws + WS_H); unsigned char* big = ws + WS_BIG; bf16_t* CQ = (bf16_t*)(big + B_CQ); bf16_t* U = (bf16_t*)(big + B_U); bf16_t* Qb = (bf16_t*)(big + B_Q); bf16_t* KVb = (bf16_t*)(big + B_KV); bf16_t* SG = (bf16_t*)(big + B_SG); bf16_t* ACT = (bf16_t*)(big + B_ACT); bf16_t* Y = (bf16_t*)(big + B_Y); bf16_t* T = (bf16_t*)(big + B_T); bf16_t* Gb = (bf16_t*)(big + B_G); bf16_t* Mb = (bf16_t*)(big + B_M); bf16_t* Ob = H;
constexpr int PPL = 13;
constexpr int NSTEPS = 2 + PPL * DEPTH;
struct Args { const float* in[29]; float* out; unsigned char* ws; int ph_lo, ph_hi; };
__global__ void __launch_bounds__(512, 2) mk_fwd(Args a) {
    extern __shared__ __attribute__((aligned(16))) unsigned char lds_raw[];
    cg::grid_group grid = cg::this_grid();
    LAS unsigned char* lds = (LAS unsigned char*)lds_raw;
    const int G = gridDim.x, NGW = G * 8;
    volatile LAS unsigned* xst = (volatile LAS unsigned*)(lds + LDS_BYTES - 64);
    if (threadIdx.x < 2) xst[threadIdx.x] = 0u;
    __syncthreads();
    XcdBarrier xbar; xbar.bar = (unsigned*)(a.ws + WS_CTL); xbar.x = 0; xbar.st = xst;
    if (a.ph_hi - a.ph_lo > 1) xbar = xcd_barrier_post((unsigned*)(a.ws + WS_CTL), xst);
    WPtrs WP{a.in[8], a.in[9], a.in[10], a.in[11], a.in[12], a.in[13], a.in[14], a.in[15], a.in[16], a.in[25], a.in[27], a.in[28]};
    S5In SP{a.in[17], a.in[18], a.in[19], a.in[20], a.in[21], a.in[22], a.in[23], a.in[24]};
#if MK_TIME >= 0
    unsigned long long tacc = 0ull;
#endif
#pragma unroll 1
    for (int step = a.ph_lo; step < a.ph_hi; ++step) {
#if MK_TIME >= 0
        const unsigned long long tph0 = __builtin_amdgcn_s_memrealtime();
#endif
        int tid = threadIdx.x; asm volatile("" : "+v"(tid));
        const int lane = tid & 63, wave = __builtin_amdgcn_readfirstlane(tid >> 6), gw = blockIdx.x * 8 + wave;
        unsigned char* ws = a.ws; asm volatile("" : "+s"(ws));
        DERIVE_PTRS
        int l = 0, p = -1;
        if (step >= 2) { l = (step - 2) / PPL; p = (step - 2) % PPL; if (p >= 6) ++p; }
        if (step == 0) mods_phase(a.in[1], a.in[3], a.in[4], a.in[5], MOD, ROPE, lds, tid);
        if (step == 0) conv_layer(WP, 0, WL, lds, gw, NGW, wave, lane, 0, 12864);
#if MK_PROBE == 9
        if (step == 0) { __syncthreads(); mods_phase(a.in[1], a.in[3], a.in[4], a.in[5], MOD, ROPE, lds, tid); conv_layer(WP, 0, WL, lds, gw, NGW, wave, lane, 0, 12864); }
#endif
        if (p == 13 && l < DEPTH - 1) conv_layer(WP, l + 1, WL, lds, gw, NGW, wave, lane, 7040, 8448);
        if (step == 1 || p == 2 || p == 10 || p == 13) {
            int s, nl, ns;
            if (step == 1) { s = -1; nl = 0; ns = 0; } else if (p == 2) { s = 0; nl = l; ns = 1; } else if (p == 10) { s = 1; nl = l; ns = 2; } else { s = 2; nl = (l < DEPTH - 1) ? l + 1 : -1; ns = 0; }
            e_phase(a.in[0], a.in[2], a.out, XC, Y, YSS, MOD, a.in[6], a.in[7], H, l, s, nl, ns, gw, NGW, lane, 1.0f, (l == DEPTH - 1 && p >= 10) ? R_LAT : R);
#if MK_PROBE == 5
            if (s >= 0) { __syncthreads(); e_phase(a.in[0], a.in[2], a.out, XC, Y, YSS, MOD, a.in[6], a.in[7], H, l, s, nl, ns, gw, NGW, lane, 0.0f, R); }
#endif
        }
        if (p == 0 || p == 1 || p == 3 || p == 4 || p == 7 || p == 8 || p == 9 || p == 11 || p == 12) {
            const int ng = (p == 4 || p == 7) ? 2 : 1;
#pragma unroll 1
            for (int gi = 0; gi < ng; ++gi) {
                pg8::Gemm g; Epi E; E.o0 = nullptr; E.o1 = nullptr; E.o2 = nullptr; E.i0 = nullptr; E.i1 = nullptr; E.ss = nullptr; E.css = CSS; E.bias = nullptr; E.rope = ROPE; E.mode = 0;
                g.M = R;
                if (p == 0 || p == 11) { g.A = H; g.Bt = WL + (p == 0 ? W_GUA : W_GUB); g.N = 5632; g.K = 1024; g.lda = 1024; E.mode = 0; E.o0 = ACT; }
                else if (p == 1 || p == 12) { g.A = ACT; g.Bt = WL + (p == 1 ? W_DA : W_DB); g.N = 1024; g.K = FF; g.lda = FF; E.mode = 1; E.o0 = Y; E.ss = YSS; }
                else if (p == 3) { g.A = H; g.Bt = WL + W_IN; g.N = 3840; g.K = 1024; g.lda = 1024; E.mode = 2; E.o0 = CQ; E.o1 = U; E.o2 = SG; E.ss = CSS; }
                else if (p == 4 && gi == 0) { g.A = CQ; g.Bt = WL + W_UQ; g.N = 1536; g.K = 256; g.lda = 768; E.mode = 3; E.o0 = Qb; }
                else if (p == 4) { g.A = CQ + 256; g.Bt = WL + W_UKV; g.N = 2048; g.K = 256; g.lda = 768; E.mode = 4; E.o0 = KVb; }
                else if (p == 7 && gi == 0) { g.A = T; g.Bt = WL + W_GLU; g.N = 1024; g.K = 1024; g.lda = 1024; E.mode = 5; E.o0 = Gb; E.i0 = T; E.bias = a.in[26] + l * 1024; }
                else if (p == 7) { g.A = Ob; g.Bt = WL + W_OMLA; g.N = 1024; g.K = 1024; g.lda = 1024; E.mode = 6; E.o0 = Mb; E.i0 = SG; }
                else if (p == 8) { g.A = Gb; g.Bt = WL + W_OS5; g.N = 1024; g.K = 1024; g.lda = 1024; E.mode = 7; E.o0 = Mb; E.i0 = Mb; E.i1 = SG + 1024; }
                else { g.A = Mb; g.Bt = WL + W_OUT; g.N = 1024; g.K = 1024; g.lda = 1024; E.mode = 1; E.o0 = Y; E.ss = YSS; }
                const int Mrows = (l == DEPTH - 1 && (p >= 7 || (p == 4 && gi == 0))) ? R_LAT : R;
                pg8::StaticOrder S; S.init(Mrows, g.N, G, (gi == 0) ? (int)blockIdx.x : (int)((blockIdx.x + (G >> 1)) % G));
                pg8::gemm_phase<Epi, pg8::StaticOrder, true, true>(lds, g, S, E, tid);
#if MK_PROBE == 3 || MK_PROBE == 6 || MK_PROBE == 7 || MK_PROBE == 8 || MK_PROBE == 10
                if ((MK_PROBE == 3 && (p == 0 || p == 11)) || (MK_PROBE == 6 && p == 9) || (MK_PROBE == 7 && (p == 1 || p == 12)) || (MK_PROBE == 8 && p == 4) || (MK_PROBE == 10 && p == 3)) { __syncthreads(); pg8::gemm_phase<Epi, pg8::StaticOrder, true, true>(lds, g, S, E, tid); }
#endif
            }
        }
        if (p == 4) {
#pragma unroll 1
            for (int rep = 0; rep < (MK_PROBE == 2 ? 2 : 1); ++rep) s5_main(SP, l, U, WEt, WYt, T, lds, tid); }
        if (G == 256) {
            const int bx = blockIdx.x;
            if (p == 1 && bx >= 32 && bx < 96) s5_prep(SP, l, bx - 32, WEt, WYt, lds, tid);
            if (l < DEPTH - 1 && bx >= 32) {
                const int vgw = (bx - 32) * 8 + wave, VNGW = 224 * 8;
                if (p == 7 && (bx < 128 || bx >= 160)) { const int v7 = ((bx < 128) ? bx - 32 : bx - 64) * 8 + wave;
                    conv_layer(WP, l + 1, WL, lds, v7, 192 * 8, wave, lane, 0, 2816); conv_layer(WP, l + 1, WL, lds, v7, 192 * 8, wave, lane, 5632, 7040); }
                if (p == 8) { conv_layer(WP, l + 1, WL, lds, vgw, VNGW, wave, lane, 8448, 11840); }
                if (p == 9) { conv_layer(WP, l + 1, WL, lds, vgw, VNGW, wave, lane, 11840, 12352); }
                if (p == 12) { conv_layer(WP, l + 1, WL, lds, vgw, VNGW, wave, lane, 12352, 12864); conv_layer(WP, l + 1, WL, lds, vgw, VNGW, wave, lane, 2816, 5632); }
            }
        }
        if (G != 256) {
            if (p == 2 && blockIdx.x < 64) s5_prep(SP, l, blockIdx.x, WEt, WYt, lds, tid);
            if (p == 13 && l < DEPTH - 1) { conv_layer(WP, l + 1, WL, lds, gw, NGW, wave, lane, 0, 7040); conv_layer(WP, l + 1, WL, lds, gw, NGW, wave, lane, 8448, 12864); }
        }
        if (p == 5) {
#pragma unroll 1
            for (int rep = 0; rep < (MK_PROBE == 1 ? 2 : 1); ++rep) attn_phase(lds, Qb, KVb, CQ, Ob, tid, (l == DEPTH - 1) ? 1024 : 1024 + 64); }
#if MK_TIME >= 0
        const unsigned long long tb0 = __builtin_amdgcn_s_memrealtime();
#endif
        if (step + 1 < a.ph_hi) {
            if (step == a.ph_lo) grid.sync(); else xcd_barrier(xbar);
#if MK_PROBE == 4
            xcd_barrier(xbar); xcd_barrier(xbar);
#endif
        }
#if MK_TIME >= 0
        { const unsigned long long tb1 = __builtin_amdgcn_s_memrealtime();
          const int cls = (step == 0) ? 10 : (step == 1 || p == 2 || p == 10 || p == 13) ? 2 : (p == 0 || p == 11) ? 0 : (p == 1 || p == 12) ? 1 : (p == 3) ? 3 : (p == 4) ? 4 : (p == 5) ? 5 : (p == 7) ? 6 : (p == 8) ? 7 : 8;
          if (MK_TIME == 99) tacc += tb1 - tb0; else if (cls == MK_TIME) tacc += tb1 - tph0; }
#endif
    }
#if MK_TIME >= 0
    if (blockIdx.x == MK_TIME_BLOCK) { const unsigned long long te = __builtin_amdgcn_s_memrealtime(); while (__builtin_amdgcn_s_memrealtime() - te < tacc) __builtin_amdgcn_s_sleep(16); }
#endif
}

extern "C" void kernel_launch(void* const* d_in, const int* in_sizes, int n_in, void* d_out, int out_size, void* d_ws, size_t ws_size, hipStream_t stream) {
    static int grid = 0;
    if (grid == 0) {
        if (n_in != 29 || out_size != R_LAT * DM || ws_size < WS_END) { fprintf(stderr, "kernel_launch: unexpected problem (n_in %d out %d ws %zu need %zu)\n", n_in, out_size, ws_size, (size_t)WS_END); grid = -1; return; }
        int dev = 0, cus = 0, per_cu = 0;
        if (hipGetDevice(&dev) != hipSuccess || hipDeviceGetAttribute(&cus, hipDeviceAttributeMultiprocessorCount, dev) != hipSuccess) { grid = -1; return; }
        if (hipFuncSetAttribute((const void*)mk_fwd, hipFuncAttributeMaxDynamicSharedMemorySize, LDS_BYTES) != hipSuccess) { fprintf(stderr, "kernel_launch: hipFuncSetAttribute failed\n"); grid = -1; return; }
        if (hipOccupancyMaxActiveBlocksPerMultiprocessor(&per_cu, (const void*)mk_fwd, 512, LDS_BYTES) != hipSuccess || per_cu < 1) { fprintf(stderr, "kernel_launch: occupancy query says %d\n", per_cu); per_cu = 1; }
        (void)hipGetLastError();
        grid = cus * 1;
    }
    if (grid < 0) return;
    if (hipMemsetAsync((char*)d_ws + WS_CTL, 0, CTL_BYTES, stream) != hipSuccess) { fprintf(stderr, "kernel_launch: memset failed\n"); return; }
    Args a{};
    for (int i = 0; i < 29; ++i) a.in[i] = (const float*)d_in[i];
    a.out = (float*)d_out; a.ws = (unsigned char*)d_ws;
#if MK_MULTI
    for (int s = 0; s < NSTEPS; ++s) { a.ph_lo = s; a.ph_hi = s + 1; void* args[] = {&a};
        hipError_t e = hipLaunchCooperativeKernel((const void*)mk_fwd, dim3(grid), dim3(512), args, LDS_BYTES, stream);
        if (e != hipSuccess) { fprintf(stderr, "cooperative launch %d failed: %s\n", s, hipGetErrorString(e)); break; } }
#else
    a.ph_lo = 0; a.ph_hi = NSTEPS; void* args[] = {&a};
    hipError_t e = hipLaunchCooperativeKernel((const void*)mk_fwd, dim3(grid), dim3(512), args, LDS_BYTES, stream);
    if (e != hipSuccess) fprintf(stderr, "cooperative launch failed: %s (grid %d)\n", hipGetErrorString(e), grid);
#endif
}
```

```cpp
#include <hip/hip_runtime.h>
#include <hip/hip_cooperative_groups.h>
#include <cstdio>
#include <cstdint>
namespace cg = cooperative_groups;
#ifndef MK_MULTI
#define MK_MULTI 0
#endif
#ifndef MK_PROBE
#define MK_PROBE 0
#endif
#ifndef MK_TIME
#define MK_TIME -1
#endif
#ifndef MK_TIME_BLOCK
#define MK_TIME_BLOCK 128
#endif
namespace pg8 {
#define PG8_LAS __attribute__((address_space(3)))
typedef unsigned short bf16_t;
typedef short bf16x8 __attribute__((ext_vector_type(8)));
typedef float f32x4 __attribute__((ext_vector_type(4)));
typedef unsigned u32x4 __attribute__((ext_vector_type(4)));
constexpr int BM = 256, BK = 64, HALF = 128, HTB = HALF * BK * 2  , STAGE_BYTES = 8 * HTB, NXCD = 8, WGM = 8;

__host__ __device__ __forceinline__ int lds_byte(int r, int c) { const int st = (r >> 4) * 2 + (c >> 5), rr = r & 15, cc = c & 31, ob = rr * 64 + cc * 2; return st * 1024 + (ob ^ (((ob >> 9) & 1) << 5)); }
__host__ __device__ __forceinline__ void stage_rc(int b, int& R, int& C) { const int st = b / 1024, sb = b % 1024, swz = sb ^ (((sb >> 9) & 1) << 5); R = (st >> 1) * 16 + swz / 64; C = (st & 1) * 32 + (swz % 64) / 2; }
__host__ __device__ __forceinline__ int perm32(int rho) { const int n = rho >> 4, i = rho & 15; return 8 * (i >> 2) + 4 * n + (i & 3); }

struct Unit { int pm, pn; };
struct Gemm { const bf16_t* A; const bf16_t* Bt; int M, N, K, lda; };

struct StaticOrder {
    int nM, nN, nwg, G, c;
    __host__ __device__ void init(int M, int N, int G_, int c_) { nM = M / BM; nN = N / BM; nwg = nM * nN; G = G_; c = c_; }
    __host__ __device__ bool next(int i, Unit& u) const {
        const long L = (long)i * G + c; if (L >= nwg) return false;
        int wgid = (int)L; { const int q = nwg / NXCD, r = nwg % NXCD, xcd = wgid % NXCD, off = wgid / NXCD; wgid = (xcd < r ? xcd * (q + 1) : r * (q + 1) + (xcd - r) * q) + off; }
        const int nig = WGM * nN, gid = wgid / nig, fm = gid * WGM, gsz = (nM - fm) < WGM ? (nM - fm) : WGM;
        u.pm = fm + ((wgid % nig) % gsz); u.pn = (wgid % nig) / gsz; return true;
    }
    __device__ __forceinline__ void a_ready(const Unit&) const {}
    __device__ __forceinline__ void done(const Unit&) const {}
};

__device__ __forceinline__ unsigned cvt_pk_bf16(float lo, float hi) { unsigned r; asm volatile("v_cvt_pk_bf16_f32 %0, %1, %2" : "=v"(r) : "v"(lo), "v"(hi)); return r; }
template <class Epi, class Sched, bool ALIGN_EPI = false, bool SP2 = false>
__device__ __forceinline__ void gemm_phase(PG8_LAS unsigned char* lds, const Gemm g, const Sched& S, const Epi& E, const int tid) {
    const int wid = __builtin_amdgcn_readfirstlane(tid >> 6), lane = tid & 63, wr = wid >> 2, wc = wid & 3, fr = lane & 15, fq = lane >> 4;
    const int K = g.K, nt = K / BK;
    unsigned voffA[2], voffB[2];
#pragma unroll
    for (int i = 0; i < 2; ++i) { int R, C; stage_rc(tid * 16 + i * 8192, R, C); const int Rb = Epi::PERM ? ((R & ~31) + perm32(R & 31)) : R;
        voffA[i] = (unsigned)(R * g.lda + C) * 2u; voffB[i] = (unsigned)(Rb * K + C) * 2u; }
    const size_t kstep = (size_t)(BK * 2);
    const size_t hstep = (size_t)HALF * K * 2;
    const size_t tstep = 2 * hstep; const size_t hstepA = (size_t)HALF * g.lda * 2, tstepA = 2 * hstepA;
    const unsigned ldsw = (unsigned)wid * 1024u;
    const int aoff = lds_byte(wr * 64 + fr, fq * 8), boff = lds_byte(wc * 32 + fr, fq * 8);
#define PG8_SA(b, h) (((b) * 2 + (h)) * HTB)
#define PG8_SB(b, h) ((4 + (b) * 2 + (h)) * HTB)
#define PG8_STAGE(bufoff, gbase, voff) do { _Pragma("unroll") for (int _i = 0; _i < 2; ++_i) \
        __builtin_amdgcn_global_load_lds((const unsigned*)((const char*)(gbase) + (voff)[_i]), (PG8_LAS unsigned*)(lds + (bufoff) + ldsw + _i * 8192), 16, 0, 0); } while (0)
#define PG8_LDA(dst, b, h) do { _Pragma("unroll") for (int m = 0; m < 4; ++m) _Pragma("unroll") for (int k = 0; k < 2; ++k) dst[m][k] = *(const PG8_LAS bf16x8*)(lds + PG8_SA(b, h) + aoff + m * 2048 + k * 1024); } while (0)
#define PG8_LDB(dst, b, h) do { _Pragma("unroll") for (int n = 0; n < 2; ++n) _Pragma("unroll") for (int k = 0; k < 2; ++k) dst[n][k] = *(const PG8_LAS bf16x8*)(lds + PG8_SB(b, h) + boff + n * 2048 + k * 1024); } while (0)
#define PG8_MMA(ai, bj, At, Bt) do { __builtin_amdgcn_s_setprio(1); _Pragma("unroll") for (int m = 0; m < 4; ++m) _Pragma("unroll") for (int n = 0; n < 2; ++n) _Pragma("unroll") for (int k = 0; k < 2; ++k) \
        acc[ai][bj][m][n] = __builtin_amdgcn_mfma_f32_16x16x32_bf16(Bt[n][k], At[m][k], acc[ai][bj][m][n], 0, 0, 0); __builtin_amdgcn_s_setprio(0); } while (0)
#define PG8_WAIT_V(n) asm volatile("s_waitcnt vmcnt(" #n ")" ::: "memory")
#define PG8_WAIT_L(n) asm volatile("s_waitcnt lgkmcnt(" #n ")" ::: "memory")
#define PG8_BAR __builtin_amdgcn_s_barrier()
#define PG8_SCHED __builtin_amdgcn_sched_barrier(0)
    Unit cur, nxt; int ui = 0;
    if (!S.next(0, cur)) return;
    f32x4 acc[2][2][4][2];
#pragma unroll
    for (int a = 0; a < 2; ++a)
#pragma unroll
        for (int b = 0; b < 2; ++b)
#pragma unroll
            for (int m = 0; m < 4; ++m)
#pragma unroll
                for (int n = 0; n < 2; ++n) acc[a][b][m][n] = (f32x4){0.f, 0.f, 0.f, 0.f};
    bf16x8 At[4][2], B0[2][2], B1[2][2];
    const char* cA = (const char*)g.A + (size_t)cur.pm * tstepA; const char* cB = (const char*)g.Bt + (size_t)cur.pn * tstep;
    S.a_ready(cur);
    if constexpr (SP2) {
        PG8_STAGE(PG8_SB(0, 0), cB, voffB); PG8_STAGE(PG8_SB(0, 1), cB + hstep, voffB); PG8_STAGE(PG8_SA(0, 0), cA, voffA); PG8_STAGE(PG8_SA(0, 1), cA + hstepA, voffA);
        if (wr == 1) PG8_BAR;
        PG8_WAIT_V(2); PG8_BAR;
        PG8_STAGE(PG8_SB(1, 0), cB + kstep, voffB); PG8_STAGE(PG8_SA(1, 0), cA + kstep, voffA); PG8_STAGE(PG8_SB(1, 1), cB + hstep + kstep, voffB);
        PG8_WAIT_V(6); PG8_BAR;
    } else {
        PG8_STAGE(PG8_SB(0, 0), cB, voffB); PG8_STAGE(PG8_SA(0, 0), cA, voffA); PG8_STAGE(PG8_SB(0, 1), cB + hstep, voffB); PG8_STAGE(PG8_SA(0, 1), cA + hstepA, voffA);
        if (wr == 1) PG8_BAR;
        PG8_WAIT_V(4); PG8_BAR;
        PG8_STAGE(PG8_SB(1, 0), cB + kstep, voffB); PG8_STAGE(PG8_SA(1, 0), cA + kstep, voffA); PG8_STAGE(PG8_SB(1, 1), cB + hstep + kstep, voffB);
        PG8_WAIT_V(6); PG8_BAR;
    }
    for (;;) {
        const bool has_next = S.next(ui + 1, nxt);
        const char* nA = has_next ? (const char*)g.A + (size_t)nxt.pm * tstepA : cA; const char* nB = has_next ? (const char*)g.Bt + (size_t)nxt.pn * tstep : cB;
        for (int t = 0; t < nt; t += 2) {
            const bool last = (t == nt - 2);
            const char* a1 = cA + (size_t)(t + 1) * kstep;
            const char* a2 = last ? nA : cA + (size_t)(t + 2) * kstep; const char* b2 = last ? nB : cB + (size_t)(t + 2) * kstep;
            const char* a3 = a2 + kstep; const char* b3 = b2 + kstep;
            if (last && has_next) S.a_ready(nxt);
            if constexpr (SP2) {
            PG8_LDB(B0, 0, 0); PG8_LDB(B1, 0, 1); PG8_SCHED; PG8_LDA(At, 0, 0); PG8_STAGE(PG8_SA(1, 1), a1 + hstepA, voffA);
            PG8_WAIT_V(8); PG8_WAIT_L(0); PG8_BAR; PG8_MMA(0, 0, At, B0); PG8_MMA(0, 1, At, B1); PG8_BAR; PG8_SCHED;
            PG8_LDA(At, 0, 1); PG8_STAGE(PG8_SB(0, 0), b2, voffB); PG8_STAGE(PG8_SB(0, 1), b2 + hstep, voffB); PG8_STAGE(PG8_SA(0, 0), a2, voffA);
            PG8_WAIT_V(8); PG8_WAIT_L(0); PG8_BAR; PG8_MMA(1, 0, At, B0); PG8_MMA(1, 1, At, B1); PG8_BAR; PG8_SCHED;
            PG8_LDB(B0, 1, 0); PG8_LDB(B1, 1, 1); PG8_SCHED; PG8_LDA(At, 1, 0); PG8_STAGE(PG8_SA(0, 1), a2 + hstepA, voffA);
            PG8_WAIT_V(8); PG8_WAIT_L(0); PG8_BAR; PG8_MMA(0, 0, At, B0); PG8_MMA(0, 1, At, B1); PG8_BAR; PG8_SCHED;
            PG8_LDA(At, 1, 1); PG8_STAGE(PG8_SB(1, 0), b3, voffB); PG8_STAGE(PG8_SB(1, 1), b3 + hstep, voffB); PG8_STAGE(PG8_SA(1, 0), a3, voffA);
            PG8_WAIT_V(8); PG8_WAIT_L(0); PG8_BAR; PG8_MMA(1, 0, At, B0); PG8_MMA(1, 1, At, B1); PG8_BAR; PG8_SCHED;
            } else {
            PG8_LDB(B0, 0, 0); PG8_SCHED; PG8_LDA(At, 0, 0); PG8_STAGE(PG8_SA(1, 1), a1 + hstepA, voffA);
            PG8_WAIT_L(8); PG8_BAR; PG8_WAIT_L(0); PG8_MMA(0, 0, At, B0); PG8_BAR; PG8_SCHED;
            PG8_LDB(B1, 0, 1); PG8_STAGE(PG8_SB(0, 0), b2, voffB);
            PG8_BAR; PG8_WAIT_L(0); PG8_MMA(0, 1, At, B1); PG8_BAR;
            PG8_LDA(At, 0, 1); PG8_STAGE(PG8_SA(0, 0), a2, voffA);
            PG8_BAR; PG8_WAIT_L(0); PG8_MMA(1, 0, At, B0); PG8_BAR; PG8_SCHED;
            PG8_STAGE(PG8_SB(0, 1), b2 + hstep, voffB);
            PG8_WAIT_V(6); PG8_BAR; PG8_MMA(1, 1, At, B1); PG8_BAR;
            PG8_LDB(B0, 1, 0); PG8_SCHED; PG8_LDA(At, 1, 0); PG8_STAGE(PG8_SA(0, 1), a2 + hstepA, voffA);
            PG8_WAIT_L(8); PG8_BAR; PG8_WAIT_L(0); PG8_MMA(0, 0, At, B0); PG8_BAR; PG8_SCHED;
            PG8_LDB(B1, 1, 1); PG8_STAGE(PG8_SB(1, 0), b3, voffB);
            PG8_BAR; PG8_WAIT_L(0); PG8_MMA(0, 1, At, B1); PG8_BAR;
            PG8_LDA(At, 1, 1); PG8_STAGE(PG8_SA(1, 0), a3, voffA);
            PG8_BAR; PG8_WAIT_L(0); PG8_MMA(1, 0, At, B0); PG8_BAR; PG8_SCHED;
            PG8_STAGE(PG8_SB(1, 1), b3 + hstep, voffB);
            PG8_WAIT_V(6); PG8_BAR; PG8_MMA(1, 1, At, B1); PG8_BAR;
            }
        }
        if constexpr (ALIGN_EPI) { if (wr == 0) PG8_BAR; }
        if constexpr (!Epi::AFTER_DRAIN) { E(acc, cur, wr, wc, fr, fq); S.done(cur); }
        if (!has_next) break;
#pragma unroll
        for (int a = 0; a < 2; ++a)
#pragma unroll
            for (int b = 0; b < 2; ++b)
#pragma unroll
                for (int m = 0; m < 4; ++m)
#pragma unroll
                    for (int n = 0; n < 2; ++n) acc[a][b][m][n] = (f32x4){0.f, 0.f, 0.f, 0.f};
        cur = nxt; cA = nA; cB = nB; ++ui;
        if constexpr (ALIGN_EPI) { if (wr == 1) PG8_BAR; }
    }
    PG8_WAIT_V(0);
    if constexpr (!ALIGN_EPI) { if (wr == 0) PG8_BAR; }
    PG8_BAR;
    if constexpr (Epi::AFTER_DRAIN) { E.fused(acc, cur, wr, wc, fr, fq, lds, wid, lane); S.done(cur); }
#undef PG8_SA
#undef PG8_SB
#undef PG8_STAGE
#undef PG8_LDA
#undef PG8_LDB
#undef PG8_MMA
#undef PG8_WAIT_V
#undef PG8_WAIT_L
#undef PG8_BAR
#undef PG8_SCHED
}
}
using pg8::bf16_t; using pg8::f32x4; using pg8::u32x4; using pg8::bf16x8; using pg8::Unit;
#define LAS __attribute__((address_space(3)))
typedef float f32x16 __attribute__((ext_vector_type(16)));
typedef unsigned u32x2 __attribute__((ext_vector_type(2)));
typedef short s16x4 __attribute__((ext_vector_type(4)));
constexpr int NB = 8, SEQ = 4096, CTXL = 256, DM = 1024, FF = 2816, DEPTH = 4, NH = 8;
constexpr int R_LAT = NB * SEQ, R_CTX = NB * CTXL, R = R_LAT + R_CTX;
constexpr float EPS = 1e-6f;
constexpr int NCH = 34;
constexpr size_t W_GUA = 0, W_DA = W_GUA + (size_t)5632 * 1024, W_GUB = W_DA + (size_t)1024 * 2816, W_DB = W_GUB + (size_t)5632 * 1024,
                 W_IN = W_DB + (size_t)1024 * 2816, W_UQ = W_IN + (size_t)3840 * 1024, W_UKV = W_UQ + (size_t)1536 * 256, W_OMLA = W_UKV + (size_t)2048 * 256,
                 W_GLU = W_OMLA + (size_t)1024 * 1024, W_OS5 = W_GLU + (size_t)1024 * 1024, W_OUT = W_OS5 + (size_t)1024 * 1024, W_END = W_OUT + (size_t)1024 * 1024;
constexpr size_t al256(size_t x) { return (x + 255) & ~(size_t)255; }
constexpr size_t WS_CTL = 0, CTL_BYTES = 16384;
constexpr size_t WS_MOD = WS_CTL + CTL_BYTES;
constexpr size_t WS_ROPE = WS_MOD + al256((size_t)4 * 9 * 9216 * 4);
constexpr size_t WS_YSS = WS_ROPE + al256(64 * 16 * 8);
constexpr size_t WS_CSS = WS_YSS + al256((size_t)R * 16 * 4);
constexpr size_t WS_S5E = WS_CSS + al256((size_t)R * 8 * 4);
constexpr size_t S5_WE_BYTES = (size_t)2 * 64 * 128 * 256 * 2, S5_WY_BYTES = (size_t)64 * 256 * 512 * 2;
constexpr size_t WS_XC = WS_S5E + al256(S5_WE_BYTES + S5_WY_BYTES);
constexpr size_t WS_WL = WS_XC + al256((size_t)R_CTX * DM * 4);
constexpr size_t WS_H = WS_WL + al256(W_END * 2);
constexpr size_t WS_BIG = WS_H + al256((size_t)R * DM * 2);
constexpr size_t B_CQ = 0, B_U = B_CQ + (size_t)R * 768 * 2, B_Q = B_U + (size_t)R * 1024 * 2, B_KV = B_Q + (size_t)R * 1536 * 2, B_SG = B_KV + (size_t)R * 2048 * 2, B_END = B_SG + (size_t)R * 2048 * 2;
constexpr size_t B_ACT = 0, B_Y = (size_t)R * FF * 2;
constexpr size_t B_T = B_U, B_G = B_KV, B_M = B_Q;
static_assert(B_Y >= B_M + (size_t)R * 1024 * 2 && B_Y + (size_t)R * 1024 * 2 <= B_SG, "Y overlay");
constexpr size_t WS_END = WS_BIG + B_END;
constexpr int LDS_BYTES = 272 * 528 + 8192 + 16 * 528 + 256;

__device__ __forceinline__ float bf2f(unsigned h) { return __uint_as_float(h << 16); }
__device__ __forceinline__ unsigned pk2(float lo, float hi) { return pg8::cvt_pk_bf16(lo, hi); }
__device__ __forceinline__ float sigm(float x) { return __builtin_amdgcn_rcpf(1.f + __builtin_amdgcn_exp2f(-1.4426950408889634f * x)); }
__device__ __forceinline__ float gelu_tanh(float x) { return x * sigm(1.5957691216057308f * (x + 0.044715f * x * x * x)); }
__device__ __forceinline__ void unpack8(const u32x4 w, float (&f)[8]) {
    f[0] = bf2f(w.x & 0xffffu); f[1] = __uint_as_float(w.x & 0xffff0000u); f[2] = bf2f(w.y & 0xffffu); f[3] = __uint_as_float(w.y & 0xffff0000u);
    f[4] = bf2f(w.z & 0xffffu); f[5] = __uint_as_float(w.z & 0xffff0000u); f[6] = bf2f(w.w & 0xffffu); f[7] = __uint_as_float(w.w & 0xffff0000u);
}
__device__ __forceinline__ u32x4 pack8(const float (&f)[8]) { u32x4 w; w.x = pk2(f[0], f[1]); w.y = pk2(f[2], f[3]); w.z = pk2(f[4], f[5]); w.w = pk2(f[6], f[7]); return w; }
__device__ __forceinline__ float wave_sum(float v) {
#pragma unroll
    for (int o = 1; o < 64; o <<= 1) v += __shfl_xor(v, o);
    return v;
}
__device__ __forceinline__ void rope8(float (&v)[8], int row, int wc, int fq, const float* tab) {
    const int t = row & 4095, pos = (wc & 1) ? (t & 63) : (t >> 6);
    const f32x4* tp = (const f32x4*)(tab + (pos * 16 + 8 * (fq & 1)) * 2);
    const f32x4 t0 = tp[0], t1 = tp[1], t2 = tp[2], t3 = tp[3];
    const float cs[8] = {t0[0], t0[2], t1[0], t1[2], t2[0], t2[2], t3[0], t3[2]}, sn[8] = {t0[1], t0[3], t1[1], t1[3], t2[1], t2[3], t3[1], t3[3]};
    const float sgn = (fq < 2) ? -1.f : 1.f;
#pragma unroll
    for (int j = 0; j < 8; ++j) { const float p = __shfl_xor(v[j], 32); v[j] = v[j] * cs[j] + sgn * p * sn[j]; }
}

struct Epi {
    static constexpr bool PERM = true, AFTER_DRAIN = false;
    int mode;
    bf16_t* o0; bf16_t* o1; bf16_t* o2; const bf16_t* i0; const bf16_t* i1; float* ss; const float* css; const float* bias; const float* rope;
    __device__ __forceinline__ void operator()(const f32x4 (&acc)[2][2][4][2], const Unit& u, int wr, int wc, int fr, int fq) const {
        const int row0 = u.pm * 256 + wr * 64 + fr, cb = wc * 32 + 8 * fq, pn = u.pn;
        if (mode == 0) {
            bf16_t* base = o0 + (size_t)pn * 128 + cb;
#pragma unroll
            for (int ai = 0; ai < 2; ++ai)
#pragma unroll
                for (int m = 0; m < 4; ++m) { const int row = row0 + ai * 128 + m * 16; float v[8];
#pragma unroll
                    for (int n = 0; n < 2; ++n)
#pragma unroll
                        for (int j = 0; j < 4; ++j) { const float g = acc[ai][0][m][n][j], up = acc[ai][1][m][n][j]; v[4 * n + j] = g * sigm(g) * up; }
                    *(u32x4*)(base + (size_t)row * FF) = pack8(v); }
        } else if (mode == 1) {
            bf16_t* base = o0 + pn * 256 + cb;
#pragma unroll
            for (int ai = 0; ai < 2; ++ai)
#pragma unroll
                for (int m = 0; m < 4; ++m) { const int row = row0 + ai * 128 + m * 16; float s = 0.f;
#pragma unroll
                    for (int bj = 0; bj < 2; ++bj) { float v[8];
#pragma unroll
                        for (int n = 0; n < 2; ++n)
#pragma unroll
                            for (int j = 0; j < 4; ++j) { const float x = acc[ai][bj][m][n][j]; v[4 * n + j] = x; s += x * x; }
                        *(u32x4*)(base + (size_t)row * 1024 + bj * 128) = pack8(v); }
                    s += __shfl_xor(s, 16); s += __shfl_xor(s, 32);
                    if (fq == 0) ss[row * 16 + pn * 4 + wc] = s; }
        } else if (mode == 2) {
            bf16_t* dst; int ldc;
            if (pn < 3) { dst = o0 + pn * 256; ldc = 768; } else if (pn < 7) { dst = o1 + (pn - 3) * 256; ldc = 1024; } else { dst = o2 + (pn - 7) * 256; ldc = 2048; }
            const bool sg = pn >= 7, docss = pn < 2, dorope = (pn == 2) && (u.pm < 128) && (wc < 2);
            dst += cb;
#pragma unroll
            for (int ai = 0; ai < 2; ++ai)
#pragma unroll
                for (int m = 0; m < 4; ++m) { const int row = row0 + ai * 128 + m * 16; float s = 0.f;
#pragma unroll
                    for (int bj = 0; bj < 2; ++bj) { float v[8];
#pragma unroll
                        for (int n = 0; n < 2; ++n)
#pragma unroll
                            for (int j = 0; j < 4; ++j) { float x = acc[ai][bj][m][n][j]; if (sg) x = sigm(x); v[4 * n + j] = x; s += x * x; }
                        if (bj == 0 && dorope) rope8(v, row, wc, fq, rope);
                        *(u32x4*)(dst + (size_t)row * ldc + bj * 128) = pack8(v); }
                    if (docss) { s += __shfl_xor(s, 16); s += __shfl_xor(s, 32); if (fq == 0) ss[row * 8 + pn * 4 + wc] = s; } }
        } else if (mode == 3 || mode == 4) {
            const int ldc = (mode == 3) ? 1536 : 2048; const float* cp = css + ((mode == 3) ? 0 : 4);
            const bool dorope = (mode == 3) && (pn >= 4) && (u.pm < 128);
            bf16_t* dst = o0 + pn * 256 + cb;
#pragma unroll
            for (int ai = 0; ai < 2; ++ai)
#pragma unroll
                for (int m = 0; m < 4; ++m) { const int row = row0 + ai * 128 + m * 16; const f32x4 c4 = *(const f32x4*)(cp + row * 8);
                    const float rs = 1.0f / sqrtf(((c4[0] + c4[1]) + (c4[2] + c4[3])) * (1.0f / 256.0f) + EPS);
#pragma unroll
                    for (int bj = 0; bj < 2; ++bj) { float v[8];
#pragma unroll
                        for (int n = 0; n < 2; ++n)
#pragma unroll
                            for (int j = 0; j < 4; ++j) v[4 * n + j] = acc[ai][bj][m][n][j] * rs;
                        if (dorope) rope8(v, row, wc, fq, rope);
                        *(u32x4*)(dst + (size_t)row * ldc + bj * 128) = pack8(v); } }
        } else {
            const int col = pn * 256 + cb;
#pragma unroll
            for (int ai = 0; ai < 2; ++ai)
#pragma unroll
                for (int m = 0; m < 4; ++m) { const int row = row0 + ai * 128 + m * 16;
#pragma unroll
                    for (int bj = 0; bj < 2; ++bj) { const int c = col + bj * 128; float v[8], a[8], b[8];
#pragma unroll
                        for (int n = 0; n < 2; ++n)
#pragma unroll
                            for (int j = 0; j < 4; ++j) v[4 * n + j] = acc[ai][bj][m][n][j];
                        if (mode == 5) { unpack8(*(const u32x4*)(i0 + (size_t)row * 1024 + c), a); const f32x4 b0 = *(const f32x4*)(bias + c), b1 = *(const f32x4*)(bias + c + 4);
#pragma unroll
                            for (int j = 0; j < 4; ++j) { v[j] = a[j] * sigm(v[j] + b0[j]); v[4 + j] = a[4 + j] * sigm(v[4 + j] + b1[j]); } }
                        else if (mode == 6) { unpack8(*(const u32x4*)(i0 + (size_t)row * 2048 + c), a);
#pragma unroll
                            for (int j = 0; j < 8; ++j) v[j] = a[j] * v[j]; }
                        else { unpack8(*(const u32x4*)(i0 + (size_t)row * 1024 + c), a); unpack8(*(const u32x4*)(i1 + (size_t)row * 2048 + c), b);
#pragma unroll
                            for (int j = 0; j < 8; ++j) v[j] = a[j] + b[j] * v[j]; }
                        *(u32x4*)(o0 + (size_t)row * 1024 + c) = pack8(v); } }
        }
    }
};
__device__ __forceinline__ void conv_item(const float* W, int ldsrc, int srccol, const float* kscale, bf16_t* WT, int K, int n0, int k0, LAS float* scr, int lane) {
    if (srccol >= 0) {
#pragma unroll 8
        for (int i = 0; i < 32; ++i) { const int kk = 2 * i + (lane >> 5); float w = W[(size_t)(k0 + kk) * ldsrc + srccol + (lane & 31)]; if (kscale) w *= kscale[k0 + kk]; scr[kk * 33 + (lane & 31)] = w; }
    } else {
#pragma unroll 8
        for (int i = 0; i < 32; ++i) { const int kk = 2 * i + (lane >> 5); scr[kk * 33 + (lane & 31)] = 0.f; }
    }
    asm volatile("s_waitcnt lgkmcnt(0)" ::: "memory");
    const int c = lane & 7;
#pragma unroll
    for (int j = 0; j < 4; ++j) { const int n = (lane >> 3) + 8 * j; const LAS float* s = scr + (8 * c) * 33 + n;
        u32x4 o; o.x = pk2(s[0 * 33], s[1 * 33]); o.y = pk2(s[2 * 33], s[3 * 33]); o.z = pk2(s[4 * 33], s[5 * 33]); o.w = pk2(s[6 * 33], s[7 * 33]);
        *(u32x4*)(WT + (size_t)(n0 + n) * K + k0 + 8 * c) = o; }
    asm volatile("s_waitcnt lgkmcnt(0)" ::: "memory");
}
struct WPtrs { const float *gate, *up, *down, *win, *qn, *wuq, *kvn, *wukv, *womla, *glu, *wos5, *wout; };
__device__ __forceinline__ void conv_layer(const WPtrs& P, int l, bf16_t* WL, LAS unsigned char* lds, int gw, int NGW, int wave, int lane, int it_lo, int it_hi) {
    LAS float* scr = (LAS float*)(lds + wave * 16384);
    constexpr int I_GU = 16 * 176, I_D = 44 * 32, I_IN = 16 * 120, I_UQ = 4 * 48, I_UKV = 4 * 64, I_SQ = 16 * 32;
    constexpr int NIT = 2 * I_GU + 2 * I_D + I_IN + I_UQ + I_UKV + 4 * I_SQ;
    static_assert(NIT == 12864, "conv items");
    for (int it = it_lo + gw; it < it_hi; it += NGW) {
        int r = it;
        if (r < 2 * I_GU) { const int f = r / I_GU; r -= f * I_GU; const int nb = r % 176, kb = r / 176, n0 = nb * 32, tile = n0 >> 8, within = n0 & 255, half = within >> 7, ffc = tile * 128 + (within & 127);
            const size_t so = (size_t)(l * 2 + f) * 1024 * FF; bf16_t* dst = WL + (f ? W_GUB : W_GUA);
            if (half) conv_item(P.up + so, FF, ffc, nullptr, dst, 1024, n0, kb * 64, scr, lane); else conv_item(P.gate + so, FF, ffc, nullptr, dst, 1024, n0, kb * 64, scr, lane);
            continue; }
        r -= 2 * I_GU;
        if (r < 2 * I_D) { const int f = r / I_D; r -= f * I_D; const int nb = r % 32, kb = r / 32;
            conv_item(P.down + (size_t)(l * 2 + f) * FF * 1024, 1024, nb * 32, nullptr, WL + (f ? W_DB : W_DA), FF, nb * 32, kb * 64, scr, lane); continue; }
        r -= 2 * I_D;
        if (r < I_IN) { const int nb = r % 120, kb = r / 120, n0 = nb * 32; int sc;
            if (n0 < 512) sc = n0; else if (n0 < 768) sc = (n0 < 576) ? n0 : -1; else sc = n0 - 768 + 576;
            conv_item(P.win + (size_t)l * 1024 * 3648, 3648, sc, nullptr, WL + W_IN, 1024, n0, kb * 64, scr, lane); continue; }
        r -= I_IN;
        if (r < I_UQ) { const int nb = r % 48, kb = r / 48, n0 = nb * 32; int sc;
            if (n0 < 1024) sc = (n0 >> 7) * 192 + (n0 & 127); else { const int rr = n0 - 1024; sc = (rr >> 6) * 192 + 128 + (rr & 63); }
            conv_item(P.wuq + (size_t)l * 256 * 1536, 1536, sc, P.qn + l * 256, WL + W_UQ, 256, n0, kb * 64, scr, lane); continue; }
        r -= I_UQ;
        if (r < I_UKV) { const int nb = r % 64, kb = r / 64;
            conv_item(P.wukv + (size_t)l * 256 * 2048, 2048, nb * 32, P.kvn + l * 256, WL + W_UKV, 256, nb * 32, kb * 64, scr, lane); continue; }
        r -= I_UKV;
        { const int q = r / I_SQ; r -= q * I_SQ; const int nb = r % 32, kb = r / 32; const size_t so = (size_t)l * 1024 * 1024;
          if (q == 0) conv_item(P.womla + so, 1024, nb * 32, nullptr, WL + W_OMLA, 1024, nb * 32, kb * 64, scr, lane);
          else if (q == 1) conv_item(P.glu + so, 1024, nb * 32, nullptr, WL + W_GLU, 1024, nb * 32, kb * 64, scr, lane);
          else if (q == 2) conv_item(P.wos5 + so, 1024, nb * 32, nullptr, WL + W_OS5, 1024, nb * 32, kb * 64, scr, lane);
          else conv_item(P.wout + so, 1024, nb * 32, nullptr, WL + W_OUT, 1024, nb * 32, kb * 64, scr, lane); }
    }
}

__device__ __forceinline__ void mods_phase(const float* c, const float* c_ctx, const float* ada_w, const float* ada_b, float* MOD, float* ROPE, LAS unsigned char* lds, const int tid) {

    LAS float* sc = (LAS float*)lds;
    LAS float* red = (LAS float*)(lds + 9 * 1024 * 4);
    if (blockIdx.x == gridDim.x - 1) {
        for (int e = tid; e < 1024; e += 512) { const int pos = e >> 4, i = e & 15; const float inv = exp2f(-(float)i * (13.287712379549449f / 16.0f)); const float ang = (float)pos * inv;
            float sn_, cs_; sincosf(ang, &sn_, &cs_); ROPE[2 * e] = cs_; ROPE[2 * e + 1] = sn_; }
    }
    bool have = false;
    for (int item = blockIdx.x; item < 576; item += gridDim.x) {
        if (!have) { for (int e = tid; e < 9 * 1024; e += 512) { const float v = (e < 8192) ? c[e] : c_ctx[e - 8192]; sc[e] = v * sigm(v); } have = true; }
        __syncthreads();
        const int l = item / 144, j0 = (item % 144) * 64, ks = tid >> 6, jj = tid & 63;
        const float* w = ada_w + ((size_t)l * 1024 + ks * 128) * 9216 + j0 + jj;
        float a[9];
#pragma unroll
        for (int s = 0; s < 9; ++s) a[s] = 0.f;
#pragma unroll 16
        for (int k = 0; k < 128; ++k) { const float wv = w[(size_t)k * 9216];
#pragma unroll
            for (int s = 0; s < 9; ++s) a[s] += sc[s * 1024 + ks * 128 + k] * wv; }
#pragma unroll
        for (int s = 0; s < 9; ++s) red[(ks * 9 + s) * 64 + jj] = a[s];
        __syncthreads();
        for (int e = tid; e < 576; e += 512) { const int s = e >> 6, j = e & 63; float t = 0.f;
#pragma unroll
            for (int q = 0; q < 8; ++q) t += red[(q * 9 + s) * 64 + j];
            MOD[((size_t)l * 9 + s) * 9216 + j0 + j] = t + ada_b[l * 9216 + j0 + j]; }
    }
    __syncthreads();
}

__device__ __forceinline__ void e_phase(const float* xin, const float* ctxin, float* xl, float* xc, const bf16_t* Y, const float* YSS, const float* MOD,
                                        const float* npre, const float* npost, bf16_t* H, int l, int s, int nl, int ns, int gw, int NGW, int lane, float wmul, int nrows) {
    for (int row = gw; row < nrows; row += NGW) {
        const bool lat = row < R_LAT; const int set = lat ? (row >> 12) : 8;
        float* xr = lat ? xl + (size_t)row * DM : xc + (size_t)(row - R_LAT) * DM;
        const float* xs = (s < 0) ? (lat ? xin + (size_t)row * DM : ctxin + (size_t)(row - R_LAT) * DM) : xr;
        f32x4 v[4];
#pragma unroll
        for (int j = 0; j < 4; ++j) v[j] = ((const f32x4*)xs)[lane + 64 * j];
        if (s >= 0) {
            const float part = (lane < 16) ? YSS[row * 16 + lane] : 0.f;
            const float rs = 1.0f / sqrtf(wave_sum(part) * (1.0f / 1024.0f) + EPS);
            const float wgt = ((s == 1) ? 1.0f : 0.5f) * wmul;
            const float* gate = MOD + ((size_t)(l * 9 + set) * 9 + 3 * s + 2) * 1024; const float* gp = npost + (l * 3 + s) * 1024;
#pragma unroll
            for (int j = 0; j < 4; ++j) { const u32x2 yw = ((const u32x2*)(Y + (size_t)row * DM))[lane + 64 * j];
                const f32x4 g4 = ((const f32x4*)gate)[lane + 64 * j], p4 = ((const f32x4*)gp)[lane + 64 * j];
                f32x4 y4; y4[0] = bf2f(yw.x & 0xffffu); y4[1] = __uint_as_float(yw.x & 0xffff0000u); y4[2] = bf2f(yw.y & 0xffffu); y4[3] = __uint_as_float(yw.y & 0xffff0000u);
                v[j] += (wgt * rs) * g4 * y4 * p4; }
        }
#pragma unroll
        for (int j = 0; j < 4; ++j) ((f32x4*)xr)[lane + 64 * j] = v[j];
        if (nl >= 0) {
            float q = 0.f;
#pragma unroll
            for (int j = 0; j < 4; ++j) q += (v[j][0] * v[j][0] + v[j][1] * v[j][1]) + (v[j][2] * v[j][2] + v[j][3] * v[j][3]);
            const float rs2 = 1.0f / sqrtf(wave_sum(q) * (1.0f / 1024.0f) + EPS);
            const float* mb = MOD + ((size_t)(nl * 9 + set) * 9 + 3 * ns) * 1024; const float* gp = npre + (nl * 3 + ns) * 1024;
#pragma unroll
            for (int j = 0; j < 4; ++j) { const f32x4 sh = ((const f32x4*)mb)[lane + 64 * j], sc = ((const f32x4*)(mb + 1024))[lane + 64 * j], p4 = ((const f32x4*)gp)[lane + 64 * j];
                const f32x4 h = v[j] * rs2 * p4 * (1.0f + sc) + sh;
                u32x2 o; o.x = pk2(h[0], h[1]); o.y = pk2(h[2], h[3]); ((u32x2*)(H + (size_t)row * DM))[lane + 64 * j] = o; }
        }
    }
}
struct S5In { const float *a_re, *a_im, *log_dt, *b_re, *b_im, *c_re, *c_im, *dsk; };
__device__ __forceinline__ void s5_abar(const S5In& P, int idx, int n, float& ar, float& ai, float& cr, float& ci) {
    const float are = P.a_re[idx * 64 + n], aim = P.a_im[idx * 64 + n];
    const float dt = expf(P.log_dt[idx]);
    const float mag = expf(dt * are); float sn, cs; sincosf(dt * aim, &sn, &cs);
    ar = mag * cs; ai = mag * sn;
    const float nr = ar - 1.f, ni = ai, den = 1.0f / (are * are + aim * aim);
    cr = (nr * are + ni * aim) * den; ci = (ni * are - nr * aim) * den;
}
__device__ __forceinline__ void s5_prep(const S5In& P, int l, int g, bf16_t* WEt, bf16_t* WYt, LAS unsigned char* lds, int tid) {
    LAS float* AP = (LAS float*)lds;
    LAS float* BB = AP + 2 * 17 * 64 * 2;
    LAS float* CC = BB + 2 * 64 * 16 * 2;
    LAS float* KL = CC + 2 * 16 * 64 * 2;
    if (tid < 128) { const int d = tid >> 6, n = tid & 63, idx = (l * 2 + d) * 64 + g; float ar, ai, cr, ci; s5_abar(P, idx, n, ar, ai, cr, ci);
        float pr = 1.f, pi = 0.f;
        for (int j = 0; j <= 16; ++j) { AP[((d * 17 + j) * 64 + n) * 2] = pr; AP[((d * 17 + j) * 64 + n) * 2 + 1] = pi; const float t0 = pr * ar - pi * ai, t1 = pr * ai + pi * ar; pr = t0; pi = t1; }
        for (int c = 0; c < 16; ++c) { const float br = P.b_re[(size_t)(idx * 64 + n) * 16 + c], bi = P.b_im[(size_t)(idx * 64 + n) * 16 + c];
            BB[((d * 64 + n) * 16 + c) * 2] = cr * br - ci * bi; BB[((d * 64 + n) * 16 + c) * 2 + 1] = cr * bi + ci * br; } }
    for (int e = tid; e < 2048; e += 512) { const int d = e >> 10, cn = e & 1023; const size_t src = (size_t)((l * 2 + d) * 64 + g) * 1024 + cn; CC[e * 2] = P.c_re[src]; CC[e * 2 + 1] = P.c_im[src]; }
    __syncthreads();
    { const int d = tid >> 8, c = (tid >> 4) & 15, cp = tid & 15; float acc[16];
#pragma unroll
      for (int j = 0; j < 16; ++j) acc[j] = 0.f;
      for (int n = 0; n < 64; ++n) { const float c_r = CC[((d * 16 + c) * 64 + n) * 2], c_i = CC[((d * 16 + c) * 64 + n) * 2 + 1], b_r = BB[((d * 64 + n) * 16 + cp) * 2], b_i = BB[((d * 64 + n) * 16 + cp) * 2 + 1];
          const float zr = c_r * b_r - c_i * b_i, zi = c_r * b_i + c_i * b_r;
#pragma unroll
          for (int j = 0; j < 16; ++j) acc[j] += zr * AP[((d * 17 + j) * 64 + n) * 2] - zi * AP[((d * 17 + j) * 64 + n) * 2 + 1]; }
#pragma unroll
      for (int j = 0; j < 16; ++j) KL[((d * 16 + j) * 16 + c) * 16 + cp] = acc[j]; }
    __syncthreads();
    for (int e = tid; e < 256 * 64; e += 512) { const int row = e >> 6, k8 = (e & 63) * 8, t = row >> 4, c = row & 15; float v[8];
        if (k8 < 256) { const int s = k8 >> 4, c0 = k8 & 15;
#pragma unroll
            for (int j = 0; j < 8; ++j) { const int cp = c0 + j; float val = 0.f;
                if (s <= t) val += KL[(((t - s)) * 16 + c) * 16 + cp];
                if (s >= t) val += KL[((16 + (s - t)) * 16 + c) * 16 + cp];
                if (s == t && cp == c) val += P.dsk[l * 1024 + g * 16 + c];
                v[j] = val; } }
        else { const int kk = k8 - 256, d = kk >> 7, im = (kk >> 6) & 1, n0 = kk & 63, jp = (d == 0) ? t + 1 : 16 - t;
#pragma unroll
            for (int j = 0; j < 8; ++j) { const int n = n0 + j; const float wr = AP[((d * 17 + jp) * 64 + n) * 2], wi = AP[((d * 17 + jp) * 64 + n) * 2 + 1], c_r = CC[((d * 16 + c) * 64 + n) * 2], c_i = CC[((d * 16 + c) * 64 + n) * 2 + 1];
                v[j] = im ? -(c_r * wi + c_i * wr) : (c_r * wr - c_i * wi); } }
        *(u32x4*)(WYt + ((size_t)g * 256 + row) * 512 + k8) = pack8(v); }
    for (int e = tid; e < 2 * 128 * 32; e += 512) { const int d = e >> 12, row = (e >> 5) & 127, k8 = (e & 31) * 8, im = row >> 6, n = row & 63, s = k8 >> 4, c0 = k8 & 15, ex = (d == 0) ? 15 - s : s; float v[8];
        const float wr = AP[((d * 17 + ex) * 64 + n) * 2], wi = AP[((d * 17 + ex) * 64 + n) * 2 + 1];
#pragma unroll
        for (int j = 0; j < 8; ++j) { const float b_r = BB[((d * 64 + n) * 16 + c0 + j) * 2], b_i = BB[((d * 64 + n) * 16 + c0 + j) * 2 + 1]; v[j] = im ? (wr * b_i + wi * b_r) : (wr * b_r - wi * b_i); }
        *(u32x4*)(WEt + ((size_t)(d * 64 + g) * 128 + row) * 256 + k8) = pack8(v); }
    __syncthreads();
}
__device__ __forceinline__ int s5_chunk_row(int b, int ch) { return ch < 16 ? R_LAT + b * 256 + 16 * ch : b * 4096 + 16 * (ch - 16); }
#define S5_BAR() do { asm volatile("s_waitcnt lgkmcnt(0)" ::: "memory"); __builtin_amdgcn_s_barrier(); asm volatile("" ::: "memory"); } while (0)
__device__ __forceinline__ void s5_main(const S5In& P, int l, const bf16_t* U, const bf16_t* WEt, const bf16_t* WYt, bf16_t* T, LAS unsigned char* lds, int tid) {
    const int lane = tid & 63, w = __builtin_amdgcn_readfirstlane(tid >> 6), fr = lane & 15, q = lane >> 4;
    constexpr int XP = 528;
    LAS unsigned char* XIN = lds; LAS float* ET = (LAS float*)(lds + 272 * XP); LAS unsigned char* UC = lds + 272 * XP + 8192;
    const int uc_chunk = tid >> 5, uc_piece = tid & 31;
    LAS u32x4* uc_dst = (LAS u32x4*)(UC + uc_chunk * XP + uc_piece * 16);
    const LAS unsigned char* uc_a = UC + fr * XP + 16 * q;
#define S5_GLOAD(tile) (*(const u32x4*)(U + (size_t)(s5_chunk_row(b, 16 * (tile) + uc_chunk) + (uc_piece >> 1)) * 1024 + g * 16 + 8 * (uc_piece & 1)))
    const int Gd = (int)gridDim.x, bxi = (int)blockIdx.x, vcu = (Gd % 8 == 0) ? (bxi % 8) * (Gd / 8) + bxi / 8 : bxi;
    for (int item = vcu; item < 512; item += Gd) {
        const int g = item & 63, b = item >> 6;
#pragma unroll 1
        for (int d = 0; d < 2; ++d) {
            bf16x8 bw[8];
            { const bf16_t* wp = WEt + ((size_t)(d * 64 + g) * 128 + 16 * w + fr) * 256 + 8 * q;
#pragma unroll
              for (int kk = 0; kk < 8; ++kk) bw[kk] = *(const bf16x8*)(wp + 32 * kk); }
            float tr = 1.f, ti = 0.f, xr = 0.f, xi = 0.f;
            if (w == 0) { float cr, ci; s5_abar(P, (l * 2 + d) * 64 + g, lane, tr, ti, cr, ci);
#pragma unroll
                for (int k = 0; k < 4; ++k) { const float n_r = tr * tr - ti * ti, n_i = 2.f * tr * ti; tr = n_r; ti = n_i; } }
#define S5_TILE(i) (((d == 0) || (i) == 0) ? (i) : 17 - (i))
            u32x4 u0 = S5_GLOAD(S5_TILE(0)), u1 = S5_GLOAD(S5_TILE(1)), u2 = S5_GLOAD(S5_TILE(2)), u3 = S5_GLOAD(S5_TILE(3)), u4 = S5_GLOAD(S5_TILE(4));
            *uc_dst = u0; u0 = u1; u1 = u2; u2 = u3; u3 = u4;
            S5_BAR();
#pragma unroll 1
            for (int i = 0; i < 17; ++i) {
                const int tile = S5_TILE(i);
                f32x4 acc = {0.f, 0.f, 0.f, 0.f};
#pragma unroll
                for (int kk = 0; kk < 8; ++kk) { const bf16x8 af = *(const LAS bf16x8*)(uc_a + 64 * kk); acc = __builtin_amdgcn_mfma_f32_16x16x32_bf16(af, bw[kk], acc, 0, 0, 0); }
#pragma unroll
                for (int r = 0; r < 4; ++r) ET[(4 * q + r) * 128 + 16 * w + fr] = acc[r];
                S5_BAR();
                if (i < 16) { *uc_dst = u0; u0 = u1; u1 = u2; u2 = u3; if (i + 5 <= 16) u3 = S5_GLOAD(S5_TILE(i + 5)); }
                if (w == 0) {
                    float er[16], ei[16];
#pragma unroll
                    for (int c = 0; c < 16; ++c) { er[c] = ET[c * 128 + lane]; ei[c] = ET[c * 128 + 64 + lane]; }
#pragma unroll
                    for (int cc = 0; cc < 16; ++cc) { const int c = d ? 15 - cc : cc;
                        LAS bf16_t* xp = (LAS bf16_t*)(XIN + (16 * tile + c) * XP) + d * 128;
                        xp[lane] = (bf16_t)(pk2(xr, 0.f) & 0xffffu); xp[64 + lane] = (bf16_t)(pk2(xi, 0.f) & 0xffffu);
                        const float nxr = tr * xr - ti * xi + er[c], nxi = tr * xi + ti * xr + ei[c]; xr = nxr; xi = nxi; }
                }
                S5_BAR();
            }
#undef S5_TILE
        }
        {
            bf16x8 by[2][16];
#pragma unroll
            for (int nt = 0; nt < 2; ++nt) { const bf16_t* wp = WYt + ((size_t)g * 256 + 32 * w + 16 * nt + fr) * 512 + 8 * q;
#pragma unroll
                for (int kk = 0; kk < 16; ++kk) by[nt][kk] = *(const bf16x8*)(wp + 32 * kk); }
            u32x4 u0 = S5_GLOAD(0), u1 = S5_GLOAD(1), u2 = S5_GLOAD(2), u3 = S5_GLOAD(3), u4 = S5_GLOAD(4);
            *uc_dst = u0; u0 = u1; u1 = u2; u2 = u3; u3 = u4;
            S5_BAR();
#pragma unroll 1
            for (int tile = 0; tile < 17; ++tile) {
                f32x4 acc0 = {0.f, 0.f, 0.f, 0.f}, acc1 = {0.f, 0.f, 0.f, 0.f};
#pragma unroll
                for (int kk = 0; kk < 8; ++kk) { const bf16x8 af = *(const LAS bf16x8*)(uc_a + 64 * kk);
                    acc0 = __builtin_amdgcn_mfma_f32_16x16x32_bf16(af, by[0][kk], acc0, 0, 0, 0); acc1 = __builtin_amdgcn_mfma_f32_16x16x32_bf16(af, by[1][kk], acc1, 0, 0, 0); }
                const LAS unsigned char* xq = XIN + (16 * tile + fr) * XP + 16 * q;
#pragma unroll
                for (int kk = 0; kk < 8; ++kk) { const bf16x8 xf = *(const LAS bf16x8*)(xq + 64 * kk);
                    acc0 = __builtin_amdgcn_mfma_f32_16x16x32_bf16(xf, by[0][8 + kk], acc0, 0, 0, 0); acc1 = __builtin_amdgcn_mfma_f32_16x16x32_bf16(xf, by[1][8 + kk], acc1, 0, 0, 0); }
                S5_BAR();
                if (tile < 16) { *uc_dst = u0; u0 = u1; u1 = u2; u2 = u3; if (tile + 5 <= 16) u3 = S5_GLOAD(tile + 5); }
#pragma unroll
                for (int r = 0; r < 4; ++r) { const int row = s5_chunk_row(b, 16 * tile + 4 * q + r) + 2 * w;
                    T[(size_t)row * 1024 + g * 16 + fr] = (bf16_t)(pk2(gelu_tanh(acc0[r]), 0.f) & 0xffffu);
                    T[(size_t)(row + 1) * 1024 + g * 16 + fr] = (bf16_t)(pk2(gelu_tanh(acc1[r]), 0.f) & 0xffffu); }
                S5_BAR();
            }
        }
    }
#undef S5_GLOAD
#undef S5_BAR
}
__device__ __forceinline__ s16x4 vtr(const LAS unsigned char* p) { return __builtin_bit_cast(s16x4, __builtin_amdgcn_ds_read_tr16_b64_v4i16((LAS s16x4*)p)); }
__device__ __forceinline__ void attn_phase(LAS unsigned char* lds, const bf16_t* Q, const bf16_t* KV, const bf16_t* CQ, bf16_t* O, const int tid, const int nunits) {
    const int lane = tid & 63, wid = __builtin_amdgcn_readfirstlane(tid >> 6), r32 = lane & 31, hi = lane >> 5;
    constexpr int KP = 400, VP = 320, BUFB = 64 * KP + 64 * VP;
    const float C = 0.07216878364870322f * 1.4426950408889634f;
    const int kn_row = tid >> 4, kn_ch = tid & 15, kr_row = tid >> 3, kr_ch = tid & 7;
    const int Gd = (int)gridDim.x, bxi = (int)blockIdx.x, vcu = (Gd % 8 == 0) ? (bxi % 8) * (Gd / 8) + bxi / 8 : bxi;
    for (int ui = 0;; ++ui) {
        const int unit = ui * (int)gridDim.x + vcu; if (unit >= nunits) break;
        int b, h, qb;
        if (unit < 1024) { const int bh = unit >> 4; qb = unit & 15; b = bh >> 3; h = bh & 7; } else { const int bh = unit - 1024; qb = 16; b = bh >> 3; h = bh & 7; }
        const int qrow0 = (qb < 16) ? b * 4096 + qb * 256 : R_LAT + b * 256;
        const int NT = (qb < 16) ? 68 : 4;
        const bf16_t* qp = Q + (size_t)(qrow0 + wid * 32 + r32) * 1536;
        bf16x8 qf[12];
#pragma unroll
        for (int s = 0; s < 8; ++s) qf[s] = *(const bf16x8*)(qp + h * 128 + 16 * s + 8 * hi);
#pragma unroll
        for (int s = 0; s < 4; ++s) qf[8 + s] = *(const bf16x8*)(qp + 1024 + h * 64 + 16 * s + 8 * hi);
        u32x4 sk0, sk1, skr, sv0, sv1;
#define ATT_KROW(t) ((qb < 16) ? (((t) < 64) ? b * 4096 + (t) * 64 : R_LAT + b * 256 + ((t) - 64) * 64) : R_LAT + b * 256 + (t) * 64)
#define ATT_LOAD(t) do { const int kr0_ = ATT_KROW(t); const bf16_t* kvp_ = KV + (size_t)(kr0_ + kn_row) * 2048 + h * 256 + kn_ch * 8; \
        sk0 = *(const u32x4*)kvp_; sk1 = *(const u32x4*)(kvp_ + 32 * 2048); sv0 = *(const u32x4*)(kvp_ + 128); sv1 = *(const u32x4*)(kvp_ + 128 + 32 * 2048); \
        skr = *(const u32x4*)(CQ + (size_t)(kr0_ + kr_row) * 768 + 512 + kr_ch * 8); } while (0)
#define ATT_STORE(buf) do { LAS unsigned char* kb_ = lds + (buf) * BUFB; LAS unsigned char* vb_ = kb_ + 64 * KP; \
        *(LAS u32x4*)(kb_ + kn_row * KP + kn_ch * 16) = sk0; *(LAS u32x4*)(kb_ + (kn_row + 32) * KP + kn_ch * 16) = sk1; *(LAS u32x4*)(kb_ + kr_row * KP + 256 + kr_ch * 16) = skr; \
        *(LAS u32x4*)(vb_ + kn_row * VP + kn_ch * 16) = sv0; *(LAS u32x4*)(vb_ + (kn_row + 32) * VP + kn_ch * 16) = sv1; } while (0)
        ATT_LOAD(0); ATT_STORE(0);
        __syncthreads();
        float mrun = -1e30f, lrun = 0.f;
        f32x16 o[4];
#pragma unroll
        for (int d = 0; d < 4; ++d)
#pragma unroll
            for (int r = 0; r < 16; ++r) o[d][r] = 0.f;
        for (int t = 0; t < NT; ++t) {
            const int cur = t & 1;
            if (t + 1 < NT) ATT_LOAD(t + 1);
            f32x16 p0, p1;
#pragma unroll
            for (int r = 0; r < 16; ++r) { p0[r] = 0.f; p1[r] = 0.f; }
            __builtin_amdgcn_s_setprio(1);
            { const LAS unsigned char* kb = lds + cur * BUFB + r32 * KP + hi * 16;
#pragma unroll
              for (int g3 = 0; g3 < 3; ++g3) { bf16x8 k0[4], k1[4];
#pragma unroll
                  for (int j = 0; j < 4; ++j) { k0[j] = *(const LAS bf16x8*)(kb + (4 * g3 + j) * 32); k1[j] = *(const LAS bf16x8*)(kb + 32 * KP + (4 * g3 + j) * 32); }
                  __builtin_amdgcn_sched_barrier(0);
#pragma unroll
                  for (int j = 0; j < 4; ++j) { p0 = __builtin_amdgcn_mfma_f32_32x32x16_bf16(k0[j], qf[4 * g3 + j], p0, 0, 0, 0); p1 = __builtin_amdgcn_mfma_f32_32x32x16_bf16(k1[j], qf[4 * g3 + j], p1, 0, 0, 0); }
                  __builtin_amdgcn_sched_barrier(0); } }
            __builtin_amdgcn_s_setprio(0);
            float mx = p0[0];
#pragma unroll
            for (int r = 0; r < 16; ++r) { mx = fmaxf(mx, p0[r]); mx = fmaxf(mx, p1[r]); }
            mx = fmaxf(mx, __shfl_xor(mx, 32)) * C;
            if (__any(mx > mrun + 8.0f)) {
                const float mn = fmaxf(mrun, mx), alpha = __builtin_amdgcn_exp2f(mrun - mn); mrun = mn; lrun *= alpha;
#pragma unroll
                for (int d = 0; d < 4; ++d)
#pragma unroll
                    for (int r = 0; r < 16; ++r) o[d][r] *= alpha;
            }
            float rsum = 0.f;
#pragma unroll
            for (int r = 0; r < 16; ++r) { p0[r] = __builtin_amdgcn_exp2f(p0[r] * C - mrun); p1[r] = __builtin_amdgcn_exp2f(p1[r] * C - mrun); rsum += p0[r] + p1[r]; }
            lrun += rsum;
            bf16x8 pf[4];
            { u32x4 w;
              w.x = pk2(p0[0], p0[1]); w.y = pk2(p0[2], p0[3]); w.z = pk2(p0[4], p0[5]); w.w = pk2(p0[6], p0[7]); pf[0] = __builtin_bit_cast(bf16x8, w);
              w.x = pk2(p0[8], p0[9]); w.y = pk2(p0[10], p0[11]); w.z = pk2(p0[12], p0[13]); w.w = pk2(p0[14], p0[15]); pf[1] = __builtin_bit_cast(bf16x8, w);
              w.x = pk2(p1[0], p1[1]); w.y = pk2(p1[2], p1[3]); w.z = pk2(p1[4], p1[5]); w.w = pk2(p1[6], p1[7]); pf[2] = __builtin_bit_cast(bf16x8, w);
              w.x = pk2(p1[8], p1[9]); w.y = pk2(p1[10], p1[11]); w.z = pk2(p1[12], p1[13]); w.w = pk2(p1[14], p1[15]); pf[3] = __builtin_bit_cast(bf16x8, w); }
            __builtin_amdgcn_s_setprio(1);
            { const LAS unsigned char* vb = lds + cur * BUFB + 64 * KP + (4 * hi + ((lane & 15) >> 2)) * VP + (16 * ((lane >> 4) & 1) + 4 * (lane & 3)) * 2;
#pragma unroll
              for (int s2 = 0; s2 < 2; ++s2) { s16x4 lo[8], hh[8];
#pragma unroll
                  for (int i = 0; i < 8; ++i) { const int s = 2 * s2 + (i >> 2), d = i & 3; lo[i] = vtr(vb + s * 16 * VP + d * 64); hh[i] = vtr(vb + s * 16 * VP + 8 * VP + d * 64); }
                  __builtin_amdgcn_sched_barrier(0);
#pragma unroll
                  for (int i = 0; i < 8; ++i) { const int s = 2 * s2 + (i >> 2), d = i & 3;
                      const bf16x8 vf = (bf16x8){lo[i][0], lo[i][1], lo[i][2], lo[i][3], hh[i][0], hh[i][1], hh[i][2], hh[i][3]};
                      o[d] = __builtin_amdgcn_mfma_f32_32x32x16_bf16(vf, pf[s], o[d], 0, 0, 0); }
                  __builtin_amdgcn_sched_barrier(0); } }
            __builtin_amdgcn_s_setprio(0);
            if (t + 1 < NT) ATT_STORE(cur ^ 1);
            __syncthreads();
        }
        const float inv = 1.0f / (lrun + __shfl_xor(lrun, 32));
        bf16_t* op = O + (size_t)(qrow0 + wid * 32 + r32) * 1024 + h * 128;
#pragma unroll
        for (int d = 0; d < 4; ++d)
#pragma unroll
            for (int i4 = 0; i4 < 4; ++i4) { u32x2 w; w.x = pk2(o[d][4 * i4] * inv, o[d][4 * i4 + 1] * inv); w.y = pk2(o[d][4 * i4 + 2] * inv, o[d][4 * i4 + 3] * inv);
                *(u32x2*)(op + 32 * d + 8 * i4 + 4 * hi) = w; }
    }
#undef ATT_KROW
#undef ATT_LOAD
#undef ATT_STORE
}
#define XB_TMO      128
#define XB_XCNT(j)  (256  + 64 * (j))
#define XB_XSUB(j)  (1280 + 64 * (j))
#define XB_XGEN(j)  (2304 + 64 * (j))
#define XB_TOP      3328
#define XB_TOPGEN   3392
#define XCD_BAR_WORDS 3456
#define XB_SPIN_CAP (1u << 18)

__device__ __forceinline__ unsigned xb_ld(unsigned* p)              { return __hip_atomic_load(p, __ATOMIC_RELAXED, __HIP_MEMORY_SCOPE_AGENT); }
__device__ __forceinline__ unsigned xb_add(unsigned* p, unsigned v) { return __hip_atomic_fetch_add(p, v, __ATOMIC_RELAXED, __HIP_MEMORY_SCOPE_AGENT); }
__device__ __forceinline__ unsigned xb_xcc_id() { return (unsigned)__builtin_amdgcn_s_getreg((3 << 11) | 20) & 0xFu; }
#define XB_SPIN(cond, bar) do { unsigned _sp = 0; while (cond) { __builtin_amdgcn_s_sleep(1); \
    if ((++_sp & 255u) == 0u) { if (xb_ld(&(bar)[XB_TMO])) break; if (_sp > XB_SPIN_CAP) { atomicAdd(&(bar)[XB_TMO], 1u); break; } } } } while (0)

struct XcdBarrier {
    unsigned* bar; unsigned x;
    volatile LAS unsigned* st;
};

__device__ __forceinline__ XcdBarrier xcd_barrier_post(unsigned* bar, volatile LAS unsigned* st) {
    XcdBarrier b; b.bar = bar; b.x = xb_xcc_id(); b.st = st;
    if (threadIdx.x == 0) (void)xb_add(&bar[XB_XCNT(b.x)], 1u);
    return b;
}
__device__ __forceinline__ void xcd_barrier_complete(unsigned* bar, unsigned x, unsigned& nloc, unsigned& nx) {
    const unsigned G = gridDim.x * gridDim.y * gridDim.z;
    unsigned sum, cnt, mine, sp = 0u;
    for (;;) {
        sum = 0u; cnt = 0u; mine = 0u;
#pragma unroll
        for (unsigned j = 0; j < 16; ++j) { const unsigned c = xb_ld(&bar[XB_XCNT(j)]); sum += c; cnt += (c > 0u) ? 1u : 0u; mine = (j == x) ? c : mine; }
        if (sum == G) break;
        __builtin_amdgcn_s_sleep(1);
        if ((++sp & 255u) == 0u) { if (xb_ld(&bar[XB_TMO])) break; if (sp > XB_SPIN_CAP) { atomicAdd(&bar[XB_TMO], 1u); break; } }
    }
    nloc = mine > 0u ? mine : 1u; nx = cnt > 0u ? cnt : 1u;
}

__device__ __forceinline__ void xcd_barrier(const XcdBarrier& b) {
    asm volatile("s_waitcnt vmcnt(0)" ::: "memory");
    __syncthreads();
    if (threadIdx.x == 0) {
        unsigned* bar = b.bar;
        __builtin_amdgcn_s_waitcnt(0);
        unsigned nloc = b.st[0], nx = b.st[1];
        if (nloc == 0u) { xcd_barrier_complete(bar, b.x, nloc, nx); b.st[0] = nloc; b.st[1] = nx; }
        const unsigned old = xb_add(&bar[XB_XSUB(b.x)], 1u);
        const unsigned gen = old / nloc;
        if (old + 1u == (gen + 1u) * nloc) {
            __builtin_amdgcn_fence(__ATOMIC_RELEASE, "agent");
            asm volatile("s_waitcnt vmcnt(0)" ::: "memory");
            const unsigned og = xb_add(&bar[XB_TOP], 1u);
            const unsigned tg = og / nx;
            if (og + 1u == (tg + 1u) * nx) xb_add(&bar[XB_TOPGEN], 1u);
            else XB_SPIN(xb_ld(&bar[XB_TOPGEN]) == tg, bar);
            __builtin_amdgcn_fence(__ATOMIC_ACQUIRE, "agent");
            xb_add(&bar[XB_XGEN(b.x)], 1u);
            asm volatile("s_waitcnt vmcnt(0)" ::: "memory");
        } else {
            XB_SPIN(xb_ld(&bar[XB_XGEN(b.x)]) == gen, bar);
            __builtin_amdgcn_fence(__ATOMIC_ACQUIRE, "agent");
            asm volatile("s_waitcnt vmcnt(0)" ::: "memory");
        }
    }
    __syncthreads();
}

#define DERIVE_PTRS float* MOD = (float*)(ws + WS_MOD); float* ROPE = (float*)(ws + WS_ROPE); float* YSS = (float*)(ws + WS_YSS); float* CSS = (float*)(ws + WS_CSS); bf16_t* WEt = (bf16_t*)(ws + WS_S5E); bf16_t* WYt = (bf16_t*)(ws + WS_S5E + S5_WE_BYTES); float* XC = (float*)(ws + WS_XC); bf16_t* WL = (bf16_t*)(ws + WS_WL); bf16_t* H = (bf16_t*)(ws + WS_H); unsigned char* big = ws + WS_BIG; bf16_t* CQ = (bf16_t*)(big + B_CQ); bf16_t* U = (bf16_t*)(big + B_U); bf16_t* Qb = (bf16_t*)(big + B_Q); bf16_t* KVb = (bf16_t*)(big + B_KV); bf16_t* SG = (bf16_t*)(big + B_SG); bf16_t* ACT = (bf16_t*)(big + B_ACT); bf16_t* Y = (bf16_t*)(big + B_Y); bf16_t* T = (bf16_t*)(big + B_T); bf16_t* Gb = (bf16_t*)(big + B_G); bf16_t* Mb = (bf16_t*)(big + B_M); bf16_t* Ob = H;
constexpr int PPL = 13;
constexpr int NSTEPS = 2 + PPL * DEPTH;
struct Args { const float* in[29]; float* out; unsigned char* ws; int ph_lo, ph_hi; };
__global__ void __launch_bounds__(512, 2) mk_fwd(Args a) {
    extern __shared__ __attribute__((aligned(16))) unsigned char lds_raw[];
    cg::grid_group grid = cg::this_grid();
    LAS unsigned char* lds = (LAS unsigned char*)lds_raw;
    const int G = gridDim.x, NGW = G * 8;
    volatile LAS unsigned* xst = (volatile LAS unsigned*)(lds + LDS_BYTES - 64);
    if (threadIdx.x < 2) xst[threadIdx.x] = 0u;
    __syncthreads();
    XcdBarrier xbar; xbar.bar = (unsigned*)(a.ws + WS_CTL); xbar.x = 0; xbar.st = xst;
    if (a.ph_hi - a.ph_lo > 1) xbar = xcd_barrier_post((unsigned*)(a.ws + WS_CTL), xst);
    WPtrs WP{a.in[8], a.in[9], a.in[10], a.in[11], a.in[12], a.in[13], a.in[14], a.in[15], a.in[16], a.in[25], a.in[27], a.in[28]};
    S5In SP{a.in[17], a.in[18], a.in[19], a.in[20], a.in[21], a.in[22], a.in[23], a.in[24]};
#if MK_TIME >= 0
    unsigned long long tacc = 0ull;
#endif
#pragma unroll 1
    for (int step = a.ph_lo; step < a.ph_hi; ++step) {
#if MK_TIME >= 0
        const unsigned long long tph0 = __builtin_amdgcn_s_memrealtime();
#endif
        int tid = threadIdx.x; asm volatile("" : "+v"(tid));
        const int lane = tid & 63, wave = __builtin_amdgcn_readfirstlane(tid >> 6), gw = blockIdx.x * 8 + wave;
        unsigned char* ws = a.ws; asm volatile("" : "+s"(ws));
        DERIVE_PTRS
        int l = 0, p = -1;
        if (step >= 2) { l = (step - 2) / PPL; p = (step - 2) % PPL; if (p >= 6) ++p; }
        if (step == 0) mods_phase(a.in[1], a.in[3], a.in[4], a.in[5], MOD, ROPE, lds, tid);
        if (step == 0) conv_layer(WP, 0, WL, lds, gw, NGW, wave, lane, 0, 12864);
#if MK_PROBE == 9
        if (step == 0) { __syncthreads(); mods_phase(a.in[1], a.in[3], a.in[4], a.in[5], MOD, ROPE, lds, tid); conv_layer(WP, 0, WL, lds, gw, NGW, wave, lane, 0, 12864); }
#endif
        if (p == 13 && l < DEPTH - 1) conv_layer(WP, l + 1, WL, lds, gw, NGW, wave, lane, 7040, 8448);
        if (step == 1 || p == 2 || p == 10 || p == 13) {
            int s, nl, ns;
            if (step == 1) { s = -1; nl = 0; ns = 0; } else if (p == 2) { s = 0; nl = l; ns = 1; } else if (p == 10) { s = 1; nl = l; ns = 2; } else { s = 2; nl = (l < DEPTH - 1) ? l + 1 : -1; ns = 0; }
            e_phase(a.in[0], a.in[2], a.out, XC, Y, YSS, MOD, a.in[6], a.in[7], H, l, s, nl, ns, gw, NGW, lane, 1.0f, (l == DEPTH - 1 && p >= 10) ? R_LAT : R);
#if MK_PROBE == 5
            if (s >= 0) { __syncthreads(); e_phase(a.in[0], a.in[2], a.out, XC, Y, YSS, MOD, a.in[6], a.in[7], H, l, s, nl, ns, gw, NGW, lane, 0.0f, R); }
#endif
        }
        if (p == 0 || p == 1 || p == 3 || p == 4 || p == 7 || p == 8 || p == 9 || p == 11 || p == 12) {
            const int ng = (p == 4 || p == 7) ? 2 : 1;
#pragma unroll 1
            for (int gi = 0; gi < ng; ++gi) {
                pg8::Gemm g; Epi E; E.o0 = nullptr; E.o1 = nullptr; E.o2 = nullptr; E.i0 = nullptr; E.i1 = nullptr; E.ss = nullptr; E.css = CSS; E.bias = nullptr; E.rope = ROPE; E.mode = 0;
                g.M = R;
                if (p == 0 || p == 11) { g.A = H; g.Bt = WL + (p == 0 ? W_GUA : W_GUB); g.N = 5632; g.K = 1024; g.lda = 1024; E.mode = 0; E.o0 = ACT; }
                else if (p == 1 || p == 12) { g.A = ACT; g.Bt = WL + (p == 1 ? W_DA : W_DB); g.N = 1024; g.K = FF; g.lda = FF; E.mode = 1; E.o0 = Y; E.ss = YSS; }
                else if (p == 3) { g.A = H; g.Bt = WL + W_IN; g.N = 3840; g.K = 1024; g.lda = 1024; E.mode = 2; E.o0 = CQ; E.o1 = U; E.o2 = SG; E.ss = CSS; }
                else if (p == 4 && gi == 0) { g.A = CQ; g.Bt = WL + W_UQ; g.N = 1536; g.K = 256; g.lda = 768; E.mode = 3; E.o0 = Qb; }
                else if (p == 4) { g.A = CQ + 256; g.Bt = WL + W_UKV; g.N = 2048; g.K = 256; g.lda = 768; E.mode = 4; E.o0 = KVb; }
                else if (p == 7 && gi == 0) { g.A = T; g.Bt = WL + W_GLU; g.N = 1024; g.K = 1024; g.lda = 1024; E.mode = 5; E.o0 = Gb; E.i0 = T; E.bias = a.in[26] + l * 1024; }
                else if (p == 7) { g.A = Ob; g.Bt = WL + W_OMLA; g.N = 1024; g.K = 1024; g.lda = 1024; E.mode = 6; E.o0 = Mb; E.i0 = SG; }
                else if (p == 8) { g.A = Gb; g.Bt = WL + W_OS5; g.N = 1024; g.K = 1024; g.lda = 1024; E.mode = 7; E.o0 = Mb; E.i0 = Mb; E.i1 = SG + 1024; }
                else { g.A = Mb; g.Bt = WL + W_OUT; g.N = 1024; g.K = 1024; g.lda = 1024; E.mode = 1; E.o0 = Y; E.ss = YSS; }
                const int Mrows = (l == DEPTH - 1 && (p >= 7 || (p == 4 && gi == 0))) ? R_LAT : R;
                pg8::StaticOrder S; S.init(Mrows, g.N, G, (gi == 0) ? (int)blockIdx.x : (int)((blockIdx.x + (G >> 1)) % G));
                pg8::gemm_phase<Epi, pg8::StaticOrder, true, true>(lds, g, S, E, tid);
#if MK_PROBE == 3 || MK_PROBE == 6 || MK_PROBE == 7 || MK_PROBE == 8 || MK_PROBE == 10
                if ((MK_PROBE == 3 && (p == 0 || p == 11)) || (MK_PROBE == 6 && p == 9) || (MK_PROBE == 7 && (p == 1 || p == 12)) || (MK_PROBE == 8 && p == 4) || (MK_PROBE == 10 && p == 3)) { __syncthreads(); pg8::gemm_phase<Epi, pg8::StaticOrder, true, true>(lds, g, S, E, tid); }
#endif
            }
        }
        if (p == 4) {
#pragma unroll 1
            for (int rep = 0; rep < (MK_PROBE == 2 ? 2 : 1); ++rep) s5_main(SP, l, U, WEt, WYt, T, lds, tid); }
        if (G == 256) {
            const int bx = blockIdx.x;
            if (p == 1 && bx >= 32 && bx < 96) s5_prep(SP, l, bx - 32, WEt, WYt, lds, tid);
            if (l < DEPTH - 1 && bx >= 32) {
                const int vgw = (bx - 32) * 8 + wave, VNGW = 224 * 8;
                if (p == 7 && (bx < 128 || bx >= 160)) { const int v7 = ((bx < 128) ? bx - 32 : bx - 64) * 8 + wave;
                    conv_layer(WP, l + 1, WL, lds, v7, 192 * 8, wave, lane, 0, 2816); conv_layer(WP, l + 1, WL, lds, v7, 192 * 8, wave, lane, 5632, 7040); }
                if (p == 8) { conv_layer(WP, l + 1, WL, lds, vgw, VNGW, wave, lane, 8448, 11840); }
                if (p == 9) { conv_layer(WP, l + 1, WL, lds, vgw, VNGW, wave, lane, 11840, 12352); }
                if (p == 12) { conv_layer(WP, l + 1, WL, lds, vgw, VNGW, wave, lane, 12352, 12864); conv_layer(WP, l + 1, WL, lds, vgw, VNGW, wave, lane, 2816, 5632); }
            }
        }
        if (G != 256) {
            if (p == 2 && blockIdx.x < 64) s5_prep(SP, l, blockIdx.x, WEt, WYt, lds, tid);
            if (p == 13 && l < DEPTH - 1) { conv_layer(WP, l + 1, WL, lds, gw, NGW, wave, lane, 0, 7040); conv_layer(WP, l + 1, WL, lds, gw, NGW, wave, lane, 8448, 12864); }
        }
        if (p == 5) {
#pragma unroll 1
            for (int rep = 0; rep < (MK_PROBE == 1 ? 2 : 1); ++rep) attn_phase(lds, Qb, KVb, CQ, Ob, tid, (l == DEPTH - 1) ? 1024 : 1024 + 64); }
#if MK_TIME >= 0
        const unsigned long long tb0 = __builtin_amdgcn_s_memrealtime();
#endif
        if (step + 1 < a.ph_hi) {
            if (step == a.ph_lo) grid.sync(); else xcd_barrier(xbar);
#if MK_PROBE == 4
            xcd_barrier(xbar); xcd_barrier(xbar);
#endif
        }
#if MK_TIME >= 0
        { const unsigned long long tb1 = __builtin_amdgcn_s_memrealtime();
          const int cls = (step == 0) ? 10 : (step == 1 || p == 2 || p == 10 || p == 13) ? 2 : (p == 0 || p == 11) ? 0 : (p == 1 || p == 12) ? 1 : (p == 3) ? 3 : (p == 4) ? 4 : (p == 5) ? 5 : (p == 7) ? 6 : (p == 8) ? 7 : 8;
          if (MK_TIME == 99) tacc += tb1 - tb0; else if (cls == MK_TIME) tacc += tb1 - tph0; }
#endif
    }
#if MK_TIME >= 0
    if (blockIdx.x == MK_TIME_BLOCK) { const unsigned long long te = __builtin_amdgcn_s_memrealtime(); while (__builtin_amdgcn_s_memrealtime() - te < tacc) __builtin_amdgcn_s_sleep(16); }
#endif
}

extern "C" void kernel_launch(void* const* d_in, const int* in_sizes, int n_in, void* d_out, int out_size, void* d_ws, size_t ws_size, hipStream_t stream) {
    static int grid = 0;
    if (grid == 0) {
        if (n_in != 29 || out_size != R_LAT * DM || ws_size < WS_END) { fprintf(stderr, "kernel_launch: unexpected problem (n_in %d out %d ws %zu need %zu)\n", n_in, out_size, ws_size, (size_t)WS_END); grid = -1; return; }
        int dev = 0, cus = 0, per_cu = 0;
        if (hipGetDevice(&dev) != hipSuccess || hipDeviceGetAttribute(&cus, hipDeviceAttributeMultiprocessorCount, dev) != hipSuccess) { grid = -1; return; }
        if (hipFuncSetAttribute((const void*)mk_fwd, hipFuncAttributeMaxDynamicSharedMemorySize, LDS_BYTES) != hipSuccess) { fprintf(stderr, "kernel_launch: hipFuncSetAttribute failed\n"); grid = -1; return; }
        if (hipOccupancyMaxActiveBlocksPerMultiprocessor(&per_cu, (const void*)mk_fwd, 512, LDS_BYTES) != hipSuccess || per_cu < 1) { fprintf(stderr, "kernel_launch: occupancy query says %d\n", per_cu); per_cu = 1; }
        (void)hipGetLastError();
        grid = cus * 1;
    }
    if (grid < 0) return;
    if (hipMemsetAsync((char*)d_ws + WS_CTL, 0, CTL_BYTES, stream) != hipSuccess) { fprintf(stderr, "kernel_launch: memset failed\n"); return; }
    Args a{};
    for (int i = 0; i < 29; ++i) a.in[i] = (const float*)d_in[i];
    a.out = (float*)d_out; a.ws = (unsigned char*)d_ws;
#if MK_MULTI
    for (int s = 0; s < NSTEPS; ++s) { a.ph_lo = s; a.ph_hi = s + 1; void* args[] = {&a};
        hipError_t e = hipLaunchCooperativeKernel((const void*)mk_fwd, dim3(grid), dim3(512), args, LDS_BYTES, stream);
        if (e != hipSuccess) { fprintf(stderr, "cooperative launch %d failed: %s\n", s, hipGetErrorString(e)); break; } }
#else
    a.ph_lo = 0; a.ph_hi = NSTEPS; void* args[] = {&a};
    hipError_t e = hipLaunchCooperativeKernel((const void*)mk_fwd, dim3(grid), dim3(512), args, LDS_BYTES, stream);
    if (e != hipSuccess) fprintf(stderr, "cooperative launch failed: %s (grid %d)\n", hipGetErrorString(e), grid);
#endif
}
```

```cpp
#include <hip/hip_runtime.h>
#include <hip/hip_cooperative_groups.h>
#include <cstdio>
#include <cstdint>
namespace cg = cooperative_groups;
#ifndef MK_MULTI
#define MK_MULTI 0
#endif
#ifndef MK_PROBE
#define MK_PROBE 0
#endif
#ifndef MK_TIME
#define MK_TIME -1
#endif
#ifndef MK_TIME_BLOCK
#define MK_TIME_BLOCK 128
#endif
namespace pg8 {
#define PG8_LAS __attribute__((address_space(3)))
typedef unsigned short bf16_t;
typedef short bf16x8 __attribute__((ext_vector_type(8)));
typedef float f32x4 __attribute__((ext_vector_type(4)));
typedef unsigned u32x4 __attribute__((ext_vector_type(4)));
constexpr int BM = 256, BK = 64, HALF = 128, HTB = HALF * BK * 2  , STAGE_BYTES = 8 * HTB, NXCD = 8, WGM = 8;

__host__ __device__ __forceinline__ int lds_byte(int r, int c) { const int st = (r >> 4) * 2 + (c >> 5), rr = r & 15, cc = c & 31, ob = rr * 64 + cc * 2; return st * 1024 + (ob ^ (((ob >> 9) & 1) << 5)); }
__host__ __device__ __forceinline__ void stage_rc(int b, int& R, int& C) { const int st = b / 1024, sb = b % 1024, swz = sb ^ (((sb >> 9) & 1) << 5); R = (st >> 1) * 16 + swz / 64; C = (st & 1) * 32 + (swz % 64) / 2; }
__host__ __device__ __forceinline__ int perm32(int rho) { const int n = rho >> 4, i = rho & 15; return 8 * (i >> 2) + 4 * n + (i & 3); }

struct Unit { int pm, pn; };
struct Gemm { const bf16_t* A; const bf16_t* Bt; int M, N, K, lda; };

struct StaticOrder {
    int nM, nN, nwg, G, c;
    __host__ __device__ void init(int M, int N, int G_, int c_) { nM = M / BM; nN = N / BM; nwg = nM * nN; G = G_; c = c_; }
    __host__ __device__ bool next(int i, Unit& u) const {
        const long L = (long)i * G + c; if (L >= nwg) return false;
        int wgid = (int)L; { const int q = nwg / NXCD, r = nwg % NXCD, xcd = wgid % NXCD, off = wgid / NXCD; wgid = (xcd < r ? xcd * (q + 1) : r * (q + 1) + (xcd - r) * q) + off; }
        const int nig = WGM * nN, gid = wgid / nig, fm = gid * WGM, gsz = (nM - fm) < WGM ? (nM - fm) : WGM;
        u.pm = fm + ((wgid % nig) % gsz); u.pn = (wgid % nig) / gsz; return true;
    }
    __device__ __forceinline__ void a_ready(const Unit&) const {}
    __device__ __forceinline__ void done(const Unit&) const {}
};

__device__ __forceinline__ unsigned cvt_pk_bf16(float lo, float hi) { unsigned r; asm volatile("v_cvt_pk_bf16_f32 %0, %1, %2" : "=v"(r) : "v"(lo), "v"(hi)); return r; }
template <class Epi, class Sched, bool ALIGN_EPI = false, bool SP2 = false>
__device__ __forceinline__ void gemm_phase(PG8_LAS unsigned char* lds, const Gemm g, const Sched& S, const Epi& E, const int tid) {
    const int wid = __builtin_amdgcn_readfirstlane(tid >> 6), lane = tid & 63, wr = wid >> 2, wc = wid & 3, fr = lane & 15, fq = lane >> 4;
    const int K = g.K, nt = K / BK;
    unsigned voffA[2], voffB[2];
#pragma unroll
    for (int i = 0; i < 2; ++i) { int R, C; stage_rc(tid * 16 + i * 8192, R, C); const int Rb = Epi::PERM ? ((R & ~31) + perm32(R & 31)) : R;
        voffA[i] = (unsigned)(R * g.lda + C) * 2u; voffB[i] = (unsigned)(Rb * K + C) * 2u; }
    const size_t kstep = (size_t)(BK * 2);
    const size_t hstep = (size_t)HALF * K * 2;
    const size_t tstep = 2 * hstep; const size_t hstepA = (size_t)HALF * g.lda * 2, tstepA = 2 * hstepA;
    const unsigned ldsw = (unsigned)wid * 1024u;
    const int aoff = lds_byte(wr * 64 + fr, fq * 8), boff = lds_byte(wc * 32 + fr, fq * 8);
#define PG8_SA(b, h) (((b) * 2 + (h)) * HTB)
#define PG8_SB(b, h) ((4 + (b) * 2 + (h)) * HTB)
#define PG8_STAGE(bufoff, gbase, voff) do { _Pragma("unroll") for (int _i = 0; _i < 2; ++_i) \
        __builtin_amdgcn_global_load_lds((const unsigned*)((const char*)(gbase) + (voff)[_i]), (PG8_LAS unsigned*)(lds + (bufoff) + ldsw + _i * 8192), 16, 0, 0); } while (0)
#define PG8_LDA(dst, b, h) do { _Pragma("unroll") for (int m = 0; m < 4; ++m) _Pragma("unroll") for (int k = 0; k < 2; ++k) dst[m][k] = *(const PG8_LAS bf16x8*)(lds + PG8_SA(b, h) + aoff + m * 2048 + k * 1024); } while (0)
#define PG8_LDB(dst, b, h) do { _Pragma("unroll") for (int n = 0; n < 2; ++n) _Pragma("unroll") for (int k = 0; k < 2; ++k) dst[n][k] = *(const PG8_LAS bf16x8*)(lds + PG8_SB(b, h) + boff + n * 2048 + k * 1024); } while (0)
#define PG8_MMA(ai, bj, At, Bt) do { __builtin_amdgcn_s_setprio(1); _Pragma("unroll") for (int m = 0; m < 4; ++m) _Pragma("unroll") for (int n = 0; n < 2; ++n) _Pragma("unroll") for (int k = 0; k < 2; ++k) \
        acc[ai][bj][m][n] = __builtin_amdgcn_mfma_f32_16x16x32_bf16(Bt[n][k], At[m][k], acc[ai][bj][m][n], 0, 0, 0); __builtin_amdgcn_s_setprio(0); } while (0)
#define PG8_WAIT_V(n) asm volatile("s_waitcnt vmcnt(" #n ")" ::: "memory")
#define PG8_WAIT_L(n) asm volatile("s_waitcnt lgkmcnt(" #n ")" ::: "memory")
#define PG8_BAR __builtin_amdgcn_s_barrier()
#define PG8_SCHED __builtin_amdgcn_sched_barrier(0)
    Unit cur, nxt; int ui = 0;
    if (!S.next(0, cur)) return;
    f32x4 acc[2][2][4][2];
#pragma unroll
    for (int a = 0; a < 2; ++a)
#pragma unroll
        for (int b = 0; b < 2; ++b)
#pragma unroll
            for (int m = 0; m < 4; ++m)
#pragma unroll
                for (int n = 0; n < 2; ++n) acc[a][b][m][n] = (f32x4){0.f, 0.f, 0.f, 0.f};
    bf16x8 At[4][2], B0[2][2], B1[2][2];
    const char* cA = (const char*)g.A + (size_t)cur.pm * tstepA; const char* cB = (const char*)g.Bt + (size_t)cur.pn * tstep;
    S.a_ready(cur);
    if constexpr (SP2) {
        PG8_STAGE(PG8_SB(0, 0), cB, voffB); PG8_STAGE(PG8_SB(0, 1), cB + hstep, voffB); PG8_STAGE(PG8_SA(0, 0), cA, voffA); PG8_STAGE(PG8_SA(0, 1), cA + hstepA, voffA);
        if (wr == 1) PG8_BAR;
        PG8_WAIT_V(2); PG8_BAR;
        PG8_STAGE(PG8_SB(1, 0), cB + kstep, voffB); PG8_STAGE(PG8_SA(1, 0), cA + kstep, voffA); PG8_STAGE(PG8_SB(1, 1), cB + hstep + kstep, voffB);
        PG8_WAIT_V(6); PG8_BAR;
    } else {
        PG8_STAGE(PG8_SB(0, 0), cB, voffB); PG8_STAGE(PG8_SA(0, 0), cA, voffA); PG8_STAGE(PG8_SB(0, 1), cB + hstep, voffB); PG8_STAGE(PG8_SA(0, 1), cA + hstepA, voffA);
        if (wr == 1) PG8_BAR;
        PG8_WAIT_V(4); PG8_BAR;
        PG8_STAGE(PG8_SB(1, 0), cB + kstep, voffB); PG8_STAGE(PG8_SA(1, 0), cA + kstep, voffA); PG8_STAGE(PG8_SB(1, 1), cB + hstep + kstep, voffB);
        PG8_WAIT_V(6); PG8_BAR;
    }
    for (;;) {
        const bool has_next = S.next(ui + 1, nxt);
        const char* nA = has_next ? (const char*)g.A + (size_t)nxt.pm * tstepA : cA; const char* nB = has_next ? (const char*)g.Bt + (size_t)nxt.pn * tstep : cB;
        for (int t = 0; t < nt; t += 2) {
            const bool last = (t == nt - 2);
            const char* a1 = cA + (size_t)(t + 1) * kstep;
            const char* a2 = last ? nA : cA + (size_t)(t + 2) * kstep; const char* b2 = last ? nB : cB + (size_t)(t + 2) * kstep;
            const char* a3 = a2 + kstep; const char* b3 = b2 + kstep;
            if (last && has_next) S.a_ready(nxt);
            if constexpr (SP2) {
            PG8_LDB(B0, 0, 0); PG8_LDB(B1, 0, 1); PG8_SCHED; PG8_LDA(At, 0, 0); PG8_STAGE(PG8_SA(1, 1), a1 + hstepA, voffA);
            PG8_WAIT_V(8); PG8_WAIT_L(0); PG8_BAR; PG8_MMA(0, 0, At, B0); PG8_MMA(0, 1, At, B1); PG8_BAR; PG8_SCHED;
            PG8_LDA(At, 0, 1); PG8_STAGE(PG8_SB(0, 0), b2, voffB); PG8_STAGE(PG8_SB(0, 1), b2 + hstep, voffB); PG8_STAGE(PG8_SA(0, 0), a2, voffA);
            PG8_WAIT_V(8); PG8_WAIT_L(0); PG8_BAR; PG8_MMA(1, 0, At, B0); PG8_MMA(1, 1, At, B1); PG8_BAR; PG8_SCHED;
            PG8_LDB(B0, 1, 0); PG8_LDB(B1, 1, 1); PG8_SCHED; PG8_LDA(At, 1, 0); PG8_STAGE(PG8_SA(0, 1), a2 + hstepA, voffA);
            PG8_WAIT_V(8); PG8_WAIT_L(0); PG8_BAR; PG8_MMA(0, 0, At, B0); PG8_MMA(0, 1, At, B1); PG8_BAR; PG8_SCHED;
            PG8_LDA(At, 1, 1); PG8_STAGE(PG8_SB(1, 0), b3, voffB); PG8_STAGE(PG8_SB(1, 1), b3 + hstep, voffB); PG8_STAGE(PG8_SA(1, 0), a3, voffA);
            PG8_WAIT_V(8); PG8_WAIT_L(0); PG8_BAR; PG8_MMA(1, 0, At, B0); PG8_MMA(1, 1, At, B1); PG8_BAR; PG8_SCHED;
            } else {
            PG8_LDB(B0, 0, 0); PG8_SCHED; PG8_LDA(At, 0, 0); PG8_STAGE(PG8_SA(1, 1), a1 + hstepA, voffA);
            PG8_WAIT_L(8); PG8_BAR; PG8_WAIT_L(0); PG8_MMA(0, 0, At, B0); PG8_BAR; PG8_SCHED;
            PG8_LDB(B1, 0, 1); PG8_STAGE(PG8_SB(0, 0), b2, voffB);
            PG8_BAR; PG8_WAIT_L(0); PG8_MMA(0, 1, At, B1); PG8_BAR;
            PG8_LDA(At, 0, 1); PG8_STAGE(PG8_SA(0, 0), a2, voffA);
            PG8_BAR; PG8_WAIT_L(0); PG8_MMA(1, 0, At, B0); PG8_BAR; PG8_SCHED;
            PG8_STAGE(PG8_SB(0, 1), b2 + hstep, voffB);
            PG8_WAIT_V(6); PG8_BAR; PG8_MMA(1, 1, At, B1); PG8_BAR;
            PG8_LDB(B0, 1, 0); PG8_SCHED; PG8_LDA(At, 1, 0); PG8_STAGE(PG8_SA(0, 1), a2 + hstepA, voffA);
            PG8_WAIT_L(8); PG8_BAR; PG8_WAIT_L(0); PG8_MMA(0, 0, At, B0); PG8_BAR; PG8_SCHED;
            PG8_LDB(B1, 1, 1); PG8_STAGE(PG8_SB(1, 0), b3, voffB);
            PG8_BAR; PG8_WAIT_L(0); PG8_MMA(0, 1, At, B1); PG8_BAR;
            PG8_LDA(At, 1, 1); PG8_STAGE(PG8_SA(1, 0), a3, voffA);
            PG8_BAR; PG8_WAIT_L(0); PG8_MMA(1, 0, At, B0); PG8_BAR; PG8_SCHED;
            PG8_STAGE(PG8_SB(1, 1), b3 + hstep, voffB);
            PG8_WAIT_V(6); PG8_BAR; PG8_MMA(1, 1, At, B1); PG8_BAR;
            }
        }
        if constexpr (ALIGN_EPI) { if (wr == 0) PG8_BAR; }
        if constexpr (!Epi::AFTER_DRAIN) { E(acc, cur, wr, wc, fr, fq); S.done(cur); }
        if (!has_next) break;
#pragma unroll
        for (int a = 0; a < 2; ++a)
#pragma unroll
            for (int b = 0; b < 2; ++b)
#pragma unroll
                for (int m = 0; m < 4; ++m)
#pragma unroll
                    for (int n = 0; n < 2; ++n) acc[a][b][m][n] = (f32x4){0.f, 0.f, 0.f, 0.f};
        cur = nxt; cA = nA; cB = nB; ++ui;
        if constexpr (ALIGN_EPI) { if (wr == 1) PG8_BAR; }
    }
    PG8_WAIT_V(0);
    if constexpr (!ALIGN_EPI) { if (wr == 0) PG8_BAR; }
    PG8_BAR;
    if constexpr (Epi::AFTER_DRAIN) { E.fused(acc, cur, wr, wc, fr, fq, lds, wid, lane); S.done(cur); }
#undef PG8_SA
#undef PG8_SB
#undef PG8_STAGE
#undef PG8_LDA
#undef PG8_LDB
#undef PG8_MMA
#undef PG8_WAIT_V
#undef PG8_WAIT_L
#undef PG8_BAR
#undef PG8_SCHED
}
}
using pg8::bf16_t; using pg8::f32x4; using pg8::u32x4; using pg8::bf16x8; using pg8::Unit;
#define LAS __attribute__((address_space(3)))
typedef float f32x16 __attribute__((ext_vector_type(16)));
typedef unsigned u32x2 __attribute__((ext_vector_type(2)));
typedef short s16x4 __attribute__((ext_vector_type(4)));
constexpr int NB = 8, SEQ = 4096, CTXL = 256, DM = 1024, FF = 2816, DEPTH = 4, NH = 8;
constexpr int R_LAT = NB * SEQ, R_CTX = NB * CTXL, R = R_LAT + R_CTX;
constexpr float EPS = 1e-6f;
constexpr int NCH = 34;
constexpr size_t W_GUA = 0, W_DA = W_GUA + (size_t)5632 * 1024, W_GUB = W_DA + (size_t)1024 * 2816, W_DB = W_GUB + (size_t)5632 * 1024,
                 W_IN = W_DB + (size_t)1024 * 2816, W_UQ = W_IN + (size_t)3840 * 1024, W_UKV = W_UQ + (size_t)1536 * 256, W_OMLA = W_UKV + (size_t)2048 * 256,
                 W_GLU = W_OMLA + (size_t)1024 * 1024, W_OS5 = W_GLU + (size_t)1024 * 1024, W_OUT = W_OS5 + (size_t)1024 * 1024, W_END = W_OUT + (size_t)1024 * 1024;
constexpr size_t al256(size_t x) { return (x + 255) & ~(size_t)255; }
constexpr size_t WS_CTL = 0, CTL_BYTES = 16384;
constexpr size_t WS_MOD = WS_CTL + CTL_BYTES;
constexpr size_t WS_ROPE = WS_MOD + al256((size_t)4 * 9 * 9216 * 4);
constexpr size_t WS_YSS = WS_ROPE + al256(64 * 16 * 8);
constexpr size_t WS_CSS = WS_YSS + al256((size_t)R * 16 * 4);
constexpr size_t WS_S5E = WS_CSS + al256((size_t)R * 8 * 4);
constexpr size_t S5_WE_BYTES = (size_t)2 * 64 * 128 * 256 * 2, S5_WY_BYTES = (size_t)64 * 256 * 512 * 2;
constexpr size_t WS_XC = WS_S5E + al256(S5_WE_BYTES + S5_WY_BYTES);
constexpr size_t WS_WL = WS_XC + al256((size_t)R_CTX * DM * 4);
constexpr size_t WS_H = WS_WL + al256(W_END * 2);
constexpr size_t WS_BIG = WS_H + al256((size_t)R * DM * 2);
constexpr size_t B_CQ = 0, B_U = B_CQ + (size_t)R * 768 * 2, B_Q = B_U + (size_t)R * 1024 * 2, B_KV = B_Q + (size_t)R * 1536 * 2, B_SG = B_KV + (size_t)R * 2048 * 2, B_END = B_SG + (size_t)R * 2048 * 2;
constexpr size_t B_ACT = 0, B_Y = (size_t)R * FF * 2;
constexpr size_t B_T = B_U, B_G = B_KV, B_M = B_Q;
static_assert(B_Y >= B_M + (size_t)R * 1024 * 2 && B_Y + (size_t)R * 1024 * 2 <= B_SG, "Y overlay");
constexpr size_t WS_END = WS_BIG + B_END;
constexpr int LDS_BYTES = 272 * 528 + 8192 + 16 * 528 + 256;

__device__ __forceinline__ float bf2f(unsigned h) { return __uint_as_float(h << 16); }
__device__ __forceinline__ unsigned pk2(float lo, float hi) { return pg8::cvt_pk_bf16(lo, hi); }
__device__ __forceinline__ float sigm(float x) { return __builtin_amdgcn_rcpf(1.f + __builtin_amdgcn_exp2f(-1.4426950408889634f * x)); }
__device__ __forceinline__ float gelu_tanh(float x) { return x * sigm(1.5957691216057308f * (x + 0.044715f * x * x * x)); }
__device__ __forceinline__ void unpack8(const u32x4 w, float (&f)[8]) {
    f[0] = bf2f(w.x & 0xffffu); f[1] = __uint_as_float(w.x & 0xffff0000u); f[2] = bf2f(w.y & 0xffffu); f[3] = __uint_as_float(w.y & 0xffff0000u);
    f[4] = bf2f(w.z & 0xffffu); f[5] = __uint_as_float(w.z & 0xffff0000u); f[6] = bf2f(w.w & 0xffffu); f[7] = __uint_as_float(w.w & 0xffff0000u);
}
__device__ __forceinline__ u32x4 pack8(const float (&f)[8]) { u32x4 w; w.x = pk2(f[0], f[1]); w.y = pk2(f[2], f[3]); w.z = pk2(f[4], f[5]); w.w = pk2(f[6], f[7]); return w; }
__device__ __forceinline__ float wave_sum(float v) {
#pragma unroll
    for (int o = 1; o < 64; o <<= 1) v += __shfl_xor(v, o);
    return v;
}
__device__ __forceinline__ void rope8(float (&v)[8], int row, int wc, int fq, const float* tab) {
    const int t = row & 4095, pos = (wc & 1) ? (t & 63) : (t >> 6);
    const f32x4* tp = (const f32x4*)(tab + (pos * 16 + 8 * (fq & 1)) * 2);
    const f32x4 t0 = tp[0], t1 = tp[1], t2 = tp[2], t3 = tp[3];
    const float cs[8] = {t0[0], t0[2], t1[0], t1[2], t2[0], t2[2], t3[0], t3[2]}, sn[8] = {t0[1], t0[3], t1[1], t1[3], t2[1], t2[3], t3[1], t3[3]};
    const float sgn = (fq < 2) ? -1.f : 1.f;
#pragma unroll
    for (int j = 0; j < 8; ++j) { const float p = __shfl_xor(v[j], 32); v[j] = v[j] * cs[j] + sgn * p * sn[j]; }
}

struct Epi {
    static constexpr bool PERM = true, AFTER_DRAIN = false;
    int mode;
    bf16_t* o0; bf16_t* o1; bf16_t* o2; const bf16_t* i0; const bf16_t* i1; float* ss; const float* css; const float* bias; const float* rope;
    __device__ __forceinline__ void operator()(const f32x4 (&acc)[2][2][4][2], const Unit& u, int wr, int wc, int fr, int fq) const {
        const int row0 = u.pm * 256 + wr * 64 + fr, cb = wc * 32 + 8 * fq, pn = u.pn;
        if (mode == 0) {
            bf16_t* base = o0 + (size_t)pn * 128 + cb;
#pragma unroll
            for (int ai = 0; ai < 2; ++ai)
#pragma unroll
                for (int m = 0; m < 4; ++m) { const int row = row0 + ai * 128 + m * 16; float v[8];
#pragma unroll
                    for (int n = 0; n < 2; ++n)
#pragma unroll
                        for (int j = 0; j < 4; ++j) { const float g = acc[ai][0][m][n][j], up = acc[ai][1][m][n][j]; v[4 * n + j] = g * sigm(g) * up; }
                    *(u32x4*)(base + (size_t)row * FF) = pack8(v); }
        } else if (mode == 1) {
            bf16_t* base = o0 + pn * 256 + cb;
#pragma unroll
            for (int ai = 0; ai < 2; ++ai)
#pragma unroll
                for (int m = 0; m < 4; ++m) { const int row = row0 + ai * 128 + m * 16; float s = 0.f;
#pragma unroll
                    for (int bj = 0; bj < 2; ++bj) { float v[8];
#pragma unroll
                        for (int n = 0; n < 2; ++n)
#pragma unroll
                            for (int j = 0; j < 4; ++j) { const float x = acc[ai][bj][m][n][j]; v[4 * n + j] = x; s += x * x; }
                        *(u32x4*)(base + (size_t)row * 1024 + bj * 128) = pack8(v); }
                    s += __shfl_xor(s, 16); s += __shfl_xor(s, 32);
                    if (fq == 0) ss[row * 16 + pn * 4 + wc] = s; }
        } else if (mode == 2) {
            bf16_t* dst; int ldc;
            if (pn < 3) { dst = o0 + pn * 256; ldc = 768; } else if (pn < 7) { dst = o1 + (pn - 3) * 256; ldc = 1024; } else { dst = o2 + (pn - 7) * 256; ldc = 2048; }
            const bool sg = pn >= 7, docss = pn < 2, dorope = (pn == 2) && (u.pm < 128) && (wc < 2);
            dst += cb;
#pragma unroll
            for (int ai = 0; ai < 2; ++ai)
#pragma unroll
                for (int m = 0; m < 4; ++m) { const int row = row0 + ai * 128 + m * 16; float s = 0.f;
#pragma unroll
                    for (int bj = 0; bj < 2; ++bj) { float v[8];
#pragma unroll
                        for (int n = 0; n < 2; ++n)
#pragma unroll
                            for (int j = 0; j < 4; ++j) { float x = acc[ai][bj][m][n][j]; if (sg) x = sigm(x); v[4 * n + j] = x; s += x * x; }
                        if (bj == 0 && dorope) rope8(v, row, wc, fq, rope);
                        *(u32x4*)(dst + (size_t)row * ldc + bj * 128) = pack8(v); }
                    if (docss) { s += __shfl_xor(s, 16); s += __shfl_xor(s, 32); if (fq == 0) ss[row * 8 + pn * 4 + wc] = s; } }
        } else if (mode == 3 || mode == 4) {
            const int ldc = (mode == 3) ? 1536 : 2048; const float* cp = css + ((mode == 3) ? 0 : 4);
            const bool dorope = (mode == 3) && (pn >= 4) && (u.pm < 128);
            bf16_t* dst = o0 + pn * 256 + cb;
#pragma unroll
            for (int ai = 0; ai < 2; ++ai)
#pragma unroll
                for (int m = 0; m < 4; ++m) { const int row = row0 + ai * 128 + m * 16; const f32x4 c4 = *(const f32x4*)(cp + row * 8);
                    const float rs = 1.0f / sqrtf(((c4[0] + c4[1]) + (c4[2] + c4[3])) * (1.0f / 256.0f) + EPS);
#pragma unroll
                    for (int bj = 0; bj < 2; ++bj) { float v[8];
#pragma unroll
                        for (int n = 0; n < 2; ++n)
#pragma unroll
                            for (int j = 0; j < 4; ++j) v[4 * n + j] = acc[ai][bj][m][n][j] * rs;
                        if (dorope) rope8(v, row, wc, fq, rope);
                        *(u32x4*)(dst + (size_t)row * ldc + bj * 128) = pack8(v); } }
        } else {
            const int col = pn * 256 + cb;
#pragma unroll
            for (int ai = 0; ai < 2; ++ai)
#pragma unroll
                for (int m = 0; m < 4; ++m) { const int row = row0 + ai * 128 + m * 16;
#pragma unroll
                    for (int bj = 0; bj < 2; ++bj) { const int c = col + bj * 128; float v[8], a[8], b[8];
#pragma unroll
                        for (int n = 0; n < 2; ++n)
#pragma unroll
                            for (int j = 0; j < 4; ++j) v[4 * n + j] = acc[ai][bj][m][n][j];
                        if (mode == 5) { unpack8(*(const u32x4*)(i0 + (size_t)row * 1024 + c), a); const f32x4 b0 = *(const f32x4*)(bias + c), b1 = *(const f32x4*)(bias + c + 4);
#pragma unroll
                            for (int j = 0; j < 4; ++j) { v[j] = a[j] * sigm(v[j] + b0[j]); v[4 + j] = a[4 + j] * sigm(v[4 + j] + b1[j]); } }
                        else if (mode == 6) { unpack8(*(const u32x4*)(i0 + (size_t)row * 2048 + c), a);
#pragma unroll
                            for (int j = 0; j < 8; ++j) v[j] = a[j] * v[j]; }
                        else { unpack8(*(const u32x4*)(i0 + (size_t)row * 1024 + c), a); unpack8(*(const u32x4*)(i1 + (size_t)row * 2048 + c), b);
#pragma unroll
                            for (int j = 0; j < 8; ++j) v[j] = a[j] + b[j] * v[j]; }
                        *(u32x4*)(o0 + (size_t)row * 1024 + c) = pack8(v); } }
        }
    }
};
__device__ __forceinline__ void conv_item(const float* W, int ldsrc, int srccol, const float* kscale, bf16_t* WT, int K, int n0, int k0, LAS float* scr, int lane) {
    if (srccol >= 0) {
#pragma unroll 8
        for (int i = 0; i < 32; ++i) { const int kk = 2 * i + (lane >> 5); float w = W[(size_t)(k0 + kk) * ldsrc + srccol + (lane & 31)]; if (kscale) w *= kscale[k0 + kk]; scr[kk * 33 + (lane & 31)] = w; }
    } else {
#pragma unroll 8
        for (int i = 0; i < 32; ++i) { const int kk = 2 * i + (lane >> 5); scr[kk * 33 + (lane & 31)] = 0.f; }
    }
    asm volatile("s_waitcnt lgkmcnt(0)" ::: "memory");
    const int c = lane & 7;
#pragma unroll
    for (int j = 0; j < 4; ++j) { const int n = (lane >> 3) + 8 * j; const LAS float* s = scr + (8 * c) * 33 + n;
        u32x4 o; o.x = pk2(s[0 * 33], s[1 * 33]); o.y = pk2(s[2 * 33], s[3 * 33]); o.z = pk2(s[4 * 33], s[5 * 33]); o.w = pk2(s[6 * 33], s[7 * 33]);
        *(u32x4*)(WT + (size_t)(n0 + n) * K + k0 + 8 * c) = o; }
    asm volatile("s_waitcnt lgkmcnt(0)" ::: "memory");
}
struct WPtrs { const float *gate, *up, *down, *win, *qn, *wuq, *kvn, *wukv, *womla, *glu, *wos5, *wout; };
__device__ __forceinline__ void conv_layer(const WPtrs& P, int l, bf16_t* WL, LAS unsigned char* lds, int gw, int NGW, int wave, int lane, int it_lo, int it_hi) {
    LAS float* scr = (LAS float*)(lds + wave * 16384);
    constexpr int I_GU = 16 * 176, I_D = 44 * 32, I_IN = 16 * 120, I_UQ = 4 * 48, I_UKV = 4 * 64, I_SQ = 16 * 32;
    constexpr int NIT = 2 * I_GU + 2 * I_D + I_IN + I_UQ + I_UKV + 4 * I_SQ;
    static_assert(NIT == 12864, "conv items");
    for (int it = it_lo + gw; it < it_hi; it += NGW) {
        int r = it;
        if (r < 2 * I_GU) { const int f = r / I_GU; r -= f * I_GU; const int nb = r % 176, kb = r / 176, n0 = nb * 32, tile = n0 >> 8, within = n0 & 255, half = within >> 7, ffc = tile * 128 + (within & 127);
            const size_t so = (size_t)(l * 2 + f) * 1024 * FF; bf16_t* dst = WL + (f ? W_GUB : W_GUA);
            if (half) conv_item(P.up + so, FF, ffc, nullptr, dst, 1024, n0, kb * 64, scr, lane); else conv_item(P.gate + so, FF, ffc, nullptr, dst, 1024, n0, kb * 64, scr, lane);
            continue; }
        r -= 2 * I_GU;
        if (r < 2 * I_D) { const int f = r / I_D; r -= f * I_D; const int nb = r % 32, kb = r / 32;
            conv_item(P.down + (size_t)(l * 2 + f) * FF * 1024, 1024, nb * 32, nullptr, WL + (f ? W_DB : W_DA), FF, nb * 32, kb * 64, scr, lane); continue; }
        r -= 2 * I_D;
        if (r < I_IN) { const int nb = r % 120, kb = r / 120, n0 = nb * 32; int sc;
            if (n0 < 512) sc = n0; else if (n0 < 768) sc = (n0 < 576) ? n0 : -1; else sc = n0 - 768 + 576;
            conv_item(P.win + (size_t)l * 1024 * 3648, 3648, sc, nullptr, WL + W_IN, 1024, n0, kb * 64, scr, lane); continue; }
        r -= I_IN;
        if (r < I_UQ) { const int nb = r % 48, kb = r / 48, n0 = nb * 32; int sc;
            if (n0 < 1024) sc = (n0 >> 7) * 192 + (n0 & 127); else { const int rr = n0 - 1024; sc = (rr >> 6) * 192 + 128 + (rr & 63); }
            conv_item(P.wuq + (size_t)l * 256 * 1536, 1536, sc, P.qn + l * 256, WL + W_UQ, 256, n0, kb * 64, scr, lane); continue; }
        r -= I_UQ;
        if (r < I_UKV) { const int nb = r % 64, kb = r / 64;
            conv_item(P.wukv + (size_t)l * 256 * 2048, 2048, nb * 32, P.kvn + l * 256, WL + W_UKV, 256, nb * 32, kb * 64, scr, lane); continue; }
        r -= I_UKV;
        { const int q = r / I_SQ; r -= q * I_SQ; const int nb = r % 32, kb = r / 32; const size_t so = (size_t)l * 1024 * 1024;
          if (q == 0) conv_item(P.womla + so, 1024, nb * 32, nullptr, WL + W_OMLA, 1024, nb * 32, kb * 64, scr, lane);
          else if (q == 1) conv_item(P.glu + so, 1024, nb * 32, nullptr, WL + W_GLU, 1024, nb * 32, kb * 64, scr, lane);
          else if (q == 2) conv_item(P.wos5 + so, 1024, nb * 32, nullptr, WL + W_OS5, 1024, nb * 32, kb * 64, scr, lane);
          else conv_item(P.wout + so, 1024, nb * 32, nullptr, WL + W_OUT, 1024, nb * 32, kb * 64, scr, lane); }
    }
}

__device__ __forceinline__ void mods_phase(const float* c, const float* c_ctx, const float* ada_w, const float* ada_b, float* MOD, float* ROPE, LAS unsigned char* lds, const int tid) {

    LAS float* sc = (LAS float*)lds;
    LAS float* red = (LAS float*)(lds + 9 * 1024 * 4);
    if (blockIdx.x == gridDim.x - 1) {
        for (int e = tid; e < 1024; e += 512) { const int pos = e >> 4, i = e & 15; const float inv = exp2f(-(float)i * (13.287712379549449f / 16.0f)); const float ang = (float)pos * inv;
            float sn_, cs_; sincosf(ang, &sn_, &cs_); ROPE[2 * e] = cs_; ROPE[2 * e + 1] = sn_; }
    }
    bool have = false;
    for (int item = blockIdx.x; item < 576; item += gridDim.x) {
        if (!have) { for (int e = tid; e < 9 * 1024; e += 512) { const float v = (e < 8192) ? c[e] : c_ctx[e - 8192]; sc[e] = v * sigm(v); } have = true; }
        __syncthreads();
        const int l = item / 144, j0 = (item % 144) * 64, ks = tid >> 6, jj = tid & 63;
        const float* w = ada_w + ((size_t)l * 1024 + ks * 128) * 9216 + j0 + jj;
        float a[9];
#pragma unroll
        for (int s = 0; s < 9; ++s) a[s] = 0.f;
#pragma unroll 16
        for (int k = 0; k < 128; ++k) { const float wv = w[(size_t)k * 9216];
#pragma unroll
            for (int s = 0; s < 9; ++s) a[s] += sc[s * 1024 + ks * 128 + k] * wv; }
#pragma unroll
        for (int s = 0; s < 9; ++s) red[(ks * 9 + s) * 64 + jj] = a[s];
        __syncthreads();
        for (int e = tid; e < 576; e += 512) { const int s = e >> 6, j = e & 63; float t = 0.f;
#pragma unroll
            for (int q = 0; q < 8; ++q) t += red[(q * 9 + s) * 64 + j];
            MOD[((size_t)l * 9 + s) * 9216 + j0 + j] = t + ada_b[l * 9216 + j0 + j]; }
    }
    __syncthreads();
}

__device__ __forceinline__ void e_phase(const float* xin, const float* ctxin, float* xl, float* xc, const bf16_t* Y, const float* YSS, const float* MOD,
                                        const float* npre, const float* npost, bf16_t* H, int l, int s, int nl, int ns, int gw, int NGW, int lane, float wmul, int nrows) {
    for (int row = gw; row < nrows; row += NGW) {
        const bool lat = row < R_LAT; const int set = lat ? (row >> 12) : 8;
        float* xr = lat ? xl + (size_t)row * DM : xc + (size_t)(row - R_LAT) * DM;
        const float* xs = (s < 0) ? (lat ? xin + (size_t)row * DM : ctxin + (size_t)(row - R_LAT) * DM) : xr;
        f32x4 v[4];
#pragma unroll
        for (int j = 0; j < 4; ++j) v[j] = __builtin_nontemporal_load((const f32x4*)xs + lane + 64 * j);
        if (s >= 0) {
            const float part = (lane < 16) ? YSS[row * 16 + lane] : 0.f;
            const float rs = 1.0f / sqrtf(wave_sum(part) * (1.0f / 1024.0f) + EPS);
            const float wgt = ((s == 1) ? 1.0f : 0.5f) * wmul;
            const float* gate = MOD + ((size_t)(l * 9 + set) * 9 + 3 * s + 2) * 1024; const float* gp = npost + (l * 3 + s) * 1024;
#pragma unroll
            for (int j = 0; j < 4; ++j) { const u32x2 yw = ((const u32x2*)(Y + (size_t)row * DM))[lane + 64 * j];
                const f32x4 g4 = ((const f32x4*)gate)[lane + 64 * j], p4 = ((const f32x4*)gp)[lane + 64 * j];
                f32x4 y4; y4[0] = bf2f(yw.x & 0xffffu); y4[1] = __uint_as_float(yw.x & 0xffff0000u); y4[2] = bf2f(yw.y & 0xffffu); y4[3] = __uint_as_float(yw.y & 0xffff0000u);
                v[j] += (wgt * rs) * g4 * y4 * p4; }
        }
#pragma unroll
        for (int j = 0; j < 4; ++j) __builtin_nontemporal_store(v[j], (f32x4*)xr + lane + 64 * j);
        if (nl >= 0) {
            float q = 0.f;
#pragma unroll
            for (int j = 0; j < 4; ++j) q += (v[j][0] * v[j][0] + v[j][1] * v[j][1]) + (v[j][2] * v[j][2] + v[j][3] * v[j][3]);
            const float rs2 = 1.0f / sqrtf(wave_sum(q) * (1.0f / 1024.0f) + EPS);
            const float* mb = MOD + ((size_t)(nl * 9 + set) * 9 + 3 * ns) * 1024; const float* gp = npre + (nl * 3 + ns) * 1024;
#pragma unroll
            for (int j = 0; j < 4; ++j) { const f32x4 sh = ((const f32x4*)mb)[lane + 64 * j], sc = ((const f32x4*)(mb + 1024))[lane + 64 * j], p4 = ((const f32x4*)gp)[lane + 64 * j];
                const f32x4 h = v[j] * rs2 * p4 * (1.0f + sc) + sh;
                u32x2 o; o.x = pk2(h[0], h[1]); o.y = pk2(h[2], h[3]); ((u32x2*)(H + (size_t)row * DM))[lane + 64 * j] = o; }
        }
    }
}
struct S5In { const float *a_re, *a_im, *log_dt, *b_re, *b_im, *c_re, *c_im, *dsk; };
__device__ __forceinline__ void s5_abar(const S5In& P, int idx, int n, float& ar, float& ai, float& cr, float& ci) {
    const float are = P.a_re[idx * 64 + n], aim = P.a_im[idx * 64 + n];
    const float dt = expf(P.log_dt[idx]);
    const float mag = expf(dt * are); float sn, cs; sincosf(dt * aim, &sn, &cs);
    ar = mag * cs; ai = mag * sn;
    const float nr = ar - 1.f, ni = ai, den = 1.0f / (are * are + aim * aim);
    cr = (nr * are + ni * aim) * den; ci = (ni * are - nr * aim) * den;
}
__device__ __forceinline__ void s5_prep(const S5In& P, int l, int g, bf16_t* WEt, bf16_t* WYt, LAS unsigned char* lds, int tid) {
    LAS float* AP = (LAS float*)lds;
    LAS float* BB = AP + 2 * 17 * 64 * 2;
    LAS float* CC = BB + 2 * 64 * 16 * 2;
    LAS float* KL = CC + 2 * 16 * 64 * 2;
    if (tid < 128) { const int d = tid >> 6, n = tid & 63, idx = (l * 2 + d) * 64 + g; float ar, ai, cr, ci; s5_abar(P, idx, n, ar, ai, cr, ci);
        float pr = 1.f, pi = 0.f;
        for (int j = 0; j <= 16; ++j) { AP[((d * 17 + j) * 64 + n) * 2] = pr; AP[((d * 17 + j) * 64 + n) * 2 + 1] = pi; const float t0 = pr * ar - pi * ai, t1 = pr * ai + pi * ar; pr = t0; pi = t1; }
        for (int c = 0; c < 16; ++c) { const float br = P.b_re[(size_t)(idx * 64 + n) * 16 + c], bi = P.b_im[(size_t)(idx * 64 + n) * 16 + c];
            BB[((d * 64 + n) * 16 + c) * 2] = cr * br - ci * bi; BB[((d * 64 + n) * 16 + c) * 2 + 1] = cr * bi + ci * br; } }
    for (int e = tid; e < 2048; e += 512) { const int d = e >> 10, cn = e & 1023; const size_t src = (size_t)((l * 2 + d) * 64 + g) * 1024 + cn; CC[e * 2] = P.c_re[src]; CC[e * 2 + 1] = P.c_im[src]; }
    __syncthreads();
    { const int d = tid >> 8, c = (tid >> 4) & 15, cp = tid & 15; float acc[16];
#pragma unroll
      for (int j = 0; j < 16; ++j) acc[j] = 0.f;
      for (int n = 0; n < 64; ++n) { const float c_r = CC[((d * 16 + c) * 64 + n) * 2], c_i = CC[((d * 16 + c) * 64 + n) * 2 + 1], b_r = BB[((d * 64 + n) * 16 + cp) * 2], b_i = BB[((d * 64 + n) * 16 + cp) * 2 + 1];
          const float zr = c_r * b_r - c_i * b_i, zi = c_r * b_i + c_i * b_r;
#pragma unroll
          for (int j = 0; j < 16; ++j) acc[j] += zr * AP[((d * 17 + j) * 64 + n) * 2] - zi * AP[((d * 17 + j) * 64 + n) * 2 + 1]; }
#pragma unroll
      for (int j = 0; j < 16; ++j) KL[((d * 16 + j) * 16 + c) * 16 + cp] = acc[j]; }
    __syncthreads();
    for (int e = tid; e < 256 * 64; e += 512) { const int row = e >> 6, k8 = (e & 63) * 8, t = row >> 4, c = row & 15; float v[8];
        if (k8 < 256) { const int s = k8 >> 4, c0 = k8 & 15;
#pragma unroll
            for (int j = 0; j < 8; ++j) { const int cp = c0 + j; float val = 0.f;
                if (s <= t) val += KL[(((t - s)) * 16 + c) * 16 + cp];
                if (s >= t) val += KL[((16 + (s - t)) * 16 + c) * 16 + cp];
                if (s == t && cp == c) val += P.dsk[l * 1024 + g * 16 + c];
                v[j] = val; } }
        else { const int kk = k8 - 256, d = kk >> 7, im = (kk >> 6) & 1, n0 = kk & 63, jp = (d == 0) ? t + 1 : 16 - t;
#pragma unroll
            for (int j = 0; j < 8; ++j) { const int n = n0 + j; const float wr = AP[((d * 17 + jp) * 64 + n) * 2], wi = AP[((d * 17 + jp) * 64 + n) * 2 + 1], c_r = CC[((d * 16 + c) * 64 + n) * 2], c_i = CC[((d * 16 + c) * 64 + n) * 2 + 1];
                v[j] = im ? -(c_r * wi + c_i * wr) : (c_r * wr - c_i * wi); } }
        *(u32x4*)(WYt + ((size_t)g * 256 + row) * 512 + k8) = pack8(v); }
    for (int e = tid; e < 2 * 128 * 32; e += 512) { const int d = e >> 12, row = (e >> 5) & 127, k8 = (e & 31) * 8, im = row >> 6, n = row & 63, s = k8 >> 4, c0 = k8 & 15, ex = (d == 0) ? 15 - s : s; float v[8];
        const float wr = AP[((d * 17 + ex) * 64 + n) * 2], wi = AP[((d * 17 + ex) * 64 + n) * 2 + 1];
#pragma unroll
        for (int j = 0; j < 8; ++j) { const float b_r = BB[((d * 64 + n) * 16 + c0 + j) * 2], b_i = BB[((d * 64 + n) * 16 + c0 + j) * 2 + 1]; v[j] = im ? (wr * b_i + wi * b_r) : (wr * b_r - wi * b_i); }
        *(u32x4*)(WEt + ((size_t)(d * 64 + g) * 128 + row) * 256 + k8) = pack8(v); }
    __syncthreads();
}
__device__ __forceinline__ int s5_chunk_row(int b, int ch) { return ch < 16 ? R_LAT + b * 256 + 16 * ch : b * 4096 + 16 * (ch - 16); }
#define S5_BAR() do { asm volatile("s_waitcnt lgkmcnt(0)" ::: "memory"); __builtin_amdgcn_s_barrier(); asm volatile("" ::: "memory"); } while (0)
__device__ __forceinline__ void s5_main(const S5In& P, int l, const bf16_t* U, const bf16_t* WEt, const bf16_t* WYt, bf16_t* T, LAS unsigned char* lds, int tid) {
    const int lane = tid & 63, w = __builtin_amdgcn_readfirstlane(tid >> 6), fr = lane & 15, q = lane >> 4;
    constexpr int XP = 528;
    LAS unsigned char* XIN = lds; LAS float* ET = (LAS float*)(lds + 272 * XP); LAS unsigned char* UC = lds + 272 * XP + 8192;
    const int uc_chunk = tid >> 5, uc_piece = tid & 31;
    LAS u32x4* uc_dst = (LAS u32x4*)(UC + uc_chunk * XP + uc_piece * 16);
    const LAS unsigned char* uc_a = UC + fr * XP + 16 * q;
#define S5_GLOAD(tile) (*(const u32x4*)(U + (size_t)(s5_chunk_row(b, 16 * (tile) + uc_chunk) + (uc_piece >> 1)) * 1024 + g * 16 + 8 * (uc_piece & 1)))
    const int Gd = (int)gridDim.x, bxi = (int)blockIdx.x, vcu = (Gd % 8 == 0) ? (bxi % 8) * (Gd / 8) + bxi / 8 : bxi;
    for (int item = vcu; item < 512; item += Gd) {
        const int g = item & 63, b = item >> 6;
#pragma unroll 1
        for (int d = 0; d < 2; ++d) {
            bf16x8 bw[8];
            { const bf16_t* wp = WEt + ((size_t)(d * 64 + g) * 128 + 16 * w + fr) * 256 + 8 * q;
#pragma unroll
              for (int kk = 0; kk < 8; ++kk) bw[kk] = *(const bf16x8*)(wp + 32 * kk); }
            float tr = 1.f, ti = 0.f, xr = 0.f, xi = 0.f;
            if (w == 0) { float cr, ci; s5_abar(P, (l * 2 + d) * 64 + g, lane, tr, ti, cr, ci);
#pragma unroll
                for (int k = 0; k < 4; ++k) { const float n_r = tr * tr - ti * ti, n_i = 2.f * tr * ti; tr = n_r; ti = n_i; } }
#define S5_TILE(i) (((d == 0) || (i) == 0) ? (i) : 17 - (i))
            u32x4 u0 = S5_GLOAD(S5_TILE(0)), u1 = S5_GLOAD(S5_TILE(1)), u2 = S5_GLOAD(S5_TILE(2)), u3 = S5_GLOAD(S5_TILE(3)), u4 = S5_GLOAD(S5_TILE(4));
            *uc_dst = u0; u0 = u1; u1 = u2; u2 = u3; u3 = u4;
            S5_BAR();
#pragma unroll 1
            for (int i = 0; i < 17; ++i) {
                const int tile = S5_TILE(i);
                f32x4 acc = {0.f, 0.f, 0.f, 0.f};
#pragma unroll
                for (int kk = 0; kk < 8; ++kk) { const bf16x8 af = *(const LAS bf16x8*)(uc_a + 64 * kk); acc = __builtin_amdgcn_mfma_f32_16x16x32_bf16(af, bw[kk], acc, 0, 0, 0); }
#pragma unroll
                for (int r = 0; r < 4; ++r) ET[(4 * q + r) * 128 + 16 * w + fr] = acc[r];
                S5_BAR();
                if (i < 16) { *uc_dst = u0; u0 = u1; u1 = u2; u2 = u3; if (i + 5 <= 16) u3 = S5_GLOAD(S5_TILE(i + 5)); }
                if (w == 0) {
                    float er[16], ei[16];
#pragma unroll
                    for (int c = 0; c < 16; ++c) { er[c] = ET[c * 128 + lane]; ei[c] = ET[c * 128 + 64 + lane]; }
#pragma unroll
                    for (int cc = 0; cc < 16; ++cc) { const int c = d ? 15 - cc : cc;
                        LAS bf16_t* xp = (LAS bf16_t*)(XIN + (16 * tile + c) * XP) + d * 128;
                        xp[lane] = (bf16_t)(pk2(xr, 0.f) & 0xffffu); xp[64 + lane] = (bf16_t)(pk2(xi, 0.f) & 0xffffu);
                        const float nxr = tr * xr - ti * xi + er[c], nxi = tr * xi + ti * xr + ei[c]; xr = nxr; xi = nxi; }
                }
                S5_BAR();
            }
#undef S5_TILE
        }
        {
            bf16x8 by[2][16];
#pragma unroll
            for (int nt = 0; nt < 2; ++nt) { const bf16_t* wp = WYt + ((size_t)g * 256 + 32 * w + 16 * nt + fr) * 512 + 8 * q;
#pragma unroll
                for (int kk = 0; kk < 16; ++kk) by[nt][kk] = *(const bf16x8*)(wp + 32 * kk); }
            u32x4 u0 = S5_GLOAD(0), u1 = S5_GLOAD(1), u2 = S5_GLOAD(2), u3 = S5_GLOAD(3), u4 = S5_GLOAD(4);
            *uc_dst = u0; u0 = u1; u1 = u2; u2 = u3; u3 = u4;
            S5_BAR();
#pragma unroll 1
            for (int tile = 0; tile < 17; ++tile) {
                f32x4 acc0 = {0.f, 0.f, 0.f, 0.f}, acc1 = {0.f, 0.f, 0.f, 0.f};
#pragma unroll
                for (int kk = 0; kk < 8; ++kk) { const bf16x8 af = *(const LAS bf16x8*)(uc_a + 64 * kk);
                    acc0 = __builtin_amdgcn_mfma_f32_16x16x32_bf16(af, by[0][kk], acc0, 0, 0, 0); acc1 = __builtin_amdgcn_mfma_f32_16x16x32_bf16(af, by[1][kk], acc1, 0, 0, 0); }
                const LAS unsigned char* xq = XIN + (16 * tile + fr) * XP + 16 * q;
#pragma unroll
                for (int kk = 0; kk < 8; ++kk) { const bf16x8 xf = *(const LAS bf16x8*)(xq + 64 * kk);
                    acc0 = __builtin_amdgcn_mfma_f32_16x16x32_bf16(xf, by[0][8 + kk], acc0, 0, 0, 0); acc1 = __builtin_amdgcn_mfma_f32_16x16x32_bf16(xf, by[1][8 + kk], acc1, 0, 0, 0); }
                S5_BAR();
                if (tile < 16) { *uc_dst = u0; u0 = u1; u1 = u2; u2 = u3; if (tile + 5 <= 16) u3 = S5_GLOAD(tile + 5); }
#pragma unroll
                for (int r = 0; r < 4; ++r) { const int row = s5_chunk_row(b, 16 * tile + 4 * q + r) + 2 * w;
                    T[(size_t)row * 1024 + g * 16 + fr] = (bf16_t)(pk2(gelu_tanh(acc0[r]), 0.f) & 0xffffu);
                    T[(size_t)(row + 1) * 1024 + g * 16 + fr] = (bf16_t)(pk2(gelu_tanh(acc1[r]), 0.f) & 0xffffu); }
                S5_BAR();
            }
        }
    }
#undef S5_GLOAD
#undef S5_BAR
}
__device__ __forceinline__ s16x4 vtr(const LAS unsigned char* p) { return __builtin_bit_cast(s16x4, __builtin_amdgcn_ds_read_tr16_b64_v4i16((LAS s16x4*)p)); }
__device__ __forceinline__ void attn_phase(LAS unsigned char* lds, const bf16_t* Q, const bf16_t* KV, const bf16_t* CQ, bf16_t* O, const int tid, const int nunits) {
    const int lane = tid & 63, wid = __builtin_amdgcn_readfirstlane(tid >> 6), r32 = lane & 31, hi = lane >> 5;
    constexpr int KP = 400, VP = 320, BUFB = 64 * KP + 64 * VP;
    const float C = 0.07216878364870322f * 1.4426950408889634f;
    const int kn_row = tid >> 4, kn_ch = tid & 15, kr_row = tid >> 3, kr_ch = tid & 7;
    const int Gd = (int)gridDim.x, bxi = (int)blockIdx.x, vcu = (Gd % 8 == 0) ? (bxi % 8) * (Gd / 8) + bxi / 8 : bxi;
    for (int ui = 0;; ++ui) {
        const int unit = ui * (int)gridDim.x + vcu; if (unit >= nunits) break;
        int b, h, qb;
        if (unit < 1024) { const int bh = unit >> 4; qb = unit & 15; b = bh >> 3; h = bh & 7; } else { const int bh = unit - 1024; qb = 16; b = bh >> 3; h = bh & 7; }
        const int qrow0 = (qb < 16) ? b * 4096 + qb * 256 : R_LAT + b * 256;
        const int NT = (qb < 16) ? 68 : 4;
        const bf16_t* qp = Q + (size_t)(qrow0 + wid * 32 + r32) * 1536;
        bf16x8 qf[12];
#pragma unroll
        for (int s = 0; s < 8; ++s) qf[s] = *(const bf16x8*)(qp + h * 128 + 16 * s + 8 * hi);
#pragma unroll
        for (int s = 0; s < 4; ++s) qf[8 + s] = *(const bf16x8*)(qp + 1024 + h * 64 + 16 * s + 8 * hi);
        u32x4 sk0, sk1, skr, sv0, sv1;
#define ATT_KROW(t) ((qb < 16) ? (((t) < 64) ? b * 4096 + (t) * 64 : R_LAT + b * 256 + ((t) - 64) * 64) : R_LAT + b * 256 + (t) * 64)
#define ATT_LOAD(t) do { const int kr0_ = ATT_KROW(t); const bf16_t* kvp_ = KV + (size_t)(kr0_ + kn_row) * 2048 + h * 256 + kn_ch * 8; \
        sk0 = *(const u32x4*)kvp_; sk1 = *(const u32x4*)(kvp_ + 32 * 2048); sv0 = *(const u32x4*)(kvp_ + 128); sv1 = *(const u32x4*)(kvp_ + 128 + 32 * 2048); \
        skr = *(const u32x4*)(CQ + (size_t)(kr0_ + kr_row) * 768 + 512 + kr_ch * 8); } while (0)
#define ATT_STORE(buf) do { LAS unsigned char* kb_ = lds + (buf) * BUFB; LAS unsigned char* vb_ = kb_ + 64 * KP; \
        *(LAS u32x4*)(kb_ + kn_row * KP + kn_ch * 16) = sk0; *(LAS u32x4*)(kb_ + (kn_row + 32) * KP + kn_ch * 16) = sk1; *(LAS u32x4*)(kb_ + kr_row * KP + 256 + kr_ch * 16) = skr; \
        *(LAS u32x4*)(vb_ + kn_row * VP + kn_ch * 16) = sv0; *(LAS u32x4*)(vb_ + (kn_row + 32) * VP + kn_ch * 16) = sv1; } while (0)
        ATT_LOAD(0); ATT_STORE(0);
        __syncthreads();
        float mrun = -1e30f, lrun = 0.f;
        f32x16 o[4];
#pragma unroll
        for (int d = 0; d < 4; ++d)
#pragma unroll
            for (int r = 0; r < 16; ++r) o[d][r] = 0.f;
        for (int t = 0; t < NT; ++t) {
            const int cur = t & 1;
            if (t + 1 < NT) ATT_LOAD(t + 1);
            f32x16 p0, p1;
#pragma unroll
            for (int r = 0; r < 16; ++r) { p0[r] = 0.f; p1[r] = 0.f; }
            __builtin_amdgcn_s_setprio(1);
            { const LAS unsigned char* kb = lds + cur * BUFB + r32 * KP + hi * 16;
#pragma unroll
              for (int g3 = 0; g3 < 3; ++g3) { bf16x8 k0[4], k1[4];
#pragma unroll
                  for (int j = 0; j < 4; ++j) { k0[j] = *(const LAS bf16x8*)(kb + (4 * g3 + j) * 32); k1[j] = *(const LAS bf16x8*)(kb + 32 * KP + (4 * g3 + j) * 32); }
                  __builtin_amdgcn_sched_barrier(0);
#pragma unroll
                  for (int j = 0; j < 4; ++j) { p0 = __builtin_amdgcn_mfma_f32_32x32x16_bf16(k0[j], qf[4 * g3 + j], p0, 0, 0, 0); p1 = __builtin_amdgcn_mfma_f32_32x32x16_bf16(k1[j], qf[4 * g3 + j], p1, 0, 0, 0); }
                  __builtin_amdgcn_sched_barrier(0); } }
            __builtin_amdgcn_s_setprio(0);
            float mx = p0[0];
#pragma unroll
            for (int r = 0; r < 16; ++r) { mx = fmaxf(mx, p0[r]); mx = fmaxf(mx, p1[r]); }
            mx = fmaxf(mx, __shfl_xor(mx, 32)) * C;
            if (__any(mx > mrun + 8.0f)) {
                const float mn = fmaxf(mrun, mx), alpha = __builtin_amdgcn_exp2f(mrun - mn); mrun = mn; lrun *= alpha;
#pragma unroll
                for (int d = 0; d < 4; ++d)
#pragma unroll
                    for (int r = 0; r < 16; ++r) o[d][r] *= alpha;
            }
            float rsum = 0.f;
#pragma unroll
            for (int r = 0; r < 16; ++r) { p0[r] = __builtin_amdgcn_exp2f(p0[r] * C - mrun); p1[r] = __builtin_amdgcn_exp2f(p1[r] * C - mrun); rsum += p0[r] + p1[r]; }
            lrun += rsum;
            bf16x8 pf[4];
            { u32x4 w;
              w.x = pk2(p0[0], p0[1]); w.y = pk2(p0[2], p0[3]); w.z = pk2(p0[4], p0[5]); w.w = pk2(p0[6], p0[7]); pf[0] = __builtin_bit_cast(bf16x8, w);
              w.x = pk2(p0[8], p0[9]); w.y = pk2(p0[10], p0[11]); w.z = pk2(p0[12], p0[13]); w.w = pk2(p0[14], p0[15]); pf[1] = __builtin_bit_cast(bf16x8, w);
              w.x = pk2(p1[0], p1[1]); w.y = pk2(p1[2], p1[3]); w.z = pk2(p1[4], p1[5]); w.w = pk2(p1[6], p1[7]); pf[2] = __builtin_bit_cast(bf16x8, w);
              w.x = pk2(p1[8], p1[9]); w.y = pk2(p1[10], p1[11]); w.z = pk2(p1[12], p1[13]); w.w = pk2(p1[14], p1[15]); pf[3] = __builtin_bit_cast(bf16x8, w); }
            __builtin_amdgcn_s_setprio(1);
            { const LAS unsigned char* vb = lds + cur * BUFB + 64 * KP + (4 * hi + ((lane & 15) >> 2)) * VP + (16 * ((lane >> 4) & 1) + 4 * (lane & 3)) * 2;
#pragma unroll
              for (int s2 = 0; s2 < 2; ++s2) { s16x4 lo[8], hh[8];
#pragma unroll
                  for (int i = 0; i < 8; ++i) { const int s = 2 * s2 + (i >> 2), d = i & 3; lo[i] = vtr(vb + s * 16 * VP + d * 64); hh[i] = vtr(vb + s * 16 * VP + 8 * VP + d * 64); }
                  __builtin_amdgcn_sched_barrier(0);
#pragma unroll
                  for (int i = 0; i < 8; ++i) { const int s = 2 * s2 + (i >> 2), d = i & 3;
                      const bf16x8 vf = (bf16x8){lo[i][0], lo[i][1], lo[i][2], lo[i][3], hh[i][0], hh[i][1], hh[i][2], hh[i][3]};
                      o[d] = __builtin_amdgcn_mfma_f32_32x32x16_bf16(vf, pf[s], o[d], 0, 0, 0); }
                  __builtin_amdgcn_sched_barrier(0); } }
            __builtin_amdgcn_s_setprio(0);
            if (t + 1 < NT) ATT_STORE(cur ^ 1);
            __syncthreads();
        }
        const float inv = 1.0f / (lrun + __shfl_xor(lrun, 32));
        bf16_t* op = O + (size_t)(qrow0 + wid * 32 + r32) * 1024 + h * 128;
#pragma unroll
        for (int d = 0; d < 4; ++d)
#pragma unroll
            for (int i4 = 0; i4 < 4; ++i4) { u32x2 w; w.x = pk2(o[d][4 * i4] * inv, o[d][4 * i4 + 1] * inv); w.y = pk2(o[d][4 * i4 + 2] * inv, o[d][4 * i4 + 3] * inv);
                *(u32x2*)(op + 32 * d + 8 * i4 + 4 * hi) = w; }
    }
#undef ATT_KROW
#undef ATT_LOAD
#undef ATT_STORE
}
#define XB_TMO      128
#define XB_XCNT(j)  (256  + 64 * (j))
#define XB_XSUB(j)  (1280 + 64 * (j))
#define XB_XGEN(j)  (2304 + 64 * (j))
#define XB_TOP      3328
#define XB_TOPGEN   3392
#define XCD_BAR_WORDS 3456
#define XB_SPIN_CAP (1u << 18)

__device__ __forceinline__ unsigned xb_ld(unsigned* p)              { return __hip_atomic_load(p, __ATOMIC_RELAXED, __HIP_MEMORY_SCOPE_AGENT); }
__device__ __forceinline__ unsigned xb_add(unsigned* p, unsigned v) { return __hip_atomic_fetch_add(p, v, __ATOMIC_RELAXED, __HIP_MEMORY_SCOPE_AGENT); }
__device__ __forceinline__ unsigned xb_xcc_id() { return (unsigned)__builtin_amdgcn_s_getreg((3 << 11) | 20) & 0xFu; }
#define XB_SPIN(cond, bar) do { unsigned _sp = 0; while (cond) { __builtin_amdgcn_s_sleep(1); \
    if ((++_sp & 255u) == 0u) { if (xb_ld(&(bar)[XB_TMO])) break; if (_sp > XB_SPIN_CAP) { atomicAdd(&(bar)[XB_TMO], 1u); break; } } } } while (0)

struct XcdBarrier {
    unsigned* bar; unsigned x;
    volatile LAS unsigned* st;
};

__device__ __forceinline__ XcdBarrier xcd_barrier_post(unsigned* bar, volatile LAS unsigned* st) {
    XcdBarrier b; b.bar = bar; b.x = xb_xcc_id(); b.st = st;
    if (threadIdx.x == 0) (void)xb_add(&bar[XB_XCNT(b.x)], 1u);
    return b;
}
__device__ __forceinline__ void xcd_barrier_complete(unsigned* bar, unsigned x, unsigned& nloc, unsigned& nx) {
    const unsigned G = gridDim.x * gridDim.y * gridDim.z;
    unsigned sum, cnt, mine, sp = 0u;
    for (;;) {
        sum = 0u; cnt = 0u; mine = 0u;
#pragma unroll
        for (unsigned j = 0; j < 16; ++j) { const unsigned c = xb_ld(&bar[XB_XCNT(j)]); sum += c; cnt += (c > 0u) ? 1u : 0u; mine = (j == x) ? c : mine; }
        if (sum == G) break;
        __builtin_amdgcn_s_sleep(1);
        if ((++sp & 255u) == 0u) { if (xb_ld(&bar[XB_TMO])) break; if (sp > XB_SPIN_CAP) { atomicAdd(&bar[XB_TMO], 1u); break; } }
    }
    nloc = mine > 0u ? mine : 1u; nx = cnt > 0u ? cnt : 1u;
}

__device__ __forceinline__ void xcd_barrier(const XcdBarrier& b) {
    asm volatile("s_waitcnt vmcnt(0)" ::: "memory");
    __syncthreads();
    if (threadIdx.x == 0) {
        unsigned* bar = b.bar;
        __builtin_amdgcn_s_waitcnt(0);
        unsigned nloc = b.st[0], nx = b.st[1];
        if (nloc == 0u) { xcd_barrier_complete(bar, b.x, nloc, nx); b.st[0] = nloc; b.st[1] = nx; }
        const unsigned old = xb_add(&bar[XB_XSUB(b.x)], 1u);
        const unsigned gen = old / nloc;
        if (old + 1u == (gen + 1u) * nloc) {
            __builtin_amdgcn_fence(__ATOMIC_RELEASE, "agent");
            asm volatile("s_waitcnt vmcnt(0)" ::: "memory");
            const unsigned og = xb_add(&bar[XB_TOP], 1u);
            const unsigned tg = og / nx;
            if (og + 1u == (tg + 1u) * nx) xb_add(&bar[XB_TOPGEN], 1u);
            else XB_SPIN(xb_ld(&bar[XB_TOPGEN]) == tg, bar);
            __builtin_amdgcn_fence(__ATOMIC_ACQUIRE, "agent");
            xb_add(&bar[XB_XGEN(b.x)], 1u);
            asm volatile("s_waitcnt vmcnt(0)" ::: "memory");
        } else {
            XB_SPIN(xb_ld(&bar[XB_XGEN(b.x)]) == gen, bar);
            __builtin_amdgcn_fence(__ATOMIC_ACQUIRE, "agent");
            asm volatile("s_waitcnt vmcnt(0)" ::: "memory");
        }
    }
    __syncthreads();
}

#define DERIVE_PTRS float* MOD = (float*)(ws + WS_MOD); float* ROPE = (float*)(ws + WS_ROPE); float* YSS = (float*)(ws + WS_YSS); float* CSS = (float*)(ws + WS_CSS); bf16_t* WEt = (bf16_t*)(ws + WS_S5E); bf16_t* WYt = (bf16_t*)(ws + WS_S5E + S5_WE_BYTES); float* XC = (float*)(ws + WS_XC); bf16_t* WL = (bf16_t*)(ws + WS_WL); bf16_t* H = (bf16_t*)(ws + WS_H); unsigned char* big = ws + WS_BIG; bf16_t* CQ = (bf16_t*)(big + B_CQ); bf16_t* U = (bf16_t*)(big + B_U); bf16_t* Qb = (bf16_t*)(big + B_Q); bf16_t* KVb = (bf16_t*)(big + B_KV); bf16_t* SG = (bf16_t*)(big + B_SG); bf16_t* ACT = (bf16_t*)(big + B_ACT); bf16_t* Y = (bf16_t*)(big + B_Y); bf16_t* T = (bf16_t*)(big + B_T); bf16_t* Gb = (bf16_t*)(big + B_G); bf16_t* Mb = (bf16_t*)(big + B_M); bf16_t* Ob = H;
constexpr int PPL = 13;
constexpr int NSTEPS = 2 + PPL * DEPTH;
struct Args { const float* in[29]; float* out; unsigned char* ws; int ph_lo, ph_hi; };
__global__ void __launch_bounds__(512, 2) mk_fwd(Args a) {
    extern __shared__ __attribute__((aligned(16))) unsigned char lds_raw[];
    cg::grid_group grid = cg::this_grid();
    LAS unsigned char* lds = (LAS unsigned char*)lds_raw;
    const int G = gridDim.x, NGW = G * 8;
    volatile LAS unsigned* xst = (volatile LAS unsigned*)(lds + LDS_BYTES - 64);
    if (threadIdx.x < 2) xst[threadIdx.x] = 0u;
    __syncthreads();
    XcdBarrier xbar; xbar.bar = (unsigned*)(a.ws + WS_CTL); xbar.x = 0; xbar.st = xst;
    if (a.ph_hi - a.ph_lo > 1) xbar = xcd_barrier_post((unsigned*)(a.ws + WS_CTL), xst);
    WPtrs WP{a.in[8], a.in[9], a.in[10], a.in[11], a.in[12], a.in[13], a.in[14], a.in[15], a.in[16], a.in[25], a.in[27], a.in[28]};
    S5In SP{a.in[17], a.in[18], a.in[19], a.in[20], a.in[21], a.in[22], a.in[23], a.in[24]};
#if MK_TIME >= 0
    unsigned long long tacc = 0ull;
#endif
#pragma unroll 1
    for (int step = a.ph_lo; step < a.ph_hi; ++step) {
#if MK_TIME >= 0
        const unsigned long long tph0 = __builtin_amdgcn_s_memrealtime();
#endif
        int tid = threadIdx.x; asm volatile("" : "+v"(tid));
        const int lane = tid & 63, wave = __builtin_amdgcn_readfirstlane(tid >> 6), gw = blockIdx.x * 8 + wave;
        unsigned char* ws = a.ws; asm volatile("" : "+s"(ws));
        DERIVE_PTRS
        int l = 0, p = -1;
        if (step >= 2) { l = (step - 2) / PPL; p = (step - 2) % PPL; if (p >= 6) ++p; }
        if (step == 0) mods_phase(a.in[1], a.in[3], a.in[4], a.in[5], MOD, ROPE, lds, tid);
        if (step == 0) conv_layer(WP, 0, WL, lds, gw, NGW, wave, lane, 0, 12864);
#if MK_PROBE == 9
        if (step == 0) { __syncthreads(); mods_phase(a.in[1], a.in[3], a.in[4], a.in[5], MOD, ROPE, lds, tid); conv_layer(WP, 0, WL, lds, gw, NGW, wave, lane, 0, 12864); }
#endif
        if (p == 13 && l < DEPTH - 1) conv_layer(WP, l + 1, WL, lds, gw, NGW, wave, lane, 7040, 8448);
        if (step == 1 || p == 2 || p == 10 || p == 13) {
            int s, nl, ns;
            if (step == 1) { s = -1; nl = 0; ns = 0; } else if (p == 2) { s = 0; nl = l; ns = 1; } else if (p == 10) { s = 1; nl = l; ns = 2; } else { s = 2; nl = (l < DEPTH - 1) ? l + 1 : -1; ns = 0; }
            e_phase(a.in[0], a.in[2], a.out, XC, Y, YSS, MOD, a.in[6], a.in[7], H, l, s, nl, ns, gw, NGW, lane, 1.0f, (l == DEPTH - 1 && p >= 10) ? R_LAT : R);
#if MK_PROBE == 5
            if (s >= 0) { __syncthreads(); e_phase(a.in[0], a.in[2], a.out, XC, Y, YSS, MOD, a.in[6], a.in[7], H, l, s, nl, ns, gw, NGW, lane, 0.0f, R); }
#endif
        }
        if (p == 0 || p == 1 || p == 3 || p == 4 || p == 7 || p == 8 || p == 9 || p == 11 || p == 12) {
            const int ng = (p == 4 || p == 7) ? 2 : 1;
#pragma unroll 1
            for (int gi = 0; gi < ng; ++gi) {
                pg8::Gemm g; Epi E; E.o0 = nullptr; E.o1 = nullptr; E.o2 = nullptr; E.i0 = nullptr; E.i1 = nullptr; E.ss = nullptr; E.css = CSS; E.bias = nullptr; E.rope = ROPE; E.mode = 0;
                g.M = R;
                if (p == 0 || p == 11) { g.A = H; g.Bt = WL + (p == 0 ? W_GUA : W_GUB); g.N = 5632; g.K = 1024; g.lda = 1024; E.mode = 0; E.o0 = ACT; }
                else if (p == 1 || p == 12) { g.A = ACT; g.Bt = WL + (p == 1 ? W_DA : W_DB); g.N = 1024; g.K = FF; g.lda = FF; E.mode = 1; E.o0 = Y; E.ss = YSS; }
                else if (p == 3) { g.A = H; g.Bt = WL + W_IN; g.N = 3840; g.K = 1024; g.lda = 1024; E.mode = 2; E.o0 = CQ; E.o1 = U; E.o2 = SG; E.ss = CSS; }
                else if (p == 4 && gi == 0) { g.A = CQ; g.Bt = WL + W_UQ; g.N = 1536; g.K = 256; g.lda = 768; E.mode = 3; E.o0 = Qb; }
                else if (p == 4) { g.A = CQ + 256; g.Bt = WL + W_UKV; g.N = 2048; g.K = 256; g.lda = 768; E.mode = 4; E.o0 = KVb; }
                else if (p == 7 && gi == 0) { g.A = T; g.Bt = WL + W_GLU; g.N = 1024; g.K = 1024; g.lda = 1024; E.mode = 5; E.o0 = Gb; E.i0 = T; E.bias = a.in[26] + l * 1024; }
                else if (p == 7) { g.A = Ob; g.Bt = WL + W_OMLA; g.N = 1024; g.K = 1024; g.lda = 1024; E.mode = 6; E.o0 = Mb; E.i0 = SG; }
                else if (p == 8) { g.A = Gb; g.Bt = WL + W_OS5; g.N = 1024; g.K = 1024; g.lda = 1024; E.mode = 7; E.o0 = Mb; E.i0 = Mb; E.i1 = SG + 1024; }
                else { g.A = Mb; g.Bt = WL + W_OUT; g.N = 1024; g.K = 1024; g.lda = 1024; E.mode = 1; E.o0 = Y; E.ss = YSS; }
                const int Mrows = (l == DEPTH - 1 && (p >= 7 || (p == 4 && gi == 0))) ? R_LAT : R;
                pg8::StaticOrder S; S.init(Mrows, g.N, G, (gi == 0) ? (int)blockIdx.x : (int)((blockIdx.x + (G >> 1)) % G));
                pg8::gemm_phase<Epi, pg8::StaticOrder, true, true>(lds, g, S, E, tid);
#if MK_PROBE == 3 || MK_PROBE == 6 || MK_PROBE == 7 || MK_PROBE == 8 || MK_PROBE == 10
                if ((MK_PROBE == 3 && (p == 0 || p == 11)) || (MK_PROBE == 6 && p == 9) || (MK_PROBE == 7 && (p == 1 || p == 12)) || (MK_PROBE == 8 && p == 4) || (MK_PROBE == 10 && p == 3)) { __syncthreads(); pg8::gemm_phase<Epi, pg8::StaticOrder, true, true>(lds, g, S, E, tid); }
#endif
            }
        }
        if (p == 4) {
#pragma unroll 1
            for (int rep = 0; rep < (MK_PROBE == 2 ? 2 : 1); ++rep) s5_main(SP, l, U, WEt, WYt, T, lds, tid); }
        if (G == 256) {
            const int bx = blockIdx.x;
            if (p == 1 && bx >= 32 && bx < 96) s5_prep(SP, l, bx - 32, WEt, WYt, lds, tid);
            if (l < DEPTH - 1 && bx >= 32) {
                const int vgw = (bx - 32) * 8 + wave, VNGW = 224 * 8;
                if (p == 7 && (bx < 128 || bx >= 160)) { const int v7 = ((bx < 128) ? bx - 32 : bx - 64) * 8 + wave;
                    conv_layer(WP, l + 1, WL, lds, v7, 192 * 8, wave, lane, 0, 2816); conv_layer(WP, l + 1, WL, lds, v7, 192 * 8, wave, lane, 5632, 7040); }
                if (p == 8) { conv_layer(WP, l + 1, WL, lds, vgw, VNGW, wave, lane, 8448, 11840); }
                if (p == 9) { conv_layer(WP, l + 1, WL, lds, vgw, VNGW, wave, lane, 11840, 12352); }
                if (p == 12) { conv_layer(WP, l + 1, WL, lds, vgw, VNGW, wave, lane, 12352, 12864); conv_layer(WP, l + 1, WL, lds, vgw, VNGW, wave, lane, 2816, 5632); }
            }
        }
        if (G != 256) {
            if (p == 2 && blockIdx.x < 64) s5_prep(SP, l, blockIdx.x, WEt, WYt, lds, tid);
            if (p == 13 && l < DEPTH - 1) { conv_layer(WP, l + 1, WL, lds, gw, NGW, wave, lane, 0, 7040); conv_layer(WP, l + 1, WL, lds, gw, NGW, wave, lane, 8448, 12864); }
        }
        if (p == 5) {
#pragma unroll 1
            for (int rep = 0; rep < (MK_PROBE == 1 ? 2 : 1); ++rep) attn_phase(lds, Qb, KVb, CQ, Ob, tid, (l == DEPTH - 1) ? 1024 : 1024 + 64); }
#if MK_TIME >= 0
        const unsigned long long tb0 = __builtin_amdgcn_s_memrealtime();
#endif
        if (step + 1 < a.ph_hi) {
            if (step == a.ph_lo) grid.sync(); else xcd_barrier(xbar);
#if MK_PROBE == 4
            xcd_barrier(xbar); xcd_barrier(xbar);
#endif
        }
#if MK_TIME >= 0
        { const unsigned long long tb1 = __builtin_amdgcn_s_memrealtime();
          const int cls = (step == 0) ? 10 : (step == 1 || p == 2 || p == 10 || p == 13) ? 2 : (p == 0 || p == 11) ? 0 : (p == 1 || p == 12) ? 1 : (p == 3) ? 3 : (p == 4) ? 4 : (p == 5) ? 5 : (p == 7) ? 6 : (p == 8) ? 7 : 8;
          if (MK_TIME == 99) tacc += tb1 - tb0; else if (cls == MK_TIME) tacc += tb1 - tph0; }
#endif
    }
#if MK_TIME >= 0
    if (blockIdx.x == MK_TIME_BLOCK) { const unsigned long long te = __builtin_amdgcn_s_memrealtime(); while (__builtin_amdgcn_s_memrealtime() - te < tacc) __builtin_amdgcn_s_sleep(16); }
#endif
}

extern "C" void kernel_launch(void* const* d_in, const int* in_sizes, int n_in, void* d_out, int out_size, void* d_ws, size_t ws_size, hipStream_t stream) {
    static int grid = 0;
    if (grid == 0) {
        if (n_in != 29 || out_size != R_LAT * DM || ws_size < WS_END) { fprintf(stderr, "kernel_launch: unexpected problem (n_in %d out %d ws %zu need %zu)\n", n_in, out_size, ws_size, (size_t)WS_END); grid = -1; return; }
        int dev = 0, cus = 0, per_cu = 0;
        if (hipGetDevice(&dev) != hipSuccess || hipDeviceGetAttribute(&cus, hipDeviceAttributeMultiprocessorCount, dev) != hipSuccess) { grid = -1; return; }
        if (hipFuncSetAttribute((const void*)mk_fwd, hipFuncAttributeMaxDynamicSharedMemorySize, LDS_BYTES) != hipSuccess) { fprintf(stderr, "kernel_launch: hipFuncSetAttribute failed\n"); grid = -1; return; }
        if (hipOccupancyMaxActiveBlocksPerMultiprocessor(&per_cu, (const void*)mk_fwd, 512, LDS_BYTES) != hipSuccess || per_cu < 1) { fprintf(stderr, "kernel_launch: occupancy query says %d\n", per_cu); per_cu = 1; }
        (void)hipGetLastError();
        grid = cus * 1;
    }
    if (grid < 0) return;
    if (hipMemsetAsync((char*)d_ws + WS_CTL, 0, CTL_BYTES, stream) != hipSuccess) { fprintf(stderr, "kernel_launch: memset failed\n"); return; }
    Args a{};
    for (int i = 0; i < 29; ++i) a.in[i] = (const float*)d_in[i];
    a.out = (float*)d_out; a.ws = (unsigned char*)d_ws;
#if MK_MULTI
    for (int s = 0; s < NSTEPS; ++s) { a.ph_lo = s; a.ph_hi = s + 1; void* args[] = {&a};
        hipError_t e = hipLaunchCooperativeKernel((const void*)mk_fwd, dim3(grid), dim3(512), args, LDS_BYTES, stream);
        if (e != hipSuccess) { fprintf(stderr, "cooperative launch %d failed: %s\n", s, hipGetErrorString(e)); break; } }
#else
    a.ph_lo = 0; a.ph_hi = NSTEPS; void* args[] = {&a};
    hipError_t e = hipLaunchCooperativeKernel((const void*)mk_fwd, dim3(grid), dim3(512), args, LDS_BYTES, stream);
    if (e != hipSuccess) fprintf(stderr, "cooperative launch failed: %s (grid %d)\n", hipGetErrorString(e), grid);
#endif
}
```

```cpp
#include <hip/hip_runtime.h>
#include <hip/hip_cooperative_groups.h>
#include <cstdio>
#include <cstdint>
namespace cg = cooperative_groups;
#ifndef MK_MULTI
#define MK_MULTI 0
#endif
#ifndef MK_PROBE
#define MK_PROBE 0
#endif
#ifndef MK_TIME
#define MK_TIME -1
#endif
#ifndef MK_TIME_BLOCK
#define MK_TIME_BLOCK 128
#endif
namespace pg8 {
#define PG8_LAS __attribute__((address_space(3)))
typedef unsigned short bf16_t;
typedef short bf16x8 __attribute__((ext_vector_type(8)));
typedef float f32x4 __attribute__((ext_vector_type(4)));
typedef unsigned u32x4 __attribute__((ext_vector_type(4)));
constexpr int BM = 256, BK = 64, HALF = 128, HTB = HALF * BK * 2  , STAGE_BYTES = 8 * HTB, NXCD = 8, WGM = 8;

__host__ __device__ __forceinline__ int lds_byte(int r, int c) { const int st = (r >> 4) * 2 + (c >> 5), rr = r & 15, cc = c & 31, ob = rr * 64 + cc * 2; return st * 1024 + (ob ^ (((ob >> 9) & 1) << 5)); }
__host__ __device__ __forceinline__ void stage_rc(int b, int& R, int& C) { const int st = b / 1024, sb = b % 1024, swz = sb ^ (((sb >> 9) & 1) << 5); R = (st >> 1) * 16 + swz / 64; C = (st & 1) * 32 + (swz % 64) / 2; }
__host__ __device__ __forceinline__ int perm32(int rho) { const int n = rho >> 4, i = rho & 15; return 8 * (i >> 2) + 4 * n + (i & 3); }

struct Unit { int pm, pn; };
struct Gemm { const bf16_t* A; const bf16_t* Bt; int M, N, K, lda; };

struct StaticOrder {
    int nM, nN, nwg, G, c;
    __host__ __device__ void init(int M, int N, int G_, int c_) { nM = M / BM; nN = N / BM; nwg = nM * nN; G = G_; c = c_; }
    __host__ __device__ bool next(int i, Unit& u) const {
        const long L = (long)i * G + c; if (L >= nwg) return false;
        int wgid = (int)L; { const int q = nwg / NXCD, r = nwg % NXCD, xcd = wgid % NXCD, off = wgid / NXCD; wgid = (xcd < r ? xcd * (q + 1) : r * (q + 1) + (xcd - r) * q) + off; }
        const int nig = WGM * nN, gid = wgid / nig, fm = gid * WGM, gsz = (nM - fm) < WGM ? (nM - fm) : WGM;
        u.pm = fm + ((wgid % nig) % gsz); u.pn = (wgid % nig) / gsz; return true;
    }
    __device__ __forceinline__ void a_ready(const Unit&) const {}
    __device__ __forceinline__ void done(const Unit&) const {}
};

__device__ __forceinline__ unsigned cvt_pk_bf16(float lo, float hi) { unsigned r; asm volatile("v_cvt_pk_bf16_f32 %0, %1, %2" : "=v"(r) : "v"(lo), "v"(hi)); return r; }
template <class Epi, class Sched, bool ALIGN_EPI = false, bool SP2 = false>
__device__ __forceinline__ void gemm_phase(PG8_LAS unsigned char* lds, const Gemm g, const Sched& S, const Epi& E, const int tid) {
    const int wid = __builtin_amdgcn_readfirstlane(tid >> 6), lane = tid & 63, wr = wid >> 2, wc = wid & 3, fr = lane & 15, fq = lane >> 4;
    const int K = g.K, nt = K / BK;
    unsigned voffA[2], voffB[2];
#pragma unroll
    for (int i = 0; i < 2; ++i) { int R, C; stage_rc(tid * 16 + i * 8192, R, C); const int Rb = Epi::PERM ? ((R & ~31) + perm32(R & 31)) : R;
        voffA[i] = (unsigned)(R * g.lda + C) * 2u; voffB[i] = (unsigned)(Rb * K + C) * 2u; }
    const size_t kstep = (size_t)(BK * 2);
    const size_t hstep = (size_t)HALF * K * 2;
    const size_t tstep = 2 * hstep; const size_t hstepA = (size_t)HALF * g.lda * 2, tstepA = 2 * hstepA;
    const unsigned ldsw = (unsigned)wid * 1024u;
    const int aoff = lds_byte(wr * 64 + fr, fq * 8), boff = lds_byte(wc * 32 + fr, fq * 8);
#define PG8_SA(b, h) (((b) * 2 + (h)) * HTB)
#define PG8_SB(b, h) ((4 + (b) * 2 + (h)) * HTB)
#define PG8_STAGE(bufoff, gbase, voff) do { _Pragma("unroll") for (int _i = 0; _i < 2; ++_i) \
        __builtin_amdgcn_global_load_lds((const unsigned*)((const char*)(gbase) + (voff)[_i]), (PG8_LAS unsigned*)(lds + (bufoff) + ldsw + _i * 8192), 16, 0, 0); } while (0)
#define PG8_LDA(dst, b, h) do { _Pragma("unroll") for (int m = 0; m < 4; ++m) _Pragma("unroll") for (int k = 0; k < 2; ++k) dst[m][k] = *(const PG8_LAS bf16x8*)(lds + PG8_SA(b, h) + aoff + m * 2048 + k * 1024); } while (0)
#define PG8_LDB(dst, b, h) do { _Pragma("unroll") for (int n = 0; n < 2; ++n) _Pragma("unroll") for (int k = 0; k < 2; ++k) dst[n][k] = *(const PG8_LAS bf16x8*)(lds + PG8_SB(b, h) + boff + n * 2048 + k * 1024); } while (0)
#define PG8_MMA(ai, bj, At, Bt) do { __builtin_amdgcn_s_setprio(1); _Pragma("unroll") for (int m = 0; m < 4; ++m) _Pragma("unroll") for (int n = 0; n < 2; ++n) _Pragma("unroll") for (int k = 0; k < 2; ++k) \
        acc[ai][bj][m][n] = __builtin_amdgcn_mfma_f32_16x16x32_bf16(Bt[n][k], At[m][k], acc[ai][bj][m][n], 0, 0, 0); __builtin_amdgcn_s_setprio(0); } while (0)
#define PG8_WAIT_V(n) asm volatile("s_waitcnt vmcnt(" #n ")" ::: "memory")
#define PG8_WAIT_L(n) asm volatile("s_waitcnt lgkmcnt(" #n ")" ::: "memory")
#define PG8_BAR __builtin_amdgcn_s_barrier()
#define PG8_SCHED __builtin_amdgcn_sched_barrier(0)
    Unit cur, nxt; int ui = 0;
    if (!S.next(0, cur)) return;
    f32x4 acc[2][2][4][2];
#pragma unroll
    for (int a = 0; a < 2; ++a)
#pragma unroll
        for (int b = 0; b < 2; ++b)
#pragma unroll
            for (int m = 0; m < 4; ++m)
#pragma unroll
                for (int n = 0; n < 2; ++n) acc[a][b][m][n] = (f32x4){0.f, 0.f, 0.f, 0.f};
    bf16x8 At[4][2], B0[2][2], B1[2][2];
    const char* cA = (const char*)g.A + (size_t)cur.pm * tstepA; const char* cB = (const char*)g.Bt + (size_t)cur.pn * tstep;
    S.a_ready(cur);
    if constexpr (SP2) {
        PG8_STAGE(PG8_SB(0, 0), cB, voffB); PG8_STAGE(PG8_SB(0, 1), cB + hstep, voffB); PG8_STAGE(PG8_SA(0, 0), cA, voffA); PG8_STAGE(PG8_SA(0, 1), cA + hstepA, voffA);
        if (wr == 1) PG8_BAR;
        PG8_WAIT_V(2); PG8_BAR;
        PG8_STAGE(PG8_SB(1, 0), cB + kstep, voffB); PG8_STAGE(PG8_SA(1, 0), cA + kstep, voffA); PG8_STAGE(PG8_SB(1, 1), cB + hstep + kstep, voffB);
        PG8_WAIT_V(6); PG8_BAR;
    } else {
        PG8_STAGE(PG8_SB(0, 0), cB, voffB); PG8_STAGE(PG8_SA(0, 0), cA, voffA); PG8_STAGE(PG8_SB(0, 1), cB + hstep, voffB); PG8_STAGE(PG8_SA(0, 1), cA + hstepA, voffA);
        if (wr == 1) PG8_BAR;
        PG8_WAIT_V(4); PG8_BAR;
        PG8_STAGE(PG8_SB(1, 0), cB + kstep, voffB); PG8_STAGE(PG8_SA(1, 0), cA + kstep, voffA); PG8_STAGE(PG8_SB(1, 1), cB + hstep + kstep, voffB);
        PG8_WAIT_V(6); PG8_BAR;
    }
    for (;;) {
        const bool has_next = S.next(ui + 1, nxt);
        const char* nA = has_next ? (const char*)g.A + (size_t)nxt.pm * tstepA : cA; const char* nB = has_next ? (const char*)g.Bt + (size_t)nxt.pn * tstep : cB;
        for (int t = 0; t < nt; t += 2) {
            const bool last = (t == nt - 2);
            const char* a1 = cA + (size_t)(t + 1) * kstep;
            const char* a2 = last ? nA : cA + (size_t)(t + 2) * kstep; const char* b2 = last ? nB : cB + (size_t)(t + 2) * kstep;
            const char* a3 = a2 + kstep; const char* b3 = b2 + kstep;
            if (last && has_next) S.a_ready(nxt);
            if constexpr (SP2) {
            PG8_LDB(B0, 0, 0); PG8_LDB(B1, 0, 1); PG8_SCHED; PG8_LDA(At, 0, 0); PG8_STAGE(PG8_SA(1, 1), a1 + hstepA, voffA);
            PG8_WAIT_V(8); PG8_WAIT_L(0); PG8_BAR; PG8_MMA(0, 0, At, B0); PG8_MMA(0, 1, At, B1); PG8_BAR; PG8_SCHED;
            PG8_LDA(At, 0, 1); PG8_STAGE(PG8_SB(0, 0), b2, voffB); PG8_STAGE(PG8_SB(0, 1), b2 + hstep, voffB); PG8_STAGE(PG8_SA(0, 0), a2, voffA);
            PG8_WAIT_V(8); PG8_WAIT_L(0); PG8_BAR; PG8_MMA(1, 0, At, B0); PG8_MMA(1, 1, At, B1); PG8_BAR; PG8_SCHED;
            PG8_LDB(B0, 1, 0); PG8_LDB(B1, 1, 1); PG8_SCHED; PG8_LDA(At, 1, 0); PG8_STAGE(PG8_SA(0, 1), a2 + hstepA, voffA);
            PG8_WAIT_V(8); PG8_WAIT_L(0); PG8_BAR; PG8_MMA(0, 0, At, B0); PG8_MMA(0, 1, At, B1); PG8_BAR; PG8_SCHED;
            PG8_LDA(At, 1, 1); PG8_STAGE(PG8_SB(1, 0), b3, voffB); PG8_STAGE(PG8_SB(1, 1), b3 + hstep, voffB); PG8_STAGE(PG8_SA(1, 0), a3, voffA);
            PG8_WAIT_V(8); PG8_WAIT_L(0); PG8_BAR; PG8_MMA(1, 0, At, B0); PG8_MMA(1, 1, At, B1); PG8_BAR; PG8_SCHED;
            } else {
            PG8_LDB(B0, 0, 0); PG8_SCHED; PG8_LDA(At, 0, 0); PG8_STAGE(PG8_SA(1, 1), a1 + hstepA, voffA);
            PG8_WAIT_L(8); PG8_BAR; PG8_WAIT_L(0); PG8_MMA(0, 0, At, B0); PG8_BAR; PG8_SCHED;
            PG8_LDB(B1, 0, 1); PG8_STAGE(PG8_SB(0, 0), b2, voffB);
            PG8_BAR; PG8_WAIT_L(0); PG8_MMA(0, 1, At, B1); PG8_BAR;
            PG8_LDA(At, 0, 1); PG8_STAGE(PG8_SA(0, 0), a2, voffA);
            PG8_BAR; PG8_WAIT_L(0); PG8_MMA(1, 0, At, B0); PG8_BAR; PG8_SCHED;
            PG8_STAGE(PG8_SB(0, 1), b2 + hstep, voffB);
            PG8_WAIT_V(6); PG8_BAR; PG8_MMA(1, 1, At, B1); PG8_BAR;
            PG8_LDB(B0, 1, 0); PG8_SCHED; PG8_LDA(At, 1, 0); PG8_STAGE(PG8_SA(0, 1), a2 + hstepA, voffA);
            PG8_WAIT_L(8); PG8_BAR; PG8_WAIT_L(0); PG8_MMA(0, 0, At, B0); PG8_BAR; PG8_SCHED;
            PG8_LDB(B1, 1, 1); PG8_STAGE(PG8_SB(1, 0), b3, voffB);
            PG8_BAR; PG8_WAIT_L(0); PG8_MMA(0, 1, At, B1); PG8_BAR;
            PG8_LDA(At, 1, 1); PG8_STAGE(PG8_SA(1, 0), a3, voffA);
            PG8_BAR; PG8_WAIT_L(0); PG8_MMA(1, 0, At, B0); PG8_BAR; PG8_SCHED;
            PG8_STAGE(PG8_SB(1, 1), b3 + hstep, voffB);
            PG8_WAIT_V(6); PG8_BAR; PG8_MMA(1, 1, At, B1); PG8_BAR;
            }
        }
        if constexpr (ALIGN_EPI) { if (wr == 0) PG8_BAR; }
        if constexpr (!Epi::AFTER_DRAIN) { E(acc, cur, wr, wc, fr, fq); S.done(cur); }
        if (!has_next) break;
#pragma unroll
        for (int a = 0; a < 2; ++a)
#pragma unroll
            for (int b = 0; b < 2; ++b)
#pragma unroll
                for (int m = 0; m < 4; ++m)
#pragma unroll
                    for (int n = 0; n < 2; ++n) acc[a][b][m][n] = (f32x4){0.f, 0.f, 0.f, 0.f};
        cur = nxt; cA = nA; cB = nB; ++ui;
        if constexpr (ALIGN_EPI) { if (wr == 1) PG8_BAR; }
    }
    PG8_WAIT_V(0);
    if constexpr (!ALIGN_EPI) { if (wr == 0) PG8_BAR; }
    PG8_BAR;
    if constexpr (Epi::AFTER_DRAIN) { E.fused(acc, cur, wr, wc, fr, fq, lds, wid, lane); S.done(cur); }
#undef PG8_SA
#undef PG8_SB
#undef PG8_STAGE
#undef PG8_LDA
#undef PG8_LDB
#undef PG8_MMA
#undef PG8_WAIT_V
#undef PG8_WAIT_L
#undef PG8_BAR
#undef PG8_SCHED
}
}
using pg8::bf16_t; using pg8::f32x4; using pg8::u32x4; using pg8::bf16x8; using pg8::Unit;
#define LAS __attribute__((address_space(3)))
typedef float f32x16 __attribute__((ext_vector_type(16)));
typedef unsigned u32x2 __attribute__((ext_vector_type(2)));
typedef short s16x4 __attribute__((ext_vector_type(4)));
constexpr int NB = 8, SEQ = 4096, CTXL = 256, DM = 1024, FF = 2816, DEPTH = 4, NH = 8;
constexpr int R_LAT = NB * SEQ, R_CTX = NB * CTXL, R = R_LAT + R_CTX;
constexpr float EPS = 1e-6f;
constexpr int NCH = 34;
constexpr size_t W_GUA = 0, W_DA = W_GUA + (size_t)5632 * 1024, W_GUB = W_DA + (size_t)1024 * 2816, W_DB = W_GUB + (size_t)5632 * 1024,
                 W_IN = W_DB + (size_t)1024 * 2816, W_UQ = W_IN + (size_t)3840 * 1024, W_UKV = W_UQ + (size_t)1536 * 256, W_OMLA = W_UKV + (size_t)2048 * 256,
                 W_GLU = W_OMLA + (size_t)1024 * 1024, W_OS5 = W_GLU + (size_t)1024 * 1024, W_OUT = W_OS5 + (size_t)1024 * 1024, W_END = W_OUT + (size_t)1024 * 1024;
constexpr size_t al256(size_t x) { return (x + 255) & ~(size_t)255; }
constexpr size_t WS_CTL = 0, CTL_BYTES = 16384;
constexpr size_t WS_MOD = WS_CTL + CTL_BYTES;
constexpr size_t WS_ROPE = WS_MOD + al256((size_t)4 * 9 * 9216 * 4);
constexpr size_t WS_YSS = WS_ROPE + al256(64 * 16 * 8);
constexpr size_t WS_CSS = WS_YSS + al256((size_t)R * 16 * 4);
constexpr size_t WS_S5E = WS_CSS + al256((size_t)R * 8 * 4);
constexpr size_t S5_WE_BYTES = (size_t)2 * 64 * 128 * 256 * 2, S5_WY_BYTES = (size_t)64 * 256 * 512 * 2;
constexpr size_t WS_XC = WS_S5E + al256(S5_WE_BYTES + S5_WY_BYTES);
constexpr size_t WS_WL = WS_XC + al256((size_t)R_CTX * DM * 4);
constexpr size_t WS_H = WS_WL + al256(W_END * 2);
constexpr size_t WS_BIG = WS_H + al256((size_t)R * DM * 2);
constexpr size_t B_CQ = 0, B_U = B_CQ + (size_t)R * 768 * 2, B_Q = B_U + (size_t)R * 1024 * 2, B_KV = B_Q + (size_t)R * 1536 * 2, B_SG = B_KV + (size_t)R * 2048 * 2, B_END = B_SG + (size_t)R * 2048 * 2;
constexpr size_t B_ACT = 0, B_Y = (size_t)R * FF * 2;
constexpr size_t B_T = B_U, B_G = B_KV, B_M = B_Q;
static_assert(B_Y >= B_M + (size_t)R * 1024 * 2 && B_Y + (size_t)R * 1024 * 2 <= B_SG, "Y overlay");
constexpr size_t WS_END = WS_BIG + B_END;
constexpr int LDS_BYTES = 272 * 528 + 8192 + 16 * 528 + 256;

__device__ __forceinline__ float bf2f(unsigned h) { return __uint_as_float(h << 16); }
__device__ __forceinline__ unsigned pk2(float lo, float hi) { return pg8::cvt_pk_bf16(lo, hi); }
__device__ __forceinline__ float sigm(float x) { return __builtin_amdgcn_rcpf(1.f + __builtin_amdgcn_exp2f(-1.4426950408889634f * x)); }
__device__ __forceinline__ float gelu_tanh(float x) { return x * sigm(1.5957691216057308f * (x + 0.044715f * x * x * x)); }
__device__ __forceinline__ void unpack8(const u32x4 w, float (&f)[8]) {
    f[0] = bf2f(w.x & 0xffffu); f[1] = __uint_as_float(w.x & 0xffff0000u); f[2] = bf2f(w.y & 0xffffu); f[3] = __uint_as_float(w.y & 0xffff0000u);
    f[4] = bf2f(w.z & 0xffffu); f[5] = __uint_as_float(w.z & 0xffff0000u); f[6] = bf2f(w.w & 0xffffu); f[7] = __uint_as_float(w.w & 0xffff0000u);
}
__device__ __forceinline__ u32x4 pack8(const float (&f)[8]) { u32x4 w; w.x = pk2(f[0], f[1]); w.y = pk2(f[2], f[3]); w.z = pk2(f[4], f[5]); w.w = pk2(f[6], f[7]); return w; }
__device__ __forceinline__ float wave_sum(float v) {
#pragma unroll
    for (int o = 1; o < 64; o <<= 1) v += __shfl_xor(v, o);
    return v;
}
__device__ __forceinline__ void rope8(float (&v)[8], int row, int wc, int fq, const float* tab) {
    const int t = row & 4095, pos = (wc & 1) ? (t & 63) : (t >> 6);
    const f32x4* tp = (const f32x4*)(tab + (pos * 16 + 8 * (fq & 1)) * 2);
    const f32x4 t0 = tp[0], t1 = tp[1], t2 = tp[2], t3 = tp[3];
    const float cs[8] = {t0[0], t0[2], t1[0], t1[2], t2[0], t2[2], t3[0], t3[2]}, sn[8] = {t0[1], t0[3], t1[1], t1[3], t2[1], t2[3], t3[1], t3[3]};
    const float sgn = (fq < 2) ? -1.f : 1.f;
#pragma unroll
    for (int j = 0; j < 8; ++j) { const float p = __shfl_xor(v[j], 32); v[j] = v[j] * cs[j] + sgn * p * sn[j]; }
}

struct Epi {
    static constexpr bool PERM = true, AFTER_DRAIN = false;
    int mode;
    bf16_t* o0; bf16_t* o1; bf16_t* o2; const bf16_t* i0; const bf16_t* i1; float* ss; const float* css; const float* bias; const float* rope;
    __device__ __forceinline__ void operator()(const f32x4 (&acc)[2][2][4][2], const Unit& u, int wr, int wc, int fr, int fq) const {
        const int row0 = u.pm * 256 + wr * 64 + fr, cb = wc * 32 + 8 * fq, pn = u.pn;
        if (mode == 0) {
            bf16_t* base = o0 + (size_t)pn * 128 + cb;
#pragma unroll
            for (int ai = 0; ai < 2; ++ai)
#pragma unroll
                for (int m = 0; m < 4; ++m) { const int row = row0 + ai * 128 + m * 16; float v[8];
#pragma unroll
                    for (int n = 0; n < 2; ++n)
#pragma unroll
                        for (int j = 0; j < 4; ++j) { const float g = acc[ai][0][m][n][j], up = acc[ai][1][m][n][j]; v[4 * n + j] = g * sigm(g) * up; }
                    *(u32x4*)(base + (size_t)row * FF) = pack8(v); }
        } else if (mode == 1) {
            bf16_t* base = o0 + pn * 256 + cb;
#pragma unroll
            for (int ai = 0; ai < 2; ++ai)
#pragma unroll
                for (int m = 0; m < 4; ++m) { const int row = row0 + ai * 128 + m * 16; float s = 0.f;
#pragma unroll
                    for (int bj = 0; bj < 2; ++bj) { float v[8];
#pragma unroll
                        for (int n = 0; n < 2; ++n)
#pragma unroll
                            for (int j = 0; j < 4; ++j) { const float x = acc[ai][bj][m][n][j]; v[4 * n + j] = x; s += x * x; }
                        *(u32x4*)(base + (size_t)row * 1024 + bj * 128) = pack8(v); }
                    s += __shfl_xor(s, 16); s += __shfl_xor(s, 32);
                    if (fq == 0) ss[row * 16 + pn * 4 + wc] = s; }
        } else if (mode == 2) {
            bf16_t* dst; int ldc;
            if (pn < 3) { dst = o0 + pn * 256; ldc = 768; } else if (pn < 7) { dst = o1 + (pn - 3) * 256; ldc = 1024; } else { dst = o2 + (pn - 7) * 256; ldc = 2048; }
            const bool sg = pn >= 7, docss = pn < 2, dorope = (pn == 2) && (u.pm < 128) && (wc < 2);
            dst += cb;
#pragma unroll
            for (int ai = 0; ai < 2; ++ai)
#pragma unroll
                for (int m = 0; m < 4; ++m) { const int row = row0 + ai * 128 + m * 16; float s = 0.f;
#pragma unroll
                    for (int bj = 0; bj < 2; ++bj) { float v[8];
#pragma unroll
                        for (int n = 0; n < 2; ++n)
#pragma unroll
                            for (int j = 0; j < 4; ++j) { float x = acc[ai][bj][m][n][j]; if (sg) x = sigm(x); v[4 * n + j] = x; s += x * x; }
                        if (bj == 0 && dorope) rope8(v, row, wc, fq, rope);
                        *(u32x4*)(dst + (size_t)row * ldc + bj * 128) = pack8(v); }
                    if (docss) { s += __shfl_xor(s, 16); s += __shfl_xor(s, 32); if (fq == 0) ss[row * 8 + pn * 4 + wc] = s; } }
        } else if (mode == 3 || mode == 4) {
            const int ldc = (mode == 3) ? 1536 : 2048; const float* cp = css + ((mode == 3) ? 0 : 4);
            const bool dorope = (mode == 3) && (pn >= 4) && (u.pm < 128);
            bf16_t* dst = o0 + pn * 256 + cb;
#pragma unroll
            for (int ai = 0; ai < 2; ++ai)
#pragma unroll
                for (int m = 0; m < 4; ++m) { const int row = row0 + ai * 128 + m * 16; const f32x4 c4 = *(const f32x4*)(cp + row * 8);
                    const float rs = 1.0f / sqrtf(((c4[0] + c4[1]) + (c4[2] + c4[3])) * (1.0f / 256.0f) + EPS);
#pragma unroll
                    for (int bj = 0; bj < 2; ++bj) { float v[8];
#pragma unroll
                        for (int n = 0; n < 2; ++n)
#pragma unroll
                            for (int j = 0; j < 4; ++j) v[4 * n + j] = acc[ai][bj][m][n][j] * rs;
                        if (dorope) rope8(v, row, wc, fq, rope);
                        *(u32x4*)(dst + (size_t)row * ldc + bj * 128) = pack8(v); } }
        } else {
            const int col = pn * 256 + cb;
#pragma unroll
            for (int ai = 0; ai < 2; ++ai)
#pragma unroll
                for (int m = 0; m < 4; ++m) { const int row = row0 + ai * 128 + m * 16;
#pragma unroll
                    for (int bj = 0; bj < 2; ++bj) { const int c = col + bj * 128; float v[8], a[8], b[8];
#pragma unroll
                        for (int n = 0; n < 2; ++n)
#pragma unroll
                            for (int j = 0; j < 4; ++j) v[4 * n + j] = acc[ai][bj][m][n][j];
                        if (mode == 5) { unpack8(*(const u32x4*)(i0 + (size_t)row * 1024 + c), a); const f32x4 b0 = *(const f32x4*)(bias + c), b1 = *(const f32x4*)(bias + c + 4);
#pragma unroll
                            for (int j = 0; j < 4; ++j) { v[j] = a[j] * sigm(v[j] + b0[j]); v[4 + j] = a[4 + j] * sigm(v[4 + j] + b1[j]); } }
                        else if (mode == 6) { unpack8(*(const u32x4*)(i0 + (size_t)row * 2048 + c), a);
#pragma unroll
                            for (int j = 0; j < 8; ++j) v[j] = a[j] * v[j]; }
                        else { unpack8(*(const u32x4*)(i0 + (size_t)row * 1024 + c), a); unpack8(*(const u32x4*)(i1 + (size_t)row * 2048 + c), b);
#pragma unroll
                            for (int j = 0; j < 8; ++j) v[j] = a[j] + b[j] * v[j]; }
                        *(u32x4*)(o0 + (size_t)row * 1024 + c) = pack8(v); } }
        }
    }
};
__device__ __forceinline__ void conv_item(const float* W, int ldsrc, int srccol, const float* kscale, bf16_t* WT, int K, int n0, int k0, LAS float* scr, int lane) {
    if (srccol >= 0) {
#pragma unroll 8
        for (int i = 0; i < 32; ++i) { const int kk = 2 * i + (lane >> 5); float w = W[(size_t)(k0 + kk) * ldsrc + srccol + (lane & 31)]; if (kscale) w *= kscale[k0 + kk]; scr[kk * 33 + (lane & 31)] = w; }
    } else {
#pragma unroll 8
        for (int i = 0; i < 32; ++i) { const int kk = 2 * i + (lane >> 5); scr[kk * 33 + (lane & 31)] = 0.f; }
    }
    asm volatile("s_waitcnt lgkmcnt(0)" ::: "memory");
    const int c = lane & 7;
#pragma unroll
    for (int j = 0; j < 4; ++j) { const int n = (lane >> 3) + 8 * j; const LAS float* s = scr + (8 * c) * 33 + n;
        u32x4 o; o.x = pk2(s[0 * 33], s[1 * 33]); o.y = pk2(s[2 * 33], s[3 * 33]); o.z = pk2(s[4 * 33], s[5 * 33]); o.w = pk2(s[6 * 33], s[7 * 33]);
        *(u32x4*)(WT + (size_t)(n0 + n) * K + k0 + 8 * c) = o; }
    asm volatile("s_waitcnt lgkmcnt(0)" ::: "memory");
}
struct WPtrs { const float *gate, *up, *down, *win, *qn, *wuq, *kvn, *wukv, *womla, *glu, *wos5, *wout; };
__device__ __forceinline__ void conv_layer(const WPtrs& P, int l, bf16_t* WL, LAS unsigned char* lds, int gw, int NGW, int wave, int lane, int it_lo, int it_hi) {
    LAS float* scr = (LAS float*)(lds + wave * 16384);
    constexpr int I_GU = 16 * 176, I_D = 44 * 32, I_IN = 16 * 120, I_UQ = 4 * 48, I_UKV = 4 * 64, I_SQ = 16 * 32;
    constexpr int NIT = 2 * I_GU + 2 * I_D + I_IN + I_UQ + I_UKV + 4 * I_SQ;
    static_assert(NIT == 12864, "conv items");
    for (int it = it_lo + gw; it < it_hi; it += NGW) {
        int r = it;
        if (r < 2 * I_GU) { const int f = r / I_GU; r -= f * I_GU; const int nb = r % 176, kb = r / 176, n0 = nb * 32, tile = n0 >> 8, within = n0 & 255, half = within >> 7, ffc = tile * 128 + (within & 127);
            const size_t so = (size_t)(l * 2 + f) * 1024 * FF; bf16_t* dst = WL + (f ? W_GUB : W_GUA);
            if (half) conv_item(P.up + so, FF, ffc, nullptr, dst, 1024, n0, kb * 64, scr, lane); else conv_item(P.gate + so, FF, ffc, nullptr, dst, 1024, n0, kb * 64, scr, lane);
            continue; }
        r -= 2 * I_GU;
        if (r < 2 * I_D) { const int f = r / I_D; r -= f * I_D; const int nb = r % 32, kb = r / 32;
            conv_item(P.down + (size_t)(l * 2 + f) * FF * 1024, 1024, nb * 32, nullptr, WL + (f ? W_DB : W_DA), FF, nb * 32, kb * 64, scr, lane); continue; }
        r -= 2 * I_D;
        if (r < I_IN) { const int nb = r % 120, kb = r / 120, n0 = nb * 32; int sc;
            if (n0 < 512) sc = n0; else if (n0 < 768) sc = (n0 < 576) ? n0 : -1; else sc = n0 - 768 + 576;
            conv_item(P.win + (size_t)l * 1024 * 3648, 3648, sc, nullptr, WL + W_IN, 1024, n0, kb * 64, scr, lane); continue; }
        r -= I_IN;
        if (r < I_UQ) { const int nb = r % 48, kb = r / 48, n0 = nb * 32; int sc;
            if (n0 < 1024) sc = (n0 >> 7) * 192 + (n0 & 127); else { const int rr = n0 - 1024; sc = (rr >> 6) * 192 + 128 + (rr & 63); }
            conv_item(P.wuq + (size_t)l * 256 * 1536, 1536, sc, P.qn + l * 256, WL + W_UQ, 256, n0, kb * 64, scr, lane); continue; }
        r -= I_UQ;
        if (r < I_UKV) { const int nb = r % 64, kb = r / 64;
            conv_item(P.wukv + (size_t)l * 256 * 2048, 2048, nb * 32, P.kvn + l * 256, WL + W_UKV, 256, nb * 32, kb * 64, scr, lane); continue; }
        r -= I_UKV;
        { const int q = r / I_SQ; r -= q * I_SQ; const int nb = r % 32, kb = r / 32; const size_t so = (size_t)l * 1024 * 1024;
          if (q == 0) conv_item(P.womla + so, 1024, nb * 32, nullptr, WL + W_OMLA, 1024, nb * 32, kb * 64, scr, lane);
          else if (q == 1) conv_item(P.glu + so, 1024, nb * 32, nullptr, WL + W_GLU, 1024, nb * 32, kb * 64, scr, lane);
          else if (q == 2) conv_item(P.wos5 + so, 1024, nb * 32, nullptr, WL + W_OS5, 1024, nb * 32, kb * 64, scr, lane);
          else conv_item(P.wout + so, 1024, nb * 32, nullptr, WL + W_OUT, 1024, nb * 32, kb * 64, scr, lane); }
    }
}

__device__ __forceinline__ void mods_phase(const float* c, const float* c_ctx, const float* ada_w, const float* ada_b, float* MOD, float* ROPE, LAS unsigned char* lds, const int tid) {

    LAS float* sc = (LAS float*)lds;
    LAS float* red = (LAS float*)(lds + 9 * 1024 * 4);
    if (blockIdx.x == gridDim.x - 1) {
        for (int e = tid; e < 1024; e += 512) { const int pos = e >> 4, i = e & 15; const float inv = exp2f(-(float)i * (13.287712379549449f / 16.0f)); const float ang = (float)pos * inv;
            float sn_, cs_; sincosf(ang, &sn_, &cs_); ROPE[2 * e] = cs_; ROPE[2 * e + 1] = sn_; }
    }
    bool have = false;
    for (int item = blockIdx.x; item < 576; item += gridDim.x) {
        if (!have) { for (int e = tid; e < 9 * 1024; e += 512) { const float v = (e < 8192) ? c[e] : c_ctx[e - 8192]; sc[e] = v * sigm(v); } have = true; }
        __syncthreads();
        const int l = item / 144, j0 = (item % 144) * 64, ks = tid >> 6, jj = tid & 63;
        const float* w = ada_w + ((size_t)l * 1024 + ks * 128) * 9216 + j0 + jj;
        float a[9];
#pragma unroll
        for (int s = 0; s < 9; ++s) a[s] = 0.f;
#pragma unroll 16
        for (int k = 0; k < 128; ++k) { const float wv = w[(size_t)k * 9216];
#pragma unroll
            for (int s = 0; s < 9; ++s) a[s] += sc[s * 1024 + ks * 128 + k] * wv; }
#pragma unroll
        for (int s = 0; s < 9; ++s) red[(ks * 9 + s) * 64 + jj] = a[s];
        __syncthreads();
        for (int e = tid; e < 576; e += 512) { const int s = e >> 6, j = e & 63; float t = 0.f;
#pragma unroll
            for (int q = 0; q < 8; ++q) t += red[(q * 9 + s) * 64 + j];
            MOD[((size_t)l * 9 + s) * 9216 + j0 + j] = t + ada_b[l * 9216 + j0 + j]; }
    }
    __syncthreads();
}

__device__ __forceinline__ void e_phase(const float* xin, const float* ctxin, float* xl, float* xc, const bf16_t* Y, const float* YSS, const float* MOD,
                                        const float* npre, const float* npost, bf16_t* H, int l, int s, int nl, int ns, int gw, int NGW, int lane, float wmul, int nrows) {
    for (int row = gw; row < nrows; row += NGW) {
        const bool lat = row < R_LAT; const int set = lat ? (row >> 12) : 8;
        float* xr = lat ? xl + (size_t)row * DM : xc + (size_t)(row - R_LAT) * DM;
        const float* xs = (s < 0) ? (lat ? xin + (size_t)row * DM : ctxin + (size_t)(row - R_LAT) * DM) : xr;
        f32x4 v[4];
#pragma unroll
        for (int j = 0; j < 4; ++j) v[j] = __builtin_nontemporal_load((const f32x4*)xs + lane + 64 * j);
        if (s >= 0) {
            const float part = (lane < 16) ? YSS[row * 16 + lane] : 0.f;
            const float rs = 1.0f / sqrtf(wave_sum(part) * (1.0f / 1024.0f) + EPS);
            const float wgt = ((s == 1) ? 1.0f : 0.5f) * wmul;
            const float* gate = MOD + ((size_t)(l * 9 + set) * 9 + 3 * s + 2) * 1024; const float* gp = npost + (l * 3 + s) * 1024;
#pragma unroll
            for (int j = 0; j < 4; ++j) { const u32x2 yw = ((const u32x2*)(Y + (size_t)row * DM))[lane + 64 * j];
                const f32x4 g4 = ((const f32x4*)gate)[lane + 64 * j], p4 = ((const f32x4*)gp)[lane + 64 * j];
                f32x4 y4; y4[0] = bf2f(yw.x & 0xffffu); y4[1] = __uint_as_float(yw.x & 0xffff0000u); y4[2] = bf2f(yw.y & 0xffffu); y4[3] = __uint_as_float(yw.y & 0xffff0000u);
                v[j] += (wgt * rs) * g4 * y4 * p4; }
        }
#pragma unroll
        for (int j = 0; j < 4; ++j) __builtin_nontemporal_store(v[j], (f32x4*)xr + lane + 64 * j);
        if (nl >= 0) {
            float q = 0.f;
#pragma unroll
            for (int j = 0; j < 4; ++j) q += (v[j][0] * v[j][0] + v[j][1] * v[j][1]) + (v[j][2] * v[j][2] + v[j][3] * v[j][3]);
            const float rs2 = 1.0f / sqrtf(wave_sum(q) * (1.0f / 1024.0f) + EPS);
            const float* mb = MOD + ((size_t)(nl * 9 + set) * 9 + 3 * ns) * 1024; const float* gp = npre + (nl * 3 + ns) * 1024;
#pragma unroll
            for (int j = 0; j < 4; ++j) { const f32x4 sh = ((const f32x4*)mb)[lane + 64 * j], sc = ((const f32x4*)(mb + 1024))[lane + 64 * j], p4 = ((const f32x4*)gp)[lane + 64 * j];
                const f32x4 h = v[j] * rs2 * p4 * (1.0f + sc) + sh;
                u32x2 o; o.x = pk2(h[0], h[1]); o.y = pk2(h[2], h[3]); ((u32x2*)(H + (size_t)row * DM))[lane + 64 * j] = o; }
        }
    }
}
struct S5In { const float *a_re, *a_im, *log_dt, *b_re, *b_im, *c_re, *c_im, *dsk; };
__device__ __forceinline__ void s5_abar(const S5In& P, int idx, int n, float& ar, float& ai, float& cr, float& ci) {
    const float are = P.a_re[idx * 64 + n], aim = P.a_im[idx * 64 + n];
    const float dt = expf(P.log_dt[idx]);
    const float mag = expf(dt * are); float sn, cs; sincosf(dt * aim, &sn, &cs);
    ar = mag * cs; ai = mag * sn;
    const float nr = ar - 1.f, ni = ai, den = 1.0f / (are * are + aim * aim);
    cr = (nr * are + ni * aim) * den; ci = (ni * are - nr * aim) * den;
}
__device__ __forceinline__ void s5_prep(const S5In& P, int l, int g, bf16_t* WEt, bf16_t* WYt, LAS unsigned char* lds, int tid) {
    LAS float* AP = (LAS float*)lds;
    LAS float* BB = AP + 2 * 17 * 64 * 2;
    LAS float* CC = BB + 2 * 64 * 16 * 2;
    LAS float* KL = CC + 2 * 16 * 64 * 2;
    if (tid < 128) { const int d = tid >> 6, n = tid & 63, idx = (l * 2 + d) * 64 + g; float ar, ai, cr, ci; s5_abar(P, idx, n, ar, ai, cr, ci);
        float pr = 1.f, pi = 0.f;
        for (int j = 0; j <= 16; ++j) { AP[((d * 17 + j) * 64 + n) * 2] = pr; AP[((d * 17 + j) * 64 + n) * 2 + 1] = pi; const float t0 = pr * ar - pi * ai, t1 = pr * ai + pi * ar; pr = t0; pi = t1; }
        for (int c = 0; c < 16; ++c) { const float br = P.b_re[(size_t)(idx * 64 + n) * 16 + c], bi = P.b_im[(size_t)(idx * 64 + n) * 16 + c];
            BB[((d * 64 + n) * 16 + c) * 2] = cr * br - ci * bi; BB[((d * 64 + n) * 16 + c) * 2 + 1] = cr * bi + ci * br; } }
    for (int e = tid; e < 2048; e += 512) { const int d = e >> 10, cn = e & 1023; const size_t src = (size_t)((l * 2 + d) * 64 + g) * 1024 + cn; CC[e * 2] = P.c_re[src]; CC[e * 2 + 1] = P.c_im[src]; }
    __syncthreads();
    { const int d = tid >> 8, c = (tid >> 4) & 15, cp = tid & 15; float acc[16];
#pragma unroll
      for (int j = 0; j < 16; ++j) acc[j] = 0.f;
      for (int n = 0; n < 64; ++n) { const float c_r = CC[((d * 16 + c) * 64 + n) * 2], c_i = CC[((d * 16 + c) * 64 + n) * 2 + 1], b_r = BB[((d * 64 + n) * 16 + cp) * 2], b_i = BB[((d * 64 + n) * 16 + cp) * 2 + 1];
          const float zr = c_r * b_r - c_i * b_i, zi = c_r * b_i + c_i * b_r;
#pragma unroll
          for (int j = 0; j < 16; ++j) acc[j] += zr * AP[((d * 17 + j) * 64 + n) * 2] - zi * AP[((d * 17 + j) * 64 + n) * 2 + 1]; }
#pragma unroll
      for (int j = 0; j < 16; ++j) KL[((d * 16 + j) * 16 + c) * 16 + cp] = acc[j]; }
    __syncthreads();
    for (int e = tid; e < 256 * 64; e += 512) { const int row = e >> 6, k8 = (e & 63) * 8, t = row >> 4, c = row & 15; float v[8];
        if (k8 < 256) { const int s = k8 >> 4, c0 = k8 & 15;
#pragma unroll
            for (int j = 0; j < 8; ++j) { const int cp = c0 + j; float val = 0.f;
                if (s <= t) val += KL[(((t - s)) * 16 + c) * 16 + cp];
                if (s >= t) val += KL[((16 + (s - t)) * 16 + c) * 16 + cp];
                if (s == t && cp == c) val += P.dsk[l * 1024 + g * 16 + c];
                v[j] = val; } }
        else { const int kk = k8 - 256, d = kk >> 7, im = (kk >> 6) & 1, n0 = kk & 63, jp = (d == 0) ? t + 1 : 16 - t;
#pragma unroll
            for (int j = 0; j < 8; ++j) { const int n = n0 + j; const float wr = AP[((d * 17 + jp) * 64 + n) * 2], wi = AP[((d * 17 + jp) * 64 + n) * 2 + 1], c_r = CC[((d * 16 + c) * 64 + n) * 2], c_i = CC[((d * 16 + c) * 64 + n) * 2 + 1];
                v[j] = im ? -(c_r * wi + c_i * wr) : (c_r * wr - c_i * wi); } }
        *(u32x4*)(WYt + ((size_t)g * 256 + row) * 512 + k8) = pack8(v); }
    for (int e = tid; e < 2 * 128 * 32; e += 512) { const int d = e >> 12, row = (e >> 5) & 127, k8 = (e & 31) * 8, im = row >> 6, n = row & 63, s = k8 >> 4, c0 = k8 & 15, ex = (d == 0) ? 15 - s : s; float v[8];
        const float wr = AP[((d * 17 + ex) * 64 + n) * 2], wi = AP[((d * 17 + ex) * 64 + n) * 2 + 1];
#pragma unroll
        for (int j = 0; j < 8; ++j) { const float b_r = BB[((d * 64 + n) * 16 + c0 + j) * 2], b_i = BB[((d * 64 + n) * 16 + c0 + j) * 2 + 1]; v[j] = im ? (wr * b_i + wi * b_r) : (wr * b_r - wi * b_i); }
        *(u32x4*)(WEt + ((size_t)(d * 64 + g) * 128 + row) * 256 + k8) = pack8(v); }
    __syncthreads();
}
__device__ __forceinline__ int s5_chunk_row(int b, int ch) { return ch < 16 ? R_LAT + b * 256 + 16 * ch : b * 4096 + 16 * (ch - 16); }
#define S5_BAR() do { asm volatile("s_waitcnt lgkmcnt(0)" ::: "memory"); __builtin_amdgcn_s_barrier(); asm volatile("" ::: "memory"); } while (0)
__device__ __forceinline__ void s5_main(const S5In& P, int l, const bf16_t* U, const bf16_t* WEt, const bf16_t* WYt, bf16_t* T, LAS unsigned char* lds, int tid) {
    const int lane = tid & 63, w = __builtin_amdgcn_readfirstlane(tid >> 6), fr = lane & 15, q = lane >> 4;
    constexpr int XP = 528;
    LAS unsigned char* XIN = lds; LAS float* ET = (LAS float*)(lds + 272 * XP); LAS unsigned char* UC = lds + 272 * XP + 8192;
    const int uc_chunk = tid >> 5, uc_piece = tid & 31;
    LAS u32x4* uc_dst = (LAS u32x4*)(UC + uc_chunk * XP + uc_piece * 16);
    const LAS unsigned char* uc_a = UC + fr * XP + 16 * q;
#define S5_GLOAD(tile) (*(const u32x4*)(U + (size_t)(s5_chunk_row(b, 16 * (tile) + uc_chunk) + (uc_piece >> 1)) * 1024 + g * 16 + 8 * (uc_piece & 1)))
    const int Gd = (int)gridDim.x, bxi = (int)blockIdx.x, vcu = (Gd % 8 == 0) ? (bxi % 8) * (Gd / 8) + bxi / 8 : bxi;
    for (int item = vcu; item < 512; item += Gd) {
        const int g = item & 63, b = item >> 6;
        {
            bf16x8 bw0[8], bw1[8];
            { const bf16_t* wp = WEt + ((size_t)g * 128 + 16 * w + fr) * 256 + 8 * q;
#pragma unroll
              for (int kk = 0; kk < 8; ++kk) { bw0[kk] = *(const bf16x8*)(wp + 32 * kk); bw1[kk] = *(const bf16x8*)(wp + (size_t)64 * 128 * 256 + 32 * kk); } }
            u32x4 u0 = S5_GLOAD(0), u1 = S5_GLOAD(1), u2 = S5_GLOAD(2), u3 = S5_GLOAD(3), u4 = S5_GLOAD(4);
            *uc_dst = u0; u0 = u1; u1 = u2; u2 = u3; u3 = u4;
            S5_BAR();
#pragma unroll 1
            for (int tile = 0; tile < 17; ++tile) {
                f32x4 e0 = {0.f, 0.f, 0.f, 0.f}, e1 = {0.f, 0.f, 0.f, 0.f};
#pragma unroll
                for (int kk = 0; kk < 8; ++kk) { const bf16x8 af = *(const LAS bf16x8*)(uc_a + 64 * kk);
                    e0 = __builtin_amdgcn_mfma_f32_16x16x32_bf16(af, bw0[kk], e0, 0, 0, 0); e1 = __builtin_amdgcn_mfma_f32_16x16x32_bf16(af, bw1[kk], e1, 0, 0, 0); }
                asm volatile("s_nop 15\n\ts_nop 7" : "+v"(e0), "+v"(e1));
#pragma unroll
                for (int r = 0; r < 4; ++r) { LAS bf16_t* ep = (LAS bf16_t*)(XIN + (16 * tile + 4 * q + r) * XP) + 16 * w + fr;
                    const unsigned pk = pk2(e0[r], e1[r]); ep[0] = (bf16_t)(pk & 0xffffu); ep[128] = (bf16_t)(pk >> 16); }
                S5_BAR();
                if (tile < 16) { *uc_dst = u0; u0 = u1; u1 = u2; u2 = u3; if (tile + 5 <= 16) u3 = S5_GLOAD(tile + 5); }
                S5_BAR();
            }
        }
        if (w < 2) {
            const int d = w;
            float tr, ti, xr = 0.f, xi = 0.f;
            { float cr, ci; s5_abar(P, (l * 2 + d) * 64 + g, lane, tr, ti, cr, ci);
#pragma unroll
              for (int k = 0; k < 4; ++k) { const float n_r = tr * tr - ti * ti, n_i = 2.f * tr * ti; tr = n_r; ti = n_i; } }
#pragma unroll 1
            for (int i = 0; i < 17; ++i) {
                const int tile = (d == 0 || i == 0) ? i : 17 - i;
                float er[16], ei[16];
#pragma unroll
                for (int c = 0; c < 16; ++c) { const LAS bf16_t* ep = (const LAS bf16_t*)(XIN + (16 * tile + c) * XP) + d * 128; er[c] = bf2f(ep[lane]); ei[c] = bf2f(ep[64 + lane]); }
                asm volatile("s_waitcnt lgkmcnt(0)" ::: "memory");
#pragma unroll
                for (int cc = 0; cc < 16; ++cc) { const int c = d ? 15 - cc : cc;
                    LAS bf16_t* xp = (LAS bf16_t*)(XIN + (16 * tile + c) * XP) + d * 128;
                    const unsigned pk = pk2(xr, xi); xp[lane] = (bf16_t)(pk & 0xffffu); xp[64 + lane] = (bf16_t)(pk >> 16);
                    const float nxr = tr * xr - ti * xi + er[c], nxi = tr * xi + ti * xr + ei[c]; xr = nxr; xi = nxi; }
            }
        }
        S5_BAR();
        {
            bf16x8 by[2][16];
#pragma unroll
            for (int nt = 0; nt < 2; ++nt) { const bf16_t* wp = WYt + ((size_t)g * 256 + 32 * w + 16 * nt + fr) * 512 + 8 * q;
#pragma unroll
                for (int kk = 0; kk < 16; ++kk) by[nt][kk] = *(const bf16x8*)(wp + 32 * kk); }
            u32x4 u0 = S5_GLOAD(0), u1 = S5_GLOAD(1), u2 = S5_GLOAD(2), u3 = S5_GLOAD(3), u4 = S5_GLOAD(4);
            *uc_dst = u0; u0 = u1; u1 = u2; u2 = u3; u3 = u4;
            S5_BAR();
#pragma unroll 1
            for (int tile = 0; tile < 17; ++tile) {
                f32x4 acc0 = {0.f, 0.f, 0.f, 0.f}, acc1 = {0.f, 0.f, 0.f, 0.f};
#pragma unroll
                for (int kk = 0; kk < 8; ++kk) { const bf16x8 af = *(const LAS bf16x8*)(uc_a + 64 * kk);
                    acc0 = __builtin_amdgcn_mfma_f32_16x16x32_bf16(af, by[0][kk], acc0, 0, 0, 0); acc1 = __builtin_amdgcn_mfma_f32_16x16x32_bf16(af, by[1][kk], acc1, 0, 0, 0); }
                const LAS unsigned char* xq = XIN + (16 * tile + fr) * XP + 16 * q;
#pragma unroll
                for (int kk = 0; kk < 8; ++kk) { const bf16x8 xf = *(const LAS bf16x8*)(xq + 64 * kk);
                    acc0 = __builtin_amdgcn_mfma_f32_16x16x32_bf16(xf, by[0][8 + kk], acc0, 0, 0, 0); acc1 = __builtin_amdgcn_mfma_f32_16x16x32_bf16(xf, by[1][8 + kk], acc1, 0, 0, 0); }
                S5_BAR();
                if (tile < 16) { *uc_dst = u0; u0 = u1; u1 = u2; u2 = u3; if (tile + 5 <= 16) u3 = S5_GLOAD(tile + 5); }
#pragma unroll
                for (int r = 0; r < 4; ++r) { const int row = s5_chunk_row(b, 16 * tile + 4 * q + r) + 2 * w;
                    T[(size_t)row * 1024 + g * 16 + fr] = (bf16_t)(pk2(gelu_tanh(acc0[r]), 0.f) & 0xffffu);
                    T[(size_t)(row + 1) * 1024 + g * 16 + fr] = (bf16_t)(pk2(gelu_tanh(acc1[r]), 0.f) & 0xffffu); }
                S5_BAR();
            }
        }
    }
#undef S5_GLOAD
#undef S5_BAR
}
__device__ __forceinline__ s16x4 vtr(const LAS unsigned char* p) { return __builtin_bit_cast(s16x4, __builtin_amdgcn_ds_read_tr16_b64_v4i16((LAS s16x4*)p)); }
__device__ __forceinline__ void attn_phase(LAS unsigned char* lds, const bf16_t* Q, const bf16_t* KV, const bf16_t* CQ, bf16_t* O, const int tid, const int nunits) {
    const int lane = tid & 63, wid = __builtin_amdgcn_readfirstlane(tid >> 6), r32 = lane & 31, hi = lane >> 5;
    constexpr int KP = 400, VP = 320, BUFB = 64 * KP + 64 * VP;
    const float C = 0.07216878364870322f * 1.4426950408889634f;
    const int kn_row = tid >> 4, kn_ch = tid & 15, kr_row = tid >> 3, kr_ch = tid & 7;
    const int Gd = (int)gridDim.x, bxi = (int)blockIdx.x, vcu = (Gd % 8 == 0) ? (bxi % 8) * (Gd / 8) + bxi / 8 : bxi;
    for (int ui = 0;; ++ui) {
        const int unit = ui * (int)gridDim.x + vcu; if (unit >= nunits) break;
        int b, h, qb;
        if (unit < 1024) { const int bh = unit >> 4; qb = unit & 15; b = bh >> 3; h = bh & 7; } else { const int bh = unit - 1024; qb = 16; b = bh >> 3; h = bh & 7; }
        const int qrow0 = (qb < 16) ? b * 4096 + qb * 256 : R_LAT + b * 256;
        const int NT = (qb < 16) ? 68 : 4;
        const bf16_t* qp = Q + (size_t)(qrow0 + wid * 32 + r32) * 1536;
        bf16x8 qf[12];
#pragma unroll
        for (int s = 0; s < 8; ++s) qf[s] = *(const bf16x8*)(qp + h * 128 + 16 * s + 8 * hi);
#pragma unroll
        for (int s = 0; s < 4; ++s) qf[8 + s] = *(const bf16x8*)(qp + 1024 + h * 64 + 16 * s + 8 * hi);
        u32x4 sk0, sk1, skr, sv0, sv1;
#define ATT_KROW(t) ((qb < 16) ? (((t) < 64) ? b * 4096 + (t) * 64 : R_LAT + b * 256 + ((t) - 64) * 64) : R_LAT + b * 256 + (t) * 64)
#define ATT_LOAD(t) do { const int kr0_ = ATT_KROW(t); const bf16_t* kvp_ = KV + (size_t)(kr0_ + kn_row) * 2048 + h * 256 + kn_ch * 8; \
        sk0 = *(const u32x4*)kvp_; sk1 = *(const u32x4*)(kvp_ + 32 * 2048); sv0 = *(const u32x4*)(kvp_ + 128); sv1 = *(const u32x4*)(kvp_ + 128 + 32 * 2048); \
        skr = *(const u32x4*)(CQ + (size_t)(kr0_ + kr_row) * 768 + 512 + kr_ch * 8); } while (0)
#define ATT_STORE(buf) do { LAS unsigned char* kb_ = lds + (buf) * BUFB; LAS unsigned char* vb_ = kb_ + 64 * KP; \
        *(LAS u32x4*)(kb_ + kn_row * KP + kn_ch * 16) = sk0; *(LAS u32x4*)(kb_ + (kn_row + 32) * KP + kn_ch * 16) = sk1; *(LAS u32x4*)(kb_ + kr_row * KP + 256 + kr_ch * 16) = skr; \
        *(LAS u32x4*)(vb_ + kn_row * VP + kn_ch * 16) = sv0; *(LAS u32x4*)(vb_ + (kn_row + 32) * VP + kn_ch * 16) = sv1; } while (0)
        ATT_LOAD(0); ATT_STORE(0);
        __syncthreads();
        float mrun = -1e30f, lrun = 0.f;
        f32x16 o[4];
#pragma unroll
        for (int d = 0; d < 4; ++d)
#pragma unroll
            for (int r = 0; r < 16; ++r) o[d][r] = 0.f;
        for (int t = 0; t < NT; ++t) {
            const int cur = t & 1;
            if (t + 1 < NT) ATT_LOAD(t + 1);
            f32x16 p0, p1;
#pragma unroll
            for (int r = 0; r < 16; ++r) { p0[r] = 0.f; p1[r] = 0.f; }
            __builtin_amdgcn_s_setprio(1);
            { const LAS unsigned char* kb = lds + cur * BUFB + r32 * KP + hi * 16;
#pragma unroll
              for (int g3 = 0; g3 < 3; ++g3) { bf16x8 k0[4], k1[4];
#pragma unroll
                  for (int j = 0; j < 4; ++j) { k0[j] = *(const LAS bf16x8*)(kb + (4 * g3 + j) * 32); k1[j] = *(const LAS bf16x8*)(kb + 32 * KP + (4 * g3 + j) * 32); }
                  __builtin_amdgcn_sched_barrier(0);
#pragma unroll
                  for (int j = 0; j < 4; ++j) { p0 = __builtin_amdgcn_mfma_f32_32x32x16_bf16(k0[j], qf[4 * g3 + j], p0, 0, 0, 0); p1 = __builtin_amdgcn_mfma_f32_32x32x16_bf16(k1[j], qf[4 * g3 + j], p1, 0, 0, 0); }
                  __builtin_amdgcn_sched_barrier(0); } }
            __builtin_amdgcn_s_setprio(0);
            float mx = p0[0];
#pragma unroll
            for (int r = 0; r < 16; ++r) { mx = fmaxf(mx, p0[r]); mx = fmaxf(mx, p1[r]); }
            mx = fmaxf(mx, __shfl_xor(mx, 32)) * C;
            if (__any(mx > mrun + 8.0f)) {
                const float mn = fmaxf(mrun, mx), alpha = __builtin_amdgcn_exp2f(mrun - mn); mrun = mn; lrun *= alpha;
#pragma unroll
                for (int d = 0; d < 4; ++d)
#pragma unroll
                    for (int r = 0; r < 16; ++r) o[d][r] *= alpha;
            }
            float rsum = 0.f;
#pragma unroll
            for (int r = 0; r < 16; ++r) { p0[r] = __builtin_amdgcn_exp2f(p0[r] * C - mrun); p1[r] = __builtin_amdgcn_exp2f(p1[r] * C - mrun); rsum += p0[r] + p1[r]; }
            lrun += rsum;
            bf16x8 pf[4];
            { u32x4 w;
              w.x = pk2(p0[0], p0[1]); w.y = pk2(p0[2], p0[3]); w.z = pk2(p0[4], p0[5]); w.w = pk2(p0[6], p0[7]); pf[0] = __builtin_bit_cast(bf16x8, w);
              w.x = pk2(p0[8], p0[9]); w.y = pk2(p0[10], p0[11]); w.z = pk2(p0[12], p0[13]); w.w = pk2(p0[14], p0[15]); pf[1] = __builtin_bit_cast(bf16x8, w);
              w.x = pk2(p1[0], p1[1]); w.y = pk2(p1[2], p1[3]); w.z = pk2(p1[4], p1[5]); w.w = pk2(p1[6], p1[7]); pf[2] = __builtin_bit_cast(bf16x8, w);
              w.x = pk2(p1[8], p1[9]); w.y = pk2(p1[10], p1[11]); w.z = pk2(p1[12], p1[13]); w.w = pk2(p1[14], p1[15]); pf[3] = __builtin_bit_cast(bf16x8, w); }
            __builtin_amdgcn_s_setprio(1);
            { const LAS unsigned char* vb = lds + cur * BUFB + 64 * KP + (4 * hi + ((lane & 15) >> 2)) * VP + (16 * ((lane >> 4) & 1) + 4 * (lane & 3)) * 2;
#pragma unroll
              for (int s2 = 0; s2 < 2; ++s2) { s16x4 lo[8], hh[8];
#pragma unroll
                  for (int i = 0; i < 8; ++i) { const int s = 2 * s2 + (i >> 2), d = i & 3; lo[i] = vtr(vb + s * 16 * VP + d * 64); hh[i] = vtr(vb + s * 16 * VP + 8 * VP + d * 64); }
                  __builtin_amdgcn_sched_barrier(0);
#pragma unroll
                  for (int i = 0; i < 8; ++i) { const int s = 2 * s2 + (i >> 2), d = i & 3;
                      const bf16x8 vf = (bf16x8){lo[i][0], lo[i][1], lo[i][2], lo[i][3], hh[i][0], hh[i][1], hh[i][2], hh[i][3]};
                      o[d] = __builtin_amdgcn_mfma_f32_32x32x16_bf16(vf, pf[s], o[d], 0, 0, 0); }
                  __builtin_amdgcn_sched_barrier(0); } }
            __builtin_amdgcn_s_setprio(0);
            if (t + 1 < NT) ATT_STORE(cur ^ 1);
            __syncthreads();
        }
        const float inv = 1.0f / (lrun + __shfl_xor(lrun, 32));
        bf16_t* op = O + (size_t)(qrow0 + wid * 32 + r32) * 1024 + h * 128;
#pragma unroll
        for (int d = 0; d < 4; ++d)
#pragma unroll
            for (int i4 = 0; i4 < 4; ++i4) { u32x2 w; w.x = pk2(o[d][4 * i4] * inv, o[d][4 * i4 + 1] * inv); w.y = pk2(o[d][4 * i4 + 2] * inv, o[d][4 * i4 + 3] * inv);
                *(u32x2*)(op + 32 * d + 8 * i4 + 4 * hi) = w; }
    }
#undef ATT_KROW
#undef ATT_LOAD
#undef ATT_STORE
}
#define XB_TMO      128
#define XB_XCNT(j)  (256  + 64 * (j))
#define XB_XSUB(j)  (1280 + 64 * (j))
#define XB_XGEN(j)  (2304 + 64 * (j))
#define XB_TOP      3328
#define XB_TOPGEN   3392
#define XCD_BAR_WORDS 3456
#define XB_SPIN_CAP (1u << 18)

__device__ __forceinline__ unsigned xb_ld(unsigned* p)              { return __hip_atomic_load(p, __ATOMIC_RELAXED, __HIP_MEMORY_SCOPE_AGENT); }
__device__ __forceinline__ unsigned xb_add(unsigned* p, unsigned v) { return __hip_atomic_fetch_add(p, v, __ATOMIC_RELAXED, __HIP_MEMORY_SCOPE_AGENT); }
__device__ __forceinline__ unsigned xb_xcc_id() { return (unsigned)__builtin_amdgcn_s_getreg((3 << 11) | 20) & 0xFu; }
#define XB_SPIN(cond, bar) do { unsigned _sp = 0; while (cond) { __builtin_amdgcn_s_sleep(1); \
    if ((++_sp & 255u) == 0u) { if (xb_ld(&(bar)[XB_TMO])) break; if (_sp > XB_SPIN_CAP) { atomicAdd(&(bar)[XB_TMO], 1u); break; } } } } while (0)

struct XcdBarrier {
    unsigned* bar; unsigned x;
    volatile LAS unsigned* st;
};

__device__ __forceinline__ XcdBarrier xcd_barrier_post(unsigned* bar, volatile LAS unsigned* st) {
    XcdBarrier b; b.bar = bar; b.x = xb_xcc_id(); b.st = st;
    if (threadIdx.x == 0) (void)xb_add(&bar[XB_XCNT(b.x)], 1u);
    return b;
}
__device__ __forceinline__ void xcd_barrier_complete(unsigned* bar, unsigned x, unsigned& nloc, unsigned& nx) {
    const unsigned G = gridDim.x * gridDim.y * gridDim.z;
    unsigned sum, cnt, mine, sp = 0u;
    for (;;) {
        sum = 0u; cnt = 0u; mine = 0u;
#pragma unroll
        for (unsigned j = 0; j < 16; ++j) { const unsigned c = xb_ld(&bar[XB_XCNT(j)]); sum += c; cnt += (c > 0u) ? 1u : 0u; mine = (j == x) ? c : mine; }
        if (sum == G) break;
        __builtin_amdgcn_s_sleep(1);
        if ((++sp & 255u) == 0u) { if (xb_ld(&bar[XB_TMO])) break; if (sp > XB_SPIN_CAP) { atomicAdd(&bar[XB_TMO], 1u); break; } }
    }
    nloc = mine > 0u ? mine : 1u; nx = cnt > 0u ? cnt : 1u;
}

__device__ __forceinline__ void xcd_barrier(const XcdBarrier& b) {
    asm volatile("s_waitcnt vmcnt(0)" ::: "memory");
    __syncthreads();
    if (threadIdx.x == 0) {
        unsigned* bar = b.bar;
        __builtin_amdgcn_s_waitcnt(0);
        unsigned nloc = b.st[0], nx = b.st[1];
        if (nloc == 0u) { xcd_barrier_complete(bar, b.x, nloc, nx); b.st[0] = nloc; b.st[1] = nx; }
        const unsigned old = xb_add(&bar[XB_XSUB(b.x)], 1u);
        const unsigned gen = old / nloc;
        if (old + 1u == (gen + 1u) * nloc) {
            __builtin_amdgcn_fence(__ATOMIC_RELEASE, "agent");
            asm volatile("s_waitcnt vmcnt(0)" ::: "memory");
            const unsigned og = xb_add(&bar[XB_TOP], 1u);
            const unsigned tg = og / nx;
            if (og + 1u == (tg + 1u) * nx) xb_add(&bar[XB_TOPGEN], 1u);
            else XB_SPIN(xb_ld(&bar[XB_TOPGEN]) == tg, bar);
            __builtin_amdgcn_fence(__ATOMIC_ACQUIRE, "agent");
            xb_add(&bar[XB_XGEN(b.x)], 1u);
            asm volatile("s_waitcnt vmcnt(0)" ::: "memory");
        } else {
            XB_SPIN(xb_ld(&bar[XB_XGEN(b.x)]) == gen, bar);
            __builtin_amdgcn_fence(__ATOMIC_ACQUIRE, "agent");
            asm volatile("s_waitcnt vmcnt(0)" ::: "memory");
        }
    }
    __syncthreads();
}

#define DERIVE_PTRS float* MOD = (float*)(ws + WS_MOD); float* ROPE = (float*)(ws + WS_ROPE); float* YSS = (float*)(ws + WS_YSS); float* CSS = (float*)(ws + WS_CSS); bf16_t* WEt = (bf16_t*)(ws + WS_S5E); bf16_t* WYt = (bf16_t*)(ws + WS_S5E + S5_WE_BYTES); float* XC = (float*)(ws + WS_XC); bf16_t* WL = (bf16_t*)(ws + WS_WL); bf16_t* H = (bf16_t*)(ws + WS_H); unsigned char* big = ws + WS_BIG; bf16_t* CQ = (bf16_t*)(big + B_CQ); bf16_t* U = (bf16_t*)(big + B_U); bf16_t* Qb = (bf16_t*)(big + B_Q); bf16_t* KVb = (bf16_t*)(big + B_KV); bf16_t* SG = (bf16_t*)(big + B_SG); bf16_t* ACT = (bf16_t*)(big + B_ACT); bf16_t* Y = (bf16_t*)(big + B_Y); bf16_t* T = (bf16_t*)(big + B_T); bf16_t* Gb = (bf16_t*)(big + B_G); bf16_t* Mb = (bf16_t*)(big + B_M); bf16_t* Ob = H;
constexpr int PPL = 13;
constexpr int NSTEPS = 2 + PPL * DEPTH;
struct Args { const float* in[29]; float* out; unsigned char* ws; int ph_lo, ph_hi; };
__global__ void __launch_bounds__(512, 2) mk_fwd(Args a) {
    extern __shared__ __attribute__((aligned(16))) unsigned char lds_raw[];
    cg::grid_group grid = cg::this_grid();
    LAS unsigned char* lds = (LAS unsigned char*)lds_raw;
    const int G = gridDim.x, NGW = G * 8;
    volatile LAS unsigned* xst = (volatile LAS unsigned*)(lds + LDS_BYTES - 64);
    if (threadIdx.x < 2) xst[threadIdx.x] = 0u;
    __syncthreads();
    XcdBarrier xbar; xbar.bar = (unsigned*)(a.ws + WS_CTL); xbar.x = 0; xbar.st = xst;
    if (a.ph_hi - a.ph_lo > 1) xbar = xcd_barrier_post((unsigned*)(a.ws + WS_CTL), xst);
    WPtrs WP{a.in[8], a.in[9], a.in[10], a.in[11], a.in[12], a.in[13], a.in[14], a.in[15], a.in[16], a.in[25], a.in[27], a.in[28]};
    S5In SP{a.in[17], a.in[18], a.in[19], a.in[20], a.in[21], a.in[22], a.in[23], a.in[24]};
#if MK_TIME >= 0
    unsigned long long tacc = 0ull;
#endif
#pragma unroll 1
    for (int step = a.ph_lo; step < a.ph_hi; ++step) {
#if MK_TIME >= 0
        const unsigned long long tph0 = __builtin_amdgcn_s_memrealtime();
#endif
        int tid = threadIdx.x; asm volatile("" : "+v"(tid));
        const int lane = tid & 63, wave = __builtin_amdgcn_readfirstlane(tid >> 6), gw = blockIdx.x * 8 + wave;
        unsigned char* ws = a.ws; asm volatile("" : "+s"(ws));
        DERIVE_PTRS
        int l = 0, p = -1;
        if (step >= 2) { l = (step - 2) / PPL; p = (step - 2) % PPL; if (p >= 6) ++p; }
        if (step == 0) mods_phase(a.in[1], a.in[3], a.in[4], a.in[5], MOD, ROPE, lds, tid);
        if (step == 0) conv_layer(WP, 0, WL, lds, gw, NGW, wave, lane, 0, 12864);
#if MK_PROBE == 9
        if (step == 0) { __syncthreads(); mods_phase(a.in[1], a.in[3], a.in[4], a.in[5], MOD, ROPE, lds, tid); conv_layer(WP, 0, WL, lds, gw, NGW, wave, lane, 0, 12864); }
#endif
        if (p == 13 && l < DEPTH - 1) conv_layer(WP, l + 1, WL, lds, gw, NGW, wave, lane, 7040, 8448);
        if (step == 1 || p == 2 || p == 10 || p == 13) {
            int s, nl, ns;
            if (step == 1) { s = -1; nl = 0; ns = 0; } else if (p == 2) { s = 0; nl = l; ns = 1; } else if (p == 10) { s = 1; nl = l; ns = 2; } else { s = 2; nl = (l < DEPTH - 1) ? l + 1 : -1; ns = 0; }
            e_phase(a.in[0], a.in[2], a.out, XC, Y, YSS, MOD, a.in[6], a.in[7], H, l, s, nl, ns, gw, NGW, lane, 1.0f, (l == DEPTH - 1 && p >= 10) ? R_LAT : R);
#if MK_PROBE == 5
            if (s >= 0) { __syncthreads(); e_phase(a.in[0], a.in[2], a.out, XC, Y, YSS, MOD, a.in[6], a.in[7], H, l, s, nl, ns, gw, NGW, lane, 0.0f, R); }
#endif
        }
        if (p == 0 || p == 1 || p == 3 || p == 4 || p == 7 || p == 8 || p == 9 || p == 11 || p == 12) {
            const int ng = (p == 4 || p == 7) ? 2 : 1;
#pragma unroll 1
            for (int gi = 0; gi < ng; ++gi) {
                pg8::Gemm g; Epi E; E.o0 = nullptr; E.o1 = nullptr; E.o2 = nullptr; E.i0 = nullptr; E.i1 = nullptr; E.ss = nullptr; E.css = CSS; E.bias = nullptr; E.rope = ROPE; E.mode = 0;
                g.M = R;
                if (p == 0 || p == 11) { g.A = H; g.Bt = WL + (p == 0 ? W_GUA : W_GUB); g.N = 5632; g.K = 1024; g.lda = 1024; E.mode = 0; E.o0 = ACT; }
                else if (p == 1 || p == 12) { g.A = ACT; g.Bt = WL + (p == 1 ? W_DA : W_DB); g.N = 1024; g.K = FF; g.lda = FF; E.mode = 1; E.o0 = Y; E.ss = YSS; }
                else if (p == 3) { g.A = H; g.Bt = WL + W_IN; g.N = 3840; g.K = 1024; g.lda = 1024; E.mode = 2; E.o0 = CQ; E.o1 = U; E.o2 = SG; E.ss = CSS; }
                else if (p == 4 && gi == 0) { g.A = CQ; g.Bt = WL + W_UQ; g.N = 1536; g.K = 256; g.lda = 768; E.mode = 3; E.o0 = Qb; }
                else if (p == 4) { g.A = CQ + 256; g.Bt = WL + W_UKV; g.N = 2048; g.K = 256; g.lda = 768; E.mode = 4; E.o0 = KVb; }
                else if (p == 7 && gi == 0) { g.A = T; g.Bt = WL + W_GLU; g.N = 1024; g.K = 1024; g.lda = 1024; E.mode = 5; E.o0 = Gb; E.i0 = T; E.bias = a.in[26] + l * 1024; }
                else if (p == 7) { g.A = Ob; g.Bt = WL + W_OMLA; g.N = 1024; g.K = 1024; g.lda = 1024; E.mode = 6; E.o0 = Mb; E.i0 = SG; }
                else if (p == 8) { g.A = Gb; g.Bt = WL + W_OS5; g.N = 1024; g.K = 1024; g.lda = 1024; E.mode = 7; E.o0 = Mb; E.i0 = Mb; E.i1 = SG + 1024; }
                else { g.A = Mb; g.Bt = WL + W_OUT; g.N = 1024; g.K = 1024; g.lda = 1024; E.mode = 1; E.o0 = Y; E.ss = YSS; }
                const int Mrows = (l == DEPTH - 1 && (p >= 7 || (p == 4 && gi == 0))) ? R_LAT : R;
                pg8::StaticOrder S; S.init(Mrows, g.N, G, (gi == 0) ? (int)blockIdx.x : (int)((blockIdx.x + (G >> 1)) % G));
                pg8::gemm_phase<Epi, pg8::StaticOrder, true, true>(lds, g, S, E, tid);
#if MK_PROBE == 3 || MK_PROBE == 6 || MK_PROBE == 7 || MK_PROBE == 8 || MK_PROBE == 10
                if ((MK_PROBE == 3 && (p == 0 || p == 11)) || (MK_PROBE == 6 && p == 9) || (MK_PROBE == 7 && (p == 1 || p == 12)) || (MK_PROBE == 8 && p == 4) || (MK_PROBE == 10 && p == 3)) { __syncthreads(); pg8::gemm_phase<Epi, pg8::StaticOrder, true, true>(lds, g, S, E, tid); }
#endif
            }
        }
        if (p == 4) {
#pragma unroll 1
            for (int rep = 0; rep < (MK_PROBE == 2 ? 2 : 1); ++rep) s5_main(SP, l, U, WEt, WYt, T, lds, tid); }
        if (G == 256) {
            const int bx = blockIdx.x;
            if (p == 1 && bx >= 32 && bx < 96) s5_prep(SP, l, bx - 32, WEt, WYt, lds, tid);
            if (l < DEPTH - 1 && bx >= 32) {
                const int vgw = (bx - 32) * 8 + wave, VNGW = 224 * 8;
                if (p == 7 && (bx < 128 || bx >= 160)) { const int v7 = ((bx < 128) ? bx - 32 : bx - 64) * 8 + wave;
                    conv_layer(WP, l + 1, WL, lds, v7, 192 * 8, wave, lane, 0, 2816); conv_layer(WP, l + 1, WL, lds, v7, 192 * 8, wave, lane, 5632, 7040); }
                if (p == 8) { conv_layer(WP, l + 1, WL, lds, vgw, VNGW, wave, lane, 8448, 11840); }
                if (p == 9) { conv_layer(WP, l + 1, WL, lds, vgw, VNGW, wave, lane, 11840, 12352); }
                if (p == 12) { conv_layer(WP, l + 1, WL, lds, vgw, VNGW, wave, lane, 12352, 12864); conv_layer(WP, l + 1, WL, lds, vgw, VNGW, wave, lane, 2816, 5632); }
            }
        }
        if (G != 256) {
            if (p == 2 && blockIdx.x < 64) s5_prep(SP, l, blockIdx.x, WEt, WYt, lds, tid);
            if (p == 13 && l < DEPTH - 1) { conv_layer(WP, l + 1, WL, lds, gw, NGW, wave, lane, 0, 7040); conv_layer(WP, l + 1, WL, lds, gw, NGW, wave, lane, 8448, 12864); }
        }
        if (p == 5) {
#pragma unroll 1
            for (int rep = 0; rep < (MK_PROBE == 1 ? 2 : 1); ++rep) attn_phase(lds, Qb, KVb, CQ, Ob, tid, (l == DEPTH - 1) ? 1024 : 1024 + 64); }
#if MK_TIME >= 0
        const unsigned long long tb0 = __builtin_amdgcn_s_memrealtime();
#endif
        if (step + 1 < a.ph_hi) {
            if (step == a.ph_lo) grid.sync(); else xcd_barrier(xbar);
#if MK_PROBE == 4
            xcd_barrier(xbar); xcd_barrier(xbar);
#endif
        }
#if MK_TIME >= 0
        { const unsigned long long tb1 = __builtin_amdgcn_s_memrealtime();
          const int cls = (step == 0) ? 10 : (step == 1 || p == 2 || p == 10 || p == 13) ? 2 : (p == 0 || p == 11) ? 0 : (p == 1 || p == 12) ? 1 : (p == 3) ? 3 : (p == 4) ? 4 : (p == 5) ? 5 : (p == 7) ? 6 : (p == 8) ? 7 : 8;
          if (MK_TIME == 99) tacc += tb1 - tb0; else if (cls == MK_TIME) tacc += tb1 - tph0; }
#endif
    }
#if MK_TIME >= 0
    if (blockIdx.x == MK_TIME_BLOCK) { const unsigned long long te = __builtin_amdgcn_s_memrealtime(); while (__builtin_amdgcn_s_memrealtime() - te < tacc) __builtin_amdgcn_s_sleep(16); }
#endif
}

extern "C" void kernel_launch(void* const* d_in, const int* in_sizes, int n_in, void* d_out, int out_size, void* d_ws, size_t ws_size, hipStream_t stream) {
    static int grid = 0;
    if (grid == 0) {
        if (n_in != 29 || out_size != R_LAT * DM || ws_size < WS_END) { fprintf(stderr, "kernel_launch: unexpected problem (n_in %d out %d ws %zu need %zu)\n", n_in, out_size, ws_size, (size_t)WS_END); grid = -1; return; }
        int dev = 0, cus = 0, per_cu = 0;
        if (hipGetDevice(&dev) != hipSuccess || hipDeviceGetAttribute(&cus, hipDeviceAttributeMultiprocessorCount, dev) != hipSuccess) { grid = -1; return; }
        if (hipFuncSetAttribute((const void*)mk_fwd, hipFuncAttributeMaxDynamicSharedMemorySize, LDS_BYTES) != hipSuccess) { fprintf(stderr, "kernel_launch: hipFuncSetAttribute failed\n"); grid = -1; return; }
        if (hipOccupancyMaxActiveBlocksPerMultiprocessor(&per_cu, (const void*)mk_fwd, 512, LDS_BYTES) != hipSuccess || per_cu < 1) { fprintf(stderr, "kernel_launch: occupancy query says %d\n", per_cu); per_cu = 1; }
        (void)hipGetLastError();
        grid = cus * 1;
    }
    if (grid < 0) return;
    if (hipMemsetAsync((char*)d_ws + WS_CTL, 0, CTL_BYTES, stream) != hipSuccess) { fprintf(stderr, "kernel_launch: memset failed\n"); return; }
    Args a{};
    for (int i = 0; i < 29; ++i) a.in[i] = (const float*)d_in[i];
    a.out = (float*)d_out; a.ws = (unsigned char*)d_ws;
#if MK_MULTI
    for (int s = 0; s < NSTEPS; ++s) { a.ph_lo = s; a.ph_hi = s + 1; void* args[] = {&a};
        hipError_t e = hipLaunchCooperativeKernel((const void*)mk_fwd, dim3(grid), dim3(512), args, LDS_BYTES, stream);
        if (e != hipSuccess) { fprintf(stderr, "cooperative launch %d failed: %s\n", s, hipGetErrorString(e)); break; } }
#else
    a.ph_lo = 0; a.ph_hi = NSTEPS; void* args[] = {&a};
    hipError_t e = hipLaunchCooperativeKernel((const void*)mk_fwd, dim3(grid), dim3(512), args, LDS_BYTES, stream);
    if (e != hipSuccess) fprintf(stderr, "cooperative launch failed: %s (grid %d)\n", hipGetErrorString(e), grid);
#endif
}
```

```cpp
#include <hip/hip_runtime.h>
#include <hip/hip_cooperative_groups.h>
#include <cstdio>
#include <cstdint>
namespace cg = cooperative_groups;
#ifndef MK_MULTI
#define MK_MULTI 0
#endif
#ifndef MK_PROBE
#define MK_PROBE 0
#endif
#ifndef MK_TIME
#define MK_TIME -1
#endif
#ifndef MK_TIME_BLOCK
#define MK_TIME_BLOCK 128
#endif
namespace pg8 {
#define PG8_LAS __attribute__((address_space(3)))
typedef unsigned short bf16_t;
typedef short bf16x8 __attribute__((ext_vector_type(8)));
typedef float f32x4 __attribute__((ext_vector_type(4)));
typedef unsigned u32x4 __attribute__((ext_vector_type(4)));
constexpr int BM = 256, BK = 64, HALF = 128, HTB = HALF * BK * 2  , STAGE_BYTES = 8 * HTB, NXCD = 8, WGM = 8;

__host__ __device__ __forceinline__ int lds_byte(int r, int c) { const int st = (r >> 4) * 2 + (c >> 5), rr = r & 15, cc = c & 31, ob = rr * 64 + cc * 2; return st * 1024 + (ob ^ (((ob >> 9) & 1) << 5)); }
__host__ __device__ __forceinline__ void stage_rc(int b, int& R, int& C) { const int st = b / 1024, sb = b % 1024, swz = sb ^ (((sb >> 9) & 1) << 5); R = (st >> 1) * 16 + swz / 64; C = (st & 1) * 32 + (swz % 64) / 2; }
__host__ __device__ __forceinline__ int perm32(int rho) { const int n = rho >> 4, i = rho & 15; return 8 * (i >> 2) + 4 * n + (i & 3); }

struct Unit { int pm, pn; };
struct Gemm { const bf16_t* A; const bf16_t* Bt; int M, N, K, lda; };

struct StaticOrder {
    int nM, nN, nwg, G, c;
    __host__ __device__ void init(int M, int N, int G_, int c_) { nM = M / BM; nN = N / BM; nwg = nM * nN; G = G_; c = c_; }
    __host__ __device__ bool next(int i, Unit& u) const {
        const long L = (long)i * G + c; if (L >= nwg) return false;
        int wgid = (int)L; { const int q = nwg / NXCD, r = nwg % NXCD, xcd = wgid % NXCD, off = wgid / NXCD; wgid = (xcd < r ? xcd * (q + 1) : r * (q + 1) + (xcd - r) * q) + off; }
        const int nig = WGM * nN, gid = wgid / nig, fm = gid * WGM, gsz = (nM - fm) < WGM ? (nM - fm) : WGM;
        u.pm = fm + ((wgid % nig) % gsz); u.pn = (wgid % nig) / gsz; return true;
    }
    __device__ __forceinline__ void a_ready(const Unit&) const {}
    __device__ __forceinline__ void done(const Unit&) const {}
};

__device__ __forceinline__ unsigned cvt_pk_bf16(float lo, float hi) { unsigned r; asm volatile("v_cvt_pk_bf16_f32 %0, %1, %2" : "=v"(r) : "v"(lo), "v"(hi)); return r; }
template <class Epi, class Sched, bool ALIGN_EPI = false, bool SP2 = false>
__device__ __forceinline__ void gemm_phase(PG8_LAS unsigned char* lds, const Gemm g, const Sched& S, const Epi& E, const int tid) {
    const int wid = __builtin_amdgcn_readfirstlane(tid >> 6), lane = tid & 63, wr = wid >> 2, wc = wid & 3, fr = lane & 15, fq = lane >> 4;
    const int K = g.K, nt = K / BK;
    unsigned voffA[2], voffB[2];
#pragma unroll
    for (int i = 0; i < 2; ++i) { int R, C; stage_rc(tid * 16 + i * 8192, R, C); const int Rb = Epi::PERM ? ((R & ~31) + perm32(R & 31)) : R;
        voffA[i] = (unsigned)(R * g.lda + C) * 2u; voffB[i] = (unsigned)(Rb * K + C) * 2u; }
    const size_t kstep = (size_t)(BK * 2);
    const size_t hstep = (size_t)HALF * K * 2;
    const size_t tstep = 2 * hstep; const size_t hstepA = (size_t)HALF * g.lda * 2, tstepA = 2 * hstepA;
    const unsigned ldsw = (unsigned)wid * 1024u;
    const int aoff = lds_byte(wr * 64 + fr, fq * 8), boff = lds_byte(wc * 32 + fr, fq * 8);
#define PG8_SA(b, h) (((b) * 2 + (h)) * HTB)
#define PG8_SB(b, h) ((4 + (b) * 2 + (h)) * HTB)
#define PG8_STAGE(bufoff, gbase, voff) do { _Pragma("unroll") for (int _i = 0; _i < 2; ++_i) \
        __builtin_amdgcn_global_load_lds((const unsigned*)((const char*)(gbase) + (voff)[_i]), (PG8_LAS unsigned*)(lds + (bufoff) + ldsw + _i * 8192), 16, 0, 0); } while (0)
#define PG8_LDA(dst, b, h) do { _Pragma("unroll") for (int m = 0; m < 4; ++m) _Pragma("unroll") for (int k = 0; k < 2; ++k) dst[m][k] = *(const PG8_LAS bf16x8*)(lds + PG8_SA(b, h) + aoff + m * 2048 + k * 1024); } while (0)
#define PG8_LDB(dst, b, h) do { _Pragma("unroll") for (int n = 0; n < 2; ++n) _Pragma("unroll") for (int k = 0; k < 2; ++k) dst[n][k] = *(const PG8_LAS bf16x8*)(lds + PG8_SB(b, h) + boff + n * 2048 + k * 1024); } while (0)
#define PG8_MMA(ai, bj, At, Bt) do { __builtin_amdgcn_s_setprio(1); _Pragma("unroll") for (int m = 0; m < 4; ++m) _Pragma("unroll") for (int n = 0; n < 2; ++n) _Pragma("unroll") for (int k = 0; k < 2; ++k) \
        acc[ai][bj][m][n] = __builtin_amdgcn_mfma_f32_16x16x32_bf16(Bt[n][k], At[m][k], acc[ai][bj][m][n], 0, 0, 0); __builtin_amdgcn_s_setprio(0); } while (0)
#define PG8_WAIT_V(n) asm volatile("s_waitcnt vmcnt(" #n ")" ::: "memory")
#define PG8_WAIT_L(n) asm volatile("s_waitcnt lgkmcnt(" #n ")" ::: "memory")
#define PG8_BAR __builtin_amdgcn_s_barrier()
#define PG8_SCHED __builtin_amdgcn_sched_barrier(0)
    Unit cur, nxt; int ui = 0;
    if (!S.next(0, cur)) return;
    f32x4 acc[2][2][4][2];
#pragma unroll
    for (int a = 0; a < 2; ++a)
#pragma unroll
        for (int b = 0; b < 2; ++b)
#pragma unroll
            for (int m = 0; m < 4; ++m)
#pragma unroll
                for (int n = 0; n < 2; ++n) acc[a][b][m][n] = (f32x4){0.f, 0.f, 0.f, 0.f};
    bf16x8 At[4][2], B0[2][2], B1[2][2];
    const char* cA = (const char*)g.A + (size_t)cur.pm * tstepA; const char* cB = (const char*)g.Bt + (size_t)cur.pn * tstep;
    S.a_ready(cur);
    if constexpr (SP2) {
        PG8_STAGE(PG8_SB(0, 0), cB, voffB); PG8_STAGE(PG8_SB(0, 1), cB + hstep, voffB); PG8_STAGE(PG8_SA(0, 0), cA, voffA); PG8_STAGE(PG8_SA(0, 1), cA + hstepA, voffA);
        if (wr == 1) PG8_BAR;
        PG8_WAIT_V(2); PG8_BAR;
        PG8_STAGE(PG8_SB(1, 0), cB + kstep, voffB); PG8_STAGE(PG8_SA(1, 0), cA + kstep, voffA); PG8_STAGE(PG8_SB(1, 1), cB + hstep + kstep, voffB);
        PG8_WAIT_V(6); PG8_BAR;
    } else {
        PG8_STAGE(PG8_SB(0, 0), cB, voffB); PG8_STAGE(PG8_SA(0, 0), cA, voffA); PG8_STAGE(PG8_SB(0, 1), cB + hstep, voffB); PG8_STAGE(PG8_SA(0, 1), cA + hstepA, voffA);
        if (wr == 1) PG8_BAR;
        PG8_WAIT_V(4); PG8_BAR;
        PG8_STAGE(PG8_SB(1, 0), cB + kstep, voffB); PG8_STAGE(PG8_SA(1, 0), cA + kstep, voffA); PG8_STAGE(PG8_SB(1, 1), cB + hstep + kstep, voffB);
        PG8_WAIT_V(6); PG8_BAR;
    }
    for (;;) {
        const bool has_next = S.next(ui + 1, nxt);
        const char* nA = has_next ? (const char*)g.A + (size_t)nxt.pm * tstepA : cA; const char* nB = has_next ? (const char*)g.Bt + (size_t)nxt.pn * tstep : cB;
        for (int t = 0; t < nt; t += 2) {
            const bool last = (t == nt - 2);
            const char* a1 = cA + (size_t)(t + 1) * kstep;
            const char* a2 = last ? nA : cA + (size_t)(t + 2) * kstep; const char* b2 = last ? nB : cB + (size_t)(t + 2) * kstep;
            const char* a3 = a2 + kstep; const char* b3 = b2 + kstep;
            if (last && has_next) S.a_ready(nxt);
            if constexpr (SP2) {
            PG8_LDB(B0, 0, 0); PG8_LDB(B1, 0, 1); PG8_SCHED; PG8_LDA(At, 0, 0); PG8_STAGE(PG8_SA(1, 1), a1 + hstepA, voffA);
            PG8_WAIT_V(8); PG8_WAIT_L(0); PG8_BAR; PG8_MMA(0, 0, At, B0); PG8_MMA(0, 1, At, B1); PG8_BAR; PG8_SCHED;
            PG8_LDA(At, 0, 1); PG8_STAGE(PG8_SB(0, 0), b2, voffB); PG8_STAGE(PG8_SB(0, 1), b2 + hstep, voffB); PG8_STAGE(PG8_SA(0, 0), a2, voffA);
            PG8_WAIT_V(8); PG8_WAIT_L(0); PG8_BAR; PG8_MMA(1, 0, At, B0); PG8_MMA(1, 1, At, B1); PG8_BAR; PG8_SCHED;
            PG8_LDB(B0, 1, 0); PG8_LDB(B1, 1, 1); PG8_SCHED; PG8_LDA(At, 1, 0); PG8_STAGE(PG8_SA(0, 1), a2 + hstepA, voffA);
            PG8_WAIT_V(8); PG8_WAIT_L(0); PG8_BAR; PG8_MMA(0, 0, At, B0); PG8_MMA(0, 1, At, B1); PG8_BAR; PG8_SCHED;
            PG8_LDA(At, 1, 1); PG8_STAGE(PG8_SB(1, 0), b3, voffB); PG8_STAGE(PG8_SB(1, 1), b3 + hstep, voffB); PG8_STAGE(PG8_SA(1, 0), a3, voffA);
            PG8_WAIT_V(8); PG8_WAIT_L(0); PG8_BAR; PG8_MMA(1, 0, At, B0); PG8_MMA(1, 1, At, B1); PG8_BAR; PG8_SCHED;
            } else {
            PG8_LDB(B0, 0, 0); PG8_SCHED; PG8_LDA(At, 0, 0); PG8_STAGE(PG8_SA(1, 1), a1 + hstepA, voffA);
            PG8_WAIT_L(8); PG8_BAR; PG8_WAIT_L(0); PG8_MMA(0, 0, At, B0); PG8_BAR; PG8_SCHED;
            PG8_LDB(B1, 0, 1); PG8_STAGE(PG8_SB(0, 0), b2, voffB);
            PG8_BAR; PG8_WAIT_L(0); PG8_MMA(0, 1, At, B1); PG8_BAR;
            PG8_LDA(At, 0, 1); PG8_STAGE(PG8_SA(0, 0), a2, voffA);
            PG8_BAR; PG8_WAIT_L(0); PG8_MMA(1, 0, At, B0); PG8_BAR; PG8_SCHED;
            PG8_STAGE(PG8_SB(0, 1), b2 + hstep, voffB);
            PG8_WAIT_V(6); PG8_BAR; PG8_MMA(1, 1, At, B1); PG8_BAR;
            PG8_LDB(B0, 1, 0); PG8_SCHED; PG8_LDA(At, 1, 0); PG8_STAGE(PG8_SA(0, 1), a2 + hstepA, voffA);
            PG8_WAIT_L(8); PG8_BAR; PG8_WAIT_L(0); PG8_MMA(0, 0, At, B0); PG8_BAR; PG8_SCHED;
            PG8_LDB(B1, 1, 1); PG8_STAGE(PG8_SB(1, 0), b3, voffB);
            PG8_BAR; PG8_WAIT_L(0); PG8_MMA(0, 1, At, B1); PG8_BAR;
            PG8_LDA(At, 1, 1); PG8_STAGE(PG8_SA(1, 0), a3, voffA);
            PG8_BAR; PG8_WAIT_L(0); PG8_MMA(1, 0, At, B0); PG8_BAR; PG8_SCHED;
            PG8_STAGE(PG8_SB(1, 1), b3 + hstep, voffB);
            PG8_WAIT_V(6); PG8_BAR; PG8_MMA(1, 1, At, B1); PG8_BAR;
            }
        }
        if constexpr (ALIGN_EPI) { if (wr == 0) PG8_BAR; }
        if constexpr (!Epi::AFTER_DRAIN) { E(acc, cur, wr, wc, fr, fq); S.done(cur); }
        if (!has_next) break;
#pragma unroll
        for (int a = 0; a < 2; ++a)
#pragma unroll
            for (int b = 0; b < 2; ++b)
#pragma unroll
                for (int m = 0; m < 4; ++m)
#pragma unroll
                    for (int n = 0; n < 2; ++n) acc[a][b][m][n] = (f32x4){0.f, 0.f, 0.f, 0.f};
        cur = nxt; cA = nA; cB = nB; ++ui;
        if constexpr (ALIGN_EPI) { if (wr == 1) PG8_BAR; }
    }
    PG8_WAIT_V(0);
    if constexpr (!ALIGN_EPI) { if (wr == 0) PG8_BAR; }
    PG8_BAR;
    if constexpr (Epi::AFTER_DRAIN) { E.fused(acc, cur, wr, wc, fr, fq, lds, wid, lane); S.done(cur); }
#undef PG8_SA
#undef PG8_SB
#undef PG8_STAGE
#undef PG8_LDA
#undef PG8_LDB
#undef PG8_MMA
#undef PG8_WAIT_V
#undef PG8_WAIT_L
#undef PG8_BAR
#undef PG8_SCHED
}
}
using pg8::bf16_t; using pg8::f32x4; using pg8::u32x4; using pg8::bf16x8; using pg8::Unit;
#define LAS __attribute__((address_space(3)))
typedef float f32x16 __attribute__((ext_vector_type(16)));
typedef unsigned u32x2 __attribute__((ext_vector_type(2)));
typedef short s16x4 __attribute__((ext_vector_type(4)));
constexpr int NB = 8, SEQ = 4096, CTXL = 256, DM = 1024, FF = 2816, DEPTH = 4, NH = 8;
constexpr int R_LAT = NB * SEQ, R_CTX = NB * CTXL, R = R_LAT + R_CTX;
constexpr float EPS = 1e-6f;
constexpr int NCH = 34;
constexpr size_t W_GUA = 0, W_DA = W_GUA + (size_t)5632 * 1024, W_GUB = W_DA + (size_t)1024 * 2816, W_DB = W_GUB + (size_t)5632 * 1024,
                 W_IN = W_DB + (size_t)1024 * 2816, W_UQ = W_IN + (size_t)3840 * 1024, W_UKV = W_UQ + (size_t)1536 * 256, W_OMLA = W_UKV + (size_t)2048 * 256,
                 W_GLU = W_OMLA + (size_t)1024 * 1024, W_OS5 = W_GLU + (size_t)1024 * 1024, W_OUT = W_OS5 + (size_t)1024 * 1024, W_END = W_OUT + (size_t)1024 * 1024;
constexpr size_t al256(size_t x) { return (x + 255) & ~(size_t)255; }
constexpr size_t WS_CTL = 0, CTL_BYTES = 16384;
constexpr size_t WS_MOD = WS_CTL + CTL_BYTES;
constexpr size_t WS_ROPE = WS_MOD + al256((size_t)4 * 9 * 9216 * 4);
constexpr size_t WS_YSS = WS_ROPE + al256(64 * 16 * 8);
constexpr size_t WS_CSS = WS_YSS + al256((size_t)R * 16 * 4);
constexpr size_t WS_S5E = WS_CSS + al256((size_t)R * 8 * 4);
constexpr size_t S5_WE_BYTES = (size_t)2 * 64 * 128 * 256 * 2, S5_WY_BYTES = (size_t)64 * 256 * 512 * 2;
constexpr size_t WS_XC = WS_S5E + al256(S5_WE_BYTES + S5_WY_BYTES);
constexpr size_t WS_WL = WS_XC + al256((size_t)R_CTX * DM * 4);
constexpr size_t WS_H = WS_WL + al256(W_END * 2);
constexpr size_t WS_BIG = WS_H + al256((size_t)R * DM * 2);
constexpr size_t B_CQ = 0, B_U = B_CQ + (size_t)R * 768 * 2, B_Q = B_U + (size_t)R * 1024 * 2, B_KV = B_Q + (size_t)R * 1536 * 2, B_SG = B_KV + (size_t)R * 2048 * 2, B_END = B_SG + (size_t)R * 2048 * 2;
constexpr size_t B_ACT = 0, B_Y = (size_t)R * FF * 2;
constexpr size_t B_T = B_U, B_G = B_KV, B_M = B_Q;
static_assert(B_Y >= B_M + (size_t)R * 1024 * 2 && B_Y + (size_t)R * 1024 * 2 <= B_SG, "Y overlay");
constexpr size_t WS_END = WS_BIG + B_END;
constexpr int LDS_BYTES = 272 * 528 + 2 * 16 * 528 + 256;

__device__ __forceinline__ float bf2f(unsigned h) { return __uint_as_float(h << 16); }
__device__ __forceinline__ unsigned pk2(float lo, float hi) { return pg8::cvt_pk_bf16(lo, hi); }
__device__ __forceinline__ float sigm(float x) { return __builtin_amdgcn_rcpf(1.f + __builtin_amdgcn_exp2f(-1.4426950408889634f * x)); }
__device__ __forceinline__ float gelu_tanh(float x) { return x * sigm(1.5957691216057308f * (x + 0.044715f * x * x * x)); }
__device__ __forceinline__ void unpack8(const u32x4 w, float (&f)[8]) {
    f[0] = bf2f(w.x & 0xffffu); f[1] = __uint_as_float(w.x & 0xffff0000u); f[2] = bf2f(w.y & 0xffffu); f[3] = __uint_as_float(w.y & 0xffff0000u);
    f[4] = bf2f(w.z & 0xffffu); f[5] = __uint_as_float(w.z & 0xffff0000u); f[6] = bf2f(w.w & 0xffffu); f[7] = __uint_as_float(w.w & 0xffff0000u);
}
__device__ __forceinline__ u32x4 pack8(const float (&f)[8]) { u32x4 w; w.x = pk2(f[0], f[1]); w.y = pk2(f[2], f[3]); w.z = pk2(f[4], f[5]); w.w = pk2(f[6], f[7]); return w; }
__device__ __forceinline__ float wave_sum(float v) {
#pragma unroll
    for (int o = 1; o < 64; o <<= 1) v += __shfl_xor(v, o);
    return v;
}
__device__ __forceinline__ void rope8(float (&v)[8], int row, int wc, int fq, const float* tab) {
    const int t = row & 4095, pos = (wc & 1) ? (t & 63) : (t >> 6);
    const f32x4* tp = (const f32x4*)(tab + (pos * 16 + 8 * (fq & 1)) * 2);
    const f32x4 t0 = tp[0], t1 = tp[1], t2 = tp[2], t3 = tp[3];
    const float cs[8] = {t0[0], t0[2], t1[0], t1[2], t2[0], t2[2], t3[0], t3[2]}, sn[8] = {t0[1], t0[3], t1[1], t1[3], t2[1], t2[3], t3[1], t3[3]};
    const float sgn = (fq < 2) ? -1.f : 1.f;
#pragma unroll
    for (int j = 0; j < 8; ++j) { const float p = __shfl_xor(v[j], 32); v[j] = v[j] * cs[j] + sgn * p * sn[j]; }
}

struct Epi {
    static constexpr bool PERM = true, AFTER_DRAIN = false;
    int mode;
    bf16_t* o0; bf16_t* o1; bf16_t* o2; const bf16_t* i0; const bf16_t* i1; float* ss; const float* css; const float* bias; const float* rope;
    __device__ __forceinline__ void operator()(const f32x4 (&acc)[2][2][4][2], const Unit& u, int wr, int wc, int fr, int fq) const {
        const int row0 = u.pm * 256 + wr * 64 + fr, cb = wc * 32 + 8 * fq, pn = u.pn;
        if (mode == 0) {
            bf16_t* base = o0 + (size_t)pn * 128 + cb;
#pragma unroll
            for (int ai = 0; ai < 2; ++ai)
#pragma unroll
                for (int m = 0; m < 4; ++m) { const int row = row0 + ai * 128 + m * 16; float v[8];
#pragma unroll
                    for (int n = 0; n < 2; ++n)
#pragma unroll
                        for (int j = 0; j < 4; ++j) { const float g = acc[ai][0][m][n][j], up = acc[ai][1][m][n][j]; v[4 * n + j] = g * sigm(g) * up; }
                    *(u32x4*)(base + (size_t)row * FF) = pack8(v); }
        } else if (mode == 1) {
            bf16_t* base = o0 + pn * 256 + cb;
#pragma unroll
            for (int ai = 0; ai < 2; ++ai)
#pragma unroll
                for (int m = 0; m < 4; ++m) { const int row = row0 + ai * 128 + m * 16; float s = 0.f;
#pragma unroll
                    for (int bj = 0; bj < 2; ++bj) { float v[8];
#pragma unroll
                        for (int n = 0; n < 2; ++n)
#pragma unroll
                            for (int j = 0; j < 4; ++j) { const float x = acc[ai][bj][m][n][j]; v[4 * n + j] = x; s += x * x; }
                        *(u32x4*)(base + (size_t)row * 1024 + bj * 128) = pack8(v); }
                    s += __shfl_xor(s, 16); s += __shfl_xor(s, 32);
                    if (fq == 0) ss[row * 16 + pn * 4 + wc] = s; }
        } else if (mode == 2) {
            bf16_t* dst; int ldc;
            if (pn < 3) { dst = o0 + pn * 256; ldc = 768; } else if (pn < 7) { dst = o1 + (pn - 3) * 256; ldc = 1024; } else { dst = o2 + (pn - 7) * 256; ldc = 2048; }
            const bool sg = pn >= 7, docss = pn < 2, dorope = (pn == 2) && (u.pm < 128) && (wc < 2);
            dst += cb;
#pragma unroll
            for (int ai = 0; ai < 2; ++ai)
#pragma unroll
                for (int m = 0; m < 4; ++m) { const int row = row0 + ai * 128 + m * 16; float s = 0.f;
#pragma unroll
                    for (int bj = 0; bj < 2; ++bj) { float v[8];
#pragma unroll
                        for (int n = 0; n < 2; ++n)
#pragma unroll
                            for (int j = 0; j < 4; ++j) { float x = acc[ai][bj][m][n][j]; if (sg) x = sigm(x); v[4 * n + j] = x; s += x * x; }
                        if (bj == 0 && dorope) rope8(v, row, wc, fq, rope);
                        *(u32x4*)(dst + (size_t)row * ldc + bj * 128) = pack8(v); }
                    if (docss) { s += __shfl_xor(s, 16); s += __shfl_xor(s, 32); if (fq == 0) ss[row * 8 + pn * 4 + wc] = s; } }
        } else if (mode == 3 || mode == 4) {
            const int ldc = (mode == 3) ? 1536 : 2048; const float* cp = css + ((mode == 3) ? 0 : 4);
            const bool dorope = (mode == 3) && (pn >= 4) && (u.pm < 128);
            bf16_t* dst = o0 + pn * 256 + cb;
#pragma unroll
            for (int ai = 0; ai < 2; ++ai)
#pragma unroll
                for (int m = 0; m < 4; ++m) { const int row = row0 + ai * 128 + m * 16; const f32x4 c4 = *(const f32x4*)(cp + row * 8);
                    const float rs = 1.0f / sqrtf(((c4[0] + c4[1]) + (c4[2] + c4[3])) * (1.0f / 256.0f) + EPS);
#pragma unroll
                    for (int bj = 0; bj < 2; ++bj) { float v[8];
#pragma unroll
                        for (int n = 0; n < 2; ++n)
#pragma unroll
                            for (int j = 0; j < 4; ++j) v[4 * n + j] = acc[ai][bj][m][n][j] * rs;
                        if (dorope) rope8(v, row, wc, fq, rope);
                        *(u32x4*)(dst + (size_t)row * ldc + bj * 128) = pack8(v); } }
        } else {
            const int col = pn * 256 + cb;
#pragma unroll
            for (int ai = 0; ai < 2; ++ai)
#pragma unroll
                for (int m = 0; m < 4; ++m) { const int row = row0 + ai * 128 + m * 16;
#pragma unroll
                    for (int bj = 0; bj < 2; ++bj) { const int c = col + bj * 128; float v[8], a[8], b[8];
#pragma unroll
                        for (int n = 0; n < 2; ++n)
#pragma unroll
                            for (int j = 0; j < 4; ++j) v[4 * n + j] = acc[ai][bj][m][n][j];
                        if (mode == 5) { unpack8(*(const u32x4*)(i0 + (size_t)row * 1024 + c), a); const f32x4 b0 = *(const f32x4*)(bias + c), b1 = *(const f32x4*)(bias + c + 4);
#pragma unroll
                            for (int j = 0; j < 4; ++j) { v[j] = a[j] * sigm(v[j] + b0[j]); v[4 + j] = a[4 + j] * sigm(v[4 + j] + b1[j]); } }
                        else if (mode == 6) { unpack8(*(const u32x4*)(i0 + (size_t)row * 2048 + c), a);
#pragma unroll
                            for (int j = 0; j < 8; ++j) v[j] = a[j] * v[j]; }
                        else { unpack8(*(const u32x4*)(i0 + (size_t)row * 1024 + c), a); unpack8(*(const u32x4*)(i1 + (size_t)row * 2048 + c), b);
#pragma unroll
                            for (int j = 0; j < 8; ++j) v[j] = a[j] + b[j] * v[j]; }
                        *(u32x4*)(o0 + (size_t)row * 1024 + c) = pack8(v); } }
        }
    }
};
__device__ __forceinline__ void conv_item(const float* W, int ldsrc, int srccol, const float* kscale, bf16_t* WT, int K, int n0, int k0, LAS float* scr, int lane) {
    if (srccol >= 0) {
#pragma unroll 8
        for (int i = 0; i < 32; ++i) { const int kk = 2 * i + (lane >> 5); float w = W[(size_t)(k0 + kk) * ldsrc + srccol + (lane & 31)]; if (kscale) w *= kscale[k0 + kk]; scr[kk * 33 + (lane & 31)] = w; }
    } else {
#pragma unroll 8
        for (int i = 0; i < 32; ++i) { const int kk = 2 * i + (lane >> 5); scr[kk * 33 + (lane & 31)] = 0.f; }
    }
    asm volatile("s_waitcnt lgkmcnt(0)" ::: "memory");
    const int c = lane & 7;
#pragma unroll
    for (int j = 0; j < 4; ++j) { const int n = (lane >> 3) + 8 * j; const LAS float* s = scr + (8 * c) * 33 + n;
        u32x4 o; o.x = pk2(s[0 * 33], s[1 * 33]); o.y = pk2(s[2 * 33], s[3 * 33]); o.z = pk2(s[4 * 33], s[5 * 33]); o.w = pk2(s[6 * 33], s[7 * 33]);
        *(u32x4*)(WT + (size_t)(n0 + n) * K + k0 + 8 * c) = o; }
    asm volatile("s_waitcnt lgkmcnt(0)" ::: "memory");
}
struct WPtrs { const float *gate, *up, *down, *win, *qn, *wuq, *kvn, *wukv, *womla, *glu, *wos5, *wout; };
__device__ __forceinline__ void conv_layer(const WPtrs& P, int l, bf16_t* WL, LAS unsigned char* lds, int gw, int NGW, int wave, int lane, int it_lo, int it_hi) {
    LAS float* scr = (LAS float*)(lds + wave * 16384);
    constexpr int I_GU = 16 * 176, I_D = 44 * 32, I_IN = 16 * 120, I_UQ = 4 * 48, I_UKV = 4 * 64, I_SQ = 16 * 32;
    constexpr int NIT = 2 * I_GU + 2 * I_D + I_IN + I_UQ + I_UKV + 4 * I_SQ;
    static_assert(NIT == 12864, "conv items");
    for (int it = it_lo + gw; it < it_hi; it += NGW) {
        int r = it;
        if (r < 2 * I_GU) { const int f = r / I_GU; r -= f * I_GU; const int nb = r % 176, kb = r / 176, n0 = nb * 32, tile = n0 >> 8, within = n0 & 255, half = within >> 7, ffc = tile * 128 + (within & 127);
            const size_t so = (size_t)(l * 2 + f) * 1024 * FF; bf16_t* dst = WL + (f ? W_GUB : W_GUA);
            if (half) conv_item(P.up + so, FF, ffc, nullptr, dst, 1024, n0, kb * 64, scr, lane); else conv_item(P.gate + so, FF, ffc, nullptr, dst, 1024, n0, kb * 64, scr, lane);
            continue; }
        r -= 2 * I_GU;
        if (r < 2 * I_D) { const int f = r / I_D; r -= f * I_D; const int nb = r % 32, kb = r / 32;
            conv_item(P.down + (size_t)(l * 2 + f) * FF * 1024, 1024, nb * 32, nullptr, WL + (f ? W_DB : W_DA), FF, nb * 32, kb * 64, scr, lane); continue; }
        r -= 2 * I_D;
        if (r < I_IN) { const int nb = r % 120, kb = r / 120, n0 = nb * 32; int sc;
            if (n0 < 512) sc = n0; else if (n0 < 768) sc = (n0 < 576) ? n0 : -1; else sc = n0 - 768 + 576;
            conv_item(P.win + (size_t)l * 1024 * 3648, 3648, sc, nullptr, WL + W_IN, 1024, n0, kb * 64, scr, lane); continue; }
        r -= I_IN;
        if (r < I_UQ) { const int nb = r % 48, kb = r / 48, n0 = nb * 32; int sc;
            if (n0 < 1024) sc = (n0 >> 7) * 192 + (n0 & 127); else { const int rr = n0 - 1024; sc = (rr >> 6) * 192 + 128 + (rr & 63); }
            conv_item(P.wuq + (size_t)l * 256 * 1536, 1536, sc, P.qn + l * 256, WL + W_UQ, 256, n0, kb * 64, scr, lane); continue; }
        r -= I_UQ;
        if (r < I_UKV) { const int nb = r % 64, kb = r / 64;
            conv_item(P.wukv + (size_t)l * 256 * 2048, 2048, nb * 32, P.kvn + l * 256, WL + W_UKV, 256, nb * 32, kb * 64, scr, lane); continue; }
        r -= I_UKV;
        { const int q = r / I_SQ; r -= q * I_SQ; const int nb = r % 32, kb = r / 32; const size_t so = (size_t)l * 1024 * 1024;
          if (q == 0) conv_item(P.womla + so, 1024, nb * 32, nullptr, WL + W_OMLA, 1024, nb * 32, kb * 64, scr, lane);
          else if (q == 1) conv_item(P.glu + so, 1024, nb * 32, nullptr, WL + W_GLU, 1024, nb * 32, kb * 64, scr, lane);
          else if (q == 2) conv_item(P.wos5 + so, 1024, nb * 32, nullptr, WL + W_OS5, 1024, nb * 32, kb * 64, scr, lane);
          else conv_item(P.wout + so, 1024, nb * 32, nullptr, WL + W_OUT, 1024, nb * 32, kb * 64, scr, lane); }
    }
}

__device__ __forceinline__ void mods_phase(const float* c, const float* c_ctx, const float* ada_w, const float* ada_b, float* MOD, float* ROPE, LAS unsigned char* lds, const int tid) {

    LAS float* sc = (LAS float*)lds;
    LAS float* red = (LAS float*)(lds + 9 * 1024 * 4);
    if (blockIdx.x == gridDim.x - 1) {
        for (int e = tid; e < 1024; e += 512) { const int pos = e >> 4, i = e & 15; const float inv = exp2f(-(float)i * (13.287712379549449f / 16.0f)); const float ang = (float)pos * inv;
            float sn_, cs_; sincosf(ang, &sn_, &cs_); ROPE[2 * e] = cs_; ROPE[2 * e + 1] = sn_; }
    }
    bool have = false;
    for (int item = blockIdx.x; item < 576; item += gridDim.x) {
        if (!have) { for (int e = tid; e < 9 * 1024; e += 512) { const float v = (e < 8192) ? c[e] : c_ctx[e - 8192]; sc[e] = v * sigm(v); } have = true; }
        __syncthreads();
        const int l = item / 144, j0 = (item % 144) * 64, ks = tid >> 6, jj = tid & 63;
        const float* w = ada_w + ((size_t)l * 1024 + ks * 128) * 9216 + j0 + jj;
        float a[9];
#pragma unroll
        for (int s = 0; s < 9; ++s) a[s] = 0.f;
#pragma unroll 16
        for (int k = 0; k < 128; ++k) { const float wv = w[(size_t)k * 9216];
#pragma unroll
            for (int s = 0; s < 9; ++s) a[s] += sc[s * 1024 + ks * 128 + k] * wv; }
#pragma unroll
        for (int s = 0; s < 9; ++s) red[(ks * 9 + s) * 64 + jj] = a[s];
        __syncthreads();
        for (int e = tid; e < 576; e += 512) { const int s = e >> 6, j = e & 63; float t = 0.f;
#pragma unroll
            for (int q = 0; q < 8; ++q) t += red[(q * 9 + s) * 64 + j];
            MOD[((size_t)l * 9 + s) * 9216 + j0 + j] = t + ada_b[l * 9216 + j0 + j]; }
    }
    __syncthreads();
}

__device__ __forceinline__ void e_phase(const float* xin, const float* ctxin, float* xl, float* xc, const bf16_t* Y, const float* YSS, const float* MOD,
                                        const float* npre, const float* npost, bf16_t* H, int l, int s, int nl, int ns, int gw, int NGW, int lane, float wmul, int nrows) {
    for (int row = gw; row < nrows; row += NGW) {
        const bool lat = row < R_LAT; const int set = lat ? (row >> 12) : 8;
        float* xr = lat ? xl + (size_t)row * DM : xc + (size_t)(row - R_LAT) * DM;
        const float* xs = (s < 0) ? (lat ? xin + (size_t)row * DM : ctxin + (size_t)(row - R_LAT) * DM) : xr;
        f32x4 v[4];
#pragma unroll
        for (int j = 0; j < 4; ++j) v[j] = __builtin_nontemporal_load((const f32x4*)xs + lane + 64 * j);
        if (s >= 0) {
            const float part = (lane < 16) ? YSS[row * 16 + lane] : 0.f;
            const float rs = 1.0f / sqrtf(wave_sum(part) * (1.0f / 1024.0f) + EPS);
            const float wgt = ((s == 1) ? 1.0f : 0.5f) * wmul;
            const float* gate = MOD + ((size_t)(l * 9 + set) * 9 + 3 * s + 2) * 1024; const float* gp = npost + (l * 3 + s) * 1024;
#pragma unroll
            for (int j = 0; j < 4; ++j) { const u32x2 yw = ((const u32x2*)(Y + (size_t)row * DM))[lane + 64 * j];
                const f32x4 g4 = ((const f32x4*)gate)[lane + 64 * j], p4 = ((const f32x4*)gp)[lane + 64 * j];
                f32x4 y4; y4[0] = bf2f(yw.x & 0xffffu); y4[1] = __uint_as_float(yw.x & 0xffff0000u); y4[2] = bf2f(yw.y & 0xffffu); y4[3] = __uint_as_float(yw.y & 0xffff0000u);
                v[j] += (wgt * rs) * g4 * y4 * p4; }
        }
#pragma unroll
        for (int j = 0; j < 4; ++j) __builtin_nontemporal_store(v[j], (f32x4*)xr + lane + 64 * j);
        if (nl >= 0) {
            float q = 0.f;
#pragma unroll
            for (int j = 0; j < 4; ++j) q += (v[j][0] * v[j][0] + v[j][1] * v[j][1]) + (v[j][2] * v[j][2] + v[j][3] * v[j][3]);
            const float rs2 = 1.0f / sqrtf(wave_sum(q) * (1.0f / 1024.0f) + EPS);
            const float* mb = MOD + ((size_t)(nl * 9 + set) * 9 + 3 * ns) * 1024; const float* gp = npre + (nl * 3 + ns) * 1024;
#pragma unroll
            for (int j = 0; j < 4; ++j) { const f32x4 sh = ((const f32x4*)mb)[lane + 64 * j], sc = ((const f32x4*)(mb + 1024))[lane + 64 * j], p4 = ((const f32x4*)gp)[lane + 64 * j];
                const f32x4 h = v[j] * rs2 * p4 * (1.0f + sc) + sh;
                u32x2 o; o.x = pk2(h[0], h[1]); o.y = pk2(h[2], h[3]); ((u32x2*)(H + (size_t)row * DM))[lane + 64 * j] = o; }
        }
    }
}
struct S5In { const float *a_re, *a_im, *log_dt, *b_re, *b_im, *c_re, *c_im, *dsk; };
__device__ __forceinline__ void s5_abar(const S5In& P, int idx, int n, float& ar, float& ai, float& cr, float& ci) {
    const float are = P.a_re[idx * 64 + n], aim = P.a_im[idx * 64 + n];
    const float dt = expf(P.log_dt[idx]);
    const float mag = expf(dt * are); float sn, cs; sincosf(dt * aim, &sn, &cs);
    ar = mag * cs; ai = mag * sn;
    const float nr = ar - 1.f, ni = ai, den = 1.0f / (are * are + aim * aim);
    cr = (nr * are + ni * aim) * den; ci = (ni * are - nr * aim) * den;
}
__device__ __forceinline__ void s5_prep(const S5In& P, int l, int g, bf16_t* WEt, bf16_t* WYt, LAS unsigned char* lds, int tid) {
    LAS float* AP = (LAS float*)lds;
    LAS float* BB = AP + 2 * 17 * 64 * 2;
    LAS float* CC = BB + 2 * 64 * 16 * 2;
    LAS float* KL = CC + 2 * 16 * 64 * 2;
    if (tid < 128) { const int d = tid >> 6, n = tid & 63, idx = (l * 2 + d) * 64 + g; float ar, ai, cr, ci; s5_abar(P, idx, n, ar, ai, cr, ci);
        float pr = 1.f, pi = 0.f;
        for (int j = 0; j <= 16; ++j) { AP[((d * 17 + j) * 64 + n) * 2] = pr; AP[((d * 17 + j) * 64 + n) * 2 + 1] = pi; const float t0 = pr * ar - pi * ai, t1 = pr * ai + pi * ar; pr = t0; pi = t1; }
        for (int c = 0; c < 16; ++c) { const float br = P.b_re[(size_t)(idx * 64 + n) * 16 + c], bi = P.b_im[(size_t)(idx * 64 + n) * 16 + c];
            BB[((d * 64 + n) * 16 + c) * 2] = cr * br - ci * bi; BB[((d * 64 + n) * 16 + c) * 2 + 1] = cr * bi + ci * br; } }
    for (int e = tid; e < 2048; e += 512) { const int d = e >> 10, cn = e & 1023; const size_t src = (size_t)((l * 2 + d) * 64 + g) * 1024 + cn; CC[e * 2] = P.c_re[src]; CC[e * 2 + 1] = P.c_im[src]; }
    __syncthreads();
    { const int d = tid >> 8, c = (tid >> 4) & 15, cp = tid & 15; float acc[16];
#pragma unroll
      for (int j = 0; j < 16; ++j) acc[j] = 0.f;
      for (int n = 0; n < 64; ++n) { const float c_r = CC[((d * 16 + c) * 64 + n) * 2], c_i = CC[((d * 16 + c) * 64 + n) * 2 + 1], b_r = BB[((d * 64 + n) * 16 + cp) * 2], b_i = BB[((d * 64 + n) * 16 + cp) * 2 + 1];
          const float zr = c_r * b_r - c_i * b_i, zi = c_r * b_i + c_i * b_r;
#pragma unroll
          for (int j = 0; j < 16; ++j) acc[j] += zr * AP[((d * 17 + j) * 64 + n) * 2] - zi * AP[((d * 17 + j) * 64 + n) * 2 + 1]; }
#pragma unroll
      for (int j = 0; j < 16; ++j) KL[((d * 16 + j) * 16 + c) * 16 + cp] = acc[j]; }
    __syncthreads();
    for (int e = tid; e < 256 * 64; e += 512) { const int row = e >> 6, k8 = (e & 63) * 8, t = row >> 4, c = row & 15; float v[8];
        if (k8 < 256) { const int s = k8 >> 4, c0 = k8 & 15;
#pragma unroll
            for (int j = 0; j < 8; ++j) { const int cp = c0 + j; float val = 0.f;
                if (s <= t) val += KL[(((t - s)) * 16 + c) * 16 + cp];
                if (s >= t) val += KL[((16 + (s - t)) * 16 + c) * 16 + cp];
                if (s == t && cp == c) val += P.dsk[l * 1024 + g * 16 + c];
                v[j] = val; } }
        else { const int kk = k8 - 256, d = kk >> 7, im = (kk >> 6) & 1, n0 = kk & 63, jp = (d == 0) ? t + 1 : 16 - t;
#pragma unroll
            for (int j = 0; j < 8; ++j) { const int n = n0 + j; const float wr = AP[((d * 17 + jp) * 64 + n) * 2], wi = AP[((d * 17 + jp) * 64 + n) * 2 + 1], c_r = CC[((d * 16 + c) * 64 + n) * 2], c_i = CC[((d * 16 + c) * 64 + n) * 2 + 1];
                v[j] = im ? -(c_r * wi + c_i * wr) : (c_r * wr - c_i * wi); } }
        *(u32x4*)(WYt + ((size_t)g * 256 + row) * 512 + k8) = pack8(v); }
    for (int e = tid; e < 2 * 128 * 32; e += 512) { const int d = e >> 12, row = (e >> 5) & 127, k8 = (e & 31) * 8, im = row >> 6, n = row & 63, s = k8 >> 4, c0 = k8 & 15, ex = (d == 0) ? 15 - s : s; float v[8];
        const float wr = AP[((d * 17 + ex) * 64 + n) * 2], wi = AP[((d * 17 + ex) * 64 + n) * 2 + 1];
#pragma unroll
        for (int j = 0; j < 8; ++j) { const float b_r = BB[((d * 64 + n) * 16 + c0 + j) * 2], b_i = BB[((d * 64 + n) * 16 + c0 + j) * 2 + 1]; v[j] = im ? (wr * b_i + wi * b_r) : (wr * b_r - wi * b_i); }
        *(u32x4*)(WEt + ((size_t)(d * 64 + g) * 128 + row) * 256 + k8) = pack8(v); }
    __syncthreads();
}
__device__ __forceinline__ int s5_chunk_row(int b, int ch) { return ch < 16 ? R_LAT + b * 256 + 16 * ch : b * 4096 + 16 * (ch - 16); }
#define S5_BAR() do { asm volatile("s_waitcnt lgkmcnt(0)" ::: "memory"); __builtin_amdgcn_s_barrier(); asm volatile("" ::: "memory"); } while (0)
__device__ __forceinline__ void s5_main(const S5In& P, int l, const bf16_t* U, const bf16_t* WEt, const bf16_t* WYt, bf16_t* T, LAS unsigned char* lds, int tid) {
    const int lane = tid & 63, w = __builtin_amdgcn_readfirstlane(tid >> 6), fr = lane & 15, q = lane >> 4;
    constexpr int XP = 528;
    LAS unsigned char* XIN = lds; LAS unsigned char* UC = lds + 272 * XP;
    const int uc_chunk = tid >> 5, uc_piece = tid & 31;
    constexpr int UCB = 16 * XP;
    LAS unsigned char* uc_dst0 = UC + uc_chunk * XP + uc_piece * 16;
    const LAS unsigned char* uc_a0 = UC + fr * XP + 16 * q;
#define S5_GLOAD(tile) (*(const u32x4*)(U + (size_t)(s5_chunk_row(b, 16 * (tile) + uc_chunk) + (uc_piece >> 1)) * 1024 + g * 16 + 8 * (uc_piece & 1)))
    const int Gd = (int)gridDim.x, bxi = (int)blockIdx.x, vcu = (Gd % 8 == 0) ? (bxi % 8) * (Gd / 8) + bxi / 8 : bxi;
    for (int item = vcu; item < 512; item += Gd) {
        const int g = item & 63, b = item >> 6;
        {
            bf16x8 bw0[8], bw1[8];
            { const bf16_t* wp = WEt + ((size_t)g * 128 + 16 * w + fr) * 256 + 8 * q;
#pragma unroll
              for (int kk = 0; kk < 8; ++kk) { bw0[kk] = *(const bf16x8*)(wp + 32 * kk); bw1[kk] = *(const bf16x8*)(wp + (size_t)64 * 128 * 256 + 32 * kk); } }
            u32x4 u0 = S5_GLOAD(0), u1 = S5_GLOAD(1), u2 = S5_GLOAD(2), u3 = S5_GLOAD(3), u4 = S5_GLOAD(4);
            *(LAS u32x4*)uc_dst0 = u0; u0 = u1; u1 = u2; u2 = u3; u3 = u4;
            S5_BAR();
            int ucoff = 0;
#pragma unroll 1
            for (int tile = 0; tile < 17; ++tile) {
                const LAS unsigned char* uc_a = uc_a0 + ucoff;
                f32x4 e0 = {0.f, 0.f, 0.f, 0.f}, e1 = {0.f, 0.f, 0.f, 0.f};
#pragma unroll
                for (int kk = 0; kk < 8; ++kk) { const bf16x8 af = *(const LAS bf16x8*)(uc_a + 64 * kk);
                    e0 = __builtin_amdgcn_mfma_f32_16x16x32_bf16(af, bw0[kk], e0, 0, 0, 0); e1 = __builtin_amdgcn_mfma_f32_16x16x32_bf16(af, bw1[kk], e1, 0, 0, 0); }
                asm volatile("s_nop 15\n\ts_nop 7" : "+v"(e0), "+v"(e1));
#pragma unroll
                for (int r = 0; r < 4; ++r) { LAS bf16_t* ep = (LAS bf16_t*)(XIN + (16 * tile + 4 * q + r) * XP) + 16 * w + fr;
                    const unsigned pk = pk2(e0[r], e1[r]); ep[0] = (bf16_t)(pk & 0xffffu); ep[128] = (bf16_t)(pk >> 16); }
                ucoff ^= UCB;
                if (tile < 16) { *(LAS u32x4*)(uc_dst0 + ucoff) = u0; u0 = u1; u1 = u2; u2 = u3; if (tile + 5 <= 16) u3 = S5_GLOAD(tile + 5); }
                S5_BAR();
            }
        }
        if (w < 2) {
            const int d = w;
            float tr, ti, xr = 0.f, xi = 0.f;
            { float cr, ci; s5_abar(P, (l * 2 + d) * 64 + g, lane, tr, ti, cr, ci);
#pragma unroll
              for (int k = 0; k < 4; ++k) { const float n_r = tr * tr - ti * ti, n_i = 2.f * tr * ti; tr = n_r; ti = n_i; } }
#pragma unroll 1
            for (int i = 0; i < 17; ++i) {
                const int tile = (d == 0 || i == 0) ? i : 17 - i;
                float er[16], ei[16];
#pragma unroll
                for (int c = 0; c < 16; ++c) { const LAS bf16_t* ep = (const LAS bf16_t*)(XIN + (16 * tile + c) * XP) + d * 128; er[c] = bf2f(ep[lane]); ei[c] = bf2f(ep[64 + lane]); }
                asm volatile("s_waitcnt lgkmcnt(0)" ::: "memory");
#pragma unroll
                for (int cc = 0; cc < 16; ++cc) { const int c = d ? 15 - cc : cc;
                    LAS bf16_t* xp = (LAS bf16_t*)(XIN + (16 * tile + c) * XP) + d * 128;
                    const unsigned pk = pk2(xr, xi); xp[lane] = (bf16_t)(pk & 0xffffu); xp[64 + lane] = (bf16_t)(pk >> 16);
                    const float nxr = tr * xr - ti * xi + er[c], nxi = tr * xi + ti * xr + ei[c]; xr = nxr; xi = nxi; }
            }
        }
        S5_BAR();
        {
            bf16x8 by[2][16];
#pragma unroll
            for (int nt = 0; nt < 2; ++nt) { const bf16_t* wp = WYt + ((size_t)g * 256 + 32 * w + 16 * nt + fr) * 512 + 8 * q;
#pragma unroll
                for (int kk = 0; kk < 16; ++kk) by[nt][kk] = *(const bf16x8*)(wp + 32 * kk); }
            u32x4 u0 = S5_GLOAD(0), u1 = S5_GLOAD(1), u2 = S5_GLOAD(2), u3 = S5_GLOAD(3), u4 = S5_GLOAD(4);
            *(LAS u32x4*)uc_dst0 = u0; u0 = u1; u1 = u2; u2 = u3; u3 = u4;
            S5_BAR();
            int ucoff = 0;
#pragma unroll 1
            for (int tile = 0; tile < 17; ++tile) {
                const LAS unsigned char* uc_a = uc_a0 + ucoff;
                f32x4 acc0 = {0.f, 0.f, 0.f, 0.f}, acc1 = {0.f, 0.f, 0.f, 0.f};
#pragma unroll
                for (int kk = 0; kk < 8; ++kk) { const bf16x8 af = *(const LAS bf16x8*)(uc_a + 64 * kk);
                    acc0 = __builtin_amdgcn_mfma_f32_16x16x32_bf16(af, by[0][kk], acc0, 0, 0, 0); acc1 = __builtin_amdgcn_mfma_f32_16x16x32_bf16(af, by[1][kk], acc1, 0, 0, 0); }
                const LAS unsigned char* xq = XIN + (16 * tile + fr) * XP + 16 * q;
#pragma unroll
                for (int kk = 0; kk < 8; ++kk) { const bf16x8 xf = *(const LAS bf16x8*)(xq + 64 * kk);
                    acc0 = __builtin_amdgcn_mfma_f32_16x16x32_bf16(xf, by[0][8 + kk], acc0, 0, 0, 0); acc1 = __builtin_amdgcn_mfma_f32_16x16x32_bf16(xf, by[1][8 + kk], acc1, 0, 0, 0); }
                ucoff ^= UCB;
                if (tile < 16) { *(LAS u32x4*)(uc_dst0 + ucoff) = u0; u0 = u1; u1 = u2; u2 = u3; if (tile + 5 <= 16) u3 = S5_GLOAD(tile + 5); }
#pragma unroll
                for (int r = 0; r < 4; ++r) { const int row = s5_chunk_row(b, 16 * tile + 4 * q + r) + 2 * w;
                    T[(size_t)row * 1024 + g * 16 + fr] = (bf16_t)(pk2(gelu_tanh(acc0[r]), 0.f) & 0xffffu);
                    T[(size_t)(row + 1) * 1024 + g * 16 + fr] = (bf16_t)(pk2(gelu_tanh(acc1[r]), 0.f) & 0xffffu); }
                S5_BAR();
            }
        }
    }
#undef S5_GLOAD
#undef S5_BAR
}
__device__ __forceinline__ s16x4 vtr(const LAS unsigned char* p) { return __builtin_bit_cast(s16x4, __builtin_amdgcn_ds_read_tr16_b64_v4i16((LAS s16x4*)p)); }
__device__ __forceinline__ void attn_phase(LAS unsigned char* lds, const bf16_t* Q, const bf16_t* KV, const bf16_t* CQ, bf16_t* O, const int tid, const int nunits) {
    const int lane = tid & 63, wid = __builtin_amdgcn_readfirstlane(tid >> 6), r32 = lane & 31, hi = lane >> 5;
    constexpr int KP = 400, VP = 320, BUFB = 64 * KP + 64 * VP;
    const float C = 0.07216878364870322f * 1.4426950408889634f;
    const int kn_row = tid >> 4, kn_ch = tid & 15, kr_row = tid >> 3, kr_ch = tid & 7;
    const int Gd = (int)gridDim.x, bxi = (int)blockIdx.x, vcu = (Gd % 8 == 0) ? (bxi % 8) * (Gd / 8) + bxi / 8 : bxi;
    for (int ui = 0;; ++ui) {
        const int unit = ui * (int)gridDim.x + vcu; if (unit >= nunits) break;
        int b, h, qb;
        if (unit < 1024) { const int bh = unit >> 4; qb = unit & 15; b = bh >> 3; h = bh & 7; } else { const int bh = unit - 1024; qb = 16; b = bh >> 3; h = bh & 7; }
        const int qrow0 = (qb < 16) ? b * 4096 + qb * 256 : R_LAT + b * 256;
        const int NT = (qb < 16) ? 68 : 4;
        const bf16_t* qp = Q + (size_t)(qrow0 + wid * 32 + r32) * 1536;
        bf16x8 qf[12];
#pragma unroll
        for (int s = 0; s < 8; ++s) qf[s] = *(const bf16x8*)(qp + h * 128 + 16 * s + 8 * hi);
#pragma unroll
        for (int s = 0; s < 4; ++s) qf[8 + s] = *(const bf16x8*)(qp + 1024 + h * 64 + 16 * s + 8 * hi);
        u32x4 sk0, sk1, skr, sv0, sv1;
#define ATT_KROW(t) ((qb < 16) ? (((t) < 64) ? b * 4096 + (t) * 64 : R_LAT + b * 256 + ((t) - 64) * 64) : R_LAT + b * 256 + (t) * 64)
#define ATT_LOAD(t) do { const int kr0_ = ATT_KROW(t); const bf16_t* kvp_ = KV + (size_t)(kr0_ + kn_row) * 2048 + h * 256 + kn_ch * 8; \
        sk0 = *(const u32x4*)kvp_; sk1 = *(const u32x4*)(kvp_ + 32 * 2048); sv0 = *(const u32x4*)(kvp_ + 128); sv1 = *(const u32x4*)(kvp_ + 128 + 32 * 2048); \
        skr = *(const u32x4*)(CQ + (size_t)(kr0_ + kr_row) * 768 + 512 + kr_ch * 8); } while (0)
#define ATT_STORE(buf) do { LAS unsigned char* kb_ = lds + (buf) * BUFB; LAS unsigned char* vb_ = kb_ + 64 * KP; \
        *(LAS u32x4*)(kb_ + kn_row * KP + kn_ch * 16) = sk0; *(LAS u32x4*)(kb_ + (kn_row + 32) * KP + kn_ch * 16) = sk1; *(LAS u32x4*)(kb_ + kr_row * KP + 256 + kr_ch * 16) = skr; \
        *(LAS u32x4*)(vb_ + kn_row * VP + kn_ch * 16) = sv0; *(LAS u32x4*)(vb_ + (kn_row + 32) * VP + kn_ch * 16) = sv1; } while (0)
        ATT_LOAD(0); ATT_STORE(0);
        __syncthreads();
        float mrun = -1e30f, lrun = 0.f;
        f32x16 o[4];
#pragma unroll
        for (int d = 0; d < 4; ++d)
#pragma unroll
            for (int r = 0; r < 16; ++r) o[d][r] = 0.f;
        for (int t = 0; t < NT; ++t) {
            const int cur = t & 1;
            if (t + 1 < NT) ATT_LOAD(t + 1);
            f32x16 p0, p1;
#pragma unroll
            for (int r = 0; r < 16; ++r) { p0[r] = 0.f; p1[r] = 0.f; }
            __builtin_amdgcn_s_setprio(1);
            { const LAS unsigned char* kb = lds + cur * BUFB + r32 * KP + hi * 16;
#pragma unroll
              for (int g3 = 0; g3 < 3; ++g3) { bf16x8 k0[4], k1[4];
#pragma unroll
                  for (int j = 0; j < 4; ++j) { k0[j] = *(const LAS bf16x8*)(kb + (4 * g3 + j) * 32); k1[j] = *(const LAS bf16x8*)(kb + 32 * KP + (4 * g3 + j) * 32); }
                  __builtin_amdgcn_sched_barrier(0);
#pragma unroll
                  for (int j = 0; j < 4; ++j) { p0 = __builtin_amdgcn_mfma_f32_32x32x16_bf16(k0[j], qf[4 * g3 + j], p0, 0, 0, 0); p1 = __builtin_amdgcn_mfma_f32_32x32x16_bf16(k1[j], qf[4 * g3 + j], p1, 0, 0, 0); }
                  __builtin_amdgcn_sched_barrier(0); } }
            __builtin_amdgcn_s_setprio(0);
            float mx = p0[0];
#pragma unroll
            for (int r = 0; r < 16; ++r) { mx = fmaxf(mx, p0[r]); mx = fmaxf(mx, p1[r]); }
            mx = fmaxf(mx, __shfl_xor(mx, 32)) * C;
            if (__any(mx > mrun + 8.0f)) {
                const float mn = fmaxf(mrun, mx), alpha = __builtin_amdgcn_exp2f(mrun - mn); mrun = mn; lrun *= alpha;
#pragma unroll
                for (int d = 0; d < 4; ++d)
#pragma unroll
                    for (int r = 0; r < 16; ++r) o[d][r] *= alpha;
            }
            float rsum = 0.f;
#pragma unroll
            for (int r = 0; r < 16; ++r) { p0[r] = __builtin_amdgcn_exp2f(p0[r] * C - mrun); p1[r] = __builtin_amdgcn_exp2f(p1[r] * C - mrun); rsum += p0[r] + p1[r]; }
            lrun += rsum;
            bf16x8 pf[4];
            { u32x4 w;
              w.x = pk2(p0[0], p0[1]); w.y = pk2(p0[2], p0[3]); w.z = pk2(p0[4], p0[5]); w.w = pk2(p0[6], p0[7]); pf[0] = __builtin_bit_cast(bf16x8, w);
              w.x = pk2(p0[8], p0[9]); w.y = pk2(p0[10], p0[11]); w.z = pk2(p0[12], p0[13]); w.w = pk2(p0[14], p0[15]); pf[1] = __builtin_bit_cast(bf16x8, w);
              w.x = pk2(p1[0], p1[1]); w.y = pk2(p1[2], p1[3]); w.z = pk2(p1[4], p1[5]); w.w = pk2(p1[6], p1[7]); pf[2] = __builtin_bit_cast(bf16x8, w);
              w.x = pk2(p1[8], p1[9]); w.y = pk2(p1[10], p1[11]); w.z = pk2(p1[12], p1[13]); w.w = pk2(p1[14], p1[15]); pf[3] = __builtin_bit_cast(bf16x8, w); }
            __builtin_amdgcn_s_setprio(1);
            { const LAS unsigned char* vb = lds + cur * BUFB + 64 * KP + (4 * hi + ((lane & 15) >> 2)) * VP + (16 * ((lane >> 4) & 1) + 4 * (lane & 3)) * 2;
#pragma unroll
              for (int s2 = 0; s2 < 2; ++s2) { s16x4 lo[8], hh[8];
#pragma unroll
                  for (int i = 0; i < 8; ++i) { const int s = 2 * s2 + (i >> 2), d = i & 3; lo[i] = vtr(vb + s * 16 * VP + d * 64); hh[i] = vtr(vb + s * 16 * VP + 8 * VP + d * 64); }
                  __builtin_amdgcn_sched_barrier(0);
#pragma unroll
                  for (int i = 0; i < 8; ++i) { const int s = 2 * s2 + (i >> 2), d = i & 3;
                      const bf16x8 vf = (bf16x8){lo[i][0], lo[i][1], lo[i][2], lo[i][3], hh[i][0], hh[i][1], hh[i][2], hh[i][3]};
                      o[d] = __builtin_amdgcn_mfma_f32_32x32x16_bf16(vf, pf[s], o[d], 0, 0, 0); }
                  __builtin_amdgcn_sched_barrier(0); } }
            __builtin_amdgcn_s_setprio(0);
            if (t + 1 < NT) ATT_STORE(cur ^ 1);
            __syncthreads();
        }
        const float inv = 1.0f / (lrun + __shfl_xor(lrun, 32));
        bf16_t* op = O + (size_t)(qrow0 + wid * 32 + r32) * 1024 + h * 128;
#pragma unroll
        for (int d = 0; d < 4; ++d)
#pragma unroll
            for (int i4 = 0; i4 < 4; ++i4) { u32x2 w; w.x = pk2(o[d][4 * i4] * inv, o[d][4 * i4 + 1] * inv); w.y = pk2(o[d][4 * i4 + 2] * inv, o[d][4 * i4 + 3] * inv);
                *(u32x2*)(op + 32 * d + 8 * i4 + 4 * hi) = w; }
    }
#undef ATT_KROW
#undef ATT_LOAD
#undef ATT_STORE
}
#define XB_TMO      128
#define XB_XCNT(j)  (256  + 64 * (j))
#define XB_XSUB(j)  (1280 + 64 * (j))
#define XB_XGEN(j)  (2304 + 64 * (j))
#define XB_TOP      3328
#define XB_TOPGEN   3392
#define XCD_BAR_WORDS 3456
#define XB_SPIN_CAP (1u << 18)

__device__ __forceinline__ unsigned xb_ld(unsigned* p)              { return __hip_atomic_load(p, __ATOMIC_RELAXED, __HIP_MEMORY_SCOPE_AGENT); }
__device__ __forceinline__ unsigned xb_add(unsigned* p, unsigned v) { return __hip_atomic_fetch_add(p, v, __ATOMIC_RELAXED, __HIP_MEMORY_SCOPE_AGENT); }
__device__ __forceinline__ unsigned xb_xcc_id() { return (unsigned)__builtin_amdgcn_s_getreg((3 << 11) | 20) & 0xFu; }
#define XB_SPIN(cond, bar) do { unsigned _sp = 0; while (cond) { __builtin_amdgcn_s_sleep(1); \
    if ((++_sp & 255u) == 0u) { if (xb_ld(&(bar)[XB_TMO])) break; if (_sp > XB_SPIN_CAP) { atomicAdd(&(bar)[XB_TMO], 1u); break; } } } } while (0)

struct XcdBarrier {
    unsigned* bar; unsigned x;
    volatile LAS unsigned* st;
};

__device__ __forceinline__ XcdBarrier xcd_barrier_post(unsigned* bar, volatile LAS unsigned* st) {
    XcdBarrier b; b.bar = bar; b.x = xb_xcc_id(); b.st = st;
    if (threadIdx.x == 0) (void)xb_add(&bar[XB_XCNT(b.x)], 1u);
    return b;
}
__device__ __forceinline__ void xcd_barrier_complete(unsigned* bar, unsigned x, unsigned& nloc, unsigned& nx) {
    const unsigned G = gridDim.x * gridDim.y * gridDim.z;
    unsigned sum, cnt, mine, sp = 0u;
    for (;;) {
        sum = 0u; cnt = 0u; mine = 0u;
#pragma unroll
        for (unsigned j = 0; j < 16; ++j) { const unsigned c = xb_ld(&bar[XB_XCNT(j)]); sum += c; cnt += (c > 0u) ? 1u : 0u; mine = (j == x) ? c : mine; }
        if (sum == G) break;
        __builtin_amdgcn_s_sleep(1);
        if ((++sp & 255u) == 0u) { if (xb_ld(&bar[XB_TMO])) break; if (sp > XB_SPIN_CAP) { atomicAdd(&bar[XB_TMO], 1u); break; } }
    }
    nloc = mine > 0u ? mine : 1u; nx = cnt > 0u ? cnt : 1u;
}

__device__ __forceinline__ void xcd_barrier(const XcdBarrier& b) {
    asm volatile("s_waitcnt vmcnt(0)" ::: "memory");
    __syncthreads();
    if (threadIdx.x == 0) {
        unsigned* bar = b.bar;
        __builtin_amdgcn_s_waitcnt(0);
        unsigned nloc = b.st[0], nx = b.st[1];
        if (nloc == 0u) { xcd_barrier_complete(bar, b.x, nloc, nx); b.st[0] = nloc; b.st[1] = nx; }
        const unsigned old = xb_add(&bar[XB_XSUB(b.x)], 1u);
        const unsigned gen = old / nloc;
        if (old + 1u == (gen + 1u) * nloc) {
            __builtin_amdgcn_fence(__ATOMIC_RELEASE, "agent");
            asm volatile("s_waitcnt vmcnt(0)" ::: "memory");
            const unsigned og = xb_add(&bar[XB_TOP], 1u);
            const unsigned tg = og / nx;
            if (og + 1u == (tg + 1u) * nx) xb_add(&bar[XB_TOPGEN], 1u);
            else XB_SPIN(xb_ld(&bar[XB_TOPGEN]) == tg, bar);
            __builtin_amdgcn_fence(__ATOMIC_ACQUIRE, "agent");
            xb_add(&bar[XB_XGEN(b.x)], 1u);
            asm volatile("s_waitcnt vmcnt(0)" ::: "memory");
        } else {
            XB_SPIN(xb_ld(&bar[XB_XGEN(b.x)]) == gen, bar);
            __builtin_amdgcn_fence(__ATOMIC_ACQUIRE, "agent");
            asm volatile("s_waitcnt vmcnt(0)" ::: "memory");
        }
    }
    __syncthreads();
}

#define DERIVE_PTRS float* MOD = (float*)(ws + WS_MOD); float* ROPE = (float*)(ws + WS_ROPE); float* YSS = (float*)(ws + WS_YSS); float* CSS = (float*)(ws + WS_CSS); bf16_t* WEt = (bf16_t*)(ws + WS_S5E); bf16_t* WYt = (bf16_t*)(ws + WS_S5E + S5_WE_BYTES); float* XC = (float*)(ws + WS_XC); bf16_t* WL = (bf16_t*)(ws + WS_WL); bf16_t* H = (bf16_t*)(ws + WS_H); unsigned char* big = ws + WS_BIG; bf16_t* CQ = (bf16_t*)(big + B_CQ); bf16_t* U = (bf16_t*)(big + B_U); bf16_t* Qb = (bf16_t*)(big + B_Q); bf16_t* KVb = (bf16_t*)(big + B_KV); bf16_t* SG = (bf16_t*)(big + B_SG); bf16_t* ACT = (bf16_t*)(big + B_ACT); bf16_t* Y = (bf16_t*)(big + B_Y); bf16_t* T = (bf16_t*)(big + B_T); bf16_t* Gb = (bf16_t*)(big + B_G); bf16_t* Mb = (bf16_t*)(big + B_M); bf16_t* Ob = H;
constexpr int PPL = 13;
constexpr int NSTEPS = 2 + PPL * DEPTH;
struct Args { const float* in[29]; float* out; unsigned char* ws; int ph_lo, ph_hi; };
__global__ void __launch_bounds__(512, 2) mk_fwd(Args a) {
    extern __shared__ __attribute__((aligned(16))) unsigned char lds_raw[];
    cg::grid_group grid = cg::this_grid();
    LAS unsigned char* lds = (LAS unsigned char*)lds_raw;
    const int G = gridDim.x, NGW = G * 8;
    volatile LAS unsigned* xst = (volatile LAS unsigned*)(lds + LDS_BYTES - 64);
    if (threadIdx.x < 2) xst[threadIdx.x] = 0u;
    __syncthreads();
    XcdBarrier xbar; xbar.bar = (unsigned*)(a.ws + WS_CTL); xbar.x = 0; xbar.st = xst;
    if (a.ph_hi - a.ph_lo > 1) xbar = xcd_barrier_post((unsigned*)(a.ws + WS_CTL), xst);
    WPtrs WP{a.in[8], a.in[9], a.in[10], a.in[11], a.in[12], a.in[13], a.in[14], a.in[15], a.in[16], a.in[25], a.in[27], a.in[28]};
    S5In SP{a.in[17], a.in[18], a.in[19], a.in[20], a.in[21], a.in[22], a.in[23], a.in[24]};
#if MK_TIME >= 0
    unsigned long long tacc = 0ull;
#endif
#pragma unroll 1
    for (int step = a.ph_lo; step < a.ph_hi; ++step) {
#if MK_TIME >= 0
        const unsigned long long tph0 = __builtin_amdgcn_s_memrealtime();
#endif
        int tid = threadIdx.x; asm volatile("" : "+v"(tid));
        const int lane = tid & 63, wave = __builtin_amdgcn_readfirstlane(tid >> 6), gw = blockIdx.x * 8 + wave;
        unsigned char* ws = a.ws; asm volatile("" : "+s"(ws));
        DERIVE_PTRS
        int l = 0, p = -1;
        if (step >= 2) { l = (step - 2) / PPL; p = (step - 2) % PPL; if (p >= 6) ++p; }
        if (step == 0) mods_phase(a.in[1], a.in[3], a.in[4], a.in[5], MOD, ROPE, lds, tid);
        if (step == 0) conv_layer(WP, 0, WL, lds, gw, NGW, wave, lane, 0, 12864);
#if MK_PROBE == 9
        if (step == 0) { __syncthreads(); mods_phase(a.in[1], a.in[3], a.in[4], a.in[5], MOD, ROPE, lds, tid); conv_layer(WP, 0, WL, lds, gw, NGW, wave, lane, 0, 12864); }
#endif
        if (p == 13 && l < DEPTH - 1) conv_layer(WP, l + 1, WL, lds, gw, NGW, wave, lane, 7040, 8448);
        if (step == 1 || p == 2 || p == 10 || p == 13) {
            int s, nl, ns;
            if (step == 1) { s = -1; nl = 0; ns = 0; } else if (p == 2) { s = 0; nl = l; ns = 1; } else if (p == 10) { s = 1; nl = l; ns = 2; } else { s = 2; nl = (l < DEPTH - 1) ? l + 1 : -1; ns = 0; }
            e_phase(a.in[0], a.in[2], a.out, XC, Y, YSS, MOD, a.in[6], a.in[7], H, l, s, nl, ns, gw, NGW, lane, 1.0f, (l == DEPTH - 1 && p >= 10) ? R_LAT : R);
#if MK_PROBE == 5
            if (s >= 0) { __syncthreads(); e_phase(a.in[0], a.in[2], a.out, XC, Y, YSS, MOD, a.in[6], a.in[7], H, l, s, nl, ns, gw, NGW, lane, 0.0f, R); }
#endif
        }
        if (p == 0 || p == 1 || p == 3 || p == 4 || p == 7 || p == 8 || p == 9 || p == 11 || p == 12) {
            const int ng = (p == 4 || p == 7) ? 2 : 1;
#pragma unroll 1
            for (int gi = 0; gi < ng; ++gi) {
                pg8::Gemm g; Epi E; E.o0 = nullptr; E.o1 = nullptr; E.o2 = nullptr; E.i0 = nullptr; E.i1 = nullptr; E.ss = nullptr; E.css = CSS; E.bias = nullptr; E.rope = ROPE; E.mode = 0;
                g.M = R;
                if (p == 0 || p == 11) { g.A = H; g.Bt = WL + (p == 0 ? W_GUA : W_GUB); g.N = 5632; g.K = 1024; g.lda = 1024; E.mode = 0; E.o0 = ACT; }
                else if (p == 1 || p == 12) { g.A = ACT; g.Bt = WL + (p == 1 ? W_DA : W_DB); g.N = 1024; g.K = FF; g.lda = FF; E.mode = 1; E.o0 = Y; E.ss = YSS; }
                else if (p == 3) { g.A = H; g.Bt = WL + W_IN; g.N = 3840; g.K = 1024; g.lda = 1024; E.mode = 2; E.o0 = CQ; E.o1 = U; E.o2 = SG; E.ss = CSS; }
                else if (p == 4 && gi == 0) { g.A = CQ; g.Bt = WL + W_UQ; g.N = 1536; g.K = 256; g.lda = 768; E.mode = 3; E.o0 = Qb; }
                else if (p == 4) { g.A = CQ + 256; g.Bt = WL + W_UKV; g.N = 2048; g.K = 256; g.lda = 768; E.mode = 4; E.o0 = KVb; }
                else if (p == 7 && gi == 0) { g.A = T; g.Bt = WL + W_GLU; g.N = 1024; g.K = 1024; g.lda = 1024; E.mode = 5; E.o0 = Gb; E.i0 = T; E.bias = a.in[26] + l * 1024; }
                else if (p == 7) { g.A = Ob; g.Bt = WL + W_OMLA; g.N = 1024; g.K = 1024; g.lda = 1024; E.mode = 6; E.o0 = Mb; E.i0 = SG; }
                else if (p == 8) { g.A = Gb; g.Bt = WL + W_OS5; g.N = 1024; g.K = 1024; g.lda = 1024; E.mode = 7; E.o0 = Mb; E.i0 = Mb; E.i1 = SG + 1024; }
                else { g.A = Mb; g.Bt = WL + W_OUT; g.N = 1024; g.K = 1024; g.lda = 1024; E.mode = 1; E.o0 = Y; E.ss = YSS; }
                const int Mrows = (l == DEPTH - 1 && (p >= 7 || (p == 4 && gi == 0))) ? R_LAT : R;
                pg8::StaticOrder S; S.init(Mrows, g.N, G, (gi == 0) ? (int)blockIdx.x : (int)((blockIdx.x + (G >> 1)) % G));
                pg8::gemm_phase<Epi, pg8::StaticOrder, true, true>(lds, g, S, E, tid);
#if MK_PROBE == 3 || MK_PROBE == 6 || MK_PROBE == 7 || MK_PROBE == 8 || MK_PROBE == 10
                if ((MK_PROBE == 3 && (p == 0 || p == 11)) || (MK_PROBE == 6 && p == 9) || (MK_PROBE == 7 && (p == 1 || p == 12)) || (MK_PROBE == 8 && p == 4) || (MK_PROBE == 10 && p == 3)) { __syncthreads(); pg8::gemm_phase<Epi, pg8::StaticOrder, true, true>(lds, g, S, E, tid); }
#endif
            }
        }
        if (p == 4) {
#pragma unroll 1
            for (int rep = 0; rep < (MK_PROBE == 2 ? 2 : 1); ++rep) s5_main(SP, l, U, WEt, WYt, T, lds, tid); }
        if (G == 256) {
            const int bx = blockIdx.x;
            if (p == 1 && bx >= 32 && bx < 96) s5_prep(SP, l, bx - 32, WEt, WYt, lds, tid);
            if (l < DEPTH - 1 && bx >= 32) {
                const int vgw = (bx - 32) * 8 + wave, VNGW = 224 * 8;
                if (p == 7 && (bx < 128 || bx >= 160)) { const int v7 = ((bx < 128) ? bx - 32 : bx - 64) * 8 + wave;
                    conv_layer(WP, l + 1, WL, lds, v7, 192 * 8, wave, lane, 0, 2816); conv_layer(WP, l + 1, WL, lds, v7, 192 * 8, wave, lane, 5632, 7040); }
                if (p == 8) { conv_layer(WP, l + 1, WL, lds, vgw, VNGW, wave, lane, 8448, 11840); }
                if (p == 9) { conv_layer(WP, l + 1, WL, lds, vgw, VNGW, wave, lane, 11840, 12352); }
                if (p == 12) { conv_layer(WP, l + 1, WL, lds, vgw, VNGW, wave, lane, 12352, 12864); conv_layer(WP, l + 1, WL, lds, vgw, VNGW, wave, lane, 2816, 5632); }
            }
        }
        if (G != 256) {
            if (p == 2 && blockIdx.x < 64) s5_prep(SP, l, blockIdx.x, WEt, WYt, lds, tid);
            if (p == 13 && l < DEPTH - 1) { conv_layer(WP, l + 1, WL, lds, gw, NGW, wave, lane, 0, 7040); conv_layer(WP, l + 1, WL, lds, gw, NGW, wave, lane, 8448, 12864); }
        }
        if (p == 5) {
#pragma unroll 1
            for (int rep = 0; rep < (MK_PROBE == 1 ? 2 : 1); ++rep) attn_phase(lds, Qb, KVb, CQ, Ob, tid, (l == DEPTH - 1) ? 1024 : 1024 + 64); }
#if MK_TIME >= 0
        const unsigned long long tb0 = __builtin_amdgcn_s_memrealtime();
#endif
        if (step + 1 < a.ph_hi) {
            if (step == a.ph_lo) grid.sync(); else xcd_barrier(xbar);
#if MK_PROBE == 4
            xcd_barrier(xbar); xcd_barrier(xbar);
#endif
        }
#if MK_TIME >= 0
        { const unsigned long long tb1 = __builtin_amdgcn_s_memrealtime();
          const int cls = (step == 0) ? 10 : (step == 1 || p == 2 || p == 10 || p == 13) ? 2 : (p == 0 || p == 11) ? 0 : (p == 1 || p == 12) ? 1 : (p == 3) ? 3 : (p == 4) ? 4 : (p == 5) ? 5 : (p == 7) ? 6 : (p == 8) ? 7 : 8;
          if (MK_TIME == 99) tacc += tb1 - tb0; else if (cls == MK_TIME) tacc += tb1 - tph0; }
#endif
    }
#if MK_TIME >= 0
    if (blockIdx.x == MK_TIME_BLOCK) { const unsigned long long te = __builtin_amdgcn_s_memrealtime(); while (__builtin_amdgcn_s_memrealtime() - te < tacc) __builtin_amdgcn_s_sleep(16); }
#endif
}

extern "C" void kernel_launch(void* const* d_in, const int* in_sizes, int n_in, void* d_out, int out_size, void* d_ws, size_t ws_size, hipStream_t stream) {
    static int grid = 0;
    if (grid == 0) {
        if (n_in != 29 || out_size != R_LAT * DM || ws_size < WS_END) { fprintf(stderr, "kernel_launch: unexpected problem (n_in %d out %d ws %zu need %zu)\n", n_in, out_size, ws_size, (size_t)WS_END); grid = -1; return; }
        int dev = 0, cus = 0, per_cu = 0;
        if (hipGetDevice(&dev) != hipSuccess || hipDeviceGetAttribute(&cus, hipDeviceAttributeMultiprocessorCount, dev) != hipSuccess) { grid = -1; return; }
        if (hipFuncSetAttribute((const void*)mk_fwd, hipFuncAttributeMaxDynamicSharedMemorySize, LDS_BYTES) != hipSuccess) { fprintf(stderr, "kernel_launch: hipFuncSetAttribute failed\n"); grid = -1; return; }
        if (hipOccupancyMaxActiveBlocksPerMultiprocessor(&per_cu, (const void*)mk_fwd, 512, LDS_BYTES) != hipSuccess || per_cu < 1) { fprintf(stderr, "kernel_launch: occupancy query says %d\n", per_cu); per_cu = 1; }
        (void)hipGetLastError();
        grid = cus * 1;
    }
    if (grid < 0) return;
    if (hipMemsetAsync((char*)d_ws + WS_CTL, 0, CTL_BYTES, stream) != hipSuccess) { fprintf(stderr, "kernel_launch: memset failed\n"); return; }
    Args a{};
    for (int i = 0; i < 29; ++i) a.in[i] = (const float*)d_in[i];
    a.out = (float*)d_out; a.ws = (unsigned char*)d_ws;
#if MK_MULTI
    for (int s = 0; s < NSTEPS; ++s) { a.ph_lo = s; a.ph_hi = s + 1; void* args[] = {&a};
        hipError_t e = hipLaunchCooperativeKernel((const void*)mk_fwd, dim3(grid), dim3(512), args, LDS_BYTES, stream);
        if (e != hipSuccess) { fprintf(stderr, "cooperative launch %d failed: %s\n", s, hipGetErrorString(e)); break; } }
#else
    a.ph_lo = 0; a.ph_hi = NSTEPS; void* args[] = {&a};
    hipError_t e = hipLaunchCooperativeKernel((const void*)mk_fwd, dim3(grid), dim3(512), args, LDS_BYTES, stream);
    if (e != hipSuccess) fprintf(stderr, "cooperative launch failed: %s (grid %d)\n", hipGetErrorString(e), grid);
#endif
}
```

```cpp
#include <hip/hip_runtime.h>
#include <hip/hip_cooperative_groups.h>
#include <cstdio>
#include <cstdint>
namespace cg = cooperative_groups;
#ifndef MK_MULTI
#define MK_MULTI 0
#endif
#ifndef MK_PROBE
#define MK_PROBE 0
#endif
#ifndef MK_TIME
#define MK_TIME -1
#endif
#ifndef MK_TIME_BLOCK
#define MK_TIME_BLOCK 128
#endif
namespace pg8 {
#define PG8_LAS __attribute__((address_space(3)))
typedef unsigned short bf16_t;
typedef short bf16x8 __attribute__((ext_vector_type(8)));
typedef float f32x4 __attribute__((ext_vector_type(4)));
typedef unsigned u32x4 __attribute__((ext_vector_type(4)));
constexpr int BM = 256, BK = 64, HALF = 128, HTB = HALF * BK * 2  , STAGE_BYTES = 8 * HTB, NXCD = 8, WGM = 8;

__host__ __device__ __forceinline__ int lds_byte(int r, int c) { const int st = (r >> 4) * 2 + (c >> 5), rr = r & 15, cc = c & 31, ob = rr * 64 + cc * 2; return st * 1024 + (ob ^ (((ob >> 9) & 1) << 5)); }
__host__ __device__ __forceinline__ void stage_rc(int b, int& R, int& C) { const int st = b / 1024, sb = b % 1024, swz = sb ^ (((sb >> 9) & 1) << 5); R = (st >> 1) * 16 + swz / 64; C = (st & 1) * 32 + (swz % 64) / 2; }
__host__ __device__ __forceinline__ int perm32(int rho) { const int n = rho >> 4, i = rho & 15; return 8 * (i >> 2) + 4 * n + (i & 3); }

struct Unit { int pm, pn; };
struct Gemm { const bf16_t* A; const bf16_t* Bt; int M, N, K, lda; };

struct StaticOrder {
    int nM, nN, nwg, G, c;
    __host__ __device__ void init(int M, int N, int G_, int c_) { nM = M / BM; nN = N / BM; nwg = nM * nN; G = G_; c = c_; }
    __host__ __device__ bool next(int i, Unit& u) const {
        const long L = (long)i * G + c; if (L >= nwg) return false;
        int wgid = (int)L; { const int q = nwg / NXCD, r = nwg % NXCD, xcd = wgid % NXCD, off = wgid / NXCD; wgid = (xcd < r ? xcd * (q + 1) : r * (q + 1) + (xcd - r) * q) + off; }
        const int nig = WGM * nN, gid = wgid / nig, fm = gid * WGM, gsz = (nM - fm) < WGM ? (nM - fm) : WGM;
        u.pm = fm + ((wgid % nig) % gsz); u.pn = (wgid % nig) / gsz; return true;
    }
    __device__ __forceinline__ void a_ready(const Unit&) const {}
    __device__ __forceinline__ void done(const Unit&) const {}
};

__device__ __forceinline__ unsigned cvt_pk_bf16(float lo, float hi) { unsigned r; asm volatile("v_cvt_pk_bf16_f32 %0, %1, %2" : "=v"(r) : "v"(lo), "v"(hi)); return r; }
template <class Epi, class Sched, bool ALIGN_EPI = false, bool SP2 = false>
__device__ __forceinline__ void gemm_phase(PG8_LAS unsigned char* lds, const Gemm g, const Sched& S, const Epi& E, const int tid) {
    const int wid = __builtin_amdgcn_readfirstlane(tid >> 6), lane = tid & 63, wr = wid >> 2, wc = wid & 3, fr = lane & 15, fq = lane >> 4;
    const int K = g.K, nt = K / BK;
    unsigned voffA[2], voffB[2];
#pragma unroll
    for (int i = 0; i < 2; ++i) { int R, C; stage_rc(tid * 16 + i * 8192, R, C); const int Rb = Epi::PERM ? ((R & ~31) + perm32(R & 31)) : R;
        voffA[i] = (unsigned)(R * g.lda + C) * 2u; voffB[i] = (unsigned)(Rb * K + C) * 2u; }
    const size_t kstep = (size_t)(BK * 2);
    const size_t hstep = (size_t)HALF * K * 2;
    const size_t tstep = 2 * hstep; const size_t hstepA = (size_t)HALF * g.lda * 2, tstepA = 2 * hstepA;
    const unsigned ldsw = (unsigned)wid * 1024u;
    const int aoff = lds_byte(wr * 64 + fr, fq * 8), boff = lds_byte(wc * 32 + fr, fq * 8);
#define PG8_SA(b, h) (((b) * 2 + (h)) * HTB)
#define PG8_SB(b, h) ((4 + (b) * 2 + (h)) * HTB)
#define PG8_STAGE(bufoff, gbase, voff) do { _Pragma("unroll") for (int _i = 0; _i < 2; ++_i) \
        __builtin_amdgcn_global_load_lds((const unsigned*)((const char*)(gbase) + (voff)[_i]), (PG8_LAS unsigned*)(lds + (bufoff) + ldsw + _i * 8192), 16, 0, 0); } while (0)
#define PG8_LDA(dst, b, h) do { _Pragma("unroll") for (int m = 0; m < 4; ++m) _Pragma("unroll") for (int k = 0; k < 2; ++k) dst[m][k] = *(const PG8_LAS bf16x8*)(lds + PG8_SA(b, h) + aoff + m * 2048 + k * 1024); } while (0)
#define PG8_LDB(dst, b, h) do { _Pragma("unroll") for (int n = 0; n < 2; ++n) _Pragma("unroll") for (int k = 0; k < 2; ++k) dst[n][k] = *(const PG8_LAS bf16x8*)(lds + PG8_SB(b, h) + boff + n * 2048 + k * 1024); } while (0)
#define PG8_MMA(ai, bj, At, Bt) do { __builtin_amdgcn_s_setprio(1); _Pragma("unroll") for (int m = 0; m < 4; ++m) _Pragma("unroll") for (int n = 0; n < 2; ++n) _Pragma("unroll") for (int k = 0; k < 2; ++k) \
        acc[ai][bj][m][n] = __builtin_amdgcn_mfma_f32_16x16x32_bf16(Bt[n][k], At[m][k], acc[ai][bj][m][n], 0, 0, 0); __builtin_amdgcn_s_setprio(0); } while (0)
#define PG8_WAIT_V(n) asm volatile("s_waitcnt vmcnt(" #n ")" ::: "memory")
#define PG8_WAIT_L(n) asm volatile("s_waitcnt lgkmcnt(" #n ")" ::: "memory")
#define PG8_BAR __builtin_amdgcn_s_barrier()
#define PG8_SCHED __builtin_amdgcn_sched_barrier(0)
    Unit cur, nxt; int ui = 0;
    if (!S.next(0, cur)) return;
    f32x4 acc[2][2][4][2];
#pragma unroll
    for (int a = 0; a < 2; ++a)
#pragma unroll
        for (int b = 0; b < 2; ++b)
#pragma unroll
            for (int m = 0; m < 4; ++m)
#pragma unroll
                for (int n = 0; n < 2; ++n) acc[a][b][m][n] = (f32x4){0.f, 0.f, 0.f, 0.f};
    bf16x8 At[4][2], B0[2][2], B1[2][2];
    const char* cA = (const char*)g.A + (size_t)cur.pm * tstepA; const char* cB = (const char*)g.Bt + (size_t)cur.pn * tstep;
    S.a_ready(cur);
    if constexpr (SP2) {
        PG8_STAGE(PG8_SB(0, 0), cB, voffB); PG8_STAGE(PG8_SB(0, 1), cB + hstep, voffB); PG8_STAGE(PG8_SA(0, 0), cA, voffA); PG8_STAGE(PG8_SA(0, 1), cA + hstepA, voffA);
        if (wr == 1) PG8_BAR;
        PG8_WAIT_V(2); PG8_BAR;
        PG8_STAGE(PG8_SB(1, 0), cB + kstep, voffB); PG8_STAGE(PG8_SA(1, 0), cA + kstep, voffA); PG8_STAGE(PG8_SB(1, 1), cB + hstep + kstep, voffB);
        PG8_WAIT_V(6); PG8_BAR;
    } else {
        PG8_STAGE(PG8_SB(0, 0), cB, voffB); PG8_STAGE(PG8_SA(0, 0), cA, voffA); PG8_STAGE(PG8_SB(0, 1), cB + hstep, voffB); PG8_STAGE(PG8_SA(0, 1), cA + hstepA, voffA);
        if (wr == 1) PG8_BAR;
        PG8_WAIT_V(4); PG8_BAR;
        PG8_STAGE(PG8_SB(1, 0), cB + kstep, voffB); PG8_STAGE(PG8_SA(1, 0), cA + kstep, voffA); PG8_STAGE(PG8_SB(1, 1), cB + hstep + kstep, voffB);
        PG8_WAIT_V(6); PG8_BAR;
    }
    for (;;) {
        const bool has_next = S.next(ui + 1, nxt);
        const char* nA = has_next ? (const char*)g.A + (size_t)nxt.pm * tstepA : cA; const char* nB = has_next ? (const char*)g.Bt + (size_t)nxt.pn * tstep : cB;
        for (int t = 0; t < nt; t += 2) {
            const bool last = (t == nt - 2);
            const char* a1 = cA + (size_t)(t + 1) * kstep;
            const char* a2 = last ? nA : cA + (size_t)(t + 2) * kstep; const char* b2 = last ? nB : cB + (size_t)(t + 2) * kstep;
            const char* a3 = a2 + kstep; const char* b3 = b2 + kstep;
            if (last && has_next) S.a_ready(nxt);
            if constexpr (SP2) {
            PG8_LDB(B0, 0, 0); PG8_LDB(B1, 0, 1); PG8_SCHED; PG8_LDA(At, 0, 0); PG8_STAGE(PG8_SA(1, 1), a1 + hstepA, voffA);
            PG8_WAIT_V(8); PG8_WAIT_L(0); PG8_BAR; PG8_MMA(0, 0, At, B0); PG8_MMA(0, 1, At, B1); PG8_BAR; PG8_SCHED;
            PG8_LDA(At, 0, 1); PG8_STAGE(PG8_SB(0, 0), b2, voffB); PG8_STAGE(PG8_SB(0, 1), b2 + hstep, voffB); PG8_STAGE(PG8_SA(0, 0), a2, voffA);
            PG8_WAIT_V(8); PG8_WAIT_L(0); PG8_BAR; PG8_MMA(1, 0, At, B0); PG8_MMA(1, 1, At, B1); PG8_BAR; PG8_SCHED;
            PG8_LDB(B0, 1, 0); PG8_LDB(B1, 1, 1); PG8_SCHED; PG8_LDA(At, 1, 0); PG8_STAGE(PG8_SA(0, 1), a2 + hstepA, voffA);
            PG8_WAIT_V(8); PG8_WAIT_L(0); PG8_BAR; PG8_MMA(0, 0, At, B0); PG8_MMA(0, 1, At, B1); PG8_BAR; PG8_SCHED;
            PG8_LDA(At, 1, 1); PG8_STAGE(PG8_SB(1, 0), b3, voffB); PG8_STAGE(PG8_SB(1, 1), b3 + hstep, voffB); PG8_STAGE(PG8_SA(1, 0), a3, voffA);
            PG8_WAIT_V(8); PG8_WAIT_L(0); PG8_BAR; PG8_MMA(1, 0, At, B0); PG8_MMA(1, 1, At, B1); PG8_BAR; PG8_SCHED;
            } else {
            PG8_LDB(B0, 0, 0); PG8_SCHED; PG8_LDA(At, 0, 0); PG8_STAGE(PG8_SA(1, 1), a1 + hstepA, voffA);
            PG8_WAIT_L(8); PG8_BAR; PG8_WAIT_L(0); PG8_MMA(0, 0, At, B0); PG8_BAR; PG8_SCHED;
            PG8_LDB(B1, 0, 1); PG8_STAGE(PG8_SB(0, 0), b2, voffB);
            PG8_BAR; PG8_WAIT_L(0); PG8_MMA(0, 1, At, B1); PG8_BAR;
            PG8_LDA(At, 0, 1); PG8_STAGE(PG8_SA(0, 0), a2, voffA);
            PG8_BAR; PG8_WAIT_L(0); PG8_MMA(1, 0, At, B0); PG8_BAR; PG8_SCHED;
            PG8_STAGE(PG8_SB(0, 1), b2 + hstep, voffB);
            PG8_WAIT_V(6); PG8_BAR; PG8_MMA(1, 1, At, B1); PG8_BAR;
            PG8_LDB(B0, 1, 0); PG8_SCHED; PG8_LDA(At, 1, 0); PG8_STAGE(PG8_SA(0, 1), a2 + hstepA, voffA);
            PG8_WAIT_L(8); PG8_BAR; PG8_WAIT_L(0); PG8_MMA(0, 0, At, B0); PG8_BAR; PG8_SCHED;
            PG8_LDB(B1, 1, 1); PG8_STAGE(PG8_SB(1, 0), b3, voffB);
            PG8_BAR; PG8_WAIT_L(0); PG8_MMA(0, 1, At, B1); PG8_BAR;
            PG8_LDA(At, 1, 1); PG8_STAGE(PG8_SA(1, 0), a3, voffA);
            PG8_BAR; PG8_WAIT_L(0); PG8_MMA(1, 0, At, B0); PG8_BAR; PG8_SCHED;
            PG8_STAGE(PG8_SB(1, 1), b3 + hstep, voffB);
            PG8_WAIT_V(6); PG8_BAR; PG8_MMA(1, 1, At, B1); PG8_BAR;
            }
        }
        if constexpr (ALIGN_EPI) { if (wr == 0) PG8_BAR; }
        if constexpr (!Epi::AFTER_DRAIN) { E(acc, cur, wr, wc, fr, fq); S.done(cur); }
        if (!has_next) break;
#pragma unroll
        for (int a = 0; a < 2; ++a)
#pragma unroll
            for (int b = 0; b < 2; ++b)
#pragma unroll
                for (int m = 0; m < 4; ++m)
#pragma unroll
                    for (int n = 0; n < 2; ++n) acc[a][b][m][n] = (f32x4){0.f, 0.f, 0.f, 0.f};
        cur = nxt; cA = nA; cB = nB; ++ui;
        if constexpr (ALIGN_EPI) { if (wr == 1) PG8_BAR; }
    }
    PG8_WAIT_V(0);
    if constexpr (!ALIGN_EPI) { if (wr == 0) PG8_BAR; }
    PG8_BAR;
    if constexpr (Epi::AFTER_DRAIN) { E.fused(acc, cur, wr, wc, fr, fq, lds, wid, lane); S.done(cur); }
#undef PG8_SA
#undef PG8_SB
#undef PG8_STAGE
#undef PG8_LDA
#undef PG8_LDB
#undef PG8_MMA
#undef PG8_WAIT_V
#undef PG8_WAIT_L
#undef PG8_BAR
#undef PG8_SCHED
}
}
using pg8::bf16_t; using pg8::f32x4; using pg8::u32x4; using pg8::bf16x8; using pg8::Unit;
#define LAS __attribute__((address_space(3)))
typedef float f32x16 __attribute__((ext_vector_type(16)));
typedef unsigned u32x2 __attribute__((ext_vector_type(2)));
typedef short s16x4 __attribute__((ext_vector_type(4)));
constexpr int NB = 8, SEQ = 4096, CTXL = 256, DM = 1024, FF = 2816, DEPTH = 4, NH = 8;
constexpr int R_LAT = NB * SEQ, R_CTX = NB * CTXL, R = R_LAT + R_CTX;
constexpr float EPS = 1e-6f;
constexpr int NCH = 34;
constexpr size_t W_GUA = 0, W_DA = W_GUA + (size_t)5632 * 1024, W_GUB = W_DA + (size_t)1024 * 2816, W_DB = W_GUB + (size_t)5632 * 1024,
                 W_IN = W_DB + (size_t)1024 * 2816, W_UQ = W_IN + (size_t)3840 * 1024, W_UKV = W_UQ + (size_t)1536 * 256, W_OMLA = W_UKV + (size_t)2048 * 256,
                 W_GLU = W_OMLA + (size_t)1024 * 1024, W_OS5 = W_GLU + (size_t)1024 * 1024, W_OUT = W_OS5 + (size_t)1024 * 1024, W_END = W_OUT + (size_t)1024 * 1024;
constexpr size_t al256(size_t x) { return (x + 255) & ~(size_t)255; }
constexpr size_t WS_CTL = 0, CTL_BYTES = 16384;
constexpr size_t WS_MOD = WS_CTL + CTL_BYTES;
constexpr size_t WS_ROPE = WS_MOD + al256((size_t)4 * 9 * 9216 * 4);
constexpr size_t WS_YSS = WS_ROPE + al256(64 * 16 * 8);
constexpr size_t WS_CSS = WS_YSS + al256((size_t)R * 16 * 4);
constexpr size_t WS_S5E = WS_CSS + al256((size_t)R * 8 * 4);
constexpr size_t S5_WE_BYTES = (size_t)2 * 64 * 128 * 256 * 2, S5_WY_BYTES = (size_t)64 * 256 * 512 * 2;
constexpr size_t WS_XC = WS_S5E + al256(S5_WE_BYTES + S5_WY_BYTES);
constexpr size_t WS_WL = WS_XC + al256((size_t)R_CTX * DM * 4);
constexpr size_t WS_H = WS_WL + al256(W_END * 2);
constexpr size_t WS_BIG = WS_H + al256((size_t)R * DM * 2);
constexpr size_t B_CQ = 0, B_U = B_CQ + (size_t)R * 768 * 2, B_Q = B_U + (size_t)R * 1024 * 2, B_KV = B_Q + (size_t)R * 1536 * 2, B_SG = B_KV + (size_t)R * 2048 * 2, B_END = B_SG + (size_t)R * 2048 * 2;
constexpr size_t B_ACT = 0, B_Y = (size_t)R * FF * 2;
constexpr size_t B_T = B_U, B_G = B_KV, B_M = B_Q;
static_assert(B_Y >= B_M + (size_t)R * 1024 * 2 && B_Y + (size_t)R * 1024 * 2 <= B_SG, "Y overlay");
constexpr size_t WS_END = WS_BIG + B_END;
constexpr int LDS_BYTES = 272 * 528 + 2 * 16 * 528 + 256;

__device__ __forceinline__ float bf2f(unsigned h) { return __uint_as_float(h << 16); }
__device__ __forceinline__ unsigned pk2(float lo, float hi) { return pg8::cvt_pk_bf16(lo, hi); }
__device__ __forceinline__ float sigm(float x) { return __builtin_amdgcn_rcpf(1.f + __builtin_amdgcn_exp2f(-1.4426950408889634f * x)); }
__device__ __forceinline__ float gelu_tanh(float x) { return x * sigm(1.5957691216057308f * (x + 0.044715f * x * x * x)); }
__device__ __forceinline__ void unpack8(const u32x4 w, float (&f)[8]) {
    f[0] = bf2f(w.x & 0xffffu); f[1] = __uint_as_float(w.x & 0xffff0000u); f[2] = bf2f(w.y & 0xffffu); f[3] = __uint_as_float(w.y & 0xffff0000u);
    f[4] = bf2f(w.z & 0xffffu); f[5] = __uint_as_float(w.z & 0xffff0000u); f[6] = bf2f(w.w & 0xffffu); f[7] = __uint_as_float(w.w & 0xffff0000u);
}
__device__ __forceinline__ u32x4 pack8(const float (&f)[8]) { u32x4 w; w.x = pk2(f[0], f[1]); w.y = pk2(f[2], f[3]); w.z = pk2(f[4], f[5]); w.w = pk2(f[6], f[7]); return w; }
__device__ __forceinline__ float wave_sum(float v) {
#pragma unroll
    for (int o = 1; o < 64; o <<= 1) v += __shfl_xor(v, o);
    return v;
}
__device__ __forceinline__ void rope8(float (&v)[8], int row, int wc, int fq, const float* tab) {
    const int t = row & 4095, pos = (wc & 1) ? (t & 63) : (t >> 6);
    const f32x4* tp = (const f32x4*)(tab + (pos * 16 + 8 * (fq & 1)) * 2);
    const f32x4 t0 = tp[0], t1 = tp[1], t2 = tp[2], t3 = tp[3];
    const float cs[8] = {t0[0], t0[2], t1[0], t1[2], t2[0], t2[2], t3[0], t3[2]}, sn[8] = {t0[1], t0[3], t1[1], t1[3], t2[1], t2[3], t3[1], t3[3]};
    const float sgn = (fq < 2) ? -1.f : 1.f;
#pragma unroll
    for (int j = 0; j < 8; ++j) { const float p = __shfl_xor(v[j], 32); v[j] = v[j] * cs[j] + sgn * p * sn[j]; }
}

struct Epi {
    static constexpr bool PERM = true, AFTER_DRAIN = false;
    int mode;
    bf16_t* o0; bf16_t* o1; bf16_t* o2; const bf16_t* i0; const bf16_t* i1; float* ss; const float* css; const float* bias; const float* rope;
    __device__ __forceinline__ void operator()(const f32x4 (&acc)[2][2][4][2], const Unit& u, int wr, int wc, int fr, int fq) const {
        const int row0 = u.pm * 256 + wr * 64 + fr, cb = wc * 32 + 8 * fq, pn = u.pn;
        if (mode == 0) {
            bf16_t* base = o0 + (size_t)pn * 128 + cb;
#pragma unroll
            for (int ai = 0; ai < 2; ++ai)
#pragma unroll
                for (int m = 0; m < 4; ++m) { const int row = row0 + ai * 128 + m * 16; float v[8];
#pragma unroll
                    for (int n = 0; n < 2; ++n)
#pragma unroll
                        for (int j = 0; j < 4; ++j) { const float g = acc[ai][0][m][n][j], up = acc[ai][1][m][n][j]; v[4 * n + j] = g * sigm(g) * up; }
                    *(u32x4*)(base + (size_t)row * FF) = pack8(v); }
        } else if (mode == 1) {
            bf16_t* base = o0 + pn * 256 + cb;
#pragma unroll
            for (int ai = 0; ai < 2; ++ai)
#pragma unroll
                for (int m = 0; m < 4; ++m) { const int row = row0 + ai * 128 + m * 16; float s = 0.f;
#pragma unroll
                    for (int bj = 0; bj < 2; ++bj) { float v[8];
#pragma unroll
                        for (int n = 0; n < 2; ++n)
#pragma unroll
                            for (int j = 0; j < 4; ++j) { const float x = acc[ai][bj][m][n][j]; v[4 * n + j] = x; s += x * x; }
                        *(u32x4*)(base + (size_t)row * 1024 + bj * 128) = pack8(v); }
                    s += __shfl_xor(s, 16); s += __shfl_xor(s, 32);
                    if (fq == 0) ss[row * 16 + pn * 4 + wc] = s; }
        } else if (mode == 2) {
            bf16_t* dst; int ldc;
            if (pn < 3) { dst = o0 + pn * 256; ldc = 768; } else if (pn < 7) { dst = o1 + (pn - 3) * 256; ldc = 1024; } else { dst = o2 + (pn - 7) * 256; ldc = 2048; }
            const bool sg = pn >= 7, docss = pn < 2, dorope = (pn == 2) && (u.pm < 128) && (wc < 2);
            dst += cb;
#pragma unroll
            for (int ai = 0; ai < 2; ++ai)
#pragma unroll
                for (int m = 0; m < 4; ++m) { const int row = row0 + ai * 128 + m * 16; float s = 0.f;
#pragma unroll
                    for (int bj = 0; bj < 2; ++bj) { float v[8];
#pragma unroll
                        for (int n = 0; n < 2; ++n)
#pragma unroll
                            for (int j = 0; j < 4; ++j) { float x = acc[ai][bj][m][n][j]; if (sg) x = sigm(x); v[4 * n + j] = x; s += x * x; }
                        if (bj == 0 && dorope) rope8(v, row, wc, fq, rope);
                        *(u32x4*)(dst + (size_t)row * ldc + bj * 128) = pack8(v); }
                    if (docss) { s += __shfl_xor(s, 16); s += __shfl_xor(s, 32); if (fq == 0) ss[row * 8 + pn * 4 + wc] = s; } }
        } else if (mode == 3 || mode == 4) {
            const int ldc = (mode == 3) ? 1536 : 2048; const float* cp = css + ((mode == 3) ? 0 : 4);
            const bool dorope = (mode == 3) && (pn >= 4) && (u.pm < 128);
            bf16_t* dst = o0 + pn * 256 + cb;
#pragma unroll
            for (int ai = 0; ai < 2; ++ai)
#pragma unroll
                for (int m = 0; m < 4; ++m) { const int row = row0 + ai * 128 + m * 16; const f32x4 c4 = *(const f32x4*)(cp + row * 8);
                    const float rs = 1.0f / sqrtf(((c4[0] + c4[1]) + (c4[2] + c4[3])) * (1.0f / 256.0f) + EPS);
#pragma unroll
                    for (int bj = 0; bj < 2; ++bj) { float v[8];
#pragma unroll
                        for (int n = 0; n < 2; ++n)
#pragma unroll
                            for (int j = 0; j < 4; ++j) v[4 * n + j] = acc[ai][bj][m][n][j] * rs;
                        if (dorope) rope8(v, row, wc, fq, rope);
                        *(u32x4*)(dst + (size_t)row * ldc + bj * 128) = pack8(v); } }
        } else {
            const int col = pn * 256 + cb;
#pragma unroll
            for (int ai = 0; ai < 2; ++ai)
#pragma unroll
                for (int m = 0; m < 4; ++m) { const int row = row0 + ai * 128 + m * 16;
#pragma unroll
                    for (int bj = 0; bj < 2; ++bj) { const int c = col + bj * 128; float v[8], a[8], b[8];
#pragma unroll
                        for (int n = 0; n < 2; ++n)
#pragma unroll
                            for (int j = 0; j < 4; ++j) v[4 * n + j] = acc[ai][bj][m][n][j];
                        if (mode == 5) { unpack8(*(const u32x4*)(i0 + (size_t)row * 1024 + c), a); const f32x4 b0 = *(const f32x4*)(bias + c), b1 = *(const f32x4*)(bias + c + 4);
#pragma unroll
                            for (int j = 0; j < 4; ++j) { v[j] = a[j] * sigm(v[j] + b0[j]); v[4 + j] = a[4 + j] * sigm(v[4 + j] + b1[j]); } }
                        else if (mode == 6) { unpack8(*(const u32x4*)(i0 + (size_t)row * 2048 + c), a);
#pragma unroll
                            for (int j = 0; j < 8; ++j) v[j] = a[j] * v[j]; }
                        else { unpack8(*(const u32x4*)(i0 + (size_t)row * 1024 + c), a); unpack8(*(const u32x4*)(i1 + (size_t)row * 2048 + c), b);
#pragma unroll
                            for (int j = 0; j < 8; ++j) v[j] = a[j] + b[j] * v[j]; }
                        *(u32x4*)(o0 + (size_t)row * 1024 + c) = pack8(v); } }
        }
    }
};
__device__ __forceinline__ void conv_item(const float* W, int ldsrc, int srccol, const float* kscale, bf16_t* WT, int K, int n0, int k0, LAS float* scr, int lane) {
    if (srccol >= 0) {
#pragma unroll 8
        for (int i = 0; i < 32; ++i) { const int kk = 2 * i + (lane >> 5); float w = W[(size_t)(k0 + kk) * ldsrc + srccol + (lane & 31)]; if (kscale) w *= kscale[k0 + kk]; scr[kk * 33 + (lane & 31)] = w; }
    } else {
#pragma unroll 8
        for (int i = 0; i < 32; ++i) { const int kk = 2 * i + (lane >> 5); scr[kk * 33 + (lane & 31)] = 0.f; }
    }
    asm volatile("s_waitcnt lgkmcnt(0)" ::: "memory");
    const int c = lane & 7;
#pragma unroll
    for (int j = 0; j < 4; ++j) { const int n = (lane >> 3) + 8 * j; const LAS float* s = scr + (8 * c) * 33 + n;
        u32x4 o; o.x = pk2(s[0 * 33], s[1 * 33]); o.y = pk2(s[2 * 33], s[3 * 33]); o.z = pk2(s[4 * 33], s[5 * 33]); o.w = pk2(s[6 * 33], s[7 * 33]);
        *(u32x4*)(WT + (size_t)(n0 + n) * K + k0 + 8 * c) = o; }
    asm volatile("s_waitcnt lgkmcnt(0)" ::: "memory");
}
struct WPtrs { const float *gate, *up, *down, *win, *qn, *wuq, *kvn, *wukv, *womla, *glu, *wos5, *wout; };
__device__ __forceinline__ void conv_layer(const WPtrs& P, int l, bf16_t* WL, LAS unsigned char* lds, int gw, int NGW, int wave, int lane, int it_lo, int it_hi) {
    LAS float* scr = (LAS float*)(lds + wave * 16384);
    constexpr int I_GU = 16 * 176, I_D = 44 * 32, I_IN = 16 * 120, I_UQ = 4 * 48, I_UKV = 4 * 64, I_SQ = 16 * 32;
    constexpr int NIT = 2 * I_GU + 2 * I_D + I_IN + I_UQ + I_UKV + 4 * I_SQ;
    static_assert(NIT == 12864, "conv items");
    for (int it = it_lo + gw; it < it_hi; it += NGW) {
        int r = it;
        if (r < 2 * I_GU) { const int f = r / I_GU; r -= f * I_GU; const int nb = r % 176, kb = r / 176, n0 = nb * 32, tile = n0 >> 8, within = n0 & 255, half = within >> 7, ffc = tile * 128 + (within & 127);
            const size_t so = (size_t)(l * 2 + f) * 1024 * FF; bf16_t* dst = WL + (f ? W_GUB : W_GUA);
            if (half) conv_item(P.up + so, FF, ffc, nullptr, dst, 1024, n0, kb * 64, scr, lane); else conv_item(P.gate + so, FF, ffc, nullptr, dst, 1024, n0, kb * 64, scr, lane);
            continue; }
        r -= 2 * I_GU;
        if (r < 2 * I_D) { const int f = r / I_D; r -= f * I_D; const int nb = r % 32, kb = r / 32;
            conv_item(P.down + (size_t)(l * 2 + f) * FF * 1024, 1024, nb * 32, nullptr, WL + (f ? W_DB : W_DA), FF, nb * 32, kb * 64, scr, lane); continue; }
        r -= 2 * I_D;
        if (r < I_IN) { const int nb = r % 120, kb = r / 120, n0 = nb * 32; int sc;
            if (n0 < 512) sc = n0; else if (n0 < 768) sc = (n0 < 576) ? n0 : -1; else sc = n0 - 768 + 576;
            conv_item(P.win + (size_t)l * 1024 * 3648, 3648, sc, nullptr, WL + W_IN, 1024, n0, kb * 64, scr, lane); continue; }
        r -= I_IN;
        if (r < I_UQ) { const int nb = r % 48, kb = r / 48, n0 = nb * 32; int sc;
            if (n0 < 1024) sc = (n0 >> 7) * 192 + (n0 & 127); else { const int rr = n0 - 1024; sc = (rr >> 6) * 192 + 128 + (rr & 63); }
            conv_item(P.wuq + (size_t)l * 256 * 1536, 1536, sc, P.qn + l * 256, WL + W_UQ, 256, n0, kb * 64, scr, lane); continue; }
        r -= I_UQ;
        if (r < I_UKV) { const int nb = r % 64, kb = r / 64;
            conv_item(P.wukv + (size_t)l * 256 * 2048, 2048, nb * 32, P.kvn + l * 256, WL + W_UKV, 256, nb * 32, kb * 64, scr, lane); continue; }
        r -= I_UKV;
        { const int q = r / I_SQ; r -= q * I_SQ; const int nb = r % 32, kb = r / 32; const size_t so = (size_t)l * 1024 * 1024;
          if (q == 0) conv_item(P.womla + so, 1024, nb * 32, nullptr, WL + W_OMLA, 1024, nb * 32, kb * 64, scr, lane);
          else if (q == 1) conv_item(P.glu + so, 1024, nb * 32, nullptr, WL + W_GLU, 1024, nb * 32, kb * 64, scr, lane);
          else if (q == 2) conv_item(P.wos5 + so, 1024, nb * 32, nullptr, WL + W_OS5, 1024, nb * 32, kb * 64, scr, lane);
          else conv_item(P.wout + so, 1024, nb * 32, nullptr, WL + W_OUT, 1024, nb * 32, kb * 64, scr, lane); }
    }
}

__device__ __forceinline__ void mods_phase(const float* c, const float* c_ctx, const float* ada_w, const float* ada_b, float* MOD, float* ROPE, LAS unsigned char* lds, const int tid) {

    LAS float* sc = (LAS float*)lds;
    LAS float* red = (LAS float*)(lds + 9 * 1024 * 4);
    if (blockIdx.x == gridDim.x - 1) {
        for (int e = tid; e < 1024; e += 512) { const int pos = e >> 4, i = e & 15; const float inv = exp2f(-(float)i * (13.287712379549449f / 16.0f)); const float ang = (float)pos * inv;
            float sn_, cs_; sincosf(ang, &sn_, &cs_); ROPE[2 * e] = cs_; ROPE[2 * e + 1] = sn_; }
    }
    bool have = false;
    for (int item = blockIdx.x; item < 576; item += gridDim.x) {
        if (!have) { for (int e = tid; e < 9 * 1024; e += 512) { const float v = (e < 8192) ? c[e] : c_ctx[e - 8192]; sc[e] = v * sigm(v); } have = true; }
        __syncthreads();
        const int l = item / 144, j0 = (item % 144) * 64, ks = tid >> 6, jj = tid & 63;
        const float* w = ada_w + ((size_t)l * 1024 + ks * 128) * 9216 + j0 + jj;
        float a[9];
#pragma unroll
        for (int s = 0; s < 9; ++s) a[s] = 0.f;
#pragma unroll 16
        for (int k = 0; k < 128; ++k) { const float wv = w[(size_t)k * 9216];
#pragma unroll
            for (int s = 0; s < 9; ++s) a[s] += sc[s * 1024 + ks * 128 + k] * wv; }
#pragma unroll
        for (int s = 0; s < 9; ++s) red[(ks * 9 + s) * 64 + jj] = a[s];
        __syncthreads();
        for (int e = tid; e < 576; e += 512) { const int s = e >> 6, j = e & 63; float t = 0.f;
#pragma unroll
            for (int q = 0; q < 8; ++q) t += red[(q * 9 + s) * 64 + j];
            MOD[((size_t)l * 9 + s) * 9216 + j0 + j] = t + ada_b[l * 9216 + j0 + j]; }
    }
    __syncthreads();
}

__device__ __forceinline__ void e_phase(const float* xin, const float* ctxin, float* xl, float* xc, const bf16_t* Y, const float* YSS, const float* MOD,
                                        const float* npre, const float* npost, bf16_t* H, int l, int s, int nl, int ns, int gw, int NGW, int lane, float wmul, int nrows) {
    for (int row = gw; row < nrows; row += NGW) {
        const bool lat = row < R_LAT; const int set = lat ? (row >> 12) : 8;
        float* xr = lat ? xl + (size_t)row * DM : xc + (size_t)(row - R_LAT) * DM;
        const float* xs = (s < 0) ? (lat ? xin + (size_t)row * DM : ctxin + (size_t)(row - R_LAT) * DM) : xr;
        f32x4 v[4];
#pragma unroll
        for (int j = 0; j < 4; ++j) v[j] = __builtin_nontemporal_load((const f32x4*)xs + lane + 64 * j);
        if (s >= 0) {
            const float part = (lane < 16) ? YSS[row * 16 + lane] : 0.f;
            const float rs = 1.0f / sqrtf(wave_sum(part) * (1.0f / 1024.0f) + EPS);
            const float wgt = ((s == 1) ? 1.0f : 0.5f) * wmul;
            const float* gate = MOD + ((size_t)(l * 9 + set) * 9 + 3 * s + 2) * 1024; const float* gp = npost + (l * 3 + s) * 1024;
#pragma unroll
            for (int j = 0; j < 4; ++j) { const u32x2 yw = ((const u32x2*)(Y + (size_t)row * DM))[lane + 64 * j];
                const f32x4 g4 = ((const f32x4*)gate)[lane + 64 * j], p4 = ((const f32x4*)gp)[lane + 64 * j];
                f32x4 y4; y4[0] = bf2f(yw.x & 0xffffu); y4[1] = __uint_as_float(yw.x & 0xffff0000u); y4[2] = bf2f(yw.y & 0xffffu); y4[3] = __uint_as_float(yw.y & 0xffff0000u);
                v[j] += (wgt * rs) * g4 * y4 * p4; }
        }
#pragma unroll
        for (int j = 0; j < 4; ++j) __builtin_nontemporal_store(v[j], (f32x4*)xr + lane + 64 * j);
        if (nl >= 0) {
            float q = 0.f;
#pragma unroll
            for (int j = 0; j < 4; ++j) q += (v[j][0] * v[j][0] + v[j][1] * v[j][1]) + (v[j][2] * v[j][2] + v[j][3] * v[j][3]);
            const float rs2 = 1.0f / sqrtf(wave_sum(q) * (1.0f / 1024.0f) + EPS);
            const float* mb = MOD + ((size_t)(nl * 9 + set) * 9 + 3 * ns) * 1024; const float* gp = npre + (nl * 3 + ns) * 1024;
#pragma unroll
            for (int j = 0; j < 4; ++j) { const f32x4 sh = ((const f32x4*)mb)[lane + 64 * j], sc = ((const f32x4*)(mb + 1024))[lane + 64 * j], p4 = ((const f32x4*)gp)[lane + 64 * j];
                const f32x4 h = v[j] * rs2 * p4 * (1.0f + sc) + sh;
                u32x2 o; o.x = pk2(h[0], h[1]); o.y = pk2(h[2], h[3]); ((u32x2*)(H + (size_t)row * DM))[lane + 64 * j] = o; }
        }
    }
}
struct S5In { const float *a_re, *a_im, *log_dt, *b_re, *b_im, *c_re, *c_im, *dsk; };
__device__ __forceinline__ void s5_abar(const S5In& P, int idx, int n, float& ar, float& ai, float& cr, float& ci) {
    const float are = P.a_re[idx * 64 + n], aim = P.a_im[idx * 64 + n];
    const float dt = expf(P.log_dt[idx]);
    const float mag = expf(dt * are); float sn, cs; sincosf(dt * aim, &sn, &cs);
    ar = mag * cs; ai = mag * sn;
    const float nr = ar - 1.f, ni = ai, den = 1.0f / (are * are + aim * aim);
    cr = (nr * are + ni * aim) * den; ci = (ni * are - nr * aim) * den;
}
__device__ __forceinline__ void s5_prep(const S5In& P, int l, int g, bf16_t* WEt, bf16_t* WYt, LAS unsigned char* lds, int tid) {
    LAS float* AP = (LAS float*)lds;
    LAS float* BB = AP + 2 * 17 * 64 * 2;
    LAS float* CC = BB + 2 * 64 * 16 * 2;
    LAS float* KL = CC + 2 * 16 * 64 * 2;
    if (tid < 128) { const int d = tid >> 6, n = tid & 63, idx = (l * 2 + d) * 64 + g; float ar, ai, cr, ci; s5_abar(P, idx, n, ar, ai, cr, ci);
        float pr = 1.f, pi = 0.f;
        for (int j = 0; j <= 16; ++j) { AP[((d * 17 + j) * 64 + n) * 2] = pr; AP[((d * 17 + j) * 64 + n) * 2 + 1] = pi; const float t0 = pr * ar - pi * ai, t1 = pr * ai + pi * ar; pr = t0; pi = t1; }
        for (int c = 0; c < 16; ++c) { const float br = P.b_re[(size_t)(idx * 64 + n) * 16 + c], bi = P.b_im[(size_t)(idx * 64 + n) * 16 + c];
            BB[((d * 64 + n) * 16 + c) * 2] = cr * br - ci * bi; BB[((d * 64 + n) * 16 + c) * 2 + 1] = cr * bi + ci * br; } }
    for (int e = tid; e < 2048; e += 512) { const int d = e >> 10, cn = e & 1023; const size_t src = (size_t)((l * 2 + d) * 64 + g) * 1024 + cn; CC[e * 2] = P.c_re[src]; CC[e * 2 + 1] = P.c_im[src]; }
    __syncthreads();
    { const int d = tid >> 8, c = (tid >> 4) & 15, cp = tid & 15; float acc[16];
#pragma unroll
      for (int j = 0; j < 16; ++j) acc[j] = 0.f;
      for (int n = 0; n < 64; ++n) { const float c_r = CC[((d * 16 + c) * 64 + n) * 2], c_i = CC[((d * 16 + c) * 64 + n) * 2 + 1], b_r = BB[((d * 64 + n) * 16 + cp) * 2], b_i = BB[((d * 64 + n) * 16 + cp) * 2 + 1];
          const float zr = c_r * b_r - c_i * b_i, zi = c_r * b_i + c_i * b_r;
#pragma unroll
          for (int j = 0; j < 16; ++j) acc[j] += zr * AP[((d * 17 + j) * 64 + n) * 2] - zi * AP[((d * 17 + j) * 64 + n) * 2 + 1]; }
#pragma unroll
      for (int j = 0; j < 16; ++j) KL[((d * 16 + j) * 16 + c) * 16 + cp] = acc[j]; }
    __syncthreads();
    for (int e = tid; e < 256 * 64; e += 512) { const int row = e >> 6, k8 = (e & 63) * 8, t = row >> 4, c = row & 15; float v[8];
        if (k8 < 256) { const int s = k8 >> 4, c0 = k8 & 15;
#pragma unroll
            for (int j = 0; j < 8; ++j) { const int cp = c0 + j; float val = 0.f;
                if (s <= t) val += KL[(((t - s)) * 16 + c) * 16 + cp];
                if (s >= t) val += KL[((16 + (s - t)) * 16 + c) * 16 + cp];
                if (s == t && cp == c) val += P.dsk[l * 1024 + g * 16 + c];
                v[j] = val; } }
        else { const int kk = k8 - 256, d = kk >> 7, im = (kk >> 6) & 1, n0 = kk & 63, jp = (d == 0) ? t + 1 : 16 - t;
#pragma unroll
            for (int j = 0; j < 8; ++j) { const int n = n0 + j; const float wr = AP[((d * 17 + jp) * 64 + n) * 2], wi = AP[((d * 17 + jp) * 64 + n) * 2 + 1], c_r = CC[((d * 16 + c) * 64 + n) * 2], c_i = CC[((d * 16 + c) * 64 + n) * 2 + 1];
                v[j] = im ? -(c_r * wi + c_i * wr) : (c_r * wr - c_i * wi); } }
        *(u32x4*)(WYt + ((size_t)g * 256 + row) * 512 + k8) = pack8(v); }
    for (int e = tid; e < 2 * 128 * 32; e += 512) { const int d = e >> 12, row = (e >> 5) & 127, k8 = (e & 31) * 8, im = row >> 6, n = row & 63, s = k8 >> 4, c0 = k8 & 15, ex = (d == 0) ? 15 - s : s; float v[8];
        const float wr = AP[((d * 17 + ex) * 64 + n) * 2], wi = AP[((d * 17 + ex) * 64 + n) * 2 + 1];
#pragma unroll
        for (int j = 0; j < 8; ++j) { const float b_r = BB[((d * 64 + n) * 16 + c0 + j) * 2], b_i = BB[((d * 64 + n) * 16 + c0 + j) * 2 + 1]; v[j] = im ? (wr * b_i + wi * b_r) : (wr * b_r - wi * b_i); }
        *(u32x4*)(WEt + ((size_t)(d * 64 + g) * 128 + row) * 256 + k8) = pack8(v); }
    __syncthreads();
}
__device__ __forceinline__ int s5_chunk_row(int b, int ch) { return ch < 16 ? R_LAT + b * 256 + 16 * ch : b * 4096 + 16 * (ch - 16); }
#define S5_BAR() do { asm volatile("s_waitcnt lgkmcnt(0)" ::: "memory"); __builtin_amdgcn_s_barrier(); asm volatile("" ::: "memory"); } while (0)
__device__ __forceinline__ void s5_main(const S5In& P, int l, const bf16_t* U, const bf16_t* WEt, const bf16_t* WYt, bf16_t* T, LAS unsigned char* lds, int tid) {
    const int lane = tid & 63, w = __builtin_amdgcn_readfirstlane(tid >> 6), fr = lane & 15, q = lane >> 4;
    constexpr int XP = 528;
    LAS unsigned char* XIN = lds; LAS unsigned char* UC = lds + 272 * XP;
    const int uc_chunk = tid >> 5, uc_piece = tid & 31;
    constexpr int UCB = 16 * XP;
    LAS unsigned char* uc_dst0 = UC + uc_chunk * XP + uc_piece * 16;
    const LAS unsigned char* uc_a0 = UC + fr * XP + 16 * q;
#define S5_GLOAD(tile) (*(const u32x4*)(U + (size_t)(s5_chunk_row(b, 16 * (tile) + uc_chunk) + (uc_piece >> 1)) * 1024 + g * 16 + 8 * (uc_piece & 1)))
    const int Gd = (int)gridDim.x, bxi = (int)blockIdx.x, vcu = (Gd % 8 == 0) ? (bxi % 8) * (Gd / 8) + bxi / 8 : bxi;
    for (int item = vcu; item < 512; item += Gd) {
        const int g = item & 63, b = item >> 6;
        {
            bf16x8 bw0[8], bw1[8];
            { const bf16_t* wp = WEt + ((size_t)g * 128 + 16 * w + fr) * 256 + 8 * q;
#pragma unroll
              for (int kk = 0; kk < 8; ++kk) { bw0[kk] = *(const bf16x8*)(wp + 32 * kk); bw1[kk] = *(const bf16x8*)(wp + (size_t)64 * 128 * 256 + 32 * kk); } }
            u32x4 u0 = S5_GLOAD(0), u1 = S5_GLOAD(1), u2 = S5_GLOAD(2), u3 = S5_GLOAD(3), u4 = S5_GLOAD(4);
            *(LAS u32x4*)uc_dst0 = u0; u0 = u1; u1 = u2; u2 = u3; u3 = u4;
            S5_BAR();
            int ucoff = 0;
#pragma unroll 1
            for (int tile = 0; tile < 17; ++tile) {
                const LAS unsigned char* uc_a = uc_a0 + ucoff;
                f32x4 e0 = {0.f, 0.f, 0.f, 0.f}, e1 = {0.f, 0.f, 0.f, 0.f};
#pragma unroll
                for (int kk = 0; kk < 8; ++kk) { const bf16x8 af = *(const LAS bf16x8*)(uc_a + 64 * kk);
                    e0 = __builtin_amdgcn_mfma_f32_16x16x32_bf16(af, bw0[kk], e0, 0, 0, 0); e1 = __builtin_amdgcn_mfma_f32_16x16x32_bf16(af, bw1[kk], e1, 0, 0, 0); }
                asm volatile("s_nop 15\n\ts_nop 7" : "+v"(e0), "+v"(e1));
#pragma unroll
                for (int r = 0; r < 4; ++r) { LAS bf16_t* ep = (LAS bf16_t*)(XIN + (16 * tile + 4 * q + r) * XP) + 16 * w + fr;
                    const unsigned pk = pk2(e0[r], e1[r]); ep[0] = (bf16_t)(pk & 0xffffu); ep[128] = (bf16_t)(pk >> 16); }
                ucoff ^= UCB;
                if (tile < 16) { *(LAS u32x4*)(uc_dst0 + ucoff) = u0; u0 = u1; u1 = u2; u2 = u3; if (tile + 5 <= 16) u3 = S5_GLOAD(tile + 5); }
                S5_BAR();
            }
        }
        if (w < 2) {
            const int d = w;
            float tr, ti, xr = 0.f, xi = 0.f;
            { float cr, ci; s5_abar(P, (l * 2 + d) * 64 + g, lane, tr, ti, cr, ci);
#pragma unroll
              for (int k = 0; k < 4; ++k) { const float n_r = tr * tr - ti * ti, n_i = 2.f * tr * ti; tr = n_r; ti = n_i; } }
#pragma unroll 1
            for (int i = 0; i < 17; ++i) {
                const int tile = (d == 0 || i == 0) ? i : 17 - i;
                float er[16], ei[16];
#pragma unroll
                for (int c = 0; c < 16; ++c) { const LAS bf16_t* ep = (const LAS bf16_t*)(XIN + (16 * tile + c) * XP) + d * 128; er[c] = bf2f(ep[lane]); ei[c] = bf2f(ep[64 + lane]); }
                asm volatile("s_waitcnt lgkmcnt(0)" ::: "memory");
#pragma unroll
                for (int cc = 0; cc < 16; ++cc) { const int c = d ? 15 - cc : cc;
                    LAS bf16_t* xp = (LAS bf16_t*)(XIN + (16 * tile + c) * XP) + d * 128;
                    const unsigned pk = pk2(xr, xi); xp[lane] = (bf16_t)(pk & 0xffffu); xp[64 + lane] = (bf16_t)(pk >> 16);
                    const float nxr = tr * xr - ti * xi + er[c], nxi = tr * xi + ti * xr + ei[c]; xr = nxr; xi = nxi; }
            }
        }
        S5_BAR();
        {
            bf16x8 by[2][16];
#pragma unroll
            for (int nt = 0; nt < 2; ++nt) { const bf16_t* wp = WYt + ((size_t)g * 256 + 32 * w + 16 * nt + fr) * 512 + 8 * q;
#pragma unroll
                for (int kk = 0; kk < 16; ++kk) by[nt][kk] = *(const bf16x8*)(wp + 32 * kk); }
            u32x4 u0 = S5_GLOAD(0), u1 = S5_GLOAD(1), u2 = S5_GLOAD(2), u3 = S5_GLOAD(3), u4 = S5_GLOAD(4);
            *(LAS u32x4*)uc_dst0 = u0; u0 = u1; u1 = u2; u2 = u3; u3 = u4;
            S5_BAR();
            int ucoff = 0;
#pragma unroll 1
            for (int tile = 0; tile < 17; ++tile) {
                const LAS unsigned char* uc_a = uc_a0 + ucoff;
                f32x4 acc0 = {0.f, 0.f, 0.f, 0.f}, acc1 = {0.f, 0.f, 0.f, 0.f};
#pragma unroll
                for (int kk = 0; kk < 8; ++kk) { const bf16x8 af = *(const LAS bf16x8*)(uc_a + 64 * kk);
                    acc0 = __builtin_amdgcn_mfma_f32_16x16x32_bf16(af, by[0][kk], acc0, 0, 0, 0); acc1 = __builtin_amdgcn_mfma_f32_16x16x32_bf16(af, by[1][kk], acc1, 0, 0, 0); }
                const LAS unsigned char* xq = XIN + (16 * tile + fr) * XP + 16 * q;
#pragma unroll
                for (int kk = 0; kk < 8; ++kk) { const bf16x8 xf = *(const LAS bf16x8*)(xq + 64 * kk);
                    acc0 = __builtin_amdgcn_mfma_f32_16x16x32_bf16(xf, by[0][8 + kk], acc0, 0, 0, 0); acc1 = __builtin_amdgcn_mfma_f32_16x16x32_bf16(xf, by[1][8 + kk], acc1, 0, 0, 0); }
                ucoff ^= UCB;
                if (tile < 16) { *(LAS u32x4*)(uc_dst0 + ucoff) = u0; u0 = u1; u1 = u2; u2 = u3; if (tile + 5 <= 16) u3 = S5_GLOAD(tile + 5); }
#pragma unroll
                for (int r = 0; r < 4; ++r) { const int row = s5_chunk_row(b, 16 * tile + 4 * q + r) + 2 * w;
                    const float g0 = gelu_tanh(acc0[r]), g1 = gelu_tanh(acc1[r]);
                    const bool odd = fr & 1;
                    const float got = __shfl_xor(odd ? g0 : g1, 1);
                    const unsigned pk = odd ? pk2(got, g1) : pk2(g0, got);
                    *(unsigned*)(T + (size_t)(row + (odd ? 1 : 0)) * 1024 + g * 16 + (fr & ~1)) = pk; }
                S5_BAR();
            }
        }
    }
#undef S5_GLOAD
#undef S5_BAR
}
__device__ __forceinline__ s16x4 vtr(const LAS unsigned char* p) { return __builtin_bit_cast(s16x4, __builtin_amdgcn_ds_read_tr16_b64_v4i16((LAS s16x4*)p)); }
__device__ __forceinline__ void attn_phase(LAS unsigned char* lds, const bf16_t* Q, const bf16_t* KV, const bf16_t* CQ, bf16_t* O, const int tid, const int nunits) {
    const int lane = tid & 63, wid = __builtin_amdgcn_readfirstlane(tid >> 6), r32 = lane & 31, hi = lane >> 5;
    constexpr int KP = 400, VP = 320, BUFB = 64 * KP + 64 * VP;
    const float C = 0.07216878364870322f * 1.4426950408889634f;
    const int kn_row = tid >> 4, kn_ch = tid & 15, kr_row = tid >> 3, kr_ch = tid & 7;
    const int Gd = (int)gridDim.x, bxi = (int)blockIdx.x, vcu = (Gd % 8 == 0) ? (bxi % 8) * (Gd / 8) + bxi / 8 : bxi;
    for (int ui = 0;; ++ui) {
        const int unit = ui * (int)gridDim.x + vcu; if (unit >= nunits) break;
        int b, h, qb;
        if (unit < 1024) { const int bh = unit >> 4; qb = unit & 15; b = bh >> 3; h = bh & 7; } else { const int bh = unit - 1024; qb = 16; b = bh >> 3; h = bh & 7; }
        const int qrow0 = (qb < 16) ? b * 4096 + qb * 256 : R_LAT + b * 256;
        const int NT = (qb < 16) ? 68 : 4;
        const bf16_t* qp = Q + (size_t)(qrow0 + wid * 32 + r32) * 1536;
        bf16x8 qf[12];
#pragma unroll
        for (int s = 0; s < 8; ++s) qf[s] = *(const bf16x8*)(qp + h * 128 + 16 * s + 8 * hi);
#pragma unroll
        for (int s = 0; s < 4; ++s) qf[8 + s] = *(const bf16x8*)(qp + 1024 + h * 64 + 16 * s + 8 * hi);
        u32x4 sk0, sk1, skr, sv0, sv1;
#define ATT_KROW(t) ((qb < 16) ? (((t) < 64) ? b * 4096 + (t) * 64 : R_LAT + b * 256 + ((t) - 64) * 64) : R_LAT + b * 256 + (t) * 64)
#define ATT_LOAD(t) do { const int kr0_ = ATT_KROW(t); const bf16_t* kvp_ = KV + (size_t)(kr0_ + kn_row) * 2048 + h * 256 + kn_ch * 8; \
        sk0 = *(const u32x4*)kvp_; sk1 = *(const u32x4*)(kvp_ + 32 * 2048); sv0 = *(const u32x4*)(kvp_ + 128); sv1 = *(const u32x4*)(kvp_ + 128 + 32 * 2048); \
        skr = *(const u32x4*)(CQ + (size_t)(kr0_ + kr_row) * 768 + 512 + kr_ch * 8); } while (0)
#define ATT_STORE(buf) do { LAS unsigned char* kb_ = lds + (buf) * BUFB; LAS unsigned char* vb_ = kb_ + 64 * KP; \
        *(LAS u32x4*)(kb_ + kn_row * KP + kn_ch * 16) = sk0; *(LAS u32x4*)(kb_ + (kn_row + 32) * KP + kn_ch * 16) = sk1; *(LAS u32x4*)(kb_ + kr_row * KP + 256 + kr_ch * 16) = skr; \
        *(LAS u32x4*)(vb_ + kn_row * VP + kn_ch * 16) = sv0; *(LAS u32x4*)(vb_ + (kn_row + 32) * VP + kn_ch * 16) = sv1; } while (0)
        ATT_LOAD(0); ATT_STORE(0);
        __syncthreads();
        float mrun = -1e30f, lrun = 0.f;
        f32x16 o[4];
#pragma unroll
        for (int d = 0; d < 4; ++d)
#pragma unroll
            for (int r = 0; r < 16; ++r) o[d][r] = 0.f;
        for (int t = 0; t < NT; ++t) {
            const int cur = t & 1;
            if (t + 1 < NT) ATT_LOAD(t + 1);
            f32x16 p0, p1;
#pragma unroll
            for (int r = 0; r < 16; ++r) { p0[r] = 0.f; p1[r] = 0.f; }
            __builtin_amdgcn_s_setprio(1);
            { const LAS unsigned char* kb = lds + cur * BUFB + r32 * KP + hi * 16;
#pragma unroll
              for (int g3 = 0; g3 < 3; ++g3) { bf16x8 k0[4], k1[4];
#pragma unroll
                  for (int j = 0; j < 4; ++j) { k0[j] = *(const LAS bf16x8*)(kb + (4 * g3 + j) * 32); k1[j] = *(const LAS bf16x8*)(kb + 32 * KP + (4 * g3 + j) * 32); }
                  __builtin_amdgcn_sched_barrier(0);
#pragma unroll
                  for (int j = 0; j < 4; ++j) { p0 = __builtin_amdgcn_mfma_f32_32x32x16_bf16(k0[j], qf[4 * g3 + j], p0, 0, 0, 0); p1 = __builtin_amdgcn_mfma_f32_32x32x16_bf16(k1[j], qf[4 * g3 + j], p1, 0, 0, 0); }
                  __builtin_amdgcn_sched_barrier(0); } }
            __builtin_amdgcn_s_setprio(0);
            float mx = p0[0];
#pragma unroll
            for (int r = 0; r < 16; ++r) { mx = fmaxf(mx, p0[r]); mx = fmaxf(mx, p1[r]); }
            mx = fmaxf(mx, __shfl_xor(mx, 32)) * C;
            if (__any(mx > mrun + 8.0f)) {
                const float mn = fmaxf(mrun, mx), alpha = __builtin_amdgcn_exp2f(mrun - mn); mrun = mn; lrun *= alpha;
#pragma unroll
                for (int d = 0; d < 4; ++d)
#pragma unroll
                    for (int r = 0; r < 16; ++r) o[d][r] *= alpha;
            }
            float rsum = 0.f;
#pragma unroll
            for (int r = 0; r < 16; ++r) { p0[r] = __builtin_amdgcn_exp2f(p0[r] * C - mrun); p1[r] = __builtin_amdgcn_exp2f(p1[r] * C - mrun); rsum += p0[r] + p1[r]; }
            lrun += rsum;
            bf16x8 pf[4];
            { u32x4 w;
              w.x = pk2(p0[0], p0[1]); w.y = pk2(p0[2], p0[3]); w.z = pk2(p0[4], p0[5]); w.w = pk2(p0[6], p0[7]); pf[0] = __builtin_bit_cast(bf16x8, w);
              w.x = pk2(p0[8], p0[9]); w.y = pk2(p0[10], p0[11]); w.z = pk2(p0[12], p0[13]); w.w = pk2(p0[14], p0[15]); pf[1] = __builtin_bit_cast(bf16x8, w);
              w.x = pk2(p1[0], p1[1]); w.y = pk2(p1[2], p1[3]); w.z = pk2(p1[4], p1[5]); w.w = pk2(p1[6], p1[7]); pf[2] = __builtin_bit_cast(bf16x8, w);
              w.x = pk2(p1[8], p1[9]); w.y = pk2(p1[10], p1[11]); w.z = pk2(p1[12], p1[13]); w.w = pk2(p1[14], p1[15]); pf[3] = __builtin_bit_cast(bf16x8, w); }
            __builtin_amdgcn_s_setprio(1);
            { const LAS unsigned char* vb = lds + cur * BUFB + 64 * KP + (4 * hi + ((lane & 15) >> 2)) * VP + (16 * ((lane >> 4) & 1) + 4 * (lane & 3)) * 2;
#pragma unroll
              for (int s2 = 0; s2 < 2; ++s2) { s16x4 lo[8], hh[8];
#pragma unroll
                  for (int i = 0; i < 8; ++i) { const int s = 2 * s2 + (i >> 2), d = i & 3; lo[i] = vtr(vb + s * 16 * VP + d * 64); hh[i] = vtr(vb + s * 16 * VP + 8 * VP + d * 64); }
                  __builtin_amdgcn_sched_barrier(0);
#pragma unroll
                  for (int i = 0; i < 8; ++i) { const int s = 2 * s2 + (i >> 2), d = i & 3;
                      const bf16x8 vf = (bf16x8){lo[i][0], lo[i][1], lo[i][2], lo[i][3], hh[i][0], hh[i][1], hh[i][2], hh[i][3]};
                      o[d] = __builtin_amdgcn_mfma_f32_32x32x16_bf16(vf, pf[s], o[d], 0, 0, 0); }
                  __builtin_amdgcn_sched_barrier(0); } }
            __builtin_amdgcn_s_setprio(0);
            if (t + 1 < NT) ATT_STORE(cur ^ 1);
            __syncthreads();
        }
        const float inv = 1.0f / (lrun + __shfl_xor(lrun, 32));
        bf16_t* op = O + (size_t)(qrow0 + wid * 32 + r32) * 1024 + h * 128;
#pragma unroll
        for (int d = 0; d < 4; ++d)
#pragma unroll
            for (int i4 = 0; i4 < 4; ++i4) { u32x2 w; w.x = pk2(o[d][4 * i4] * inv, o[d][4 * i4 + 1] * inv); w.y = pk2(o[d][4 * i4 + 2] * inv, o[d][4 * i4 + 3] * inv);
                *(u32x2*)(op + 32 * d + 8 * i4 + 4 * hi) = w; }
    }
#undef ATT_KROW
#undef ATT_LOAD
#undef ATT_STORE
}
#define XB_TMO      128
#define XB_XCNT(j)  (256  + 64 * (j))
#define XB_XSUB(j)  (1280 + 64 * (j))
#define XB_XGEN(j)  (2304 + 64 * (j))
#define XB_TOP      3328
#define XB_TOPGEN   3392
#define XCD_BAR_WORDS 3456
#define XB_SPIN_CAP (1u << 18)

__device__ __forceinline__ unsigned xb_ld(unsigned* p)              { return __hip_atomic_load(p, __ATOMIC_RELAXED, __HIP_MEMORY_SCOPE_AGENT); }
__device__ __forceinline__ unsigned xb_add(unsigned* p, unsigned v) { return __hip_atomic_fetch_add(p, v, __ATOMIC_RELAXED, __HIP_MEMORY_SCOPE_AGENT); }
__device__ __forceinline__ unsigned xb_xcc_id() { return (unsigned)__builtin_amdgcn_s_getreg((3 << 11) | 20) & 0xFu; }
#define XB_SPIN(cond, bar) do { unsigned _sp = 0; while (cond) { __builtin_amdgcn_s_sleep(1); \
    if ((++_sp & 255u) == 0u) { if (xb_ld(&(bar)[XB_TMO])) break; if (_sp > XB_SPIN_CAP) { atomicAdd(&(bar)[XB_TMO], 1u); break; } } } } while (0)

struct XcdBarrier {
    unsigned* bar; unsigned x;
    volatile LAS unsigned* st;
};

__device__ __forceinline__ XcdBarrier xcd_barrier_post(unsigned* bar, volatile LAS unsigned* st) {
    XcdBarrier b; b.bar = bar; b.x = xb_xcc_id(); b.st = st;
    if (threadIdx.x == 0) (void)xb_add(&bar[XB_XCNT(b.x)], 1u);
    return b;
}
__device__ __forceinline__ void xcd_barrier_complete(unsigned* bar, unsigned x, unsigned& nloc, unsigned& nx) {
    const unsigned G = gridDim.x * gridDim.y * gridDim.z;
    unsigned sum, cnt, mine, sp = 0u;
    for (;;) {
        sum = 0u; cnt = 0u; mine = 0u;
#pragma unroll
        for (unsigned j = 0; j < 16; ++j) { const unsigned c = xb_ld(&bar[XB_XCNT(j)]); sum += c; cnt += (c > 0u) ? 1u : 0u; mine = (j == x) ? c : mine; }
        if (sum == G) break;
        __builtin_amdgcn_s_sleep(1);
        if ((++sp & 255u) == 0u) { if (xb_ld(&bar[XB_TMO])) break; if (sp > XB_SPIN_CAP) { atomicAdd(&bar[XB_TMO], 1u); break; } }
    }
    nloc = mine > 0u ? mine : 1u; nx = cnt > 0u ? cnt : 1u;
}

__device__ __forceinline__ void xcd_barrier(const XcdBarrier& b) {
    asm volatile("s_waitcnt vmcnt(0)" ::: "memory");
    __syncthreads();
    if (threadIdx.x == 0) {
        unsigned* bar = b.bar;
        __builtin_amdgcn_s_waitcnt(0);
        unsigned nloc = b.st[0], nx = b.st[1];
        if (nloc == 0u) { xcd_barrier_complete(bar, b.x, nloc, nx); b.st[0] = nloc; b.st[1] = nx; }
        const unsigned old = xb_add(&bar[XB_XSUB(b.x)], 1u);
        const unsigned gen = old / nloc;
        if (old + 1u == (gen + 1u) * nloc) {
            __builtin_amdgcn_fence(__ATOMIC_RELEASE, "agent");
            asm volatile("s_waitcnt vmcnt(0)" ::: "memory");
            const unsigned og = xb_add(&bar[XB_TOP], 1u);
            const unsigned tg = og / nx;
            if (og + 1u == (tg + 1u) * nx) xb_add(&bar[XB_TOPGEN], 1u);
            else XB_SPIN(xb_ld(&bar[XB_TOPGEN]) == tg, bar);
            __builtin_amdgcn_fence(__ATOMIC_ACQUIRE, "agent");
            xb_add(&bar[XB_XGEN(b.x)], 1u);
            asm volatile("s_waitcnt vmcnt(0)" ::: "memory");
        } else {
            XB_SPIN(xb_ld(&bar[XB_XGEN(b.x)]) == gen, bar);
            __builtin_amdgcn_fence(__ATOMIC_ACQUIRE, "agent");
            asm volatile("s_waitcnt vmcnt(0)" ::: "memory");
        }
    }
    __syncthreads();
}

#define DERIVE_PTRS float* MOD = (float*)(ws + WS_MOD); float* ROPE = (float*)(ws + WS_ROPE); float* YSS = (float*)(ws + WS_YSS); float* CSS = (float*)(ws + WS_CSS); bf16_t* WEt = (bf16_t*)(ws + WS_S5E); bf16_t* WYt = (bf16_t*)(ws + WS_S5E + S5_WE_BYTES); float* XC = (float*)(ws + WS_XC); bf16_t* WL = (bf16_t*)(ws + WS_WL); bf16_t* H = (bf16_t*)(ws + WS_H); unsigned char* big = ws + WS_BIG; bf16_t* CQ = (bf16_t*)(big + B_CQ); bf16_t* U = (bf16_t*)(big + B_U); bf16_t* Qb = (bf16_t*)(big + B_Q); bf16_t* KVb = (bf16_t*)(big + B_KV); bf16_t* SG = (bf16_t*)(big + B_SG); bf16_t* ACT = (bf16_t*)(big + B_ACT); bf16_t* Y = (bf16_t*)(big + B_Y); bf16_t* T = (bf16_t*)(big + B_T); bf16_t* Gb = (bf16_t*)(big + B_G); bf16_t* Mb = (bf16_t*)(big + B_M); bf16_t* Ob = H;
constexpr int PPL = 13;
constexpr int NSTEPS = 2 + PPL * DEPTH;
struct Args { const float* in[29]; float* out; unsigned char* ws; int ph_lo, ph_hi; };
__global__ void __launch_bounds__(512, 2) mk_fwd(Args a) {
    extern __shared__ __attribute__((aligned(16))) unsigned char lds_raw[];
    cg::grid_group grid = cg::this_grid();
    LAS unsigned char* lds = (LAS unsigned char*)lds_raw;
    const int G = gridDim.x, NGW = G * 8;
    volatile LAS unsigned* xst = (volatile LAS unsigned*)(lds + LDS_BYTES - 64);
    if (threadIdx.x < 2) xst[threadIdx.x] = 0u;
    __syncthreads();
    XcdBarrier xbar; xbar.bar = (unsigned*)(a.ws + WS_CTL); xbar.x = 0; xbar.st = xst;
    if (a.ph_hi - a.ph_lo > 1) xbar = xcd_barrier_post((unsigned*)(a.ws + WS_CTL), xst);
    WPtrs WP{a.in[8], a.in[9], a.in[10], a.in[11], a.in[12], a.in[13], a.in[14], a.in[15], a.in[16], a.in[25], a.in[27], a.in[28]};
    S5In SP{a.in[17], a.in[18], a.in[19], a.in[20], a.in[21], a.in[22], a.in[23], a.in[24]};
#if MK_TIME >= 0
    unsigned long long tacc = 0ull;
#endif
#pragma unroll 1
    for (int step = a.ph_lo; step < a.ph_hi; ++step) {
#if MK_TIME >= 0
        const unsigned long long tph0 = __builtin_amdgcn_s_memrealtime();
#endif
        int tid = threadIdx.x; asm volatile("" : "+v"(tid));
        const int lane = tid & 63, wave = __builtin_amdgcn_readfirstlane(tid >> 6), gw = blockIdx.x * 8 + wave;
        unsigned char* ws = a.ws; asm volatile("" : "+s"(ws));
        DERIVE_PTRS
        int l = 0, p = -1;
        if (step >= 2) { l = (step - 2) / PPL; p = (step - 2) % PPL; if (p >= 6) ++p; }
        if (step == 0) mods_phase(a.in[1], a.in[3], a.in[4], a.in[5], MOD, ROPE, lds, tid);
        if (step == 0) conv_layer(WP, 0, WL, lds, gw, NGW, wave, lane, 0, 12864);
#if MK_PROBE == 9
        if (step == 0) { __syncthreads(); mods_phase(a.in[1], a.in[3], a.in[4], a.in[5], MOD, ROPE, lds, tid); conv_layer(WP, 0, WL, lds, gw, NGW, wave, lane, 0, 12864); }
#endif
        if (p == 13 && l < DEPTH - 1) conv_layer(WP, l + 1, WL, lds, gw, NGW, wave, lane, 7040, 8448);
        if (step == 1 || p == 2 || p == 10 || p == 13) {
            int s, nl, ns;
            if (step == 1) { s = -1; nl = 0; ns = 0; } else if (p == 2) { s = 0; nl = l; ns = 1; } else if (p == 10) { s = 1; nl = l; ns = 2; } else { s = 2; nl = (l < DEPTH - 1) ? l + 1 : -1; ns = 0; }
            e_phase(a.in[0], a.in[2], a.out, XC, Y, YSS, MOD, a.in[6], a.in[7], H, l, s, nl, ns, gw, NGW, lane, 1.0f, (l == DEPTH - 1 && p >= 10) ? R_LAT : R);
#if MK_PROBE == 5
            if (s >= 0) { __syncthreads(); e_phase(a.in[0], a.in[2], a.out, XC, Y, YSS, MOD, a.in[6], a.in[7], H, l, s, nl, ns, gw, NGW, lane, 0.0f, R); }
#endif
        }
        if (p == 0 || p == 1 || p == 3 || p == 4 || p == 7 || p == 8 || p == 9 || p == 11 || p == 12) {
            const int ng = (p == 4 || p == 7) ? 2 : 1;
#pragma unroll 1
            for (int gi = 0; gi < ng; ++gi) {
                pg8::Gemm g; Epi E; E.o0 = nullptr; E.o1 = nullptr; E.o2 = nullptr; E.i0 = nullptr; E.i1 = nullptr; E.ss = nullptr; E.css = CSS; E.bias = nullptr; E.rope = ROPE; E.mode = 0;
                g.M = R;
                if (p == 0 || p == 11) { g.A = H; g.Bt = WL + (p == 0 ? W_GUA : W_GUB); g.N = 5632; g.K = 1024; g.lda = 1024; E.mode = 0; E.o0 = ACT; }
                else if (p == 1 || p == 12) { g.A = ACT; g.Bt = WL + (p == 1 ? W_DA : W_DB); g.N = 1024; g.K = FF; g.lda = FF; E.mode = 1; E.o0 = Y; E.ss = YSS; }
                else if (p == 3) { g.A = H; g.Bt = WL + W_IN; g.N = 3840; g.K = 1024; g.lda = 1024; E.mode = 2; E.o0 = CQ; E.o1 = U; E.o2 = SG; E.ss = CSS; }
                else if (p == 4 && gi == 0) { g.A = CQ; g.Bt = WL + W_UQ; g.N = 1536; g.K = 256; g.lda = 768; E.mode = 3; E.o0 = Qb; }
                else if (p == 4) { g.A = CQ + 256; g.Bt = WL + W_UKV; g.N = 2048; g.K = 256; g.lda = 768; E.mode = 4; E.o0 = KVb; }
                else if (p == 7 && gi == 0) { g.A = T; g.Bt = WL + W_GLU; g.N = 1024; g.K = 1024; g.lda = 1024; E.mode = 5; E.o0 = Gb; E.i0 = T; E.bias = a.in[26] + l * 1024; }
                else if (p == 7) { g.A = Ob; g.Bt = WL + W_OMLA; g.N = 1024; g.K = 1024; g.lda = 1024; E.mode = 6; E.o0 = Mb; E.i0 = SG; }
                else if (p == 8) { g.A = Gb; g.Bt = WL + W_OS5; g.N = 1024; g.K = 1024; g.lda = 1024; E.mode = 7; E.o0 = Mb; E.i0 = Mb; E.i1 = SG + 1024; }
                else { g.A = Mb; g.Bt = WL + W_OUT; g.N = 1024; g.K = 1024; g.lda = 1024; E.mode = 1; E.o0 = Y; E.ss = YSS; }
                const int Mrows = (l == DEPTH - 1 && (p >= 7 || (p == 4 && gi == 0))) ? R_LAT : R;
                pg8::StaticOrder S; S.init(Mrows, g.N, G, (gi == 0) ? (int)blockIdx.x : (int)((blockIdx.x + (G >> 1)) % G));
                pg8::gemm_phase<Epi, pg8::StaticOrder, true, true>(lds, g, S, E, tid);
#if MK_PROBE == 3 || MK_PROBE == 6 || MK_PROBE == 7 || MK_PROBE == 8 || MK_PROBE == 10
                if ((MK_PROBE == 3 && (p == 0 || p == 11)) || (MK_PROBE == 6 && p == 9) || (MK_PROBE == 7 && (p == 1 || p == 12)) || (MK_PROBE == 8 && p == 4) || (MK_PROBE == 10 && p == 3)) { __syncthreads(); pg8::gemm_phase<Epi, pg8::StaticOrder, true, true>(lds, g, S, E, tid); }
#endif
            }
        }
        if (p == 4) {
#pragma unroll 1
            for (int rep = 0; rep < (MK_PROBE == 2 ? 2 : 1); ++rep) s5_main(SP, l, U, WEt, WYt, T, lds, tid); }
        if (G == 256) {
            const int bx = blockIdx.x;
            if (p == 1 && bx >= 32 && bx < 96) s5_prep(SP, l, bx - 32, WEt, WYt, lds, tid);
            if (l < DEPTH - 1 && bx >= 32) {
                const int vgw = (bx - 32) * 8 + wave, VNGW = 224 * 8;
                if (p == 7 && (bx < 128 || bx >= 160)) { const int v7 = ((bx < 128) ? bx - 32 : bx - 64) * 8 + wave;
                    conv_layer(WP, l + 1, WL, lds, v7, 192 * 8, wave, lane, 0, 2816); conv_layer(WP, l + 1, WL, lds, v7, 192 * 8, wave, lane, 5632, 7040); }
                if (p == 8) { conv_layer(WP, l + 1, WL, lds, vgw, VNGW, wave, lane, 8448, 11840); }
                if (p == 9) { conv_layer(WP, l + 1, WL, lds, vgw, VNGW, wave, lane, 11840, 12352); }
                if (p == 12) { conv_layer(WP, l + 1, WL, lds, vgw, VNGW, wave, lane, 12352, 12864); conv_layer(WP, l + 1, WL, lds, vgw, VNGW, wave, lane, 2816, 5632); }
            }
        }
        if (G != 256) {
            if (p == 2 && blockIdx.x < 64) s5_prep(SP, l, blockIdx.x, WEt, WYt, lds, tid);
            if (p == 13 && l < DEPTH - 1) { conv_layer(WP, l + 1, WL, lds, gw, NGW, wave, lane, 0, 7040); conv_layer(WP, l + 1, WL, lds, gw, NGW, wave, lane, 8448, 12864); }
        }
        if (p == 5) {
#pragma unroll 1
            for (int rep = 0; rep < (MK_PROBE == 1 ? 2 : 1); ++rep) attn_phase(lds, Qb, KVb, CQ, Ob, tid, (l == DEPTH - 1) ? 1024 : 1024 + 64); }
#if MK_TIME >= 0
        const unsigned long long tb0 = __builtin_amdgcn_s_memrealtime();
#endif
        if (step + 1 < a.ph_hi) {
            if (step == a.ph_lo) grid.sync(); else xcd_barrier(xbar);
#if MK_PROBE == 4
            xcd_barrier(xbar); xcd_barrier(xbar);
#endif
        }
#if MK_TIME >= 0
        { const unsigned long long tb1 = __builtin_amdgcn_s_memrealtime();
          const int cls = (step == 0) ? 10 : (step == 1 || p == 2 || p == 10 || p == 13) ? 2 : (p == 0 || p == 11) ? 0 : (p == 1 || p == 12) ? 1 : (p == 3) ? 3 : (p == 4) ? 4 : (p == 5) ? 5 : (p == 7) ? 6 : (p == 8) ? 7 : 8;
          if (MK_TIME == 99) tacc += tb1 - tb0; else if (cls == MK_TIME) tacc += tb1 - tph0; }
#endif
    }
#if MK_TIME >= 0
    if (blockIdx.x == MK_TIME_BLOCK) { const unsigned long long te = __builtin_amdgcn_s_memrealtime(); while (__builtin_amdgcn_s_memrealtime() - te < tacc) __builtin_amdgcn_s_sleep(16); }
#endif
}

extern "C" void kernel_launch(void* const* d_in, const int* in_sizes, int n_in, void* d_out, int out_size, void* d_ws, size_t ws_size, hipStream_t stream) {
    static int grid = 0;
    if (grid == 0) {
        if (n_in != 29 || out_size != R_LAT * DM || ws_size < WS_END) { fprintf(stderr, "kernel_launch: unexpected problem (n_in %d out %d ws %zu need %zu)\n", n_in, out_size, ws_size, (size_t)WS_END); grid = -1; return; }
        int dev = 0, cus = 0, per_cu = 0;
        if (hipGetDevice(&dev) != hipSuccess || hipDeviceGetAttribute(&cus, hipDeviceAttributeMultiprocessorCount, dev) != hipSuccess) { grid = -1; return; }
        if (hipFuncSetAttribute((const void*)mk_fwd, hipFuncAttributeMaxDynamicSharedMemorySize, LDS_BYTES) != hipSuccess) { fprintf(stderr, "kernel_launch: hipFuncSetAttribute failed\n"); grid = -1; return; }
        if (hipOccupancyMaxActiveBlocksPerMultiprocessor(&per_cu, (const void*)mk_fwd, 512, LDS_BYTES) != hipSuccess || per_cu < 1) { fprintf(stderr, "kernel_launch: occupancy query says %d\n", per_cu); per_cu = 1; }
        (void)hipGetLastError();
        grid = cus * 1;
    }
    if (grid < 0) return;
    if (hipMemsetAsync((char*)d_ws + WS_CTL, 0, CTL_BYTES, stream) != hipSuccess) { fprintf(stderr, "kernel_launch: memset failed\n"); return; }
    Args a{};
    for (int i = 0; i < 29; ++i) a.in[i] = (const float*)d_in[i];
    a.out = (float*)d_out; a.ws = (unsigned char*)d_ws;
#if MK_MULTI
    for (int s = 0; s < NSTEPS; ++s) { a.ph_lo = s; a.ph_hi = s + 1; void* args[] = {&a};
        hipError_t e = hipLaunchCooperativeKernel((const void*)mk_fwd, dim3(grid), dim3(512), args, LDS_BYTES, stream);
        if (e != hipSuccess) { fprintf(stderr, "cooperative launch %d failed: %s\n", s, hipGetErrorString(e)); break; } }
#else
    a.ph_lo = 0; a.ph_hi = NSTEPS; void* args[] = {&a};
    hipError_t e = hipLaunchCooperativeKernel((const void*)mk_fwd, dim3(grid), dim3(512), args, LDS_BYTES, stream);
    if (e != hipSuccess) fprintf(stderr, "cooperative launch failed: %s (grid %d)\n", hipGetErrorString(e), grid);
#endif
}
```
